# Optimizing an MI355X kernel written in HIP

```python
import math
import jax
import jax.numpy as jnp
from jax import lax
import numpy as np

D_MODEL = 1024
BATCH = 8
SEQ = 2048
DEPTH = 2

GRID_W = 64
CTX_LEN = 256
N_EVEN = (DEPTH + 1) // 2
N_ODD = DEPTH // 2
N_MOD = 6
RMS_EPS = 1e-6

DA_HEADS = 4
DA_DIM = 64
DA_VDIM = 2 * DA_DIM
DA_QK_WIDTH = DA_HEADS * 2 * DA_DIM
DA_WIDTH = DA_HEADS * DA_VDIM
DA_COLS = 2 * DA_QK_WIDTH + DA_WIDTH
Q_BLOCK = 128
ROPE_BASE = 10000.0
ROPE_PAIRS = DA_DIM // 4

RW_HEADS = 8
RW_DIM = 64
RW_WIDTH = RW_HEADS * RW_DIM
RW_DECAY_LORA = 64
RW_AAA_LORA = 64
RW_GATE_LORA = 128
RW_LN_EPS = 64e-5
RW_COLS = 3 * RW_WIDTH + RW_DECAY_LORA + RW_AAA_LORA + RW_GATE_LORA
EV_COLS = DA_COLS + RW_COLS
MIX_WIDTH = DA_WIDTH + RW_WIDTH

HG_HEADS = 8
HG_KDIM = 128
HG_VDIM = 128
HG_WIDTH = HG_HEADS * HG_KDIM
HG_CHUNK = 64
OD_COLS = 5 * HG_WIDTH

N_EXPERTS = 32
TOP_K = 4
D_EXPERT = 1024
SWIGLU_LIMIT = 7.0
SWIGLU_ALPHA = 1.702
MOE_BLOCK = 128

kernel_name = 'hybrid_diffattn_rwkv7_hgrn2_moe_dit'


def rms_norm(x, g):
    xf = x.astype(jnp.float32)
    y = xf * lax.rsqrt(jnp.mean(xf * xf, axis=-1, keepdims=True) + RMS_EPS)
    return (y * g.astype(jnp.float32)).astype(x.dtype)


def _both(t):
    return jnp.broadcast_to(t[None], (2,) + t.shape)


def axial_rope_tables(n_lat):
    pos = jnp.arange(n_lat, dtype=jnp.int32)
    rowcol = jnp.stack([pos // GRID_W, pos % GRID_W], axis=-1).astype(jnp.float32)
    inv = ROPE_BASE ** (-jnp.arange(ROPE_PAIRS, dtype=jnp.float32) / ROPE_PAIRS)
    ang = rowcol[:, :, None] * inv
    return jnp.cos(ang), jnp.sin(ang)


def rope_2d(x, cos, sin):
    sh = x.shape
    xr = x.astype(jnp.float32).reshape(sh[:-1] + (2, 2, ROPE_PAIRS))
    x1, x2 = xr[..., 0, :], xr[..., 1, :]
    bshape = (1, sh[1]) + (1,) * (x.ndim - 3) + (2, ROPE_PAIRS)
    c = cos.reshape(bshape)
    s = sin.reshape(bshape)
    out = jnp.stack([x1 * c - x2 * s, x2 * c + x1 * s], axis=-2)
    return out.reshape(sh).astype(x.dtype)


def diff_attention(q, k, v, lam):
    s = jnp.einsum('bqhmd,bkhmd->bhmqk', q, k).astype(jnp.float32) * (DA_DIM ** -0.5)
    p = jax.nn.softmax(s, axis=-1)
    p = p[:, :, 0] - lam * p[:, :, 1]
    return jnp.einsum('bhqk,bkhv->bqhv', p.astype(v.dtype), v)


def centred_shift(y, mu):
    zero = jnp.zeros_like(y[:, :1])
    prev = jnp.concatenate([zero, y[:, :-1]], axis=1)
    nxt = jnp.concatenate([y[:, 1:], zero], axis=1)
    return y + mu * (0.5 * (prev + nxt) - y)


def rwkv7_features(y, mu, w0, w2, a0, a2, g2, k_k, k_a):
    f32 = jnp.float32
    y = centred_shift(y, mu)
    cuts = [RW_WIDTH, 2 * RW_WIDTH, 3 * RW_WIDTH, 3 * RW_WIDTH + RW_DECAY_LORA,
            3 * RW_WIDTH + RW_DECAY_LORA + RW_AAA_LORA]
    r, k, v, wd, ad, gd = jnp.split(y, cuts, axis=-1)
    w_log = -jax.nn.softplus(-(w0[:, None, None, :] + jnp.einsum('btl,zlc->zbtc', jnp.tanh(wd), w2)).astype(f32)) - 0.5
    decay = jnp.exp(-jnp.exp(w_log))
    a_rate = jax.nn.sigmoid((a0[:, None, None, :] + jnp.einsum('btl,zlc->zbtc', ad, a2)).astype(f32))
    g = jax.nn.sigmoid(gd) @ g2
    hd = lambda t: t.reshape(t.shape[:-1] + (RW_HEADS, RW_DIM))
    kk = hd((k * k_k).astype(f32))
    kk = kk / jnp.maximum(jnp.sqrt(jnp.sum(kk * kk, axis=-1, keepdims=True)), 1e-12)
    k_dir = hd(k.astype(f32)[None] * (1.0 + (a_rate - 1.0) * k_a.astype(f32)))
    b_vec = kk[None] * hd(a_rate)
    return (hd(r), k_dir, hd(v), kk, hd(decay), b_vec, g)


def _dirs_time_major(t):
    t = jnp.stack([t[0], jnp.flip(t[1], axis=1)], axis=0)
    return jnp.moveaxis(t, 2, 0)


def wkv7_bidir(s0, r, k_dir, v, kk, decay, b_vec):
    f32 = jnp.float32
    seqs = tuple(_dirs_time_major(t.astype(f32)) for t in
                 (_both(r), decay, k_dir, _both(v), _both(-kk), b_vec))

    def step(s, inp):
        r_t, w_t, k_t, v_t, a_t, b_t = inp
        sa = jnp.einsum('zbhvk,zbhk->zbhv', s, a_t)
        s = s * w_t[..., None, :] + sa[..., None] * b_t[..., None, :] + v_t[..., None] * k_t[..., None, :]
        return s, jnp.einsum('zbhvk,zbhk->zbhv', s, r_t)

    s, y = lax.scan(step, s0, seqs)
    y = jnp.moveaxis(y, 0, 2)
    return s, y[0] + jnp.flip(y[1], axis=1)


def rwkv7_readout(y, r, k_dir, v, g, r_k, ln_w, ln_b):
    f32 = jnp.float32
    mean = jnp.mean(y, axis=-1, keepdims=True)
    var = jnp.mean(jnp.square(y - mean), axis=-1, keepdims=True)
    yn = (y - mean) * lax.rsqrt(var + RW_LN_EPS)
    bonus = jnp.sum(r.astype(f32)[None] * k_dir * r_k.astype(f32), axis=(0, -1))[..., None] * v.astype(f32)
    out = (yn + bonus).reshape(y.shape[:2] + (RW_WIDTH,))
    return (out * ln_w.astype(f32) + ln_b.astype(f32)) * g.astype(f32) if False else ((yn.reshape(y.shape[:2] + (RW_WIDTH,)) * ln_w.astype(f32) + ln_b.astype(f32) + bonus.reshape(y.shape[:2] + (RW_WIDTH,))) * g.astype(f32))


def even_mixer(hx, hc, cos, sin, lam_init, need_ctx, w_in, w_out, q_norm, k_norm, lam_p, subln,
               mu, w0, w2, a0, a2, g2, k_k, k_a, r_k, ln_w, ln_b):
    n_b, n_lat, _ = hx.shape
    px = hx @ w_in
    pc = hc @ w_in

    def qkv(p):
        lead = p.shape[:2]
        q = rms_norm(p[..., :DA_QK_WIDTH].reshape(lead + (DA_HEADS, 2, DA_DIM)), q_norm)
        k = rms_norm(p[..., DA_QK_WIDTH:2 * DA_QK_WIDTH].reshape(lead + (DA_HEADS, 2, DA_DIM)), k_norm)
        v = p[..., 2 * DA_QK_WIDTH:DA_COLS].reshape(lead + (DA_HEADS, DA_VDIM))
        return q, k, v

    qx, kx, vx = qkv(px)
    qc, kc, vc = qkv(pc)
    qx = rope_2d(qx, cos, sin)
    kx = rope_2d(kx, cos, sin)
    lf = lam_p.astype(jnp.float32)
    lam = jnp.exp(jnp.sum(lf[0] * lf[1])) - jnp.exp(jnp.sum(lf[2] * lf[3])) + lam_init

    k_all = jnp.concatenate([kc, kx], axis=1)
    v_all = jnp.concatenate([vc, vx], axis=1)
    n_blk = n_lat // Q_BLOCK
    qb = jnp.moveaxis(qx.reshape((n_b, n_blk, Q_BLOCK) + qx.shape[2:]), 1, 0)
    ob = lax.map(lambda qi: diff_attention(qi, k_all, v_all, lam), qb)
    att_x = jnp.moveaxis(ob, 0, 1).reshape(n_b, n_lat, DA_HEADS, DA_VDIM)

    def att_readout(o):
        o = rms_norm(o, subln) * (1.0 - lam_init)
        return o.reshape(o.shape[:2] + (DA_WIDTH,))

    rw_par = (mu, w0, w2, a0, a2, g2, k_k, k_a)
    fc = rwkv7_features(pc[..., DA_COLS:], *rw_par)
    fx = rwkv7_features(px[..., DA_COLS:], *rw_par)
    s0 = jnp.zeros((2, n_b, RW_HEADS, RW_DIM, RW_DIM), jnp.float32)
    s_ctx, yc = wkv7_bidir(s0, *fc[:6])
    _, yx = wkv7_bidir(s_ctx, *fx[:6])

    def mix_out(att, feats, y):
        r, k_dir, v, _, _, _, g = feats
        rw = rwkv7_readout(y, r, k_dir, v, g, r_k, ln_w, ln_b)
        merged = jnp.concatenate([att_readout(att).astype(jnp.float32), rw], axis=-1)
        return (merged @ w_out).astype(hx.dtype)

    ox = mix_out(att_x, fx, yx)
    oc = mix_out(diff_attention(qc, kc, vc, lam), fc, yc) if need_ctx else None
    return ox, oc


def hgrn2_features(p, lb):
    f32 = jnp.float32
    q = jax.nn.silu(p[..., :HG_WIDTH])
    f = jnp.stack([p[..., HG_WIDTH:2 * HG_WIDTH], p[..., 2 * HG_WIDTH:3 * HG_WIDTH]], axis=0).astype(f32)
    i = p[..., 3 * HG_WIDTH:4 * HG_WIDTH]
    g = p[..., 4 * HG_WIDTH:]
    forget = lb + (1.0 - lb) * jax.nn.sigmoid(f)
    hk = lambda t: t.reshape(t.shape[:-1] + (HG_HEADS, HG_KDIM))
    hv = lambda t: t.reshape(t.shape[:-1] + (HG_HEADS, HG_VDIM))
    return (hk(q), hk(1.0 - forget), hk(jnp.log(forget)), hv(i), g)


def hgrn2_bidir(s0, q, k, logf, v):
    n_b, n_t = q.shape[:2]
    n_chunk = n_t // HG_CHUNK

    def chunks(t):
        t = jnp.stack([t[0], jnp.flip(t[1], axis=1)], axis=0).astype(jnp.float32)
        t = t.reshape(t.shape[:2] + (n_chunk, HG_CHUNK) + t.shape[3:])
        return t.transpose(2, 0, 1, 4, 3, 5)

    mask = jnp.tril(jnp.ones((HG_CHUNK, HG_CHUNK), jnp.float32))[:, :, None]

    def step(s, inp):
        qc, kc, gc, vc = inp
        b = jnp.cumsum(gc, axis=-2)
        o_inter = jnp.einsum('zbhcd,zbhdv->zbhcv', qc * jnp.exp(b), s)
        rel = jnp.exp(jnp.minimum(b[..., :, None, :] - b[..., None, :, :], 0.0)) * mask
        scores = jnp.einsum('zbhtd,zbhtsd,zbhsd->zbhts', qc, rel, kc)
        o = o_inter + jnp.einsum('zbhts,zbhsv->zbhtv', scores, vc)
        b_last = b[..., -1:, :]
        s = jnp.exp(b_last)[..., 0, :, None] * s + jnp.einsum('zbhsd,zbhsv->zbhdv', kc * jnp.exp(b_last - b), vc)
        return s, o

    s, o = lax.scan(step, s0, (chunks(_both(q)), chunks(k), chunks(logf), chunks(_both(v))))
    o = o.transpose(1, 2, 0, 4, 3, 5).reshape(2, n_b, n_t, HG_HEADS, HG_VDIM)
    return s, o[0] + jnp.flip(o[1], axis=1)


def odd_mixer(hx, hc, lb, need_ctx, w_in, w_out, norm_g):
    fx = hgrn2_features(hx @ w_in, lb)
    fc = hgrn2_features(hc @ w_in, lb)
    s0 = jnp.zeros((2, hx.shape[0], HG_HEADS, HG_KDIM, HG_VDIM), jnp.float32)
    s_ctx, yc = hgrn2_bidir(s0, *fc[:4])
    _, yx = hgrn2_bidir(s_ctx, *fx[:4])

    def readout(y, g):
        o = rms_norm(y, norm_g) * jax.nn.silu(g.astype(jnp.float32).reshape(y.shape))
        return (o.reshape(o.shape[:2] + (HG_WIDTH,)) @ w_out).astype(hx.dtype)

    ox = readout(yx, fx[4])
    oc = readout(yc, fc[4]) if need_ctx else None
    return ox, oc


def moe_ffn(h, w_r, b_r, w_gu, b_gu, w_dn, b_dn):
    n_tok, d = h.shape
    logits = (h @ w_r + b_r).astype(jnp.float32)
    top_v, top_e = lax.top_k(logits, TOP_K)
    gates = jax.nn.softmax(top_v, axis=-1)
    n_asg = n_tok * TOP_K
    flat_e = top_e.reshape(-1)
    order = jnp.argsort(flat_e)
    sorted_e = flat_e[order]
    counts = jnp.bincount(flat_e, length=N_EXPERTS)
    padded = (counts + MOE_BLOCK - 1) // MOE_BLOCK * MOE_BLOCK
    pad_end = jnp.cumsum(padded)
    pad_start = pad_end - padded
    start = jnp.cumsum(counts) - counts
    dest = pad_start[sorted_e] + jnp.arange(n_asg, dtype=jnp.int32) - start[sorted_e]
    n_blocks = -(-n_asg // MOE_BLOCK) + N_EXPERTS
    n_rows = n_blocks * MOE_BLOCK
    row_tok = jnp.full((n_rows,), n_tok, jnp.int32).at[dest].set((order // TOP_K).astype(jnp.int32))
    row_gate = jnp.zeros((n_rows,), jnp.float32).at[dest].set(gates.reshape(-1)[order])
    block_e = jnp.minimum(jnp.searchsorted(pad_end, jnp.arange(n_blocks, dtype=jnp.int32) * MOE_BLOCK,
                                           side='right'), N_EXPERTS - 1)
    h_pad = jnp.concatenate([h, jnp.zeros((1, d), h.dtype)], axis=0)
    xb = h_pad[row_tok].reshape(n_blocks, MOE_BLOCK, d)

    def expert(args):
        xe, e = args
        gu = xe @ w_gu[e] + b_gu[e]
        gate = jnp.minimum(gu[:, :D_EXPERT], SWIGLU_LIMIT)
        up = jnp.clip(gu[:, D_EXPERT:], -SWIGLU_LIMIT, SWIGLU_LIMIT)
        act = (up + 1.0) * gate * jax.nn.sigmoid(SWIGLU_ALPHA * gate)
        return act @ w_dn[e] + b_dn[e]

    yb = lax.map(expert, (xb, block_e)).reshape(n_rows, d)
    y = jnp.zeros((n_tok + 1, d), jnp.float32).at[row_tok].add(yb.astype(jnp.float32) * row_gate[:, None])
    return y[:n_tok].astype(h.dtype)


def setup_inputs(seed: int = 0) -> dict:
    key = jax.random.key(seed)
    ks = iter(jax.random.split(key, 40))
    f32 = jnp.float32
    D = D_MODEL

    def nrm(shape, scale):
        return scale * jax.random.normal(next(ks), shape, f32)

    def gain(shape):
        return 1.0 + nrm(shape, 0.02)

    return {
        'x': nrm((BATCH, SEQ, D), 1.0),
        'c': nrm((BATCH, D), 1.0),
        'ctx': nrm((BATCH, CTX_LEN, D), 1.0),
        'c_ctx': nrm((D,), 1.0),
        'ada_w': nrm((DEPTH, D, N_MOD * D), 0.5 * D ** -0.5),
        'ada_b': nrm((DEPTH, N_MOD * D), 0.01),
        'norm1_g': gain((DEPTH, D)),
        'norm2_g': gain((DEPTH, D)),
        'ev_w_in': nrm((N_EVEN, D, EV_COLS), D ** -0.5),
        'ev_w_out': nrm((N_EVEN, MIX_WIDTH, D), MIX_WIDTH ** -0.5),
        'da_q_norm': gain((N_EVEN, DA_DIM)),
        'da_k_norm': gain((N_EVEN, DA_DIM)),
        'da_lambda': nrm((N_EVEN, 4, DA_DIM), 0.1),
        'da_subln': gain((N_EVEN, DA_VDIM)),
        'rw_mu': 0.5 + nrm((N_EVEN, RW_COLS), 0.1),
        'rw_w0': jax.random.uniform(next(ks), (N_EVEN, 2, RW_WIDTH), f32, -6.5, -1.5),
        'rw_w2': nrm((N_EVEN, 2, RW_DECAY_LORA, RW_WIDTH), 0.5 * RW_DECAY_LORA ** -0.5),
        'rw_a0': nrm((N_EVEN, 2, RW_WIDTH), 0.1),
        'rw_a2': nrm((N_EVEN, 2, RW_AAA_LORA, RW_WIDTH), 0.5 * RW_AAA_LORA ** -0.5),
        'rw_g2': nrm((N_EVEN, RW_GATE_LORA, RW_WIDTH), RW_GATE_LORA ** -0.5),
        'rw_k_k': 0.85 + nrm((N_EVEN, RW_WIDTH), 0.05),
        'rw_k_a': 1.0 + nrm((N_EVEN, RW_WIDTH), 0.05),
        'rw_r_k': nrm((N_EVEN, RW_HEADS, RW_DIM), 0.1),
        'rw_ln_w': gain((N_EVEN, RW_WIDTH)),
        'rw_ln_b': nrm((N_EVEN, RW_WIDTH), 0.01),
        'od_w_in': nrm((N_ODD, D, OD_COLS), D ** -0.5),
        'od_w_out': nrm((N_ODD, HG_WIDTH, D), HG_WIDTH ** -0.5),
        'hg_norm': gain((N_ODD, HG_VDIM)),
        'hg_lower_bounds': nrm((DEPTH, HG_WIDTH), 0.1),
        'router_w': nrm((DEPTH, D, N_EXPERTS), D ** -0.5),
        'router_b': nrm((DEPTH, N_EXPERTS), 0.01),
        'moe_w_gu': nrm((DEPTH, N_EXPERTS, D, 2 * D_EXPERT), D ** -0.5),
        'moe_b_gu': nrm((DEPTH, N_EXPERTS, 2 * D_EXPERT), 0.01),
        'moe_w_dn': nrm((DEPTH, N_EXPERTS, D_EXPERT, D), D_EXPERT ** -0.5),
        'moe_b_dn': nrm((DEPTH, N_EXPERTS, D), 0.01),
    }


def reference(x, c, ctx, c_ctx, ada_w, ada_b, norm1_g, norm2_g, ev_w_in, ev_w_out, da_q_norm, da_k_norm,
              da_lambda, da_subln, rw_mu, rw_w0, rw_w2, rw_a0, rw_a2, rw_g2, rw_k_k, rw_k_a, rw_r_k,
              rw_ln_w, rw_ln_b, od_w_in, od_w_out, hg_norm, hg_lower_bounds, router_w, router_b,
              moe_w_gu, moe_b_gu, moe_w_dn, moe_b_dn):
    n_b, n_lat, d = x.shape
    cos, sin = axial_rope_tables(n_lat)
    lb_all = jax.nn.softmax(hg_lower_bounds.astype(jnp.float32), axis=0)
    lb_all = jnp.cumsum(lb_all, axis=0) - lb_all[0]
    for l in range(DEPTH):
        last = l == DEPTH - 1
        sh1, sc1, g1, sh2, sc2, g2 = jnp.split(jax.nn.silu(c) @ ada_w[l] + ada_b[l], N_MOD, axis=-1)
        csh1, csc1, cg1, csh2, csc2, cg2 = jnp.split(jax.nn.silu(c_ctx) @ ada_w[l] + ada_b[l], N_MOD, axis=-1)
        hx = rms_norm(x, norm1_g[l]) * (1.0 + sc1[:, None]) + sh1[:, None]
        hc = rms_norm(ctx, norm1_g[l]) * (1.0 + csc1) + csh1
        if l % 2 == 0:
            e = l // 2
            lam_init = 0.8 - 0.6 * math.exp(-0.3 * l)
            ox, oc = even_mixer(hx, hc, cos, sin, lam_init, not last, ev_w_in[e], ev_w_out[e], da_q_norm[e],
                                da_k_norm[e], da_lambda[e], da_subln[e], rw_mu[e], rw_w0[e], rw_w2[e],
                                rw_a0[e], rw_a2[e], rw_g2[e], rw_k_k[e], rw_k_a[e], rw_r_k[e],
                                rw_ln_w[e], rw_ln_b[e])
        else:
            o = l // 2
            ox, oc = odd_mixer(hx, hc, lb_all[l], not last, od_w_in[o], od_w_out[o], hg_norm[o])
        x = x + g1[:, None] * ox
        hx = rms_norm(x, norm2_g[l]) * (1.0 + sc2[:, None]) + sh2[:, None]
        moe_par = (router_w[l], router_b[l], moe_w_gu[l], moe_b_gu[l], moe_w_dn[l], moe_b_dn[l])
        if last:
            x = x + g2[:, None] * moe_ffn(hx.reshape(-1, d), *moe_par).reshape(x.shape)
        else:
            ctx = ctx + cg1 * oc
            hc = rms_norm(ctx, norm2_g[l]) * (1.0 + csc2) + csh2
            tokens = jnp.concatenate([hx.reshape(-1, d), hc.reshape(-1, d)], axis=0)
            y = moe_ffn(tokens, *moe_par)
            x = x + g2[:, None] * y[:n_b * n_lat].reshape(x.shape)
            ctx = ctx + cg2 * y[n_b * n_lat:].reshape(ctx.shape)
    return x
```

```cpp
#include <hip/hip_runtime.h>
#include <hip/hip_cooperative_groups.h>
#include <stdint.h>
#include <stdio.h>

namespace cg = cooperative_groups;

typedef unsigned short bf16_t;
typedef short bf16x8 __attribute__((ext_vector_type(8)));
typedef float f32x4 __attribute__((ext_vector_type(4)));
typedef unsigned u32x4 __attribute__((ext_vector_type(4)));

#define NX 16384
#define NC 2048
#define NT 18432
#define DM 1024
#define SEQ 2048
#define CTXL 256
#define NKEY 2304
#define EVC 3328
#define ODC 5120
#define NEXP 32
#define NASG (NT * 4)

#ifndef MULTI_LAUNCH
#define MULTI_LAUNCH 1
#endif

struct Params {
    const float *x, *c, *ctx, *c_ctx, *ada_w, *ada_b, *norm1_g, *norm2_g, *ev_w_in, *ev_w_out, *da_q_norm, *da_k_norm,
        *da_lambda, *da_subln, *rw_mu, *rw_w0, *rw_w2, *rw_a0, *rw_a2, *rw_g2, *rw_k_k, *rw_k_a, *rw_r_k, *rw_ln_w,
        *rw_ln_b, *od_w_in, *od_w_out, *hg_norm, *hg_lb, *router_w, *router_b, *moe_w_gu, *moe_b_gu, *moe_w_dn, *moe_b_dn;
    float* out;
    bf16_t *wt_evin, *wt_evout, *wt_odin, *wt_odout, *wt_gu, *wt_dn, *wt_w2, *wt_a2, *wt_g2;
    float *mod_part, *mod, *rope_cos, *rope_sin, *scal;
    int *counts, *lists;
    unsigned* bar;
    bf16_t* H;
    float* P;
    bf16_t *Q, *Qc, *Kd, *Vd;
    float *rR, *rK, *rV, *rKK, *rW, *rKD, *rBV, *rG, *rY;
    bf16_t *rTW, *rAD, *rSG;
    bf16_t* MG;
    float *X1, *X2;
    float* GATE;
    bf16_t* ACT;
    float* YS;
    float* HO;
};

__device__ __forceinline__ bf16_t f2bf(float f) {
    unsigned u = __float_as_uint(f);
    u += 0x7fffu + ((u >> 16) & 1u);
    return (bf16_t)(u >> 16);
}
__device__ __forceinline__ float bf2f(bf16_t h) { return __uint_as_float(((unsigned)h) << 16); }
__device__ __forceinline__ unsigned pack2(float a, float b) { return (unsigned)f2bf(a) | ((unsigned)f2bf(b) << 16); }
__device__ __forceinline__ float wave_sum(float v) {
#pragma unroll
    for (int o = 32; o > 0; o >>= 1) v += __shfl_xor(v, o);
    return v;
}
__device__ __forceinline__ float sigmoidf_(float x) { return 1.0f / (1.0f + __expf(-x)); }
__device__ __forceinline__ float siluf_(float x) { return x / (1.0f + __expf(-x)); }
__device__ __forceinline__ int modrow(int tok) { return tok < NX ? (tok >> 11) : 8; }

struct ARows {
    const bf16_t* base;
    int lda;
    const int* idx;
    int shift;
    int row0;
};

template <bool PAIRED, class Epi>
__device__ __forceinline__ void gemm_tile(const ARows ar, int mcount, const bf16_t* __restrict__ Bt, int ldb, int K, Epi& epi, char* smem) {
    const int tid = threadIdx.x, lane = tid & 63, wid = tid >> 6;
    const int wr = wid >> 1, wc = wid & 1, fr = lane & 15, fq = lane >> 4;
    bf16_t* sA = (bf16_t*)smem;
    bf16_t* sB = sA + 128 * 64;
    const int lrow = tid >> 3, lch = tid & 7;
    const bf16_t* aptr[4];
    const bf16_t* bptr[4];
#pragma unroll
    for (int i = 0; i < 4; ++i) {
        const int r = lrow + 32 * i;
        const int rr = r < mcount ? r : 0;
        const int rowid = ar.idx ? (ar.idx[rr] >> ar.shift) : (ar.row0 + rr);
        aptr[i] = ar.base + (size_t)rowid * ar.lda + lch * 8;
        bptr[i] = Bt + (size_t)r * ldb + lch * 8;
    }
    u32x4 ra[4], rb[4];
#pragma unroll
    for (int i = 0; i < 4; ++i) { ra[i] = *(const u32x4*)(aptr[i]); rb[i] = *(const u32x4*)(bptr[i]); }
    f32x4 acc[4][4];
#pragma unroll
    for (int m = 0; m < 4; ++m)
#pragma unroll
        for (int n = 0; n < 4; ++n) acc[m][n] = (f32x4){0.f, 0.f, 0.f, 0.f};
    const int nk = K >> 6;
    for (int kt = 0; kt < nk; ++kt) {
#pragma unroll
        for (int i = 0; i < 4; ++i) {
            const int r = lrow + 32 * i;
            const int off = r * 64 + ((lch ^ (r & 7)) << 3);
            *(u32x4*)(sA + off) = ra[i];
            *(u32x4*)(sB + off) = rb[i];
        }
        __syncthreads();
        if (kt + 1 < nk) {
#pragma unroll
            for (int i = 0; i < 4; ++i) { ra[i] = *(const u32x4*)(aptr[i] + (kt + 1) * 64); rb[i] = *(const u32x4*)(bptr[i] + (kt + 1) * 64); }
        }
#pragma unroll
        for (int ks = 0; ks < 2; ++ks) {
            bf16x8 af[4], bfr[4];
            const int ch = ks * 4 + fq;
#pragma unroll
            for (int m = 0; m < 4; ++m) { const int r = wr * 64 + m * 16 + fr; af[m] = *(const bf16x8*)(sA + r * 64 + ((ch ^ (r & 7)) << 3)); }
#pragma unroll
            for (int n = 0; n < 4; ++n) { const int r = wc * 64 + n * 16 + fr; bfr[n] = *(const bf16x8*)(sB + r * 64 + ((ch ^ (r & 7)) << 3)); }
#pragma unroll
            for (int m = 0; m < 4; ++m)
#pragma unroll
                for (int n = 0; n < 4; ++n) acc[m][n] = __builtin_amdgcn_mfma_f32_16x16x32_bf16(bfr[n], af[m], acc[m][n], 0, 0, 0);
        }
        __syncthreads();
    }
#pragma unroll
    for (int m = 0; m < 4; ++m) {
        const int r = wr * 64 + m * 16 + fr;
        if (r < mcount) {
            if constexpr (PAIRED) {
                epi.pair(r, wc * 32 + fq * 4, acc[m][0], acc[m][1]);
                epi.pair(r, wc * 32 + 16 + fq * 4, acc[m][2], acc[m][3]);
            } else {
#pragma unroll
                for (int n = 0; n < 4; ++n) epi.one(r, wc * 64 + n * 16 + fq * 4, acc[m][n]);
            }
        }
    }
}

__device__ __forceinline__ int gu_row(int col) {
    const int half = col >> 10, unit = col & 1023, T = unit >> 6, u = unit & 63, nbp = u >> 4, w = u & 15;
    return 128 * T + (nbp * 2 + half) * 16 + w;
}

__device__ __forceinline__ void conv_tile(const float* __restrict__ src, int N, bf16_t* __restrict__ dst, int Kd, int kt, int nt, bool permGU, float* lds) {
    const int tid = threadIdx.x;
    {
        const int r = tid >> 4, c4 = (tid & 15) * 4;
#pragma unroll
        for (int i = 0; i < 4; ++i) {
            const int k = r + 16 * i;
            const float4 v = *(const float4*)(src + (size_t)(kt * 64 + k) * N + nt * 64 + c4);
            float* d = lds + k * 65 + c4;
            d[0] = v.x; d[1] = v.y; d[2] = v.z; d[3] = v.w;
        }
    }
    __syncthreads();
    {
        const int n = tid >> 2, kseg = (tid & 3) * 16;
        unsigned w[8];
#pragma unroll
        for (int j = 0; j < 8; ++j) w[j] = pack2(lds[(kseg + 2 * j) * 65 + n], lds[(kseg + 2 * j + 1) * 65 + n]);
        const int ncol = nt * 64 + n;
        const int row = permGU ? gu_row(ncol) : ncol;
        uint4* d = (uint4*)(dst + (size_t)row * Kd + kt * 64 + kseg);
        d[0] = make_uint4(w[0], w[1], w[2], w[3]);
        d[1] = make_uint4(w[4], w[5], w[6], w[7]);
    }
    __syncthreads();
}

#define N_MODP 768
#define CV0 832
#define CV1 (CV0 + 16)
#define CV2 (CV1 + 16)
#define CV3 (CV2 + 16)
#define CV4 (CV3 + 256)
#define CV5 (CV4 + 1280)
#define CV6 (CV5 + 256)
#define CV7 (CV6 + 32768)
#define CV8 (CV7 + 16384)
#define N_CONV CV8
#define N_ROPE 64
#define N_P0A (N_MODP + N_CONV + N_ROPE + 1)

__device__ __forceinline__ void phase0a(const Params& p, int bid, int nblk, char* smem) {
    const int tid = threadIdx.x;
    float* lds = (float*)smem;
    for (int it = bid; it < N_P0A; it += nblk) {
        if (it < N_MODP) {
            const int l = it / 384, rem = it % 384, cb = rem / 16, kc = rem % 16;
            for (int e = tid; e < 9 * 64; e += 256) {
                const int r = e >> 6, k = e & 63;
                const float v = (r < 8) ? p.c[r * DM + kc * 64 + k] : p.c_ctx[kc * 64 + k];
                lds[e] = siluf_(v);
            }
            __syncthreads();
            const int col = cb * 256 + tid;
            const float* w = p.ada_w + (size_t)l * DM * 6144 + (size_t)(kc * 64) * 6144 + col;
            float acc[9];
#pragma unroll
            for (int r = 0; r < 9; ++r) acc[r] = 0.f;
            for (int k = 0; k < 64; ++k) {
                const float wv = w[(size_t)k * 6144];
#pragma unroll
                for (int r = 0; r < 9; ++r) acc[r] += lds[r * 64 + k] * wv;
            }
#pragma unroll
            for (int r = 0; r < 9; ++r) p.mod_part[((size_t)(kc * 2 + l) * 9 + r) * 6144 + col] = acc[r];
            __syncthreads();
        } else if (it < N_MODP + N_CONV) {
            const int j = it - N_MODP;
            if (j < CV0) { conv_tile(p.ev_w_in, EVC, p.wt_evin, 1024, j / 52, j % 52, false, lds); }
            else if (j < CV1) { const int q = j - CV0, z = q >> 3, nt = q & 7; conv_tile(p.rw_w2 + (size_t)z * 64 * 512, 512, p.wt_w2 + (size_t)z * 512 * 64, 64, 0, nt, false, lds); }
            else if (j < CV2) { const int q = j - CV1, z = q >> 3, nt = q & 7; conv_tile(p.rw_a2 + (size_t)z * 64 * 512, 512, p.wt_a2 + (size_t)z * 512 * 64, 64, 0, nt, false, lds); }
            else if (j < CV3) { const int q = j - CV2, kt = q >> 3, nt = q & 7; conv_tile(p.rw_g2, 512, p.wt_g2, 128, kt, nt, false, lds); }
            else if (j < CV4) { const int q = j - CV3; conv_tile(p.ev_w_out, 1024, p.wt_evout, 1024, q >> 4, q & 15, false, lds); }
            else if (j < CV5) { const int q = j - CV4; conv_tile(p.od_w_in, ODC, p.wt_odin, 1024, q / 80, q % 80, false, lds); }
            else if (j < CV6) { const int q = j - CV5; conv_tile(p.od_w_out, 1024, p.wt_odout, 1024, q >> 4, q & 15, false, lds); }
            else if (j < CV7) { const int q = j - CV6, mat = q >> 9, t = q & 511; conv_tile(p.moe_w_gu + (size_t)mat * 1024 * 2048, 2048, p.wt_gu + (size_t)mat * 2048 * 1024, 1024, t >> 5, t & 31, true, lds); }
            else { const int q = j - CV7, mat = q >> 8, t = q & 255; conv_tile(p.moe_w_dn + (size_t)mat * 1024 * 1024, 1024, p.wt_dn + (size_t)mat * 1024 * 1024, 1024, t >> 4, t & 15, false, lds); }
        } else if (it < N_MODP + N_CONV + N_ROPE) {
            const int j = it - N_MODP - N_CONV;
#pragma unroll
            for (int i = 0; i < 4; ++i) {
                const int e = (j * 4 + i) * 256 + tid;
                const int t = e >> 5, a = (e >> 4) & 1, pp = e & 15;
                const float pos = (float)(a == 0 ? (t >> 6) : (t & 63));
                const float inv = powf(10000.0f, -(float)pp / 16.0f);
                const float ang = pos * inv;
                p.rope_cos[e] = cosf(ang);
                p.rope_sin[e] = sinf(ang);
            }
        } else {
            if (tid < 64) {
                const float* lf = p.da_lambda;
                float a = lf[tid] * lf[64 + tid], b = lf[128 + tid] * lf[192 + tid];
                a = wave_sum(a); b = wave_sum(b);
                if (tid == 0) p.scal[0] = expf(a) - expf(b) + 0.2f;
            }
            if (tid < 64) p.counts[tid] = 0;
        }
    }
}

__device__ __forceinline__ void phase0b(const Params& p, int bid, int nblk) {
    for (int e = bid * 256 + threadIdx.x; e < 2 * 9 * 6144; e += nblk * 256) {
        const int l = e / (9 * 6144), rem = e % (9 * 6144);
        float s = p.ada_b[l * 6144 + rem % 6144];
#pragma unroll
        for (int kc = 0; kc < 16; ++kc) s += p.mod_part[(size_t)(kc * 2 + l) * 9 * 6144 + rem];
        p.mod[e] = s;
    }
}

__device__ __forceinline__ void phase_norm(const Params& p, int bid, int nblk, const float* xs_lat, const float* xs_ctx, const float* gain, const float* modl, int sh_off, int ntok) {
    const int lane = threadIdx.x & 63, wid = threadIdx.x >> 6;
    for (int tok = bid * 4 + wid; tok < ntok; tok += nblk * 4) {
        const float* xr = tok < NX ? xs_lat + (size_t)tok * DM : xs_ctx + (size_t)(tok - NX) * DM;
        const float* mr = modl + modrow(tok) * 6144 + sh_off;
        float4 v[4];
        float ss = 0.f;
#pragma unroll
        for (int i = 0; i < 4; ++i) { v[i] = *(const float4*)(xr + lane * 4 + 256 * i); ss += v[i].x * v[i].x + v[i].y * v[i].y + v[i].z * v[i].z + v[i].w * v[i].w; }
        ss = wave_sum(ss);
        const float rstd = rsqrtf(ss * (1.0f / 1024.0f) + 1e-6f);
#pragma unroll
        for (int i = 0; i < 4; ++i) {
            const int c = lane * 4 + 256 * i;
            const float4 g = *(const float4*)(gain + c), sh = *(const float4*)(mr + c), sc = *(const float4*)(mr + 1024 + c);
            const float a0 = v[i].x * rstd * g.x * (1.f + sc.x) + sh.x, a1 = v[i].y * rstd * g.y * (1.f + sc.y) + sh.y;
            const float a2 = v[i].z * rstd * g.z * (1.f + sc.z) + sh.z, a3 = v[i].w * rstd * g.w * (1.f + sc.w) + sh.w;
            *(uint2*)(p.H + (size_t)tok * DM + c) = make_uint2(pack2(a0, a1), pack2(a2, a3));
        }
    }
}

struct EpiStoreF32 {
    float* C; int ldc; int row0; int col0;
    __device__ __forceinline__ void one(int r, int c, f32x4 v) const { *(f32x4*)(C + (size_t)(row0 + r) * ldc + col0 + c) = v; }
};

__device__ __forceinline__ void phase_gemm_store(const bf16_t* A, int M, const bf16_t* Wt, int N, int K, float* C, int bid, int nblk, char* smem) {
    const int ntn = N / 128, ntm = M / 128;
    for (int it = bid; it < ntm * ntn; it += nblk) {
        const int mt = it / ntn, nt = it % ntn;
        ARows ar{A, K, nullptr, 0, mt * 128};
        EpiStoreF32 epi{C, N, mt * 128, nt * 128};
        gemm_tile<false>(ar, 128, Wt + (size_t)nt * 128 * K, K, K, epi, smem);
    }
}

struct EpiResid {
    const float* xin_lat; const float* xin_ctx; float* xout; const float* gmod; int row0; int col0;
    __device__ __forceinline__ void one(int r, int c, f32x4 v) const {
        const int tok = row0 + r, cc = col0 + c;
        const float* xr = tok < NX ? xin_lat + (size_t)tok * DM : xin_ctx + (size_t)(tok - NX) * DM;
        const f32x4 xi = *(const f32x4*)(xr + cc);
        const f32x4 g = *(const f32x4*)(gmod + modrow(tok) * 6144 + cc);
        *(f32x4*)(xout + (size_t)tok * DM + cc) = xi + g * v;
    }
};
__device__ __forceinline__ void phase_outproj(const Params& p, int bid, int nblk, char* smem, const bf16_t* Wt, int ntok, const float* xin_lat, const float* xin_ctx, float* xout, const float* gmod) {
    const int ntm = ntok / 128;
    for (int it = bid; it < ntm * 8; it += nblk) {
        const int mt = it >> 3, nt = it & 7;
        ARows ar{p.MG, DM, nullptr, 0, mt * 128};
        EpiResid epi{xin_lat, xin_ctx, xout, gmod, mt * 128, nt * 128};
        gemm_tile<false>(ar, 128, Wt + (size_t)nt * 128 * DM, DM, DM, epi, smem);
    }
}

__device__ __forceinline__ void phase_feat0(const Params& p, int bid, int nblk) {
    const int lane = threadIdx.x & 63, wid = threadIdx.x >> 6;
    const float lamunused = 0.f; (void)lamunused;
    for (int tok = bid * 4 + wid; tok < NT; tok += nblk * 4) {
        const bool lat = tok < NX;
        const int b = lat ? (tok >> 11) : ((tok - NX) >> 8);
        const int t = lat ? (tok & 2047) : ((tok - NX) & 255);
        const int key = lat ? (CTXL + t) : t;
        const float* pr = p.P + (size_t)tok * EVC;
        const int a = lane >> 5, pp = lane & 15, hf = (lane >> 4) & 1;
        float cs = 1.f, sn = 0.f;
        if (lat) { cs = p.rope_cos[t * 32 + a * 16 + pp]; sn = p.rope_sin[t * 32 + a * 16 + pp]; }
        const float qn = p.da_q_norm[lane], kn = p.da_k_norm[lane];
#pragma unroll
        for (int g = 0; g < 8; ++g) {
            {
                const float v = pr[g * 64 + lane];
                const float ss = wave_sum(v * v);
                float y = v * rsqrtf(ss * (1.0f / 64.0f) + 1e-6f) * qn;
                const float o = __shfl_xor(y, 16);
                if (lat) y = hf == 0 ? (y * cs - o * sn) : (y * cs + o * sn);
                if (lat) p.Q[(((size_t)b * 8 + g) * SEQ + t) * 64 + lane] = f2bf(y);
                else p.Qc[(((size_t)b * 8 + g) * CTXL + t) * 64 + lane] = f2bf(y);
            }
            {
                const float v = pr[512 + g * 64 + lane];
                const float ss = wave_sum(v * v);
                float y = v * rsqrtf(ss * (1.0f / 64.0f) + 1e-6f) * kn;
                const float o = __shfl_xor(y, 16);
                if (lat) y = hf == 0 ? (y * cs - o * sn) : (y * cs + o * sn);
                p.Kd[(((size_t)b * 8 + g) * NKEY + key) * 64 + lane] = f2bf(y);
            }
        }
#pragma unroll
        for (int i = 0; i < 8; ++i) {
            const int cidx = i * 64 + lane, h = cidx >> 7, dv = cidx & 127;
            p.Vd[(((size_t)b * 4 + h) * NKEY + key) * 128 + dv] = f2bf(pr[1024 + cidx]);
        }
        const int slen = lat ? SEQ : CTXL;
        const bool hasp = t > 0, hasn = t < slen - 1;
        const float* pw = pr + 1536;
        float ysh[28];
#pragma unroll
        for (int i = 0; i < 28; ++i) {
            const int cidx = i * 64 + lane;
            const float y = pw[cidx];
            const float pv = hasp ? pw[cidx - EVC] : 0.f;
            const float nv = hasn ? pw[cidx + EVC] : 0.f;
            ysh[i] = y + p.rw_mu[cidx] * (0.5f * (pv + nv) - y);
        }
#pragma unroll
        for (int i = 0; i < 8; ++i) {
            const int cidx = i * 64 + lane;
            p.rR[(size_t)tok * 512 + cidx] = ysh[i];
            p.rV[(size_t)tok * 512 + cidx] = ysh[16 + i];
            const float k = ysh[8 + i];
            p.rK[(size_t)tok * 512 + cidx] = k;
            const float kk = k * p.rw_k_k[cidx];
            const float nrm = sqrtf(wave_sum(kk * kk));
            p.rKK[(size_t)tok * 512 + cidx] = kk / fmaxf(nrm, 1e-12f);
        }
        p.rTW[(size_t)tok * 64 + lane] = f2bf(tanhf(ysh[24]));
        p.rAD[(size_t)tok * 64 + lane] = f2bf(ysh[25]);
        p.rSG[(size_t)tok * 128 + lane] = f2bf(sigmoidf_(ysh[26]));
        p.rSG[(size_t)tok * 128 + 64 + lane] = f2bf(sigmoidf_(ysh[27]));
    }
}

struct EpiDecay {
    const float* w0; float* W; int row0; int col0;
    __device__ __forceinline__ void one(int r, int c, f32x4 v) const {
        const int tok = row0 + r, cc = col0 + c, z = cc >> 9, ch = cc & 511;
        f32x4 o;
#pragma unroll
        for (int j = 0; j < 4; ++j) {
            const float x = w0[z * 512 + ch + j] + v[j];
            const float u = -x;
            const float sp = fmaxf(u, 0.f) + log1pf(__expf(-fabsf(u)));
            const float wlog = -sp - 0.5f;
            o[j] = __expf(-__expf(wlog));
        }
        *(f32x4*)(W + ((size_t)z * NT + tok) * 512 + ch) = o;
    }
};
struct EpiArate {
    const float* a0; const float* k_a; const float* rK; const float* rKK; float* KD; float* BV; int row0; int col0;
    __device__ __forceinline__ void one(int r, int c, f32x4 v) const {
        const int tok = row0 + r, cc = col0 + c, z = cc >> 9, ch = cc & 511;
        const f32x4 k = *(const f32x4*)(rK + (size_t)tok * 512 + ch);
        const f32x4 kk = *(const f32x4*)(rKK + (size_t)tok * 512 + ch);
        f32x4 kd, bv;
#pragma unroll
        for (int j = 0; j < 4; ++j) {
            const float arate = sigmoidf_(a0[z * 512 + ch + j] + v[j]);
            kd[j] = k[j] * (1.f + (arate - 1.f) * k_a[ch + j]);
            bv[j] = kk[j] * arate;
        }
        *(f32x4*)(KD + ((size_t)z * NT + tok) * 512 + ch) = kd;
        *(f32x4*)(BV + ((size_t)z * NT + tok) * 512 + ch) = bv;
    }
};
__device__ __forceinline__ void phase_lora(const Params& p, int bid, int nblk, char* smem) {
    for (int it = bid; it < 144 * 8; it += nblk) {
        const int mt = it >> 3, q = it & 7;
        ARows ar{p.rTW, 64, nullptr, 0, mt * 128};
        EpiDecay epi{p.rw_w0, p.rW, mt * 128, q * 128};
        gemm_tile<false>(ar, 128, p.wt_w2 + (size_t)q * 128 * 64, 64, 64, epi, smem);
    }
    for (int it = bid; it < 144 * 8; it += nblk) {
        const int mt = it >> 3, q = it & 7;
        ARows ar{p.rAD, 64, nullptr, 0, mt * 128};
        EpiArate epi{p.rw_a0, p.rw_k_a, p.rK, p.rKK, p.rKD, p.rBV, mt * 128, q * 128};
        gemm_tile<false>(ar, 128, p.wt_a2 + (size_t)q * 128 * 64, 64, 64, epi, smem);
    }
    for (int it = bid; it < 144 * 4; it += nblk) {
        const int mt = it >> 2, q = it & 3;
        ARows ar{p.rSG, 128, nullptr, 0, mt * 128};
        EpiStoreF32 epi{p.rG, 512, mt * 128, q * 128};
        gemm_tile<false>(ar, 128, p.wt_g2 + (size_t)q * 128 * 128, 128, 128, epi, smem);
    }
}

__device__ __forceinline__ int scan_tok(int z, int b, int s) {
    if (s < CTXL) { const int tc = z == 0 ? s : (CTXL - 1 - s); return NX + b * CTXL + tc; }
    const int t = s - CTXL; return b * SEQ + (z == 0 ? t : (SEQ - 1 - t));
}
__device__ __forceinline__ void rwkv_scan_chain(const Params& p, int chain, char* smem) {
    const int z = chain >> 6, b = (chain >> 3) & 7, h = chain & 7;
    const int tid = threadIdx.x, vrow = tid >> 2, kq = tid & 3;
    float* lds = (float*)smem;
    float s[16];
#pragma unroll
    for (int j = 0; j < 16; ++j) s[j] = 0.f;
    const int lstep = tid >> 4, c4 = (tid & 15) * 4;
    const size_t zoff = (size_t)z * NT * 512;
    float4 pre[6];
    auto issue = [&](int chunk) {
        const int tok = scan_tok(z, b, chunk * 16 + lstep);
        const size_t o = (size_t)tok * 512 + h * 64 + c4;
        pre[0] = *(const float4*)(p.rR + o);
        pre[1] = *(const float4*)(p.rW + zoff + o);
        pre[2] = *(const float4*)(p.rKD + zoff + o);
        pre[3] = *(const float4*)(p.rKK + o);
        pre[4] = *(const float4*)(p.rBV + zoff + o);
        pre[5] = *(const float4*)(p.rV + o);
    };
    issue(0);
    for (int chunk = 0; chunk < 144; ++chunk) {
        __syncthreads();
#pragma unroll
        for (int i = 0; i < 6; ++i) {
            float4 v = pre[i];
            if (i == 3) { v.x = -v.x; v.y = -v.y; v.z = -v.z; v.w = -v.w; }
            *(float4*)(lds + (i * 16 + lstep) * 64 + c4) = v;
        }
        __syncthreads();
        if (chunk + 1 < 144) issue(chunk + 1);
        for (int st = 0; st < 16; ++st) {
            const float* base = lds + st * 64 + kq * 16;
            float rr[16], ww[16], kk[16], aa[16], bb[16];
#pragma unroll
            for (int j = 0; j < 4; ++j) {
                *(float4*)(rr + 4 * j) = *(const float4*)(base + 0 * 1024 + 4 * j);
                *(float4*)(ww + 4 * j) = *(const float4*)(base + 1 * 1024 + 4 * j);
                *(float4*)(kk + 4 * j) = *(const float4*)(base + 2 * 1024 + 4 * j);
                *(float4*)(aa + 4 * j) = *(const float4*)(base + 3 * 1024 + 4 * j);
                *(float4*)(bb + 4 * j) = *(const float4*)(base + 4 * 1024 + 4 * j);
            }
            const float vv = lds[5 * 1024 + st * 64 + vrow];
            float sa0 = 0.f, sa1 = 0.f, sa2 = 0.f, sa3 = 0.f;
#pragma unroll
            for (int j = 0; j < 4; ++j) { sa0 += s[j] * aa[j]; sa1 += s[4 + j] * aa[4 + j]; sa2 += s[8 + j] * aa[8 + j]; sa3 += s[12 + j] * aa[12 + j]; }
            float sa = (sa0 + sa1) + (sa2 + sa3);
            sa += __shfl_xor(sa, 1); sa += __shfl_xor(sa, 2);
            float y0 = 0.f, y1 = 0.f, y2 = 0.f, y3 = 0.f;
#pragma unroll
            for (int j = 0; j < 16; ++j) s[j] = s[j] * ww[j] + sa * bb[j] + vv * kk[j];
#pragma unroll
            for (int j = 0; j < 4; ++j) { y0 += s[j] * rr[j]; y1 += s[4 + j] * rr[4 + j]; y2 += s[8 + j] * rr[8 + j]; y3 += s[12 + j] * rr[12 + j]; }
            float y = (y0 + y1) + (y2 + y3);
            y += __shfl_xor(y, 1); y += __shfl_xor(y, 2);
            if (kq == 0) {
                const int tok = scan_tok(z, b, chunk * 16 + st);
                p.rY[zoff + (size_t)tok * 512 + h * 64 + vrow] = y;
            }
        }
    }
}

__device__ __forceinline__ void attn_item(const Params& p, int b, int h, int q0, bool isctx, char* smem) {
    const int tid = threadIdx.x, ql = tid & 31, m = (tid >> 5) & 1, dvq = tid >> 6;
    float* Ks = (float*)smem;
    float* Vs = Ks + 2 * 32 * 64;
    const int nkeys = isctx ? CTXL : NKEY;
    float q[64];
    {
        const bf16_t* qp = isctx ? p.Qc + (((size_t)b * 8 + h * 2 + m) * CTXL + q0 + ql) * 64 : p.Q + (((size_t)b * 8 + h * 2 + m) * SEQ + q0 + ql) * 64;
#pragma unroll
        for (int i = 0; i < 8; ++i) {
            const uint4 u = *(const uint4*)(qp + i * 8);
            const unsigned w[4] = {u.x, u.y, u.z, u.w};
#pragma unroll
            for (int j = 0; j < 4; ++j) { q[i * 8 + 2 * j] = __uint_as_float(w[j] << 16) * 0.125f; q[i * 8 + 2 * j + 1] = __uint_as_float(w[j] & 0xffff0000u) * 0.125f; }
        }
    }
    float acc[32];
#pragma unroll
    for (int i = 0; i < 32; ++i) acc[i] = 0.f;
    float mrun = -1e30f, lrun = 0.f;
    for (int k0 = 0; k0 < nkeys; k0 += 32) {
        __syncthreads();
        {
            const int comp = tid >> 7, key = (tid >> 2) & 31, seg = tid & 3;
            const bf16_t* kp = p.Kd + (((size_t)b * 8 + h * 2 + comp) * NKEY + k0 + key) * 64 + seg * 16;
            const uint4 u0 = *(const uint4*)kp, u1 = *(const uint4*)(kp + 8);
            const unsigned w[8] = {u0.x, u0.y, u0.z, u0.w, u1.x, u1.y, u1.z, u1.w};
            float* d = Ks + (comp * 32 + key) * 64 + seg * 16;
#pragma unroll
            for (int j = 0; j < 8; ++j) { d[2 * j] = __uint_as_float(w[j] << 16); d[2 * j + 1] = __uint_as_float(w[j] & 0xffff0000u); }
            const int vkey = tid >> 3, vseg = tid & 7;
            const bf16_t* vp = p.Vd + (((size_t)b * 4 + h) * NKEY + k0 + vkey) * 128 + vseg * 16;
            const uint4 v0 = *(const uint4*)vp, v1 = *(const uint4*)(vp + 8);
            const unsigned x[8] = {v0.x, v0.y, v0.z, v0.w, v1.x, v1.y, v1.z, v1.w};
            float* dv = Vs + vkey * 128 + vseg * 16;
#pragma unroll
            for (int j = 0; j < 8; ++j) { dv[2 * j] = __uint_as_float(x[j] << 16); dv[2 * j + 1] = __uint_as_float(x[j] & 0xffff0000u); }
        }
        __syncthreads();
        float sc[32];
        float mx = -1e30f;
#pragma unroll 4
        for (int j = 0; j < 32; ++j) {
            const float* kr = Ks + (m * 32 + j) * 64;
            float d0 = 0.f, d1 = 0.f;
#pragma unroll
            for (int i = 0; i < 16; ++i) {
                const float4 kv = *(const float4*)(kr + 4 * i);
                d0 += q[4 * i] * kv.x + q[4 * i + 2] * kv.z;
                d1 += q[4 * i + 1] * kv.y + q[4 * i + 3] * kv.w;
            }
            sc[j] = d0 + d1;
            mx = fmaxf(mx, sc[j]);
        }
        const float mnew = fmaxf(mrun, mx);
        const float scale = __expf(mrun - mnew);
        mrun = mnew;
        lrun *= scale;
#pragma unroll
        for (int i = 0; i < 32; ++i) acc[i] *= scale;
#pragma unroll 4
        for (int j = 0; j < 32; ++j) {
            const float pj = __expf(sc[j] - mnew);
            lrun += pj;
            const float* vr = Vs + j * 128 + dvq * 32;
#pragma unroll
            for (int i = 0; i < 8; ++i) {
                const float4 vv = *(const float4*)(vr + 4 * i);
                acc[4 * i] += pj * vv.x; acc[4 * i + 1] += pj * vv.y; acc[4 * i + 2] += pj * vv.z; acc[4 * i + 3] += pj * vv.w;
            }
        }
    }
    __syncthreads();
    float* Os = (float*)smem;
    {
        const float inv = 1.0f / lrun;
        float* d = Os + (m * 32 + ql) * 128 + dvq * 32;
#pragma unroll
        for (int i = 0; i < 32; ++i) d[i] = acc[i] * inv;
    }
    __syncthreads();
    {
        const float lam = p.scal[0];
        const int qq = tid >> 3, part = tid & 7;
        float o[16];
        float ss = 0.f;
#pragma unroll
        for (int i = 0; i < 16; ++i) {
            o[i] = Os[(0 * 32 + qq) * 128 + part * 16 + i] - lam * Os[(1 * 32 + qq) * 128 + part * 16 + i];
            ss += o[i] * o[i];
        }
        ss += __shfl_xor(ss, 1); ss += __shfl_xor(ss, 2); ss += __shfl_xor(ss, 4);
        const float rstd = rsqrtf(ss * (1.0f / 128.0f) + 1e-6f) * 0.8f;
        const int tok = isctx ? NX + b * CTXL + q0 + qq : b * SEQ + q0 + qq;
        bf16_t* dst = p.MG + (size_t)tok * DM + h * 128 + part * 16;
        unsigned w[8];
#pragma unroll
        for (int i = 0; i < 8; ++i) w[i] = pack2(o[2 * i] * rstd * p.da_subln[part * 16 + 2 * i], o[2 * i + 1] * rstd * p.da_subln[part * 16 + 2 * i + 1]);
        *(uint4*)dst = make_uint4(w[0], w[1], w[2], w[3]);
        *(uint4*)(dst + 8) = make_uint4(w[4], w[5], w[6], w[7]);
    }
    __syncthreads();
}

#define N_ATT_LAT 2048
#define N_ATT_CTX 256
__device__ __forceinline__ void phase_scan_attn(const Params& p, int bid, int nblk, char* smem) {
    for (int it = bid; it < 128 + N_ATT_LAT + N_ATT_CTX; it += nblk) {
        if (it < 128) rwkv_scan_chain(p, it, smem);
        else if (it < 128 + N_ATT_LAT) { const int j = it - 128; attn_item(p, j >> 8, (j >> 6) & 3, (j & 63) * 32, false, smem); }
        else { const int j = it - 128 - N_ATT_LAT; attn_item(p, j >> 5, (j >> 3) & 3, (j & 7) * 32, true, smem); }
    }
}

__device__ __forceinline__ void phase_rw_readout(const Params& p, int bid, int nblk) {
    const int lane = threadIdx.x & 63, wid = threadIdx.x >> 6;
    for (int tok = bid * 4 + wid; tok < NT; tok += nblk * 4) {
#pragma unroll
        for (int h = 0; h < 8; ++h) {
            const int c = h * 64 + lane;
            const size_t o = (size_t)tok * 512 + c;
            const float y = p.rY[o] + p.rY[(size_t)NT * 512 + o];
            const float mean = wave_sum(y) * (1.0f / 64.0f);
            const float d = y - mean;
            const float var = wave_sum(d * d) * (1.0f / 64.0f);
            const float yn = d * rsqrtf(var + 64e-5f);
            const float r = p.rR[o];
            const float bon = wave_sum(r * (p.rKD[o] + p.rKD[(size_t)NT * 512 + o]) * p.rw_r_k[c]);
            const float outv = (yn * p.rw_ln_w[c] + p.rw_ln_b[c] + bon * p.rV[o]) * p.rG[o];
            p.MG[(size_t)tok * DM + 512 + c] = f2bf(outv);
        }
    }
}

__device__ __forceinline__ void phase_router(const Params& p, int bid, int nblk, char* smem, int layer, const float* X, int ntok) {
    const int tid = threadIdx.x, lane = tid & 63, wid = tid >> 6;
    float* hrow = (float*)smem;
    float* logits = hrow + 8 * 1024;
    const float* gain = p.norm2_g + layer * DM;
    const float* modl = p.mod + (size_t)layer * 9 * 6144;
    const float* wr = p.router_w + (size_t)layer * DM * NEXP;
    const float* br = p.router_b + layer * NEXP;
    int* counts = p.counts + layer * NEXP;
    int* lists = p.lists + (size_t)layer * NEXP * NT;
    for (int it = bid; it < ntok / 8; it += nblk) {
        __syncthreads();
#pragma unroll
        for (int u = 0; u < 2; ++u) {
            const int tl = wid * 2 + u, tok = it * 8 + tl;
            const float* xr = X + (size_t)tok * DM;
            const float* mr = modl + modrow(tok) * 6144 + 3072;
            float4 v[4];
            float ss = 0.f;
#pragma unroll
            for (int i = 0; i < 4; ++i) { v[i] = *(const float4*)(xr + lane * 4 + 256 * i); ss += v[i].x * v[i].x + v[i].y * v[i].y + v[i].z * v[i].z + v[i].w * v[i].w; }
            ss = wave_sum(ss);
            const float rstd = rsqrtf(ss * (1.0f / 1024.0f) + 1e-6f);
#pragma unroll
            for (int i = 0; i < 4; ++i) {
                const int c = lane * 4 + 256 * i;
                const float4 g = *(const float4*)(gain + c), sh = *(const float4*)(mr + c), sc = *(const float4*)(mr + 1024 + c);
                float4 a;
                a.x = v[i].x * rstd * g.x * (1.f + sc.x) + sh.x; a.y = v[i].y * rstd * g.y * (1.f + sc.y) + sh.y;
                a.z = v[i].z * rstd * g.z * (1.f + sc.z) + sh.z; a.w = v[i].w * rstd * g.w * (1.f + sc.w) + sh.w;
                *(uint2*)(p.H + (size_t)tok * DM + c) = make_uint2(pack2(a.x, a.y), pack2(a.z, a.w));
                *(float4*)(hrow + tl * 1024 + c) = a;
            }
        }
        __syncthreads();
        {
            const int tl = tid >> 5, e = tid & 31;
            const float* hr = hrow + tl * 1024;
            float a0 = 0.f, a1 = 0.f, a2 = 0.f, a3 = 0.f;
            for (int k = 0; k < 1024; k += 4) {
                const float4 hv = *(const float4*)(hr + k);
                a0 += hv.x * wr[(k + 0) * 32 + e]; a1 += hv.y * wr[(k + 1) * 32 + e];
                a2 += hv.z * wr[(k + 2) * 32 + e]; a3 += hv.w * wr[(k + 3) * 32 + e];
            }
            logits[tl * 32 + e] = (a0 + a1) + (a2 + a3) + br[e];
        }
        __syncthreads();
        if (tid < 8) {
            const int tok = it * 8 + tid;
            float lv[32];
#pragma unroll
            for (int e = 0; e < 32; ++e) lv[e] = logits[tid * 32 + e];
            float tv[4]; int te[4];
#pragma unroll
            for (int k = 0; k < 4; ++k) {
                float best = -3.0e38f; int bi = 0;
#pragma unroll
                for (int e = 0; e < 32; ++e) { if (lv[e] > best) { best = lv[e]; bi = e; } }
                tv[k] = best; te[k] = bi;
#pragma unroll
                for (int e = 0; e < 32; ++e) { if (e == bi) lv[e] = -3.0e38f; }
            }
            const float e1 = __expf(tv[1] - tv[0]), e2 = __expf(tv[2] - tv[0]), e3 = __expf(tv[3] - tv[0]);
            const float inv = 1.0f / (1.0f + e1 + e2 + e3);
            const float gt[4] = {inv, e1 * inv, e2 * inv, e3 * inv};
#pragma unroll
            for (int k = 0; k < 4; ++k) {
                p.GATE[(size_t)tok * 4 + k] = gt[k];
                const int pos = atomicAdd(&counts[te[k]], 1);
                lists[(size_t)te[k] * NT + pos] = tok * 4 + k;
            }
        }
    }
}

struct EpiGU {
    const float* bias; bf16_t* act; int pos0; int unit0;
    __device__ __forceinline__ void pair(int r, int cu, f32x4 g, f32x4 u) const {
        const int unit = unit0 + cu;
        unsigned w[2]; float o[4];
#pragma unroll
        for (int j = 0; j < 4; ++j) {
            const float gate = fminf(g[j] + bias[unit + j], 7.0f);
            const float up = fminf(fmaxf(u[j] + bias[1024 + unit + j], -7.0f), 7.0f);
            o[j] = (up + 1.0f) * gate * sigmoidf_(1.702f * gate);
        }
        w[0] = pack2(o[0], o[1]); w[1] = pack2(o[2], o[3]);
        *(uint2*)(act + (size_t)(pos0 + r) * 1024 + unit) = make_uint2(w[0], w[1]);
    }
};
struct EpiDN {
    const float* bias; float* ys; const int* idx; int col0;
    __device__ __forceinline__ void one(int r, int c, f32x4 v) const {
        const int a = idx[r];
        const f32x4 b = *(const f32x4*)(bias + col0 + c);
        *(f32x4*)(ys + (size_t)a * 1024 + col0 + c) = v + b;
    }
};
__device__ __forceinline__ bool moe_find(const int* counts, int mtg, int& e, int& mt, int& off, int& cnt) {
    int o = 0, tsum = 0;
    for (int i = 0; i < NEXP; ++i) {
        const int c = counts[i], nt = (c + 127) >> 7;
        if (mtg < tsum + nt) { e = i; mt = mtg - tsum; off = o; cnt = c; return true; }
        tsum += nt; o += c;
    }
    return false;
}
__device__ __forceinline__ void phase_moe_gu(const Params& p, int bid, int nblk, char* smem, int layer) {
    const int* counts = p.counts + layer * NEXP;
    const int* lists = p.lists + (size_t)layer * NEXP * NT;
    for (int it = bid;; it += nblk) {
        const int mtg = it >> 4, nt = it & 15;
        int e, mt, off, cnt;
        if (!moe_find(counts, mtg, e, mt, off, cnt)) break;
        const int mcount = min(128, cnt - mt * 128);
        ARows ar{p.H, DM, lists + (size_t)e * NT + mt * 128, 2, 0};
        EpiGU epi{p.moe_b_gu + (size_t)(layer * NEXP + e) * 2048, p.ACT, off + mt * 128, nt * 64};
        gemm_tile<true>(ar, mcount, p.wt_gu + ((size_t)(layer * NEXP + e) * 2048 + nt * 128) * 1024, 1024, 1024, epi, smem);
    }
}
__device__ __forceinline__ void phase_moe_dn(const Params& p, int bid, int nblk, char* smem, int layer) {
    const int* counts = p.counts + layer * NEXP;
    const int* lists = p.lists + (size_t)layer * NEXP * NT;
    for (int it = bid;; it += nblk) {
        const int mtg = it >> 3, nt = it & 7;
        int e, mt, off, cnt;
        if (!moe_find(counts, mtg, e, mt, off, cnt)) break;
        const int mcount = min(128, cnt - mt * 128);
        ARows ar{p.ACT, DM, nullptr, 0, off + mt * 128};
        EpiDN epi{p.moe_b_dn + (size_t)(layer * NEXP + e) * 1024, p.YS, lists + (size_t)e * NT + mt * 128, nt * 128};
        gemm_tile<false>(ar, mcount, p.wt_dn + ((size_t)(layer * NEXP + e) * 1024 + nt * 128) * 1024, 1024, 1024, epi, smem);
    }
}

__device__ __forceinline__ void phase_combine(const Params& p, int bid, int nblk, const float* Xin, float* Xout, const float* gmod  , int ntok,
                              bool do_norm, const float* gain, const float* modn) {
    const int lane = threadIdx.x & 63, wid = threadIdx.x >> 6;
    for (int tok = bid * 4 + wid; tok < ntok; tok += nblk * 4) {
        const float* gr = gmod + modrow(tok) * 6144;
        const float g0 = p.GATE[(size_t)tok * 4 + 0], g1 = p.GATE[(size_t)tok * 4 + 1], g2 = p.GATE[(size_t)tok * 4 + 2], g3 = p.GATE[(size_t)tok * 4 + 3];
        const float* ys = p.YS + (size_t)tok * 4 * 1024;
        float4 v[4];
        float ss = 0.f;
#pragma unroll
        for (int i = 0; i < 4; ++i) {
            const int c = lane * 4 + 256 * i;
            const float4 xi = *(const float4*)(Xin + (size_t)tok * DM + c), gg = *(const float4*)(gr + c);
            const float4 y0 = *(const float4*)(ys + c), y1 = *(const float4*)(ys + 1024 + c), y2 = *(const float4*)(ys + 2048 + c), y3 = *(const float4*)(ys + 3072 + c);
            v[i].x = xi.x + gg.x * (g0 * y0.x + g1 * y1.x + g2 * y2.x + g3 * y3.x);
            v[i].y = xi.y + gg.y * (g0 * y0.y + g1 * y1.y + g2 * y2.y + g3 * y3.y);
            v[i].z = xi.z + gg.z * (g0 * y0.z + g1 * y1.z + g2 * y2.z + g3 * y3.z);
            v[i].w = xi.w + gg.w * (g0 * y0.w + g1 * y1.w + g2 * y2.w + g3 * y3.w);
            *(float4*)(Xout + (size_t)tok * DM + c) = v[i];
            ss += v[i].x * v[i].x + v[i].y * v[i].y + v[i].z * v[i].z + v[i].w * v[i].w;
        }
        if (do_norm) {
            ss = wave_sum(ss);
            const float rstd = rsqrtf(ss * (1.0f / 1024.0f) + 1e-6f);
            const float* mr = modn + modrow(tok) * 6144;
#pragma unroll
            for (int i = 0; i < 4; ++i) {
                const int c = lane * 4 + 256 * i;
                const float4 g = *(const float4*)(gain + c), sh = *(const float4*)(mr + c), sc = *(const float4*)(mr + 1024 + c);
                const float a0 = v[i].x * rstd * g.x * (1.f + sc.x) + sh.x, a1 = v[i].y * rstd * g.y * (1.f + sc.y) + sh.y;
                const float a2 = v[i].z * rstd * g.z * (1.f + sc.z) + sh.z, a3 = v[i].w * rstd * g.w * (1.f + sc.w) + sh.w;
                *(uint2*)(p.H + (size_t)tok * DM + c) = make_uint2(pack2(a0, a1), pack2(a2, a3));
            }
        }
    }
}

__device__ __forceinline__ void hgrn_chain(const Params& p, int chain, char* smem) {
    const int z = chain >> 6, b = (chain >> 3) & 7, h = chain & 7;
    const int tid = threadIdx.x, v = tid & 127, dh = tid >> 7;
    float* sq = (float*)smem;
    float* sf = sq + 1024;
    float* si = sf + 1024;
    float* so = si + 1024;
    float S[64];
#pragma unroll
    for (int d = 0; d < 64; ++d) S[d] = 0.f;
    const int sst = tid >> 5, sc4 = (tid & 31) * 4;
    float4 lbv;
    {
        const float4 h0 = *(const float4*)(p.hg_lb + h * 128 + sc4), h1 = *(const float4*)(p.hg_lb + 1024 + h * 128 + sc4);
        lbv.x = 1.0f / (1.0f + __expf(h0.x - h1.x)); lbv.y = 1.0f / (1.0f + __expf(h0.y - h1.y));
        lbv.z = 1.0f / (1.0f + __expf(h0.z - h1.z)); lbv.w = 1.0f / (1.0f + __expf(h0.w - h1.w));
    }
    float4 pq, pf, pi;
    auto issue = [&](int chunk) {
        const int tok = scan_tok(z, b, chunk * 8 + sst);
        const float* pr = p.P + (size_t)tok * ODC + h * 128 + sc4;
        pq = *(const float4*)(pr);
        pf = *(const float4*)(pr + 1024 * (1 + z));
        pi = *(const float4*)(pr + 3072);
    };
    issue(0);
    for (int chunk = 0; chunk < 288; ++chunk) {
        __syncthreads();
        {
            float4 q, f;
            q.x = siluf_(pq.x); q.y = siluf_(pq.y); q.z = siluf_(pq.z); q.w = siluf_(pq.w);
            f.x = lbv.x + (1.f - lbv.x) * sigmoidf_(pf.x); f.y = lbv.y + (1.f - lbv.y) * sigmoidf_(pf.y);
            f.z = lbv.z + (1.f - lbv.z) * sigmoidf_(pf.z); f.w = lbv.w + (1.f - lbv.w) * sigmoidf_(pf.w);
            *(float4*)(sq + sst * 128 + sc4) = q;
            *(float4*)(sf + sst * 128 + sc4) = f;
            *(float4*)(si + sst * 128 + sc4) = pi;
        }
        __syncthreads();
        if (chunk + 1 < 288) issue(chunk + 1);
#pragma unroll 1
        for (int st = 0; st < 8; ++st) {
            const float iv = si[st * 128 + v];
            const float* qv = sq + st * 128 + dh * 64;
            const float* fv = sf + st * 128 + dh * 64;
            float o0 = 0.f, o1 = 0.f;
#pragma unroll
            for (int d = 0; d < 64; d += 4) {
                const float4 f4 = *(const float4*)(fv + d), q4 = *(const float4*)(qv + d);
                S[d] = f4.x * S[d] + (1.f - f4.x) * iv; o0 += S[d] * q4.x;
                S[d + 1] = f4.y * S[d + 1] + (1.f - f4.y) * iv; o1 += S[d + 1] * q4.y;
                S[d + 2] = f4.z * S[d + 2] + (1.f - f4.z) * iv; o0 += S[d + 2] * q4.z;
                S[d + 3] = f4.w * S[d + 3] + (1.f - f4.w) * iv; o1 += S[d + 3] * q4.w;
            }
            so[(dh * 8 + st) * 128 + v] = o0 + o1;
        }
        if (chunk >= 32) {
            __syncthreads();
#pragma unroll
            for (int i = 0; i < 4; ++i) {
                const int e = i * 256 + tid, st = e >> 7, vv = e & 127;
                const int tok = scan_tok(z, b, chunk * 8 + st);
                p.HO[((size_t)z * NX + tok) * 1024 + h * 128 + vv] = so[st * 128 + vv] + so[(8 + st) * 128 + vv];
            }
        }
    }
}
__device__ __forceinline__ void phase_hgrn(const Params& p, int bid, int nblk, char* smem) {
    for (int it = bid; it < 128; it += nblk) hgrn_chain(p, it, smem);
}
__device__ __forceinline__ void phase_hgrn_readout(const Params& p, int bid, int nblk) {
    const int lane = threadIdx.x & 63, wid = threadIdx.x >> 6;
    for (int tok = bid * 4 + wid; tok < NX; tok += nblk * 4) {
#pragma unroll
        for (int h = 0; h < 8; ++h) {
            const int c0 = h * 128 + lane, c1 = c0 + 64;
            const size_t o = (size_t)tok * 1024;
            const float y0 = p.HO[o + c0] + p.HO[(size_t)NX * 1024 + o + c0];
            const float y1 = p.HO[o + c1] + p.HO[(size_t)NX * 1024 + o + c1];
            const float ss = wave_sum(y0 * y0 + y1 * y1);
            const float rstd = rsqrtf(ss * (1.0f / 128.0f) + 1e-6f);
            const float g0 = p.P[(size_t)tok * ODC + 4096 + c0], g1 = p.P[(size_t)tok * ODC + 4096 + c1];
            p.MG[o + c0] = f2bf(y0 * rstd * p.hg_norm[lane] * siluf_(g0));
            p.MG[o + c1] = f2bf(y1 * rstd * p.hg_norm[64 + lane] * siluf_(g1));
        }
    }
}

#define N_PHASES 20
__device__ __forceinline__ void run_phase(const Params& p, int ph, int bid, int nblk, char* smem) {
    const float* mod0 = p.mod;
    const float* mod1 = p.mod + 9 * 6144;
    switch (ph) {
    case 0: phase0a(p, bid, nblk, smem); break;
    case 1: phase0b(p, bid, nblk); break;
    case 2: phase_norm(p, bid, nblk, p.x, p.ctx, p.norm1_g, mod0, 0, NT); break;
    case 3: phase_gemm_store(p.H, NT, p.wt_evin, EVC, DM, p.P, bid, nblk, smem); break;
    case 4: phase_feat0(p, bid, nblk); break;
    case 5: phase_lora(p, bid, nblk, smem); break;
    case 6: phase_scan_attn(p, bid, nblk, smem); break;
    case 7: phase_rw_readout(p, bid, nblk); break;
    case 8: phase_outproj(p, bid, nblk, smem, p.wt_evout, NT, p.x, p.ctx, p.X1, mod0 + 2048); break;
    case 9: phase_router(p, bid, nblk, smem, 0, p.X1, NT); break;
    case 10: phase_moe_gu(p, bid, nblk, smem, 0); break;
    case 11: phase_moe_dn(p, bid, nblk, smem, 0); break;
    case 12: phase_combine(p, bid, nblk, p.X1, p.X2, mod0 + 5120, NT, true, p.norm1_g + DM, mod1); break;
    case 13: phase_gemm_store(p.H, NT, p.wt_odin, ODC, DM, p.P, bid, nblk, smem); break;
    case 14: phase_hgrn(p, bid, nblk, smem); break;
    case 15: phase_hgrn_readout(p, bid, nblk); break;
    case 16: phase_outproj(p, bid, nblk, smem, p.wt_odout, NX, p.X2, p.X2 + (size_t)NX * DM, p.X1, mod1 + 2048); break;
    case 17: phase_router(p, bid, nblk, smem, 1, p.X1, NX); break;
    case 18: phase_moe_gu(p, bid, nblk, smem, 1); break;
    case 19: phase_moe_dn(p, bid, nblk, smem, 1); break;
    default: break;
    }
}
__device__ __forceinline__ void final_phase(const Params& p, int bid, int nblk) {
    phase_combine(p, bid, nblk, p.X1, p.out, p.mod + 9 * 6144 + 5120, NX, false, nullptr, nullptr);
}

#define SMEM_BYTES 34048
template <int PH>
__global__ void __launch_bounds__(256, 2) k_phase(Params p) {
    __shared__ __attribute__((aligned(16))) char smem[SMEM_BYTES];
    if (PH < N_PHASES) run_phase(p, PH, blockIdx.x, gridDim.x, smem);
    else final_phase(p, blockIdx.x, gridDim.x);
}
template <int PH> static void launch_all(const Params& p, hipStream_t stream) {
    hipLaunchKernelGGL(k_phase<PH>, dim3(1024), dim3(256), 0, stream, p);
    if constexpr (PH < N_PHASES) launch_all<PH + 1>(p, stream);
}

extern "C" void kernel_launch(void* const* d_in, const int* in_sizes, int n_in, void* d_out, int out_size, void* d_ws, size_t ws_size, hipStream_t stream) {
    Params p{};
    const float** ins = (const float**)&p;
    for (int i = 0; i < 35; ++i) ins[i] = (const float*)d_in[i];
    p.out = (float*)d_out;
    char* ws = (char*)d_ws;
    size_t off = 0;
    auto take = [&](size_t bytes) { char* r = ws + off; off += (bytes + 255) & ~(size_t)255; return r; };
    p.bar = (unsigned*)take(4096);
    p.counts = (int*)take(256);
    p.scal = (float*)take(256);
    p.mod = (float*)take((size_t)2 * 9 * 6144 * 4);
    p.mod_part = (float*)take((size_t)16 * 2 * 9 * 6144 * 4);
    p.rope_cos = (float*)take((size_t)65536 * 4);
    p.rope_sin = (float*)take((size_t)65536 * 4);
    p.wt_evin = (bf16_t*)take((size_t)EVC * 1024 * 2);
    p.wt_evout = (bf16_t*)take((size_t)1024 * 1024 * 2);
    p.wt_odin = (bf16_t*)take((size_t)ODC * 1024 * 2);
    p.wt_odout = (bf16_t*)take((size_t)1024 * 1024 * 2);
    p.wt_w2 = (bf16_t*)take((size_t)1024 * 64 * 2);
    p.wt_a2 = (bf16_t*)take((size_t)1024 * 64 * 2);
    p.wt_g2 = (bf16_t*)take((size_t)512 * 128 * 2);
    p.wt_gu = (bf16_t*)take((size_t)64 * 2048 * 1024 * 2);
    p.wt_dn = (bf16_t*)take((size_t)64 * 1024 * 1024 * 2);
    p.lists = (int*)take((size_t)2 * NEXP * NT * 4);
    p.GATE = (float*)take((size_t)NASG * 4);
    p.H = (bf16_t*)take((size_t)NT * DM * 2);
    p.MG = (bf16_t*)take((size_t)NT * DM * 2);
    p.X1 = (float*)take((size_t)NT * DM * 4);
    p.X2 = (float*)take((size_t)NT * DM * 4);
    const size_t scratch0 = off;
    p.P = (float*)take((size_t)NT * ODC * 4);
    const size_t after_p = off;
    p.Q = (bf16_t*)take((size_t)8 * 8 * SEQ * 64 * 2);
    p.Qc = (bf16_t*)take((size_t)8 * 8 * CTXL * 64 * 2);
    p.Kd = (bf16_t*)take((size_t)8 * 8 * NKEY * 64 * 2);
    p.Vd = (bf16_t*)take((size_t)8 * 4 * NKEY * 128 * 2);
    p.rR = (float*)take((size_t)NT * 512 * 4);
    p.rK = (float*)take((size_t)NT * 512 * 4);
    p.rV = (float*)take((size_t)NT * 512 * 4);
    p.rKK = (float*)take((size_t)NT * 512 * 4);
    p.rG = (float*)take((size_t)NT * 512 * 4);
    p.rW = (float*)take((size_t)2 * NT * 512 * 4);
    p.rKD = (float*)take((size_t)2 * NT * 512 * 4);
    p.rBV = (float*)take((size_t)2 * NT * 512 * 4);
    p.rY = (float*)take((size_t)2 * NT * 512 * 4);
    p.rTW = (bf16_t*)take((size_t)NT * 64 * 2);
    p.rAD = (bf16_t*)take((size_t)NT * 64 * 2);
    p.rSG = (bf16_t*)take((size_t)NT * 128 * 2);
    const size_t end_l0 = off;
    off = after_p;
    p.HO = (float*)take((size_t)2 * NX * 1024 * 4);
    const size_t end_l1 = off;
    off = scratch0;
    p.ACT = (bf16_t*)take((size_t)NASG * 1024 * 2);
    p.YS = (float*)take((size_t)NASG * 1024 * 4);
    const size_t end_moe = off;
    size_t total = end_l0 > end_l1 ? end_l0 : end_l1;
    if (end_moe > total) total = end_moe;
    if (total > ws_size) { fprintf(stderr, "workspace too small: need %zu have %zu\n", total, ws_size); return; }

    launch_all<0>(p, stream);
}
```

```cpp
#include <hip/hip_runtime.h>
#include <hip/hip_cooperative_groups.h>
#include <stdint.h>
#include <stdio.h>

namespace cg = cooperative_groups;

typedef unsigned short bf16_t;
typedef short bf16x8 __attribute__((ext_vector_type(8)));
typedef float f32x4 __attribute__((ext_vector_type(4)));
typedef unsigned u32x4 __attribute__((ext_vector_type(4)));

#define NX 16384
#define NC 2048
#define NT 18432
#define DM 1024
#define SEQ 2048
#define CTXL 256
#define NKEY 2304
#define EVC 3328
#define ODC 5120
#define NEXP 32
#define NASG (NT * 4)
#ifndef EXTRA
#define EXTRA 0
#endif
#define NTHR 512
#define SMEM_BYTES 131072
#define HLDS 65536

#ifndef MULTI_LAUNCH
#define MULTI_LAUNCH 0
#endif

struct Params {
    const float *x, *c, *ctx, *c_ctx, *ada_w, *ada_b, *norm1_g, *norm2_g, *ev_w_in, *ev_w_out, *da_q_norm, *da_k_norm,
        *da_lambda, *da_subln, *rw_mu, *rw_w0, *rw_w2, *rw_a0, *rw_a2, *rw_g2, *rw_k_k, *rw_k_a, *rw_r_k, *rw_ln_w,
        *rw_ln_b, *od_w_in, *od_w_out, *hg_norm, *hg_lb, *router_w, *router_b, *moe_w_gu, *moe_b_gu, *moe_w_dn, *moe_b_dn;
    float* out;
    bf16_t *wt_evin, *wt_evout, *wt_odin, *wt_odout, *wt_gu, *wt_dn, *wt_w2, *wt_a2, *wt_g2;
    float *mod_part, *mod, *rope_cos, *rope_sin, *scal;
    int *counts, *lists;
    unsigned* bar;
    bf16_t* H;
    float* P;
    bf16_t *Q, *Qc, *Kd, *Vd;
    float *rR, *rK, *rV, *rKK, *rW, *rKD, *rBV, *rG, *rY;
    bf16_t *rTW, *rAD, *rSG;
    bf16_t* MG;
    float *X1, *X2;
    float* GATE;
    bf16_t* ACT;
    bf16_t* YS;
    float* HO;
};

typedef float f32x2_ __attribute__((ext_vector_type(2)));
typedef __bf16 bf16x2_ __attribute__((ext_vector_type(2)));
__device__ __forceinline__ unsigned pack2(float a, float b) {
    const f32x2_ v = {a, b};
    return __builtin_bit_cast(unsigned, __builtin_convertvector(v, bf16x2_));
}
__device__ __forceinline__ bf16_t f2bf(float f) { return (bf16_t)(pack2(f, 0.f) & 0xffffu); }
__device__ __forceinline__ int tidx() { int t = __builtin_amdgcn_workitem_id_x(); asm volatile("" : "+v"(t)); return t; }
__device__ __forceinline__ int uni(int v) { return __builtin_amdgcn_readfirstlane(v); }
template <class T> __device__ __forceinline__ T* uni_ptr(T* ptr) {
    const unsigned long long v = (unsigned long long)ptr;
    const unsigned lo = (unsigned)__builtin_amdgcn_readfirstlane((int)(unsigned)v), hi = (unsigned)__builtin_amdgcn_readfirstlane((int)(unsigned)(v >> 32));
    return (T*)(((unsigned long long)hi << 32) | lo);
}
__device__ __forceinline__ float bf2f(bf16_t h) { return __uint_as_float(((unsigned)h) << 16); }
template <int CTRL, int ROWMASK> __device__ __forceinline__ float dpp_zero(float x) {
    return __int_as_float(__builtin_amdgcn_update_dpp(0, __float_as_int(x), CTRL, ROWMASK, 0xf, false));
}
__device__ __forceinline__ float wave_sum(float v) {
    v += dpp_zero<0xB1, 0xf>(v);
    v += dpp_zero<0x4E, 0xf>(v);
    v += dpp_zero<0x141, 0xf>(v);
    v += dpp_zero<0x140, 0xf>(v);
    v += dpp_zero<0x142, 0xa>(v);
    v += dpp_zero<0x143, 0xc>(v);
    return __int_as_float(__builtin_amdgcn_readlane(__float_as_int(v), 63));
}
template <int CTRL> __device__ __forceinline__ float dpp_f(float x) {
    return __int_as_float(__builtin_amdgcn_mov_dpp(__float_as_int(x), CTRL, 0xf, 0xf, true));
}
__device__ __forceinline__ float sum8(float x) {
    x += dpp_f<0xB1>(x);
    x += dpp_f<0x4E>(x);
    x += dpp_f<0x141>(x);
    return x;
}
__device__ __forceinline__ float sigmoidf_(float x) { return __builtin_amdgcn_rcpf(1.0f + __expf(-x)); }
__device__ __forceinline__ float siluf_(float x) { return x * __builtin_amdgcn_rcpf(1.0f + __expf(-x)); }
__device__ __forceinline__ int modrow(int tok) { return tok < NX ? (tok >> 11) : 8; }


#define XB_TMO      128
#define XB_XCNT(j)  (256  + 64 * (j))
#define XB_XSUB(j)  (1280 + 64 * (j))
#define XB_XGEN(j)  (2304 + 64 * (j))
#define XB_TOP      3328
#define XB_TOPGEN   3392
#define XCD_BAR_WORDS 3456
#define XB_SPIN_CAP (1u << 27)
#define LAS __attribute__((address_space(3)))
__device__ __forceinline__ unsigned xb_ld(unsigned* p)              { return __hip_atomic_load(p, __ATOMIC_RELAXED, __HIP_MEMORY_SCOPE_AGENT); }
__device__ __forceinline__ unsigned xb_add(unsigned* p, unsigned v) { return __hip_atomic_fetch_add(p, v, __ATOMIC_RELAXED, __HIP_MEMORY_SCOPE_AGENT); }
__device__ __forceinline__ unsigned xb_xcc_id() { return (unsigned)__builtin_amdgcn_s_getreg((3 << 11) | 20) & 0xFu; }
#define XB_SPIN(cond, bar) do { unsigned _sp = 0; while (cond) { __builtin_amdgcn_s_sleep(1); \
    if ((++_sp & 255u) == 0u) { if (xb_ld(&(bar)[XB_TMO])) break; if (_sp > XB_SPIN_CAP) { atomicAdd(&(bar)[XB_TMO], 1u); break; } } } } while (0)
struct XcdBarrier { unsigned* bar; unsigned x; volatile LAS unsigned* st; };
__device__ __forceinline__ XcdBarrier xcd_barrier_post(unsigned* bar, volatile LAS unsigned* st) {
    XcdBarrier b; b.bar = bar; b.x = xb_xcc_id(); b.st = st;
    if (tidx() == 0) (void)xb_add(&bar[XB_XCNT(b.x)], 1u);
    return b;
}
__device__ __forceinline__ void xcd_barrier_complete(unsigned* bar, unsigned x, unsigned& nloc, unsigned& nx) {
    const unsigned G = gridDim.x * gridDim.y * gridDim.z;
    unsigned sum, cnt, mine, sp = 0u;
    for (;;) {
        sum = 0u; cnt = 0u; mine = 0u;
#pragma unroll
        for (unsigned j = 0; j < 16; ++j) { const unsigned c = xb_ld(&bar[XB_XCNT(j)]); sum += c; cnt += (c > 0u) ? 1u : 0u; mine = (j == x) ? c : mine; }
        if (sum == G) break;
        __builtin_amdgcn_s_sleep(1);
        if ((++sp & 255u) == 0u) { if (xb_ld(&bar[XB_TMO])) break; if (sp > XB_SPIN_CAP) { atomicAdd(&bar[XB_TMO], 1u); break; } }
    }
    nloc = mine > 0u ? mine : 1u; nx = cnt > 0u ? cnt : 1u;
}
__device__ __forceinline__ void xcd_barrier(const XcdBarrier& b) {
    asm volatile("s_waitcnt vmcnt(0)" ::: "memory");
    __syncthreads();
    if (tidx() == 0) {
        unsigned* bar = b.bar;
        __builtin_amdgcn_s_waitcnt(0);
        unsigned nloc = b.st[0], nx = b.st[1];
        if (nloc == 0u) { xcd_barrier_complete(bar, b.x, nloc, nx); b.st[0] = nloc; b.st[1] = nx; }
        const unsigned old = xb_add(&bar[XB_XSUB(b.x)], 1u);
        const unsigned gen = old / nloc;
        if (old + 1u == (gen + 1u) * nloc) {
            __builtin_amdgcn_fence(__ATOMIC_RELEASE, "agent");
            asm volatile("s_waitcnt vmcnt(0)" ::: "memory");
            const unsigned og = xb_add(&bar[XB_TOP], 1u);
            const unsigned tg = og / nx;
            if (og + 1u == (tg + 1u) * nx) xb_add(&bar[XB_TOPGEN], 1u);
            else XB_SPIN(xb_ld(&bar[XB_TOPGEN]) == tg, bar);
            __builtin_amdgcn_fence(__ATOMIC_ACQUIRE, "agent");
            xb_add(&bar[XB_XGEN(b.x)], 1u);
            asm volatile("s_waitcnt vmcnt(0)" ::: "memory");
        } else {
            XB_SPIN(xb_ld(&bar[XB_XGEN(b.x)]) == gen, bar);
            __builtin_amdgcn_fence(__ATOMIC_ACQUIRE, "agent");
            asm volatile("s_waitcnt vmcnt(0)" ::: "memory");
        }
    }
    __syncthreads();
}


__device__ __forceinline__ int q_next(int* ctr, char* smem) {
    volatile unsigned* slot = (volatile unsigned*)(smem + SMEM_BYTES + 8);
    __syncthreads();
    if (tidx() == 0) *slot = (unsigned)atomicAdd(ctr, 1);
    __syncthreads();
    return (int)*slot;
}

struct ARows {
    const bf16_t* base;
    int lda;
    const int* idx;
    int shift;
    int row0;
};

template <bool PAIRED, class Epi>
__device__ __forceinline__ void gemm_tile(const ARows ar, int mcount, const bf16_t* __restrict__ Bt, int ldb, int K, Epi& epi, char* smem) {
    const int tid = tidx() & 255, lane = tid & 63, wid = tid >> 6;
    const int wr = wid >> 1, wc = wid & 1, fr = lane & 15, fq = lane >> 4;
    bf16_t* sA = (bf16_t*)smem;
    bf16_t* sB = sA + 128 * 64;
    const int lrow = tid >> 3, lch = tid & 7;
    const bf16_t* aptr[4];
    const bf16_t* bptr[4];
#pragma unroll
    for (int i = 0; i < 4; ++i) {
        const int r = lrow + 32 * i;
        const int rr = r < mcount ? r : 0;
        const int rowid = ar.idx ? (ar.idx[rr] >> ar.shift) : (ar.row0 + rr);
        aptr[i] = ar.base + (size_t)rowid * ar.lda + lch * 8;
        bptr[i] = Bt + (size_t)r * ldb + lch * 8;
    }
    u32x4 ra[4], rb[4];
#pragma unroll
    for (int i = 0; i < 4; ++i) { ra[i] = *(const u32x4*)(aptr[i]); rb[i] = *(const u32x4*)(bptr[i]); }
    f32x4 acc[4][4];
#pragma unroll
    for (int m = 0; m < 4; ++m)
#pragma unroll
        for (int n = 0; n < 4; ++n) acc[m][n] = (f32x4){0.f, 0.f, 0.f, 0.f};
    const int nk = K >> 6;
    for (int kt = 0; kt < nk; ++kt) {
#pragma unroll
        for (int i = 0; i < 4; ++i) {
            const int r = lrow + 32 * i;
            const int off = r * 64 + ((lch ^ (r & 7)) << 3);
            *(u32x4*)(sA + off) = ra[i];
            *(u32x4*)(sB + off) = rb[i];
        }
        __syncthreads();
        if (kt + 1 < nk) {
#pragma unroll
            for (int i = 0; i < 4; ++i) { ra[i] = *(const u32x4*)(aptr[i] + (kt + 1) * 64); rb[i] = *(const u32x4*)(bptr[i] + (kt + 1) * 64); }
        }
#pragma unroll
        for (int ks = 0; ks < 2; ++ks) {
            bf16x8 af[4], bfr[4];
            const int ch = ks * 4 + fq;
#pragma unroll
            for (int m = 0; m < 4; ++m) { const int r = wr * 64 + m * 16 + fr; af[m] = *(const bf16x8*)(sA + r * 64 + ((ch ^ (r & 7)) << 3)); }
#pragma unroll
            for (int n = 0; n < 4; ++n) { const int r = wc * 64 + n * 16 + fr; bfr[n] = *(const bf16x8*)(sB + r * 64 + ((ch ^ (r & 7)) << 3)); }
#pragma unroll
            for (int m = 0; m < 4; ++m)
#pragma unroll
                for (int n = 0; n < 4; ++n) acc[m][n] = __builtin_amdgcn_mfma_f32_16x16x32_bf16(bfr[n], af[m], acc[m][n], 0, 0, 0);
        }
        __syncthreads();
    }
#pragma unroll
    for (int m = 0; m < 4; ++m) {
        const int r = wr * 64 + m * 16 + fr;
        if (r < mcount) {
            if constexpr (PAIRED) {
                epi.pair(r, wc * 32 + fq * 4, acc[m][0], acc[m][1]);
                epi.pair(r, wc * 32 + 16 + fq * 4, acc[m][2], acc[m][3]);
            } else {
#pragma unroll
                for (int n = 0; n < 4; ++n) epi.one(r, wc * 64 + n * 16 + fq * 4, acc[m][n]);
            }
        }
    }
}


namespace g8 {
#define G8_LAS __attribute__((address_space(3)))
constexpr int BM = 256, BK = 64, HALF = 128, HTB = HALF * BK * 2;
__device__ __forceinline__ int lds_byte(int r, int c) { const int st = (r >> 4) * 2 + (c >> 5), rr = r & 15, cc = c & 31, ob = rr * 64 + cc * 2; return st * 1024 + (ob ^ (((ob >> 9) & 1) << 5)); }
__device__ __forceinline__ void stage_rc(int b, int& R, int& C) { const int st = b / 1024, sb = b % 1024, swz = sb ^ (((sb >> 9) & 1) << 5); R = (st >> 1) * 16 + swz / 64; C = (st & 1) * 32 + (swz % 64) / 2; }
struct Unit {
    const char* a;
    const char* b;
    const int* gidx;
    const int* idx;
    int shift, rows;
    int i0, i1, i2;
};
template <class Epi, class Sched>
__device__ __forceinline__ void gemm_phase(G8_LAS unsigned char* lds, const int K, Sched& S, const Epi& E) {
    const int tid = tidx(), wid = __builtin_amdgcn_readfirstlane(tid >> 6), lane = tid & 63, wr = wid >> 2, wc = wid & 3, fr = lane & 15, fq = lane >> 4;
    const int nt = K / BK;
    int sR[2], sC[2];
    unsigned voffB[2];
#pragma unroll
    for (int i = 0; i < 2; ++i) { stage_rc(tid * 16 + i * 8192, sR[i], sC[i]); voffB[i] = (unsigned)(sR[i] * K + sC[i]) * 2u; }
    const size_t kstep = (size_t)(BK * 2);
    const size_t hstep = (size_t)HALF * K * 2;
    const unsigned ldsw = (unsigned)wid * 1024u;
    const int aoff = lds_byte(wr * 64 + fr, fq * 8), boff = lds_byte(wc * 32 + fr, fq * 8);
    auto a_offsets = [&](const Unit& u, unsigned (&o)[2][2]) {
#pragma unroll
        for (int h = 0; h < 2; ++h)
#pragma unroll
            for (int i = 0; i < 2; ++i) {
                int r = sR[i] + h * HALF;
                if (u.gidx) { r = r < u.rows ? r : (u.rows - 1); r = u.gidx[r] >> u.shift; }
                o[h][i] = (unsigned)(r * K + sC[i]) * 2u;
            }
    };
#define G8_SA(b, h) (((b) * 2 + (h)) * HTB)
#define G8_SB(b, h) ((4 + (b) * 2 + (h)) * HTB)
#define G8_STAGE2(bufoff, gbase, o0, o1) do { \
        __builtin_amdgcn_global_load_lds((const unsigned*)((const char*)(gbase) + (o0)), (G8_LAS unsigned*)(lds + (bufoff) + ldsw), 16, 0, 0); \
        __builtin_amdgcn_global_load_lds((const unsigned*)((const char*)(gbase) + (o1)), (G8_LAS unsigned*)(lds + (bufoff) + ldsw + 8192), 16, 0, 0); } while (0)
#define G8_STAGE_B(bufoff, gbase) G8_STAGE2(bufoff, gbase, voffB[0], voffB[1])
#define G8_LDA(dst, b, h) do { _Pragma("unroll") for (int m = 0; m < 4; ++m) _Pragma("unroll") for (int k = 0; k < 2; ++k) dst[m][k] = *(const G8_LAS bf16x8*)(lds + G8_SA(b, h) + aoff + m * 2048 + k * 1024); } while (0)
#define G8_LDB(dst, b, h) do { _Pragma("unroll") for (int n = 0; n < 2; ++n) _Pragma("unroll") for (int k = 0; k < 2; ++k) dst[n][k] = *(const G8_LAS bf16x8*)(lds + G8_SB(b, h) + boff + n * 2048 + k * 1024); } while (0)
#define G8_MMA(ai, bj, At, Bt) do { __builtin_amdgcn_s_setprio(1); _Pragma("unroll") for (int m = 0; m < 4; ++m) _Pragma("unroll") for (int n = 0; n < 2; ++n) _Pragma("unroll") for (int k = 0; k < 2; ++k) \
        acc[ai][bj][m][n] = __builtin_amdgcn_mfma_f32_16x16x32_bf16(Bt[n][k], At[m][k], acc[ai][bj][m][n], 0, 0, 0); __builtin_amdgcn_s_setprio(0); } while (0)
#define G8_WAIT_V(n) asm volatile("s_waitcnt vmcnt(" #n ")" ::: "memory")
#define G8_WAIT_L(n) asm volatile("s_waitcnt lgkmcnt(" #n ")" ::: "memory")
#define G8_BAR __builtin_amdgcn_s_barrier()
#define G8_SCHED __builtin_amdgcn_sched_barrier(0)
    Unit cur, nxt;
    if (!S.next(cur)) return;
    unsigned oc[2][2], on[2][2];
    a_offsets(cur, oc);
    f32x4 acc[2][2][4][2];
#pragma unroll
    for (int a = 0; a < 2; ++a)
#pragma unroll
        for (int b = 0; b < 2; ++b)
#pragma unroll
            for (int m = 0; m < 4; ++m)
#pragma unroll
                for (int n = 0; n < 2; ++n) acc[a][b][m][n] = (f32x4){0.f, 0.f, 0.f, 0.f};
    bf16x8 At[4][2], B0[2][2], B1[2][2];
    const char* cA = cur.a; const char* cB = cur.b;
    G8_STAGE_B(G8_SB(0, 0), cB); G8_STAGE_B(G8_SB(0, 1), cB + hstep); G8_STAGE2(G8_SA(0, 0), cA, oc[0][0], oc[0][1]); G8_STAGE2(G8_SA(0, 1), cA, oc[1][0], oc[1][1]);
    if (wr == 1) G8_BAR;
    G8_WAIT_V(2); G8_BAR;
    G8_STAGE_B(G8_SB(1, 0), cB + kstep); G8_STAGE2(G8_SA(1, 0), cA + kstep, oc[0][0], oc[0][1]); G8_STAGE_B(G8_SB(1, 1), cB + hstep + kstep);
    G8_WAIT_V(6); G8_BAR;
    for (;;) {
        const bool has_next = S.next(nxt);
        if (has_next) a_offsets(nxt, on);
        else {
#pragma unroll
            for (int h = 0; h < 2; ++h) { on[h][0] = oc[h][0]; on[h][1] = oc[h][1]; }
        }
        const char* nA = has_next ? nxt.a : cA; const char* nB = has_next ? nxt.b : cB;
        for (int t = 0; t < nt; t += 2) {
            const bool last = (t == nt - 2);
            const char* a1 = cA + (size_t)(t + 1) * kstep;
            const char* a2 = last ? nA : cA + (size_t)(t + 2) * kstep; const char* b2 = last ? nB : cB + (size_t)(t + 2) * kstep;
            const char* a3 = a2 + kstep; const char* b3 = b2 + kstep;
            const unsigned p00 = last ? on[0][0] : oc[0][0], p01 = last ? on[0][1] : oc[0][1], p10 = last ? on[1][0] : oc[1][0], p11 = last ? on[1][1] : oc[1][1];
            G8_LDB(B0, 0, 0); G8_LDB(B1, 0, 1); G8_SCHED; G8_LDA(At, 0, 0); G8_STAGE2(G8_SA(1, 1), a1, oc[1][0], oc[1][1]);
            G8_WAIT_V(8); G8_WAIT_L(0); G8_BAR; G8_MMA(0, 0, At, B0); G8_MMA(0, 1, At, B1); G8_BAR; G8_SCHED;
            G8_LDA(At, 0, 1); G8_STAGE_B(G8_SB(0, 0), b2); G8_STAGE_B(G8_SB(0, 1), b2 + hstep); G8_STAGE2(G8_SA(0, 0), a2, p00, p01);
            G8_WAIT_V(8); G8_WAIT_L(0); G8_BAR; G8_MMA(1, 0, At, B0); G8_MMA(1, 1, At, B1); G8_BAR; G8_SCHED;
            G8_LDB(B0, 1, 0); G8_LDB(B1, 1, 1); G8_SCHED; G8_LDA(At, 1, 0); G8_STAGE2(G8_SA(0, 1), a2, p10, p11);
            G8_WAIT_V(8); G8_WAIT_L(0); G8_BAR; G8_MMA(0, 0, At, B0); G8_MMA(0, 1, At, B1); G8_BAR; G8_SCHED;
            G8_LDA(At, 1, 1); G8_STAGE_B(G8_SB(1, 0), b3); G8_STAGE_B(G8_SB(1, 1), b3 + hstep); G8_STAGE2(G8_SA(1, 0), a3, p00, p01);
            G8_WAIT_V(8); G8_WAIT_L(0); G8_BAR; G8_MMA(1, 0, At, B0); G8_MMA(1, 1, At, B1); G8_BAR; G8_SCHED;
        }
        if (wr == 0) G8_BAR;
        E(acc, cur, wr, wc, fr, fq);
        if (!has_next) break;
#pragma unroll
        for (int a = 0; a < 2; ++a)
#pragma unroll
            for (int b = 0; b < 2; ++b)
#pragma unroll
                for (int m = 0; m < 4; ++m)
#pragma unroll
                    for (int n = 0; n < 2; ++n) acc[a][b][m][n] = (f32x4){0.f, 0.f, 0.f, 0.f};
        cur = nxt; cA = nA; cB = nB;
#pragma unroll
        for (int h = 0; h < 2; ++h) { oc[h][0] = on[h][0]; oc[h][1] = on[h][1]; }
        if (wr == 1) G8_BAR;
    }
    G8_WAIT_V(0);
    G8_BAR;
#undef G8_SA
#undef G8_SB
#undef G8_STAGE2
#undef G8_STAGE_B
#undef G8_LDA
#undef G8_LDB
#undef G8_MMA
#undef G8_WAIT_V
#undef G8_WAIT_L
#undef G8_BAR
#undef G8_SCHED
}
}

__device__ __forceinline__ int gu_row(int col) {
    const int half = col >> 10, unit = col & 1023, T = unit >> 7, ul = unit & 127, wc = ul >> 5, r = ul & 31, fq = r >> 3, bj = (r >> 2) & 1, jj = r & 3;
    return 256 * T + 128 * bj + 32 * wc + 16 * half + 4 * fq + jj;
}
__device__ __forceinline__ int p32_row(int col) {
    const int x = col & 31;
    return (col & ~31) + 16 * ((x >> 2) & 1) + 4 * (x >> 3) + (x & 3);
}
struct ConvDesc { const float* src; bf16_t* dst; int N, Kd, kt, nt, perm, pad; };
struct ConvRegs { f32x4 v0, v1, v2, v3; };
__device__ __forceinline__ ConvRegs conv_load(const ConvDesc& d) {
    const int tid = tidx() & 255, r = tid >> 4, c4 = (tid & 15) * 4;
    ConvRegs x;
    const float* b0 = d.src + (size_t)(d.kt * 64 + r) * d.N + d.nt * 64 + c4;
    x.v0 = *(const f32x4*)(b0); x.v1 = *(const f32x4*)(b0 + (size_t)16 * d.N); x.v2 = *(const f32x4*)(b0 + (size_t)32 * d.N); x.v3 = *(const f32x4*)(b0 + (size_t)48 * d.N);
    return x;
}
__device__ __forceinline__ void conv_store(const ConvRegs& x, const ConvDesc& d, float* lds) {
    const int tid = tidx() & 255;
    {
        const int r = tid >> 4, c4 = (tid & 15) * 4;
        float* q = lds + r * 65 + c4;
        q[0] = x.v0[0]; q[1] = x.v0[1]; q[2] = x.v0[2]; q[3] = x.v0[3];
        q[16 * 65 + 0] = x.v1[0]; q[16 * 65 + 1] = x.v1[1]; q[16 * 65 + 2] = x.v1[2]; q[16 * 65 + 3] = x.v1[3];
        q[32 * 65 + 0] = x.v2[0]; q[32 * 65 + 1] = x.v2[1]; q[32 * 65 + 2] = x.v2[2]; q[32 * 65 + 3] = x.v2[3];
        q[48 * 65 + 0] = x.v3[0]; q[48 * 65 + 1] = x.v3[1]; q[48 * 65 + 2] = x.v3[2]; q[48 * 65 + 3] = x.v3[3];
    }
    __syncthreads();
    {
        const int n = tid >> 2, kseg = (tid & 3) * 16;
        unsigned w[8];
#pragma unroll
        for (int j = 0; j < 8; ++j) w[j] = pack2(lds[(kseg + 2 * j) * 65 + n], lds[(kseg + 2 * j + 1) * 65 + n]);
        const int ncol = d.nt * 64 + n;
        const int row = d.perm == 1 ? gu_row(ncol) : (d.perm == 2 ? p32_row(ncol) : (d.perm == 3 ? ((ncol >> 6) * 128 + (ncol & 63)) : ncol));
        uint4* q = (uint4*)(d.dst + (size_t)row * d.Kd + d.kt * 64 + kseg);
        q[0] = make_uint4(w[0], w[1], w[2], w[3]);
        q[1] = make_uint4(w[4], w[5], w[6], w[7]);
    }
    __syncthreads();
}
__device__ __forceinline__ void conv_tile(const float* __restrict__ src, int N, bf16_t* __restrict__ dst, int Kd, int kt, int nt, int perm, float* lds) {
    const ConvDesc d{src, dst, N, Kd, kt, nt, perm, 0};
    const ConvRegs x = conv_load(d);
    conv_store(x, d, lds);
}

#define CONV_GRP 8
#define N_MODP 768
#define CV0 832
#define CV1 (CV0 + 16)
#define CV2 (CV1 + 16)
#define CV3 (CV2 + 16)
#define CV4 (CV3 + 256)
#define N_CONV CV4
#define N_ROPE 64
#define N_P0A (N_MODP + N_CONV + N_ROPE + 2)

__device__ __forceinline__ void phase0a(const Params& p, int bid, int nblk, char* smem) {
    const int half = tidx() >> 8, tid = tidx() & 255;
    float* lds = (float*)(smem + half * HLDS);
    for (int it0 = bid * 2; it0 < N_P0A; it0 += nblk * 2) {
        const int it = it0 + half;
        if (it < N_MODP) {
            const int l = it / 384, rem = it % 384, cb = rem / 16, kc = rem % 16;
            for (int e = tid; e < 9 * 64; e += 256) {
                const int r = e >> 6, k = e & 63;
                const float v = (r < 8) ? p.c[r * DM + kc * 64 + k] : p.c_ctx[kc * 64 + k];
                lds[e] = siluf_(v);
            }
            __syncthreads();
            const int col = cb * 256 + tid;
            const float* w = p.ada_w + (size_t)l * DM * 6144 + (size_t)(kc * 64) * 6144 + col;
            float acc[9];
#pragma unroll
            for (int r = 0; r < 9; ++r) acc[r] = 0.f;
#pragma unroll 1
            for (int k0 = 0; k0 < 64; k0 += 16) {
                float wv[16];
#pragma unroll
                for (int k = 0; k < 16; ++k) wv[k] = w[(size_t)(k0 + k) * 6144];
#pragma unroll
                for (int k = 0; k < 16; ++k)
#pragma unroll
                    for (int r = 0; r < 9; ++r) acc[r] += lds[r * 64 + k0 + k] * wv[k];
            }
#pragma unroll
            for (int r = 0; r < 9; ++r) p.mod_part[((size_t)(kc * 2 + l) * 9 + r) * 6144 + col] = acc[r];
            __syncthreads();
        } else if (it < N_MODP + N_CONV) {
            const int j = it - N_MODP;
            if (j < CV0) { conv_tile(p.ev_w_in, EVC, p.wt_evin, 1024, j / 52, j % 52, 2, lds); }
            else if (j < CV1) { const int q = j - CV0, z = q >> 3, nt = q & 7; conv_tile(p.rw_w2 + (size_t)z * 64 * 512, 512, p.wt_w2 + (size_t)z * 512 * 64, 64, 0, nt, 0, lds); }
            else if (j < CV2) { const int q = j - CV1, z = q >> 3, nt = q & 7; conv_tile(p.rw_a2 + (size_t)z * 64 * 512, 512, p.wt_a2 + (size_t)z * 64 * 64, 64, 0, nt, 3, lds); }
            else if (j < CV3) { const int q = j - CV2, kt = q >> 3, nt = q & 7; conv_tile(p.rw_g2, 512, p.wt_g2, 128, kt, nt, 0, lds); }
            else { const int q = j - CV3; conv_tile(p.ev_w_out, 1024, p.wt_evout, 1024, q >> 4, q & 15, 0, lds); }
        } else if (it < N_MODP + N_CONV + N_ROPE) {
            const int j = it - N_MODP - N_CONV;
#pragma unroll
            for (int i = 0; i < 4; ++i) {
                const int e = (j * 4 + i) * 256 + tid;
                const int t = e >> 5, a = (e >> 4) & 1, pp = e & 15;
                const float pos = (float)(a == 0 ? (t >> 6) : (t & 63));
                const float inv = powf(10000.0f, -(float)pp / 16.0f);
                const float ang = pos * inv;
                p.rope_cos[e] = cosf(ang);
                p.rope_sin[e] = sinf(ang);
            }
        } else if (it == N_MODP + N_CONV + N_ROPE) {
            if (tid < 64) {
                const float* lf = p.da_lambda;
                float a = lf[tid] * lf[64 + tid], b = lf[128 + tid] * lf[192 + tid];
                a = wave_sum(a); b = wave_sum(b);
                if (tid == 0) p.scal[0] = expf(a) - expf(b) + 0.2f;
            }
            if (tid < 128) p.counts[tid] = 0;
        }
    }
}

__device__ __forceinline__ void phase0b(const Params& p, int bid, int nblk) {
    for (int e = bid * NTHR + tidx(); e < 2 * 9 * 6144; e += nblk * NTHR) {
        const int l = e / (9 * 6144), rem = e % (9 * 6144);
        float s = p.ada_b[l * 6144 + rem % 6144];
#pragma unroll
        for (int kc = 0; kc < 16; ++kc) s += p.mod_part[(size_t)(kc * 2 + l) * 9 * 6144 + rem];
        p.mod[e] = s;
    }
}

__device__ __forceinline__ void phase_norm(const Params& p, int bid, int nblk, const float* xs_lat, const float* xs_ctx, const float* gain, const float* modl, int sh_off, int ntok) {
    const int lane = tidx() & 63, wid = tidx() >> 6;
    for (int tok = bid * 8 + wid; tok < ntok; tok += nblk * 8) {
        const float* xr = tok < NX ? xs_lat + (size_t)tok * DM : xs_ctx + (size_t)(tok - NX) * DM;
        const float* mr = modl + modrow(tok) * 6144 + sh_off;
        float4 v[4];
        float ss = 0.f;
#pragma unroll
        for (int i = 0; i < 4; ++i) { v[i] = *(const float4*)(xr + lane * 4 + 256 * i); ss += v[i].x * v[i].x + v[i].y * v[i].y + v[i].z * v[i].z + v[i].w * v[i].w; }
        ss = wave_sum(ss);
        const float rstd = rsqrtf(ss * (1.0f / 1024.0f) + 1e-6f);
#pragma unroll
        for (int i = 0; i < 4; ++i) {
            const int c = lane * 4 + 256 * i;
            const float4 g = *(const float4*)(gain + c), sh = *(const float4*)(mr + c), sc = *(const float4*)(mr + 1024 + c);
            const float a0 = v[i].x * rstd * g.x * (1.f + sc.x) + sh.x, a1 = v[i].y * rstd * g.y * (1.f + sc.y) + sh.y;
            const float a2 = v[i].z * rstd * g.z * (1.f + sc.z) + sh.z, a3 = v[i].w * rstd * g.w * (1.f + sc.w) + sh.w;
            *(uint2*)(p.H + (size_t)tok * DM + c) = make_uint2(pack2(a0, a1), pack2(a2, a3));
        }
    }
}

struct EpiStoreF32 {
    float* C; int ldc; int row0; int col0;
    __device__ __forceinline__ void one(int r, int c, f32x4 v) const { *(f32x4*)(C + (size_t)(row0 + r) * ldc + col0 + c) = v; }
};


struct TileIter {
    int mg0, mcnt, ntn, total, full, i, step;
    __device__ __forceinline__ void init(int MT, int NTN, int bid, int nblk) {
        const int g = bid & 7, lb = (bid >> 3) * 2 + (tidx() >> 8), nb = (nblk >> 3) * 2;
        mg0 = (MT * g) >> 3; mcnt = ((MT * (g + 1)) >> 3) - mg0; ntn = NTN; total = mcnt * NTN; full = mcnt >> 3; i = lb; step = nb;
    }
    __device__ __forceinline__ bool next(int& mt, int& nt) {
        if (i >= total) return false;
        const int band = 8 * ntn;
        if (i < full * band) { const int ms = i / band, r = i - ms * band; nt = r >> 3; mt = mg0 + ms * 8 + (r & 7); }
        else { const int rem = mcnt - full * 8, j = i - full * band; nt = j / rem; mt = mg0 + full * 8 + (j - nt * rem); }
        i += step;
        return true;
    }
};
__device__ __forceinline__ void phase_gemm_store(const bf16_t* A, int M, const bf16_t* Wt, int N, int K, float* C, int bid, int nblk, char* smem) {
    TileIter ti; ti.init(M / 128, N / 128, bid, nblk);
    char* hs = smem + (tidx() >> 8) * HLDS;
    for (;;) {
        int mt = 0, nt = 0;
        const bool v = ti.next(mt, nt);
        if (!__syncthreads_or(v ? 1 : 0)) break;
        if (!v) { mt = 0; nt = 0; }
        ARows ar{A, K, nullptr, 0, mt * 128};
        EpiStoreF32 epi{C, N, mt * 128, nt * 128};
        gemm_tile<false>(ar, v ? 128 : 0, Wt + (size_t)nt * 128 * K, K, K, epi, hs);
    }
}

struct EpiResid {
    const float* xin_lat; const float* xin_ctx; float* xout; const float* gmod; int row0; int col0;
    __device__ __forceinline__ void one(int r, int c, f32x4 v) const {
        const int tok = row0 + r, cc = col0 + c;
        const float* xr = tok < NX ? xin_lat + (size_t)tok * DM : xin_ctx + (size_t)(tok - NX) * DM;
        const f32x4 xi = *(const f32x4*)(xr + cc);
        const f32x4 g = *(const f32x4*)(gmod + modrow(tok) * 6144 + cc);
        *(f32x4*)(xout + (size_t)tok * DM + cc) = xi + g * v;
    }
};
__device__ __forceinline__ void phase_outproj(const Params& p, int bid, int nblk, char* smem, const bf16_t* Wt, int ntok, const float* xin_lat, const float* xin_ctx, float* xout, const float* gmod) {
    TileIter ti; ti.init(ntok / 128, 8, bid, nblk);
    char* hs = smem + (tidx() >> 8) * HLDS;
    for (;;) {
        int mt = 0, nt = 0;
        const bool v = ti.next(mt, nt);
        if (!__syncthreads_or(v ? 1 : 0)) break;
        if (!v) { mt = 0; nt = 0; }
        ARows ar{p.MG, DM, nullptr, 0, mt * 128};
        EpiResid epi{xin_lat, xin_ctx, xout, gmod, mt * 128, nt * 128};
        gemm_tile<false>(ar, v ? 128 : 0, Wt + (size_t)nt * 128 * DM, DM, DM, epi, hs);
    }
}

__device__ __forceinline__ void unpack8(const u32x4 w, float (&v)[8]) {
#pragma unroll
    for (int i = 0; i < 4; ++i) { v[2 * i] = __uint_as_float(w[i] << 16); v[2 * i + 1] = __uint_as_float(w[i] & 0xffff0000u); }
}
__device__ __forceinline__ u32x4 pack8f(const float (&v)[8]) { return (u32x4){pack2(v[0], v[1]), pack2(v[2], v[3]), pack2(v[4], v[5]), pack2(v[6], v[7])}; }
__device__ __forceinline__ void phase_feat0(const Params& p, int bid, int nblk, char* smem) {
    const int lane = tidx() & 63, wid = tidx() >> 6;
    const bf16_t* P16 = (const bf16_t*)p.P;
    const int l7 = lane & 7, g = lane >> 3;
    for (int tok = bid * 8 + wid; tok < NT; tok += nblk * 8) {
        const bool lat = tok < NX;
        const int b = lat ? (tok >> 11) : ((tok - NX) >> 8);
        const int t = lat ? (tok & 2047) : ((tok - NX) & 255);
        const int key = lat ? (CTXL + t) : t;
        const bf16_t* pr = P16 + (size_t)tok * EVC;
        {
            float cs[8], sn[8];
            if (lat) {
                const int a = l7 >> 2, ro = t * 32 + a * 16 + (l7 & 1) * 8;
                const f32x4 c0 = *(const f32x4*)(p.rope_cos + ro), c1 = *(const f32x4*)(p.rope_cos + ro + 4), s0 = *(const f32x4*)(p.rope_sin + ro), s1 = *(const f32x4*)(p.rope_sin + ro + 4);
#pragma unroll
                for (int j = 0; j < 4; ++j) { cs[j] = c0[j]; cs[4 + j] = c1[j]; sn[j] = s0[j]; sn[4 + j] = s1[j]; }
            }
            const bool hf = (l7 >> 1) & 1;
#pragma unroll
            for (int qk = 0; qk < 2; ++qk) {
                float v[8];
                unpack8(*(const u32x4*)(pr + qk * 512 + lane * 8), v);
                const float* nw = (qk == 0 ? p.da_q_norm : p.da_k_norm) + l7 * 8;
                const f32x4 n0 = *(const f32x4*)nw, n1 = *(const f32x4*)(nw + 4);
                float ss = 0.f;
#pragma unroll
                for (int j = 0; j < 8; ++j) ss += v[j] * v[j];
                ss = sum8(ss);
                const float rstd = rsqrtf(ss * (1.0f / 64.0f) + 1e-6f) * (qk == 0 ? 0.125f * 1.4426950408889634f : 1.0f);
#pragma unroll
                for (int j = 0; j < 8; ++j) v[j] = v[j] * rstd * (j < 4 ? n0[j] : n1[j - 4]);
                if (lat) {
#pragma unroll
                    for (int j = 0; j < 8; ++j) {
                        const float o = dpp_f<0x4E>(v[j]);
                        v[j] = hf ? (v[j] * cs[j] + o * sn[j]) : (v[j] * cs[j] - o * sn[j]);
                    }
                }
                const u32x4 w = pack8f(v);
                if (qk == 0) {
                    if (lat) *(u32x4*)(p.Q + (((size_t)b * 8 + g) * SEQ + t) * 64 + l7 * 8) = w;
                    else *(u32x4*)(p.Qc + (((size_t)b * 8 + g) * CTXL + t) * 64 + l7 * 8) = w;
                } else *(u32x4*)(p.Kd + (((size_t)b * 8 + g) * NKEY + key) * 64 + l7 * 8) = w;
            }
        }
        const int slen = lat ? SEQ : CTXL;
        const bool hasp = t > 0, hasn = t < slen - 1;
        const bf16_t* pw = pr + 1536;
        auto shifted = [&](int c0, float (&y)[8]) {
            float pv[8], nv[8];
            unpack8(*(const u32x4*)(pw + c0), y);
            if (hasp) unpack8(*(const u32x4*)(pw + c0 - EVC), pv); else {
#pragma unroll
                for (int j = 0; j < 8; ++j) pv[j] = 0.f; }
            if (hasn) unpack8(*(const u32x4*)(pw + c0 + EVC), nv); else {
#pragma unroll
                for (int j = 0; j < 8; ++j) nv[j] = 0.f; }
            const f32x4 m0 = *(const f32x4*)(p.rw_mu + c0), m1 = *(const f32x4*)(p.rw_mu + c0 + 4);
#pragma unroll
            for (int j = 0; j < 8; ++j) y[j] = y[j] + (j < 4 ? m0[j] : m1[j - 4]) * (0.5f * (pv[j] + nv[j]) - y[j]);
        };
        {
            float y[8];
            shifted(lane * 8, y);
            float* d = p.rR + (size_t)tok * 512 + lane * 8;
            *(f32x4*)d = (f32x4){y[0], y[1], y[2], y[3]}; *(f32x4*)(d + 4) = (f32x4){y[4], y[5], y[6], y[7]};
        }
        {
            float y[8];
            shifted(512 + lane * 8, y);
            float* d = p.rK + (size_t)tok * 512 + lane * 8;
            *(f32x4*)d = (f32x4){y[0], y[1], y[2], y[3]}; *(f32x4*)(d + 4) = (f32x4){y[4], y[5], y[6], y[7]};
            const f32x4 k0 = *(const f32x4*)(p.rw_k_k + lane * 8), k1 = *(const f32x4*)(p.rw_k_k + lane * 8 + 4);
            float ss = 0.f;
#pragma unroll
            for (int j = 0; j < 8; ++j) { y[j] *= (j < 4 ? k0[j] : k1[j - 4]); ss += y[j] * y[j]; }
            const float inv = 1.0f / fmaxf(sqrtf(sum8(ss)), 1e-12f);
            float* e = p.rKK + (size_t)tok * 512 + lane * 8;
            *(f32x4*)e = (f32x4){y[0] * inv, y[1] * inv, y[2] * inv, y[3] * inv}; *(f32x4*)(e + 4) = (f32x4){y[4] * inv, y[5] * inv, y[6] * inv, y[7] * inv};
        }
        {
            float y[8];
            shifted(1024 + lane * 8, y);
            float* d = p.rV + (size_t)tok * 512 + lane * 8;
            *(f32x4*)d = (f32x4){y[0], y[1], y[2], y[3]}; *(f32x4*)(d + 4) = (f32x4){y[4], y[5], y[6], y[7]};
        }
        if (lane < 32) {
            float y[8];
            shifted(1536 + lane * 8, y);
            if (lane < 8) {
#pragma unroll
                for (int j = 0; j < 8; ++j) y[j] = tanhf(y[j]);
                *(u32x4*)(p.rTW + (size_t)tok * 64 + lane * 8) = pack8f(y);
            } else if (lane < 16) {
                *(u32x4*)(p.rAD + (size_t)tok * 64 + (lane - 8) * 8) = pack8f(y);
            } else {
#pragma unroll
                for (int j = 0; j < 8; ++j) y[j] = sigmoidf_(y[j]);
                *(u32x4*)(p.rSG + (size_t)tok * 128 + (lane - 16) * 8) = pack8f(y);
            }
        }
    }
    {
        const int half = tidx() >> 8, tid = tidx() & 255;
        float* lds = (float*)(smem + half * HLDS);
        for (int it = bid * 2 + half; it < 8 * 36 * 4; it += nblk * 2) {
            const int b = it / 144, rem = it % 144, kt = rem >> 2, h = rem & 3;
            __syncthreads();
#pragma unroll
            for (int i = 0; i < 8; ++i) {
                const int e = i * 256 + tid, key = e >> 5, c4 = (e & 31) * 4;
                const int kg = kt * 64 + key;
                const int tok = kg < CTXL ? NX + b * CTXL + kg : b * SEQ + (kg - CTXL);
                const uint2 v = *(const uint2*)((const bf16_t*)p.P + (size_t)tok * EVC + 1024 + h * 128 + c4);
                float* d = lds + key * 129 + c4;
                d[0] = __uint_as_float(v.x << 16); d[1] = __uint_as_float(v.x & 0xffff0000u); d[2] = __uint_as_float(v.y << 16); d[3] = __uint_as_float(v.y & 0xffff0000u);
            }
            __syncthreads();
            {
                const int dv = tid >> 1, half = tid & 1;
                unsigned w[16];
#pragma unroll
                for (int j = 0; j < 16; ++j) { const int q = 2 * j, key = 16 * ((q >> 2) & 1) + 4 * (q >> 3) + (q & 3);
                    w[j] = pack2(lds[(half * 32 + key) * 129 + dv], lds[(half * 32 + key + 1) * 129 + dv]); }
                u32x4* dst = (u32x4*)(p.Vd + (((size_t)b * 4 + h) * 128 + dv) * NKEY + kt * 64 + half * 32);
#pragma unroll
                for (int j = 0; j < 4; ++j) dst[j] = (u32x4){w[4 * j], w[4 * j + 1], w[4 * j + 2], w[4 * j + 3]};
            }
        }
    }
}

struct EpiDecay {
    const float* w0; float* W; int row0; int col0;
    __device__ __forceinline__ void one(int r, int c, f32x4 v) const {
        const int tok = row0 + r, cc = col0 + c, z = cc >> 9, ch = cc & 511;
        f32x4 o;
        const f32x4 w0v = *(const f32x4*)(w0 + z * 512 + ch);
#pragma unroll
        for (int j = 0; j < 4; ++j) {
            const float x = w0v[j] + v[j];
            const float u = -x;
            const float sp = fmaxf(u, 0.f) + __logf(1.0f + __expf(-fabsf(u)));
            const float wlog = -sp - 0.5f;
            o[j] = __expf(-__expf(wlog));
        }
        *(f32x4*)(W + ((size_t)z * NT + tok) * 512 + ch) = o;
    }
};
struct EpiArate {
    const float* a0; const float* k_a; const float* rK; const float* rKK; float* KD; float* BV; int row0; int col0;
    __device__ __forceinline__ void one(int r, int c, f32x4 v) const {
        const int tok = row0 + r, z = (c >> 6) & 1, ch = (col0 >> 1) + (c & 63);
        const f32x4 k = *(const f32x4*)(rK + (size_t)tok * 512 + ch);
        const f32x4 kk = *(const f32x4*)(rKK + (size_t)tok * 512 + ch);
        f32x4 kd, bv;
        const f32x4 a0v = *(const f32x4*)(a0 + z * 512 + ch), kav = *(const f32x4*)(k_a + ch);
#pragma unroll
        for (int j = 0; j < 4; ++j) {
            const float arate = sigmoidf_(a0v[j] + v[j]);
            kd[j] = k[j] * (1.f + (arate - 1.f) * kav[j]);
            bv[j] = kk[j] * arate;
        }
        *(f32x4*)(KD + ((size_t)z * NT + tok) * 512 + ch) = kd;
        *(f32x4*)(BV + ((size_t)z * NT + tok) * 512 + ch) = bv;
    }
};
__device__ __forceinline__ void phase_lora(const Params& p, int bid, int nblk, char* smem) {
    const int half = tidx() >> 8;
    char* hs = smem + half * HLDS;
    for (int it0 = bid * 2; it0 < 144 * 20; it0 += nblk * 2) {
        const int it = it0 + half;
        if (it < 1152) {
            const int mt = it >> 3, q = it & 7;
            ARows ar{p.rTW, 64, nullptr, 0, mt * 128};
            EpiDecay epi{p.rw_w0, p.rW, mt * 128, q * 128};
            gemm_tile<false>(ar, 128, p.wt_w2 + (size_t)q * 128 * 64, 64, 64, epi, hs);
        } else if (it < 2304) {
            const int j = it - 1152, mt = j >> 3, q = j & 7;
            ARows ar{p.rAD, 64, nullptr, 0, mt * 128};
            EpiArate epi{p.rw_a0, p.rw_k_a, p.rK, p.rKK, p.rKD, p.rBV, mt * 128, q * 128};
            gemm_tile<false>(ar, 128, p.wt_a2 + (size_t)q * 128 * 64, 64, 64, epi, hs);
        } else {
            const int j = it - 2304, mt = j >> 2, q = j & 3;
            ARows ar{p.rSG, 128, nullptr, 0, mt * 128};
            EpiStoreF32 epi{p.rG, 512, mt * 128, q * 128};
            gemm_tile<false>(ar, 128, p.wt_g2 + (size_t)q * 128 * 128, 128, 128, epi, hs);
        }
    }
}

__device__ __forceinline__ int scan_tok(int z, int b, int s) {
    if (s < CTXL) { const int tc = z == 0 ? s : (CTXL - 1 - s); return NX + b * CTXL + tc; }
    const int t = s - CTXL; return b * SEQ + (z == 0 ? t : (SEQ - 1 - t));
}
typedef float f32x2 __attribute__((ext_vector_type(2)));
__device__ __forceinline__ void rwkv_scan_chain(const Params& p, int chain, char* smem) {
    const int z = chain >> 6, b = (chain >> 3) & 7, h = chain & 7;
    const int tid = tidx(), vrow = tid >> 3, kq = tid & 7;
    float* lds = (float*)smem;
    f32x2 s[4];
#pragma unroll
    for (int j = 0; j < 4; ++j) s[j] = (f32x2){0.f, 0.f};
    const int wv_ = __builtin_amdgcn_readfirstlane(tid >> 6);
    const int ah = wv_ >> 2, lstep = ((tid & 255) >> 4), c4 = (tid & 15) * 4;
    const size_t zoff = (size_t)z * NT * 512;
    const float* g0 = ah ? p.rW + zoff : p.rR;
    const float* g1 = ah ? p.rKK : p.rKD + zoff;
    const float* g2 = ah ? p.rV : p.rBV + zoff;
    const unsigned ldsw = (unsigned)(ah * 4096 + (wv_ & 3) * 1024);
    auto issue = [&](int chunk) {
        const int tok = scan_tok(z, b, chunk * 16 + lstep);
        const size_t o = (size_t)tok * 512 + h * 64 + c4;
        char* bb = smem + (chunk & 3) * 24576 + ldsw;
        __builtin_amdgcn_global_load_lds((const unsigned*)(g0 + o), (__attribute__((address_space(3))) unsigned*)(bb), 16, 0, 0);
        __builtin_amdgcn_global_load_lds((const unsigned*)(g1 + o), (__attribute__((address_space(3))) unsigned*)(bb + 8192), 16, 0, 0);
        __builtin_amdgcn_global_load_lds((const unsigned*)(g2 + o), (__attribute__((address_space(3))) unsigned*)(bb + 16384), 16, 0, 0);
    };
    issue(0); issue(1); issue(2);
    __builtin_amdgcn_s_setprio(3);
    for (int chunk = 0; chunk < 144; ++chunk) {
        if (chunk + 3 <= 144) asm volatile("s_waitcnt vmcnt(6)" ::: "memory");
        else asm volatile("s_waitcnt vmcnt(0)" ::: "memory");
        asm volatile("s_waitcnt lgkmcnt(0)" ::: "memory");
        __builtin_amdgcn_s_barrier();
        asm volatile("" ::: "memory");
        if (chunk + 3 < 144) issue(chunk + 3);
        const float* cb = lds + (chunk & 3) * 6144;
        const int tokbase = scan_tok(z, b, chunk * 16);
        const int tokdir = z == 0 ? 1 : -1;
        struct StepIn { f32x4 r0, r1, w0, w1, k0, k1, a0, a1, b0, b1; float vv; };
        auto ldstep = [&](int st) {
            StepIn x;
            const float* base = cb + st * 64 + kq * 8;
            x.r0 = *(const f32x4*)(base); x.r1 = *(const f32x4*)(base + 4);
            x.w0 = *(const f32x4*)(base + 1024); x.w1 = *(const f32x4*)(base + 1028);
            x.k0 = *(const f32x4*)(base + 2048); x.k1 = *(const f32x4*)(base + 2052);
            x.a0 = *(const f32x4*)(base + 3072); x.a1 = *(const f32x4*)(base + 3076);
            x.b0 = *(const f32x4*)(base + 4096); x.b1 = *(const f32x4*)(base + 4100);
            x.vv = cb[5 * 1024 + st * 64 + vrow];
            return x;
        };
        StepIn cur = ldstep(0);
#pragma unroll
        for (int sg = 0; sg < 2; ++sg) {
            float ykeep = 0.f;
#pragma unroll
            for (int s8 = 0; s8 < 8; ++s8) {
                const int st = sg * 8 + s8;
                StepIn nxt = cur;
                if (st + 1 < 16) nxt = ldstep(st + 1);
                __builtin_amdgcn_sched_barrier(0);
                const f32x2 av[4] = {{cur.a0[0], cur.a0[1]}, {cur.a0[2], cur.a0[3]}, {cur.a1[0], cur.a1[1]}, {cur.a1[2], cur.a1[3]}};
                const f32x2 wv[4] = {{cur.w0[0], cur.w0[1]}, {cur.w0[2], cur.w0[3]}, {cur.w1[0], cur.w1[1]}, {cur.w1[2], cur.w1[3]}};
                const f32x2 kv[4] = {{cur.k0[0], cur.k0[1]}, {cur.k0[2], cur.k0[3]}, {cur.k1[0], cur.k1[1]}, {cur.k1[2], cur.k1[3]}};
                const f32x2 bv[4] = {{cur.b0[0], cur.b0[1]}, {cur.b0[2], cur.b0[3]}, {cur.b1[0], cur.b1[1]}, {cur.b1[2], cur.b1[3]}};
                const f32x2 rv[4] = {{cur.r0[0], cur.r0[1]}, {cur.r0[2], cur.r0[3]}, {cur.r1[0], cur.r1[1]}, {cur.r1[2], cur.r1[3]}};
                const f32x2 t2 = (s[0] * av[0] + s[1] * av[1]) + (s[2] * av[2] + s[3] * av[3]);
                const float sa = -sum8(t2[0] + t2[1]);
                const f32x2 vv2 = (f32x2){cur.vv, cur.vv}, sa2 = (f32x2){sa, sa};
#pragma unroll
                for (int j = 0; j < 4; ++j) s[j] = (s[j] * wv[j] + vv2 * kv[j]) + sa2 * bv[j];
                const f32x2 y2 = (s[0] * rv[0] + s[1] * rv[1]) + (s[2] * rv[2] + s[3] * rv[3]);
                const float y = sum8(y2[0] + y2[1]);
                ykeep = (kq == s8) ? y : ykeep;
                cur = nxt;
            }
            p.rY[zoff + (size_t)(tokbase + tokdir * (sg * 8 + kq)) * 512 + h * 64 + vrow] = ykeep;
        }
    }
    __builtin_amdgcn_s_setprio(0);
    asm volatile("s_waitcnt vmcnt(0)" ::: "memory");
    __syncthreads();
}

__device__ __forceinline__ bf16x8 cvt8(const f32x4 a, const f32x4 b) {
    union { bf16x8 v; unsigned u[4]; } r;
    r.u[0] = pack2(a[0], a[1]); r.u[1] = pack2(a[2], a[3]); r.u[2] = pack2(b[0], b[1]); r.u[3] = pack2(b[2], b[3]);
    return r.v;
}
__device__ __forceinline__ void rwkv_chunk_chain(const Params& p, int chain, char* smem) {
    const int z = chain >> 6, b = (chain >> 3) & 7, h = chain & 7;
    const int tid = tidx(), lane = tid & 63, fr = lane & 15, fq = lane >> 4;
    const int wv_ = __builtin_amdgcn_readfirstlane(tid >> 6);
    float* ring = (float*)smem;
    bf16_t* AR = (bf16_t*)(smem + 73728);
    bf16_t* BK = (bf16_t*)(smem + 77824);
    bf16_t* BKT = (bf16_t*)(smem + 81920);
    bf16_t* VT = (bf16_t*)(smem + 86016);
    bf16_t* SB = (bf16_t*)(smem + 90112);
    float* AM = (float*)(smem + 98304);
    float* RH = (float*)(smem + 102400);
    float* PT = (float*)(smem + 106496);
    float* GC = (float*)(smem + 108544);
    f32x4 S0 = (f32x4){0.f, 0.f, 0.f, 0.f}, S1 = S0;
    for (int i = tid; i < 2048; i += NTHR) ((unsigned*)SB)[i] = 0u;
    const int ah = wv_ >> 2, lstep = ((tid & 255) >> 4), c4 = (tid & 15) * 4;
    const size_t zoff = (size_t)z * NT * 512;
    const float* g0 = ah ? p.rW + zoff : p.rR;
    const float* g1 = ah ? p.rKK : p.rKD + zoff;
    const float* g2 = ah ? p.rV : p.rBV + zoff;
    const unsigned ldsw = (unsigned)(ah * 4096 + (wv_ & 3) * 1024);
    auto issue = [&](int chunk) {
        const int tok = scan_tok(z, b, chunk * 16 + lstep);
        const size_t o = (size_t)tok * 512 + h * 64 + c4;
        char* bb = smem + (chunk % 3) * 24576 + ldsw;
        __builtin_amdgcn_global_load_lds((const unsigned*)(g0 + o), (__attribute__((address_space(3))) unsigned*)(bb), 16, 0, 0);
        __builtin_amdgcn_global_load_lds((const unsigned*)(g1 + o), (__attribute__((address_space(3))) unsigned*)(bb + 8192), 16, 0, 0);
        __builtin_amdgcn_global_load_lds((const unsigned*)(g2 + o), (__attribute__((address_space(3))) unsigned*)(bb + 16384), 16, 0, 0);
    };
    issue(0); issue(1);
    const int ch = lane, t0 = 2 * wv_, t1 = t0 + 1;
    const int tokdir = z == 0 ? 1 : -1;
    for (int chunk = 0; chunk < 144; ++chunk) {
        if (chunk + 1 < 144) asm volatile("s_waitcnt vmcnt(3)" ::: "memory"); else asm volatile("s_waitcnt vmcnt(0)" ::: "memory");
        __syncthreads();
        if (chunk + 2 < 144) issue(chunk + 2);
        const float* cb = ring + (chunk % 3) * 6144;
        const float w0 = cb[1024 + t0 * 64 + ch], w1 = cb[1024 + t1 * 64 + ch];
        {
            float gb = 1.f, gall = 1.f;
#pragma unroll
            for (int t = 0; t < 16; ++t) { const float wt = cb[1024 + t * 64 + ch]; gall *= wt; if (t < t0) gb *= wt; }
            const float gt0 = gb * w0, gt1 = gt0 * w1;
            const float ig0 = __builtin_amdgcn_rcpf(gt0), ig1 = __builtin_amdgcn_rcpf(gt1);
            const float a0 = -gb * cb[3072 + t0 * 64 + ch], a1 = -gt0 * cb[3072 + t1 * 64 + ch];
            const float r0 = gt0 * cb[t0 * 64 + ch], r1 = gt1 * cb[t1 * 64 + ch];
            const float b0 = cb[4096 + t0 * 64 + ch] * ig0, b1 = cb[4096 + t1 * 64 + ch] * ig1;
            const float k0 = cb[2048 + t0 * 64 + ch] * ig0, k1 = cb[2048 + t1 * 64 + ch] * ig1;
            const float v0 = cb[5120 + t0 * 64 + ch], v1 = cb[5120 + t1 * 64 + ch];
            const int cc = ch >> 3, cw = ch & 7;
            AR[t0 * 64 + ((cc ^ (t0 & 7)) << 3) + cw] = f2bf(a0);
            AR[t1 * 64 + ((cc ^ (t1 & 7)) << 3) + cw] = f2bf(a1);
            AR[(16 + t0) * 64 + ((cc ^ (t0 & 7)) << 3) + cw] = f2bf(r0);
            AR[(16 + t1) * 64 + ((cc ^ (t1 & 7)) << 3) + cw] = f2bf(r1);
            BK[t0 * 64 + ((cc ^ (t0 & 7)) << 3) + cw] = f2bf(b0);
            BK[t1 * 64 + ((cc ^ (t1 & 7)) << 3) + cw] = f2bf(b1);
            BK[(16 + t0) * 64 + ((cc ^ (t0 & 7)) << 3) + cw] = f2bf(k0);
            BK[(16 + t1) * 64 + ((cc ^ (t1 & 7)) << 3) + cw] = f2bf(k1);
            const int sw = (ch >> 2) & 3;
            *(unsigned*)(BKT + ch * 32 + (((t0 >> 3) ^ sw) << 3) + (t0 & 7)) = pack2(b0, b1);
            *(unsigned*)(BKT + ch * 32 + ((((16 + t0) >> 3) ^ sw) << 3) + (t0 & 7)) = pack2(k0, k1);
            *(unsigned*)(VT + ch * 32 + ((((16 + t0) >> 3) ^ sw) << 3) + (t0 & 7)) = pack2(v0, v1);
            if (wv_ == 0) GC[ch] = gall;
        }
        __syncthreads();
        f32x4 G2 = (f32x4){0.f, 0.f, 0.f, 0.f};
        {
            const int rb = wv_ >> 2, vb = wv_ & 3;
            const int ra = 16 * rb + fr, rs = 16 * vb + fr;
#pragma unroll
            for (int ks = 0; ks < 2; ++ks) {
                const int c = ks * 4 + fq;
                const bf16x8 af = *(const bf16x8*)(AR + ra * 64 + ((c ^ (ra & 7)) << 3));
                const bf16x8 sf = *(const bf16x8*)(SB + rs * 64 + ((c ^ (rs & 7)) << 3));
                G2 = __builtin_amdgcn_mfma_f32_16x16x32_bf16(af, sf, G2, 0, 0, 0);
            }
        }
        if (wv_ < 4) {
            const int rb = wv_ >> 1, cbk = wv_ & 1;
            const int ra = 16 * rb + fr, rk = 16 * cbk + fr;
            f32x4 G1 = (f32x4){0.f, 0.f, 0.f, 0.f};
#pragma unroll
            for (int ks = 0; ks < 2; ++ks) {
                const int c = ks * 4 + fq;
                const bf16x8 af = *(const bf16x8*)(AR + ra * 64 + ((c ^ (ra & 7)) << 3));
                const bf16x8 bf = *(const bf16x8*)(BK + rk * 64 + ((c ^ (rk & 7)) << 3));
                G1 = __builtin_amdgcn_mfma_f32_16x16x32_bf16(af, bf, G1, 0, 0, 0);
            }
            if (wv_ == 0) {
                f32x4 m;
#pragma unroll
                for (int j = 0; j < 4; ++j) m[j] = (fr < 4 * fq + j) ? G1[j] : 0.f;
                *(f32x4*)(AM + fr * 16 + 4 * fq) = m;
            } else {
#pragma unroll
                for (int j = 0; j < 4; ++j) {
                    const int t = 4 * fq + j;
                    const bool keep = rb == 0 ? (fr < t) : (fr <= t);
                    AM[wv_ * 256 + t * 16 + fr] = keep ? G1[j] : 0.f;
                }
            }
        }
        __syncthreads();
        if (wv_ < 4) {
            union { bf16x8 v; unsigned u[4]; } af;
            if (fq < 2) {
                const f32x4 x0 = *(const f32x4*)(AM + 256 + fr * 16 + 8 * fq), x1 = *(const f32x4*)(AM + 256 + fr * 16 + 8 * fq + 4);
                af.v = cvt8(x0, x1);
            } else { af.u[0] = 0u; af.u[1] = 0u; af.u[2] = 0u; af.u[3] = 0u; }
            const int rv = 16 * wv_ + fr;
            const bf16x8 vf = *(const bf16x8*)(VT + rv * 32 + (((2 + (fq & 1)) ^ ((rv >> 2) & 3)) << 3));
            G2 = __builtin_amdgcn_mfma_f32_16x16x32_bf16(af.v, vf, G2, 0, 0, 0);
#pragma unroll
            for (int j = 0; j < 4; ++j) RH[(4 * fq + j) * 64 + rv] = G2[j];
        }
        __syncthreads();
        if (wv_ == 0) {
            float x[16];
#pragma unroll
            for (int t = 0; t < 16; ++t) x[t] = RH[t * 64 + lane];
#pragma unroll
            for (int i = 0; i < 15; ++i) {
                const float xi = x[i];
#pragma unroll
                for (int q = 0; q < 4; ++q) {
                    if (4 * q + 3 > i) {
                        const f32x4 acol = *(const f32x4*)(AM + i * 16 + 4 * q);
#pragma unroll
                        for (int j = 0; j < 4; ++j) if (4 * q + j > i) x[4 * q + j] += acol[j] * xi;
                    }
                }
            }
            const int sw = (lane >> 2) & 3;
            *(u32x4*)(VT + lane * 32 + ((0 ^ sw) << 3)) = (u32x4){pack2(x[0], x[1]), pack2(x[2], x[3]), pack2(x[4], x[5]), pack2(x[6], x[7])};
            *(u32x4*)(VT + lane * 32 + ((1 ^ sw) << 3)) = (u32x4){pack2(x[8], x[9]), pack2(x[10], x[11]), pack2(x[12], x[13]), pack2(x[14], x[15])};
        }
        __syncthreads();
        if (wv_ >= 4) {
            const int vb = wv_ & 3, rv = 16 * vb + fr;
            const float* am = AM + (fq < 2 ? 512 : 768) + fr * 16 + 8 * (fq & 1);
            const bf16x8 af = cvt8(*(const f32x4*)am, *(const f32x4*)(am + 4));
            const bf16x8 vf = *(const bf16x8*)(VT + rv * 32 + ((fq ^ ((rv >> 2) & 3)) << 3));
            G2 = __builtin_amdgcn_mfma_f32_16x16x32_bf16(af, vf, G2, 0, 0, 0);
            const int tokbase = scan_tok(z, b, chunk * 16);
#pragma unroll
            for (int j = 0; j < 4; ++j) p.rY[zoff + (size_t)(tokbase + tokdir * (4 * fq + j)) * 512 + h * 64 + rv] = G2[j];
        }
        {
            const int vb = wv_ >> 1, kb0 = 2 * (wv_ & 1);
            const int rv = 16 * vb + fr;
            const bf16x8 uf = *(const bf16x8*)(VT + rv * 32 + ((fq ^ ((rv >> 2) & 3)) << 3));
            const int rk0 = 16 * kb0 + fr, rk1 = rk0 + 16;
            const bf16x8 b0 = *(const bf16x8*)(BKT + rk0 * 32 + ((fq ^ ((rk0 >> 2) & 3)) << 3));
            const bf16x8 b1 = *(const bf16x8*)(BKT + rk1 * 32 + ((fq ^ ((rk1 >> 2) & 3)) << 3));
            S0 = __builtin_amdgcn_mfma_f32_16x16x32_bf16(uf, b0, S0, 0, 0, 0);
            S1 = __builtin_amdgcn_mfma_f32_16x16x32_bf16(uf, b1, S1, 0, 0, 0);
            const float gc0 = GC[rk0], gc1 = GC[rk1];
            S0 *= gc0; S1 *= gc1;
#pragma unroll
            for (int j = 0; j < 4; ++j) {
                const int v = 16 * vb + 4 * fq + j;
                SB[v * 64 + (((rk0 >> 3) ^ (v & 7)) << 3) + (rk0 & 7)] = f2bf(S0[j]);
                SB[v * 64 + (((rk1 >> 3) ^ (v & 7)) << 3) + (rk1 & 7)] = f2bf(S1[j]);
            }
        }
    }
    asm volatile("s_waitcnt vmcnt(0)" ::: "memory");
    __syncthreads();
}

__device__ __forceinline__ float max3_s(float a, float b, float c) { float r; asm("v_max3_f32 %0, %1, %2, %3" : "=v"(r) : "v"(a), "v"(b), "v"(c)); return r; }
__device__ __forceinline__ void attn_item(const Params& p, int b, int h, int q0, bool isctx, char* smem) {
    const int tid = tidx(), lane = tid & 63, wid = tid >> 6, fr = lane & 15, fq = lane >> 4;
    bf16_t* sKV = (bf16_t*)smem;
    const int ntiles = isctx ? (CTXL / 64) : (NKEY / 64);
    bf16x8 qf[2][2];
#pragma unroll
    for (int m = 0; m < 2; ++m) {
        const bf16_t* qp = isctx ? p.Qc + (((size_t)b * 8 + h * 2 + m) * CTXL + q0 + wid * 16 + fr) * 64
                                 : p.Q + (((size_t)b * 8 + h * 2 + m) * SEQ + q0 + wid * 16 + fr) * 64;
        qf[m][0] = *(const bf16x8*)(qp + fq * 8);
        qf[m][1] = *(const bf16x8*)(qp + 32 + fq * 8);
    }
    f32x4 o[2][8];
#pragma unroll
    for (int m = 0; m < 2; ++m)
#pragma unroll
        for (int mb = 0; mb < 8; ++mb) o[m][mb] = (f32x4){0.f, 0.f, 0.f, 0.f};
    float mrun[2] = {0.f, 0.f}, lrun[2] = {0.f, 0.f};
    const int lrow = tid >> 3, lch = tid & 7;
    const bf16_t* kbase = p.Kd + (((size_t)b * 8 + h * 2) * NKEY + lrow) * 64 + lch * 8;
    const bf16_t* vbase = p.Vd + (((size_t)b * 4 + h) * 128 + lrow) * NKEY + lch * 8;
    u32x4 rk[2], rv[2];
#pragma unroll
    for (int i = 0; i < 2; ++i) { rk[i] = *(const u32x4*)(kbase + i * (NKEY * 64)); rv[i] = *(const u32x4*)(vbase + i * (64 * NKEY)); }
    __syncthreads();
#pragma unroll
    for (int i = 0; i < 2; ++i) {
        const int r = lrow + 64 * i;
        const int off = r * 64 + ((lch ^ (r & 7)) << 3);
        *(u32x4*)(sKV + off) = rk[i];
        *(u32x4*)(sKV + 8192 + off) = rv[i];
    }
    if (ntiles > 1) {
#pragma unroll
        for (int i = 0; i < 2; ++i) { rk[i] = *(const u32x4*)(kbase + 4096 + i * (NKEY * 64)); rv[i] = *(const u32x4*)(vbase + 64 + i * (64 * NKEY)); }
    }
    for (int t = 0; t < ntiles; ++t) {
        __syncthreads();
        const bf16_t* sK = sKV + (t & 1) * 16384;
        const bf16_t* sV = sK + 8192;
        if (t + 1 < ntiles) {
            bf16_t* dK = sKV + ((t + 1) & 1) * 16384;
#pragma unroll
            for (int i = 0; i < 2; ++i) {
                const int r = lrow + 64 * i;
                const int off = r * 64 + ((lch ^ (r & 7)) << 3);
                *(u32x4*)(dK + off) = rk[i];
                *(u32x4*)(dK + 8192 + off) = rv[i];
            }
            if (t + 2 < ntiles) {
#pragma unroll
                for (int i = 0; i < 2; ++i) { rk[i] = *(const u32x4*)(kbase + (t + 2) * 4096 + i * (NKEY * 64)); rv[i] = *(const u32x4*)(vbase + (t + 2) * 64 + i * (64 * NKEY)); }
            }
        }
        bf16x8 pf[2][2];
#pragma unroll
        for (int m = 0; m < 2; ++m) {
            f32x4 sc[4];
            const float nm = -mrun[m];
#pragma unroll
            for (int kb = 0; kb < 4; ++kb) {
                sc[kb] = (f32x4){nm, nm, nm, nm};
                const int r = m * 64 + kb * 16 + fr;
#pragma unroll
                for (int ks = 0; ks < 2; ++ks) {
                    const bf16x8 kf = *(const bf16x8*)(sK + r * 64 + (((ks * 4 + fq) ^ (r & 7)) << 3));
                    sc[kb] = __builtin_amdgcn_mfma_f32_16x16x32_bf16(kf, qf[m][ks], sc[kb], 0, 0, 0);
                }
            }
            float mx = max3_s(sc[0][0], sc[0][1], sc[0][2]);
            mx = max3_s(mx, sc[0][3], sc[1][0]); mx = max3_s(mx, sc[1][1], sc[1][2]); mx = max3_s(mx, sc[1][3], sc[2][0]);
            mx = max3_s(mx, sc[2][1], sc[2][2]); mx = max3_s(mx, sc[2][3], sc[3][0]); mx = max3_s(mx, sc[3][1], sc[3][2]);
            mx = fmaxf(mx, sc[3][3]);
            mx = fmaxf(mx, __shfl_xor(mx, 16));
            mx = fmaxf(mx, __shfl_xor(mx, 32));
            if (!__all(mx <= 8.0f)) {
                const float d = mx > 8.0f ? mx : 0.f;
                const float scale = __builtin_amdgcn_exp2f(-d);
                mrun[m] += d;
                lrun[m] *= scale;
#pragma unroll
                for (int mb = 0; mb < 8; ++mb) o[m][mb] *= scale;
#pragma unroll
                for (int kb = 0; kb < 4; ++kb) sc[kb] -= d;
            }
            float ls = 0.f;
#pragma unroll
            for (int kb = 0; kb < 4; ++kb)
#pragma unroll
                for (int j = 0; j < 4; ++j) { const float e = __builtin_amdgcn_exp2f(sc[kb][j]); sc[kb][j] = e; ls += e; }
            lrun[m] += ls;
#pragma unroll
            for (int ksp = 0; ksp < 2; ++ksp) {
                const u32x4 pk = (u32x4){pack2(sc[2 * ksp][0], sc[2 * ksp][1]), pack2(sc[2 * ksp][2], sc[2 * ksp][3]), pack2(sc[2 * ksp + 1][0], sc[2 * ksp + 1][1]), pack2(sc[2 * ksp + 1][2], sc[2 * ksp + 1][3])};
                pf[m][ksp] = __builtin_bit_cast(bf16x8, pk);
            }
        }
#pragma unroll
        for (int ksp = 0; ksp < 2; ++ksp) {
#pragma unroll
            for (int mb = 0; mb < 8; ++mb) {
                const int r = mb * 16 + fr;
                const bf16x8 vfv = *(const bf16x8*)(sV + r * 64 + (((4 * ksp + fq) ^ (r & 7)) << 3));
                o[0][mb] = __builtin_amdgcn_mfma_f32_16x16x32_bf16(vfv, pf[0][ksp], o[0][mb], 0, 0, 0);
                o[1][mb] = __builtin_amdgcn_mfma_f32_16x16x32_bf16(vfv, pf[1][ksp], o[1][mb], 0, 0, 0);
                if ((mb & 3) == 3) asm volatile("" ::: "memory");
            }
        }
    }
    {
        float l0 = lrun[0], l1 = lrun[1];
        l0 += __shfl_xor(l0, 16); l0 += __shfl_xor(l0, 32);
        l1 += __shfl_xor(l1, 16); l1 += __shfl_xor(l1, 32);
        const float i0 = 1.0f / l0, i1 = p.scal[0] / l1;
        float ss = 0.f;
#pragma unroll
        for (int mb = 0; mb < 8; ++mb) {
            o[0][mb] = o[0][mb] * i0 - o[1][mb] * i1;
            ss += o[0][mb][0] * o[0][mb][0] + o[0][mb][1] * o[0][mb][1] + o[0][mb][2] * o[0][mb][2] + o[0][mb][3] * o[0][mb][3];
        }
        ss += __shfl_xor(ss, 16); ss += __shfl_xor(ss, 32);
        const float rstd = rsqrtf(ss * (1.0f / 128.0f) + 1e-6f) * 0.8f;
        const int tok = (isctx ? NX + b * CTXL : b * SEQ) + q0 + wid * 16 + fr;
        bf16_t* dst = p.MG + (size_t)tok * DM + h * 128 + fq * 4;
#pragma unroll
        for (int mb = 0; mb < 8; ++mb) {
            const f32x4 g = *(const f32x4*)(p.da_subln + mb * 16 + fq * 4);
            *(uint2*)(dst + mb * 16) = make_uint2(pack2(o[0][mb][0] * rstd * g[0], o[0][mb][1] * rstd * g[1]), pack2(o[0][mb][2] * rstd * g[2], o[0][mb][3] * rstd * g[3]));
        }
    }
}

#define N_ATT_LAT 512
#define N_ATT_CTX 64
#define N_CONV_LATE (1280 + 256 + 16384 + 8192)
__device__ __forceinline__ ConvDesc conv_late_desc(const Params& p, int pr) {
    const int j = pr * 2 + (tidx() >> 8);
    if (j < 1280) return ConvDesc{p.od_w_in, p.wt_odin, ODC, 1024, j / 80, j % 80, 0, 0};
    if (j < 1536) { const int q = j - 1280; return ConvDesc{p.od_w_out, p.wt_odout, 1024, 1024, q >> 4, q & 15, 0, 0}; }
    if (j < 1536 + 16384) { const int q = j - 1536, mat = q >> 9, t = q & 511; return ConvDesc{p.moe_w_gu + (size_t)mat * 1024 * 2048, p.wt_gu + (size_t)mat * 2048 * 1024, 2048, 1024, t >> 5, t & 31, 1, 0}; }
    const int q = j - 1536 - 16384, mat = q >> 8, t = q & 255;
    return ConvDesc{p.moe_w_dn + (size_t)mat * 1024 * 1024, p.wt_dn + (size_t)mat * 1024 * 1024, 1024, 1024, t >> 4, t & 15, 2, 0};
}
__device__ __forceinline__ ConvDesc conv_l1_desc(const Params& p, int pr) {
    const int j = pr * 2 + (tidx() >> 8);
    if (j < 16384) { const int mat = 32 + (j >> 9), t = j & 511; return ConvDesc{p.moe_w_gu + (size_t)mat * 1024 * 2048, p.wt_gu + (size_t)mat * 2048 * 1024, 2048, 1024, t >> 5, t & 31, 1, 0}; }
    const int q = j - 16384, mat = 32 + (q >> 8), t = q & 255;
    return ConvDesc{p.moe_w_dn + (size_t)mat * 1024 * 1024, p.wt_dn + (size_t)mat * 1024 * 1024, 1024, 1024, t >> 4, t & 15, 2, 0};
}
template <bool L1> __device__ __forceinline__ void conv_group(const Params& p, int g, char* smem) {
    float* lds = (float*)(smem + (tidx() >> 8) * HLDS);
    ConvDesc d = L1 ? conv_l1_desc(p, g * CONV_GRP) : conv_late_desc(p, g * CONV_GRP);
    ConvRegs x = conv_load(d);
#pragma unroll 1
    for (int q = 0; q < CONV_GRP; ++q) {
        ConvDesc dn = d; ConvRegs xn = x;
        if (q + 1 < CONV_GRP) { dn = L1 ? conv_l1_desc(p, g * CONV_GRP + q + 1) : conv_late_desc(p, g * CONV_GRP + q + 1); xn = conv_load(dn); }
        conv_store(x, d, lds);
        d = dn; x = xn;
    }
}
__device__ __forceinline__ void phase_scan_attn(const Params& p, int bid, int nblk, char* smem) {
    for (int it = bid; it < 128; it += nblk) rwkv_chunk_chain(p, it, smem);
    const int n_att = N_ATT_LAT + N_ATT_CTX, n_all = n_att + (N_CONV_LATE / 2) / CONV_GRP;
    for (;;) {
        const int it = q_next(p.counts + 64, smem);
        if (it >= n_all) break;
        if (it < N_ATT_LAT) attn_item(p, it >> 6, (it >> 4) & 3, (it & 15) * 128, false, smem);
        else if (it < n_att) { const int j = it - N_ATT_LAT; attn_item(p, j >> 3, (j >> 1) & 3, (j & 1) * 128, true, smem); }
        else {
            conv_group<false>(p, it - n_att, smem);
        }
    }
}

__device__ __forceinline__ void phase_rw_readout(const Params& p, int bid, int nblk) {
    const int lane = tidx() & 63, wid = tidx() >> 6;
    const int c0 = lane * 8;
    f32x4 rk0 = *(const f32x4*)(p.rw_r_k + c0), rk1 = *(const f32x4*)(p.rw_r_k + c0 + 4);
    f32x4 lw0 = *(const f32x4*)(p.rw_ln_w + c0), lw1 = *(const f32x4*)(p.rw_ln_w + c0 + 4);
    f32x4 lb0 = *(const f32x4*)(p.rw_ln_b + c0), lb1 = *(const f32x4*)(p.rw_ln_b + c0 + 4);
    for (int tok = bid * 8 + wid; tok < NT; tok += nblk * 8) {
        const size_t o = (size_t)tok * 512 + c0, zo = (size_t)NT * 512;
        const f32x4 ya0 = *(const f32x4*)(p.rY + o), ya1 = *(const f32x4*)(p.rY + o + 4), yb0 = *(const f32x4*)(p.rY + zo + o), yb1 = *(const f32x4*)(p.rY + zo + o + 4);
        const f32x4 r0 = *(const f32x4*)(p.rR + o), r1 = *(const f32x4*)(p.rR + o + 4);
        const f32x4 ka0 = *(const f32x4*)(p.rKD + o), ka1 = *(const f32x4*)(p.rKD + o + 4), kb0 = *(const f32x4*)(p.rKD + zo + o), kb1 = *(const f32x4*)(p.rKD + zo + o + 4);
        const f32x4 v0 = *(const f32x4*)(p.rV + o), v1 = *(const f32x4*)(p.rV + o + 4), g0 = *(const f32x4*)(p.rG + o), g1 = *(const f32x4*)(p.rG + o + 4);
        const f32x4 y0 = ya0 + yb0, y1 = ya1 + yb1;
        const float mean = sum8((y0[0] + y0[1]) + (y0[2] + y0[3]) + (y1[0] + y1[1]) + (y1[2] + y1[3])) * (1.0f / 64.0f);
        const f32x4 d0 = y0 - mean, d1 = y1 - mean;
        const float var = sum8((d0[0] * d0[0] + d0[1] * d0[1]) + (d0[2] * d0[2] + d0[3] * d0[3]) + (d1[0] * d1[0] + d1[1] * d1[1]) + (d1[2] * d1[2] + d1[3] * d1[3])) * (1.0f / 64.0f);
        const float rs = rsqrtf(var + 64e-5f);
        const f32x4 b0 = r0 * (ka0 + kb0) * rk0, b1 = r1 * (ka1 + kb1) * rk1;
        const float bon = sum8((b0[0] + b0[1]) + (b0[2] + b0[3]) + (b1[0] + b1[1]) + (b1[2] + b1[3]));
        const f32x4 o0 = (d0 * rs * lw0 + lb0 + bon * v0) * g0, o1 = (d1 * rs * lw1 + lb1 + bon * v1) * g1;
        *(u32x4*)(p.MG + (size_t)tok * DM + 512 + c0) = (u32x4){pack2(o0[0], o0[1]), pack2(o0[2], o0[3]), pack2(o1[0], o1[1]), pack2(o1[2], o1[3])};
    }
}

__device__ __forceinline__ void phase_router(const Params& p, int bid, int nblk, char* smem, int layer, const float* X, int ntok, bool dry = false) {
    const int tid = tidx(), lane = tid & 63, wid = tid >> 6;
    float* hrow = (float*)smem;
    float* part = hrow + 16 * 1028;
    float* logits = part + 8 * 512;
    const float* gain = p.norm2_g + layer * DM;
    const float* modl = p.mod + (size_t)layer * 9 * 6144;
    const float* wr = p.router_w + (size_t)layer * DM * NEXP;
    const float* br = p.router_b + layer * NEXP;
    int* counts = p.counts + layer * NEXP;
    int* lists = p.lists + (size_t)layer * NEXP * NT;
    for (int it = bid; it < ntok / 16; it += nblk) {
        __syncthreads();
#pragma unroll
        for (int u = 0; u < 2; ++u) {
            const int tl = wid * 2 + u, tok = it * 16 + tl;
            const float* xr = X + (size_t)tok * DM;
            const float* mr = modl + modrow(tok) * 6144 + 3072;
            float4 v[4];
            float ss = 0.f;
#pragma unroll
            for (int i = 0; i < 4; ++i) { v[i] = *(const float4*)(xr + lane * 4 + 256 * i); ss += v[i].x * v[i].x + v[i].y * v[i].y + v[i].z * v[i].z + v[i].w * v[i].w; }
            ss = wave_sum(ss);
            const float rstd = rsqrtf(ss * (1.0f / 1024.0f) + 1e-6f);
#pragma unroll
            for (int i = 0; i < 4; ++i) {
                const int c = lane * 4 + 256 * i;
                const float4 g = *(const float4*)(gain + c), sh = *(const float4*)(mr + c), sc = *(const float4*)(mr + 1024 + c);
                float4 a;
                a.x = v[i].x * rstd * g.x * (1.f + sc.x) + sh.x; a.y = v[i].y * rstd * g.y * (1.f + sc.y) + sh.y;
                a.z = v[i].z * rstd * g.z * (1.f + sc.z) + sh.z; a.w = v[i].w * rstd * g.w * (1.f + sc.w) + sh.w;
                *(uint2*)(p.H + (size_t)tok * DM + c) = make_uint2(pack2(a.x, a.y), pack2(a.z, a.w));
                *(float4*)(hrow + tl * 1028 + c) = a;
            }
        }
        __syncthreads();
        {
            const int tokl = lane & 15, kq = lane >> 4;
            f32x4 c0 = (f32x4){0.f, 0.f, 0.f, 0.f}, c1 = c0;
            const float* hp = hrow + tokl * 1028 + wid * 128 + kq;
            const float* wp = wr + (size_t)(wid * 128 + kq) * 32 + tokl;
#pragma unroll 8
            for (int ks = 0; ks < 32; ++ks) {
                const float a = hp[ks * 4];
                const float b0 = wp[ks * 128], b1 = wp[ks * 128 + 16];
                c0 = __builtin_amdgcn_mfma_f32_16x16x4f32(a, b0, c0, 0, 0, 0);
                c1 = __builtin_amdgcn_mfma_f32_16x16x4f32(a, b1, c1, 0, 0, 0);
            }
#pragma unroll
            for (int j = 0; j < 4; ++j) {
                part[wid * 512 + (4 * kq + j) * 32 + tokl] = c0[j];
                part[wid * 512 + (4 * kq + j) * 32 + 16 + tokl] = c1[j];
            }
        }
        __syncthreads();
        {
            const int tl = tid >> 5, e = tid & 31;
            float a = br[e];
#pragma unroll
            for (int w = 0; w < 8; ++w) a += part[w * 512 + tl * 32 + e];
            logits[tl * 32 + e] = a;
        }
        __syncthreads();
        if (tid < 16) {
            const int tok = it * 16 + tid;
            float lv[32];
#pragma unroll
            for (int e = 0; e < 32; ++e) lv[e] = logits[tid * 32 + e];
            float tv[4]; int te[4];
#pragma unroll
            for (int k = 0; k < 4; ++k) {
                float best = -3.0e38f; int bi = 0;
#pragma unroll
                for (int e = 0; e < 32; ++e) { if (lv[e] > best) { best = lv[e]; bi = e; } }
                tv[k] = best; te[k] = bi;
#pragma unroll
                for (int e = 0; e < 32; ++e) { if (e == bi) lv[e] = -3.0e38f; }
            }
            const float e1 = __expf(tv[1] - tv[0]), e2 = __expf(tv[2] - tv[0]), e3 = __expf(tv[3] - tv[0]);
            const float inv = 1.0f / (1.0f + e1 + e2 + e3);
            const float gt[4] = {inv, e1 * inv, e2 * inv, e3 * inv};
#pragma unroll
            for (int k = 0; k < 4; ++k) {
                p.GATE[(size_t)tok * 4 + k] = gt[k];
                if (!dry) {
                    const int pos = atomicAdd(&counts[te[k]], 1);
                    lists[(size_t)te[k] * NT + pos] = tok * 4 + k;
                }
            }
        }
    }
}

struct EpiGU {
    const float* bias; bf16_t* act; int pos0; int unit0;
    __device__ __forceinline__ void pair(int r, int cu, f32x4 g, f32x4 u) const {
        const int unit = unit0 + cu;
        unsigned w[2]; float o[4];
#pragma unroll
        for (int j = 0; j < 4; ++j) {
            const float gate = fminf(g[j] + bias[unit + j], 7.0f);
            const float up = fminf(fmaxf(u[j] + bias[1024 + unit + j], -7.0f), 7.0f);
            o[j] = (up + 1.0f) * gate * sigmoidf_(1.702f * gate);
        }
        w[0] = pack2(o[0], o[1]); w[1] = pack2(o[2], o[3]);
        *(uint2*)(act + (size_t)(pos0 + r) * 1024 + unit) = make_uint2(w[0], w[1]);
    }
};
struct MoeIter {
    int cnt[4], off[4], tiles[4], ntn, i, step, g;
    __device__ __forceinline__ void init(const int* counts, int NTN, int bid, int nblk) {
        g = bid & 7; i = (bid >> 3) * 2 + (tidx() >> 8); step = (nblk >> 3) * 2; ntn = NTN;
        int o = 0;
#pragma unroll
        for (int q = 0; q < 4; ++q) { cnt[q] = 0; off[q] = 0; tiles[q] = 0; }
        for (int e = 0; e < NEXP; ++e) {
            const int c = counts[e];
            if ((e & 7) == g) {
                const int q = e >> 3;
#pragma unroll
                for (int qq = 0; qq < 4; ++qq) if (qq == q) { cnt[qq] = c; off[qq] = o; tiles[qq] = ((c + 127) >> 7) * NTN; }
            }
            o += c;
        }
    }
    __device__ __forceinline__ bool next(int& e, int& mt, int& nt, int& eoff, int& ecnt) {
        int j = i, q = 0;
        if (j >= tiles[0]) { j -= tiles[0]; q = 1; if (j >= tiles[1]) { j -= tiles[1]; q = 2; if (j >= tiles[2]) { j -= tiles[2]; q = 3; if (j >= tiles[3]) return false; } } }
        int c = cnt[0], o = off[0];
        if (q == 1) { c = cnt[1]; o = off[1]; } else if (q == 2) { c = cnt[2]; o = off[2]; } else if (q == 3) { c = cnt[3]; o = off[3]; }
        const int mcnt = (c + 127) >> 7, full = mcnt >> 3, band = 8 * ntn;
        if (j < full * band) { const int ms = j / band, r = j - ms * band; nt = r >> 3; mt = ms * 8 + (r & 7); }
        else { const int rem = mcnt - full * 8, jj = j - full * band; nt = jj / rem; mt = full * 8 + (jj - nt * rem); }
        e = q * 8 + g; eoff = o; ecnt = c;
        i += step;
        return true;
    }
};

struct PlainOrder8 {
    const char* A; const char* Bt; int K;
    int mg0, mcnt, ntn, total, full, i, step;
    __device__ __forceinline__ void init(const bf16_t* A_, const bf16_t* Bt_, int K_, int MT, int NTN, int bid, int nblk) {
        A = (const char*)A_; Bt = (const char*)Bt_; K = K_;
        const int g = bid & 7;
        mg0 = (MT * g) >> 3; mcnt = ((MT * (g + 1)) >> 3) - mg0; ntn = NTN; total = mcnt * NTN; full = mcnt >> 3; i = bid >> 3; step = nblk >> 3;
    }
    __device__ __forceinline__ bool next(g8::Unit& u) {
        if (i >= total) return false;
        int mt, nt;
        const int band = 8 * ntn;
        if (i < full * band) { const int ms = i / band, r = i - ms * band; nt = r >> 3; mt = mg0 + ms * 8 + (r & 7); }
        else { const int rem = mcnt - full * 8, j = i - full * band; nt = j / rem; mt = mg0 + full * 8 + (j - nt * rem); }
        i += step;
        u.a = A + (size_t)mt * 256 * K * 2; u.b = Bt + (size_t)nt * 256 * K * 2; u.gidx = nullptr; u.idx = nullptr; u.shift = 0; u.rows = 256; u.i0 = mt * 256; u.i1 = nt * 256; u.i2 = 0;
        return true;
    }
};
struct Epi8Store {
    float* C; int ldc;
    __device__ __forceinline__ void operator()(const f32x4 (&acc)[2][2][4][2], const g8::Unit& u, int wr, int wc, int fr, int fq) const {
#pragma unroll
        for (int ai = 0; ai < 2; ++ai)
#pragma unroll
            for (int m = 0; m < 4; ++m) {
                float* rowp = C + (size_t)(u.i0 + ai * 128 + wr * 64 + m * 16 + fr) * ldc + u.i1 + wc * 32 + fq * 4;
#pragma unroll
                for (int bj = 0; bj < 2; ++bj)
#pragma unroll
                    for (int n = 0; n < 2; ++n) *(f32x4*)(rowp + bj * 128 + n * 16) = acc[ai][bj][m][n];
            }
    }
};
struct Epi8StoreBf {
    bf16_t* C; int ldc;
    __device__ __forceinline__ void operator()(const f32x4 (&acc)[2][2][4][2], const g8::Unit& u, int wr, int wc, int fr, int fq) const {
#pragma unroll
        for (int ai = 0; ai < 2; ++ai)
#pragma unroll
            for (int m = 0; m < 4; ++m) {
                bf16_t* rowp = C + (size_t)(u.i0 + ai * 128 + wr * 64 + m * 16 + fr) * ldc + u.i1 + wc * 32 + fq * 8;
#pragma unroll
                for (int bj = 0; bj < 2; ++bj) {
                    const f32x4 v0 = acc[ai][bj][m][0], v1 = acc[ai][bj][m][1];
                    *(u32x4*)(rowp + bj * 128) = (u32x4){pack2(v0[0], v0[1]), pack2(v0[2], v0[3]), pack2(v1[0], v1[1]), pack2(v1[2], v1[3])};
                }
            }
    }
};
struct Epi8StoreHg {
    float* C; const float* hg_lb;
    __device__ __forceinline__ void operator()(const f32x4 (&acc)[2][2][4][2], const g8::Unit& u, int wr, int wc, int fr, int fq) const {
        const int c0 = u.i1 + wc * 32 + fq * 4;
        const int kind = u.i1 < 1024 ? 0 : (u.i1 < 3072 ? 1 : 2);
        f32x4 lbv[2][2];
        if (kind == 1) {
#pragma unroll
            for (int bj = 0; bj < 2; ++bj)
#pragma unroll
                for (int n = 0; n < 2; ++n) {
                    const int ch = (c0 + bj * 128 + n * 16) & 1023;
                    const f32x4 h0 = *(const f32x4*)(hg_lb + ch), h1 = *(const f32x4*)(hg_lb + 1024 + ch);
#pragma unroll
                    for (int j = 0; j < 4; ++j) lbv[bj][n][j] = __builtin_amdgcn_rcpf(1.0f + __expf(h0[j] - h1[j]));
                }
        }
#pragma unroll
        for (int ai = 0; ai < 2; ++ai)
#pragma unroll
            for (int m = 0; m < 4; ++m) {
                float* rowp = C + (size_t)(u.i0 + ai * 128 + wr * 64 + m * 16 + fr) * ODC + c0;
#pragma unroll
                for (int bj = 0; bj < 2; ++bj)
#pragma unroll
                    for (int n = 0; n < 2; ++n) {
                        f32x4 v = acc[ai][bj][m][n];
                        if (kind == 0) {
#pragma unroll
                            for (int j = 0; j < 4; ++j) v[j] = siluf_(v[j]);
                        } else if (kind == 1) {
#pragma unroll
                            for (int j = 0; j < 4; ++j) { const float lb = lbv[bj][n][j]; v[j] = lb + (1.f - lb) * sigmoidf_(v[j]); }
                        }
                        *(f32x4*)(rowp + bj * 128 + n * 16) = v;
                    }
                asm volatile("" ::: "memory");
            }
    }
};
struct Epi8Resid {
    const float* xin_lat; const float* xin_ctx; float* xout; const float* gmod;
    __device__ __forceinline__ void operator()(const f32x4 (&acc)[2][2][4][2], const g8::Unit& u, int wr, int wc, int fr, int fq) const {
        const int c0 = u.i1 + wc * 32 + fq * 4;
        const float* gr = gmod + modrow(u.i0) * 6144 + c0;
        f32x4 g[2][2];
#pragma unroll
        for (int bj = 0; bj < 2; ++bj)
#pragma unroll
            for (int n = 0; n < 2; ++n) g[bj][n] = *(const f32x4*)(gr + bj * 128 + n * 16);
#pragma unroll
        for (int ai = 0; ai < 2; ++ai)
#pragma unroll
            for (int m = 0; m < 4; ++m) {
                const int tok = u.i0 + ai * 128 + wr * 64 + m * 16 + fr;
                const float* xr = (tok < NX ? xin_lat + (size_t)tok * DM : xin_ctx + (size_t)(tok - NX) * DM) + c0;
                float* orow = xout + (size_t)tok * DM + c0;
                f32x4 xi[2][2];
#pragma unroll
                for (int bj = 0; bj < 2; ++bj)
#pragma unroll
                    for (int n = 0; n < 2; ++n) xi[bj][n] = *(const f32x4*)(xr + bj * 128 + n * 16);
#pragma unroll
                for (int bj = 0; bj < 2; ++bj)
#pragma unroll
                    for (int n = 0; n < 2; ++n) *(f32x4*)(orow + bj * 128 + n * 16) = xi[bj][n] + g[bj][n] * acc[ai][bj][m][n];
                asm volatile("" ::: "memory");
            }
    }
};
struct MoeOrder8 {
    int cvec;
    const int* lists; const char* A; const char* W; int wrows, ntn, i, step, g;
    bool gather;
    __device__ __forceinline__ void init(const int* counts_, const int* lists_, const bf16_t* A_, const bf16_t* W_, int wrows_, bool gather_, int bid, int nblk) {
        cvec = counts_[tidx() & 31]; lists = lists_; A = (const char*)A_; W = (const char*)W_; wrows = wrows_; ntn = wrows_ / 256; gather = gather_;
        g = bid & 7; i = bid >> 3; step = nblk >> 3;
    }
    __device__ __forceinline__ bool next(g8::Unit& u) {
        int j = i, o = 0, fe = -1, fo = 0, fc = 0, fm = 1;
#pragma unroll
        for (int e = 0; e < NEXP; ++e) {
            const int c = __builtin_amdgcn_readlane(cvec, e);
            if ((e & 7) == g && fe < 0) {
                const int mcnt = (c + 255) >> 8, t = mcnt * ntn;
                if (j < t) { fe = e; fo = o; fc = c; fm = mcnt; }
                else j -= t;
            }
            o += c;
        }
        if (fe < 0) return false;
        const int nt = j / fm, mt = j - nt * fm;
        i += step;
        u.idx = lists + (size_t)fe * NT + mt * 256; u.gidx = gather ? u.idx : nullptr; u.rows = min(256, fc - mt * 256); u.shift = 2;
        u.a = gather ? A : A + (size_t)(fo + mt * 256) * 1024 * 2;
        u.b = W + ((size_t)fe * wrows + (size_t)nt * 256) * 1024 * 2;
        u.i0 = fo + mt * 256;
        u.i1 = nt;
        u.i2 = fe;
        return true;
    }
};
struct Epi8GU {
    const float* bias; bf16_t* act;
    __device__ __forceinline__ void operator()(const f32x4 (&acc)[2][2][4][2], const g8::Unit& u, int wr, int wc, int fr, int fq) const {
        const float* be = bias + (size_t)u.i2 * 2048;
        const int unit = u.i1 * 128 + wc * 32 + fq * 8;
        const f32x4 bg0 = *(const f32x4*)(be + unit), bg1 = *(const f32x4*)(be + unit + 4), bu0 = *(const f32x4*)(be + 1024 + unit), bu1 = *(const f32x4*)(be + 1024 + unit + 4);
#pragma unroll
        for (int ai = 0; ai < 2; ++ai)
#pragma unroll
            for (int m = 0; m < 4; ++m) {
                const int r = ai * 128 + wr * 64 + m * 16 + fr;
                if (r < u.rows) {
                    float o[8];
#pragma unroll
                    for (int bj = 0; bj < 2; ++bj) {
                        const f32x4 g = acc[ai][bj][m][0] + (bj ? bg1 : bg0), up = acc[ai][bj][m][1] + (bj ? bu1 : bu0);
#pragma unroll
                        for (int j = 0; j < 4; ++j) {
                            const float gate = fminf(g[j], 7.0f);
                            const float uu = fminf(fmaxf(up[j], -7.0f), 7.0f);
                            o[bj * 4 + j] = (uu + 1.0f) * gate * sigmoidf_(1.702f * gate);
                        }
                    }
                    *(u32x4*)(act + (size_t)(u.i0 + r) * 1024 + unit) = (u32x4){pack2(o[0], o[1]), pack2(o[2], o[3]), pack2(o[4], o[5]), pack2(o[6], o[7])};
                }
                asm volatile("" ::: "memory");
            }
    }
};
struct Epi8DN {
    const float* bias; bf16_t* ys;
    __device__ __forceinline__ void operator()(const f32x4 (&acc)[2][2][4][2], const g8::Unit& u, int wr, int wc, int fr, int fq) const {
        const int cb = u.i1 * 256 + wc * 32 + fq * 8;
        const float* be = bias + (size_t)u.i2 * 1024 + cb;
        const f32x4 b00 = *(const f32x4*)(be), b01 = *(const f32x4*)(be + 4), b10 = *(const f32x4*)(be + 128), b11 = *(const f32x4*)(be + 132);
#pragma unroll
        for (int ai = 0; ai < 2; ++ai)
#pragma unroll
            for (int m = 0; m < 4; ++m) {
                const int r = ai * 128 + wr * 64 + m * 16 + fr;
                if (r < u.rows) {
                    const int a = u.idx[r];
                    bf16_t* orow = ys + (size_t)a * 1024 + cb;
#pragma unroll
                    for (int bj = 0; bj < 2; ++bj) {
                        const f32x4 v0 = acc[ai][bj][m][0] + (bj ? b10 : b00), v1 = acc[ai][bj][m][1] + (bj ? b11 : b01);
                        *(u32x4*)(orow + bj * 128) = (u32x4){pack2(v0[0], v0[1]), pack2(v0[2], v0[3]), pack2(v1[0], v1[1]), pack2(v1[2], v1[3])};
                    }
                }
                asm volatile("" ::: "memory");
            }
    }
};
__device__ __forceinline__ void phase_gemm8_store(const bf16_t* A, int M, const bf16_t* Wt, int N, float* C, int bid, int nblk, char* smem) {
    PlainOrder8 S; S.init(A, Wt, DM, M / 256, N / 256, bid, nblk);
    Epi8Store E{C, N};
    g8::gemm_phase((G8_LAS unsigned char*)smem, DM, S, E);
}
__device__ __forceinline__ void phase_gemm8_store_bf(const bf16_t* A, int M, const bf16_t* Wt, int N, bf16_t* C, int bid, int nblk, char* smem) {
    PlainOrder8 S; S.init(A, Wt, DM, M / 256, N / 256, bid, nblk);
    Epi8StoreBf E{C, N};
    g8::gemm_phase((G8_LAS unsigned char*)smem, DM, S, E);
}
__device__ __forceinline__ void phase_gemm8_store_hg(const Params& p, int bid, int nblk, char* smem) {
    PlainOrder8 S; S.init(p.H, p.wt_odin, DM, NT / 256, ODC / 256, bid, nblk);
    Epi8StoreHg E{p.P, p.hg_lb};
    g8::gemm_phase((G8_LAS unsigned char*)smem, DM, S, E);
}
__device__ __forceinline__ void phase_outproj8(const Params& p, int bid, int nblk, char* smem, const bf16_t* Wt, int ntok, const float* xin_lat, const float* xin_ctx, float* xout, const float* gmod) {
    PlainOrder8 S; S.init(p.MG, Wt, DM, ntok / 256, 4, bid, nblk);
    Epi8Resid E{xin_lat, xin_ctx, xout, gmod};
    g8::gemm_phase((G8_LAS unsigned char*)smem, DM, S, E);
}
__device__ __forceinline__ void phase_moe_gu8(const Params& p, int bid, int nblk, char* smem, int layer) {
    MoeOrder8 S; S.init(p.counts + layer * NEXP, p.lists + (size_t)layer * NEXP * NT, p.H, p.wt_gu + (size_t)layer * NEXP * 2048 * 1024, 2048, true, bid, nblk);
    Epi8GU E{p.moe_b_gu + (size_t)layer * NEXP * 2048, p.ACT};
    g8::gemm_phase((G8_LAS unsigned char*)smem, DM, S, E);
}
__device__ __forceinline__ void phase_moe_dn8(const Params& p, int bid, int nblk, char* smem, int layer) {
    MoeOrder8 S; S.init(p.counts + layer * NEXP, p.lists + (size_t)layer * NEXP * NT, p.ACT, p.wt_dn + (size_t)layer * NEXP * 1024 * 1024, 1024, false, bid, nblk);
    Epi8DN E{p.moe_b_dn + (size_t)layer * NEXP * 1024, p.YS};
    g8::gemm_phase((G8_LAS unsigned char*)smem, DM, S, E);
}

__device__ __forceinline__ void phase_combine(const Params& p, int bid, int nblk, const float* Xin, float* Xout, const float* gmod  , int ntok,
                              bool do_norm, const float* gain, const float* modn) {
    const int lane = tidx() & 63, wid = tidx() >> 6;
    for (int tok = bid * 8 + wid; tok < ntok; tok += nblk * 8) {
        const float* gr = gmod + modrow(tok) * 6144;
        const float g0 = p.GATE[(size_t)tok * 4 + 0], g1 = p.GATE[(size_t)tok * 4 + 1], g2 = p.GATE[(size_t)tok * 4 + 2], g3 = p.GATE[(size_t)tok * 4 + 3];
        const bf16_t* ys = p.YS + (size_t)tok * 4 * 1024;
        float4 v[4];
        float ss = 0.f;
#pragma unroll
        for (int i = 0; i < 4; ++i) {
            const int c = lane * 4 + 256 * i;
            const float4 xi = *(const float4*)(Xin + (size_t)tok * DM + c), gg = *(const float4*)(gr + c);
            float4 y0, y1, y2, y3;
            { const uint2 u0 = *(const uint2*)(ys + c), u1 = *(const uint2*)(ys + 1024 + c), u2 = *(const uint2*)(ys + 2048 + c), u3 = *(const uint2*)(ys + 3072 + c);
              y0 = make_float4(__uint_as_float(u0.x << 16), __uint_as_float(u0.x & 0xffff0000u), __uint_as_float(u0.y << 16), __uint_as_float(u0.y & 0xffff0000u));
              y1 = make_float4(__uint_as_float(u1.x << 16), __uint_as_float(u1.x & 0xffff0000u), __uint_as_float(u1.y << 16), __uint_as_float(u1.y & 0xffff0000u));
              y2 = make_float4(__uint_as_float(u2.x << 16), __uint_as_float(u2.x & 0xffff0000u), __uint_as_float(u2.y << 16), __uint_as_float(u2.y & 0xffff0000u));
              y3 = make_float4(__uint_as_float(u3.x << 16), __uint_as_float(u3.x & 0xffff0000u), __uint_as_float(u3.y << 16), __uint_as_float(u3.y & 0xffff0000u)); }
            v[i].x = xi.x + gg.x * (g0 * y0.x + g1 * y1.x + g2 * y2.x + g3 * y3.x);
            v[i].y = xi.y + gg.y * (g0 * y0.y + g1 * y1.y + g2 * y2.y + g3 * y3.y);
            v[i].z = xi.z + gg.z * (g0 * y0.z + g1 * y1.z + g2 * y2.z + g3 * y3.z);
            v[i].w = xi.w + gg.w * (g0 * y0.w + g1 * y1.w + g2 * y2.w + g3 * y3.w);
            *(float4*)(Xout + (size_t)tok * DM + c) = v[i];
            ss += v[i].x * v[i].x + v[i].y * v[i].y + v[i].z * v[i].z + v[i].w * v[i].w;
        }
        if (do_norm) {
            ss = wave_sum(ss);
            const float rstd = rsqrtf(ss * (1.0f / 1024.0f) + 1e-6f);
            const float* mr = modn + modrow(tok) * 6144;
#pragma unroll
            for (int i = 0; i < 4; ++i) {
                const int c = lane * 4 + 256 * i;
                const float4 g = *(const float4*)(gain + c), sh = *(const float4*)(mr + c), sc = *(const float4*)(mr + 1024 + c);
                const float a0 = v[i].x * rstd * g.x * (1.f + sc.x) + sh.x, a1 = v[i].y * rstd * g.y * (1.f + sc.y) + sh.y;
                const float a2 = v[i].z * rstd * g.z * (1.f + sc.z) + sh.z, a3 = v[i].w * rstd * g.w * (1.f + sc.w) + sh.w;
                *(uint2*)(p.H + (size_t)tok * DM + c) = make_uint2(pack2(a0, a1), pack2(a2, a3));
            }
        }
    }
}

__device__ __forceinline__ bf16x8 pack8(const f32x4 a, const f32x4 b) {
    union { bf16x8 v; unsigned u[4]; } r;
    r.u[0] = pack2(a[0], a[1]); r.u[1] = pack2(a[2], a[3]); r.u[2] = pack2(b[0], b[1]); r.u[3] = pack2(b[2], b[3]);
    return r.v;
}
__device__ __forceinline__ void hgrn_chain(const Params& p, int chain, char* smem) {
    const int z = chain >> 6, b = (chain >> 3) & 7, h = chain & 7;
    const int tid = tidx(), lane = tid & 63, wid = tid >> 6, fr = lane & 15, fq = lane >> 4;
    bf16_t* sQ = (bf16_t*)smem;
    bf16_t* sK = sQ + 32 * 128;
    bf16_t* sKL = sK + 32 * 128;
    bf16_t* sV = sKL + 128 * 32;
    float* sT = (float*)(sV + 128 * 32);
    float* sEBL = sT + 512;
    const int ch = tid & 127, th = tid >> 7;
    f32x4 S[8];
#pragma unroll
    for (int mi = 0; mi < 8; ++mi) S[mi] = (f32x4){0.f, 0.f, 0.f, 0.f};
    float qA[8], fA[8], iA[8], qB[8], fB[8], iB[8];
    auto issue = [&](int chunk, float (&rq)[8], float (&rf)[8], float (&ri)[8]) {
        const int tok0 = scan_tok(z, b, chunk * 32 + th * 8);
        const float* pr = p.P + (size_t)tok0 * ODC + h * 128 + ch;
        const int stride = z == 0 ? ODC : -ODC;
#pragma unroll
        for (int i = 0; i < 8; ++i) {
            rq[i] = pr[0]; rf[i] = pr[1024 * (1 + z)]; ri[i] = pr[3072];
            pr += stride;
        }
    };
    issue(0, qA, fA, iA);
    issue(1, qB, fB, iB);
    auto body = [&](int chunk, float (&rq)[8], float (&rf)[8], float (&ri)[8]) {
        float bc[8];
        {
            float run = 1.f;
#pragma unroll
            for (int i = 0; i < 8; ++i) {
                const float f = rf[i];
                rf[i] = 1.f - f;
                run *= f;
                bc[i] = run;
            }
            sT[th * 128 + ch] = run;
        }
        __syncthreads();
        {
            const float t0 = sT[ch], t1 = sT[128 + ch], t2 = sT[256 + ch], t3 = sT[384 + ch];
            const float boff = th == 0 ? 1.f : (th == 1 ? t0 : (th == 2 ? t0 * t1 : t0 * t1 * t2));
            const float ebl = (t0 * t1) * (t2 * t3);
            if (th == 0) sEBL[ch] = ebl;
            unsigned wkl[4], wv[4];
            float klp = 0.f, vp = 0.f;
#pragma unroll
            for (int i = 0; i < 8; ++i) {
                const int t = th * 8 + i;
                const float eb = bc[i] * boff;
                const float emb = __builtin_amdgcn_rcpf(eb);
                const float qe = rq[i] * eb;
                const float ke = rf[i] * emb;
                const float kl = ke * ebl;
                const int off = t * 128 + (((ch >> 3) ^ (t & 15)) << 3) + (ch & 7);
                sQ[off] = f2bf(qe);
                sK[off] = f2bf(ke);
                if (i & 1) { wkl[i >> 1] = pack2(klp, kl); wv[i >> 1] = pack2(vp, ri[i]); } else { klp = kl; vp = ri[i]; }
            }
            const int sw = (ch >> 2) & 3;
            *(u32x4*)(sKL + ch * 32 + ((th ^ sw) << 3)) = (u32x4){wkl[0], wkl[1], wkl[2], wkl[3]};
            *(u32x4*)(sV + ch * 32 + ((th ^ sw) << 3)) = (u32x4){wv[0], wv[1], wv[2], wv[3]};
        }
        __syncthreads();
        if (chunk + 2 < 72) issue(chunk + 2, rq, rf, ri);
        f32x4 sc00 = (f32x4){0.f, 0.f, 0.f, 0.f}, sc01 = sc00, sc11 = sc00;
#pragma unroll
        for (int ks = 0; ks < 4; ++ks) {
            const int c = ks * 4 + fq;
            const bf16x8 k0 = *(const bf16x8*)(sK + fr * 128 + ((c ^ fr) << 3));
            const bf16x8 k1 = *(const bf16x8*)(sK + (16 + fr) * 128 + ((c ^ fr) << 3));
            const bf16x8 q0 = *(const bf16x8*)(sQ + fr * 128 + ((c ^ fr) << 3));
            const bf16x8 q1 = *(const bf16x8*)(sQ + (16 + fr) * 128 + ((c ^ fr) << 3));
            sc00 = __builtin_amdgcn_mfma_f32_16x16x32_bf16(k0, q0, sc00, 0, 0, 0);
            sc01 = __builtin_amdgcn_mfma_f32_16x16x32_bf16(k0, q1, sc01, 0, 0, 0);
            sc11 = __builtin_amdgcn_mfma_f32_16x16x32_bf16(k1, q1, sc11, 0, 0, 0);
        }
#pragma unroll
        for (int j = 0; j < 4; ++j) { if (4 * fq + j > fr) { sc00[j] = 0.f; sc11[j] = 0.f; } }
        const f32x4 zero4 = (f32x4){0.f, 0.f, 0.f, 0.f};
        const bf16x8 pf0 = pack8(sc00, zero4), pf1 = pack8(sc01, sc11);
        asm volatile("" ::: "memory");
        f32x4 o[2];
        o[0] = zero4; o[1] = zero4;
        const int r0 = wid * 16 + fr;
        {
            union { bf16x8 v; uint2 u[2]; } vp0;
            vp0.u[0] = *(const uint2*)(sV + r0 * 32 + ((((fq >> 1)) ^ ((r0 >> 2) & 3)) << 3) + (fq & 1) * 4);
            vp0.u[1] = *(const uint2*)(sV + r0 * 32 + (((2 + (fq >> 1)) ^ ((r0 >> 2) & 3)) << 3) + (fq & 1) * 4);
            o[0] = __builtin_amdgcn_mfma_f32_16x16x32_bf16(vp0.v, pf0, o[0], 0, 0, 0);
            o[1] = __builtin_amdgcn_mfma_f32_16x16x32_bf16(vp0.v, pf1, o[1], 0, 0, 0);
        }
#pragma unroll
        for (int kp = 0; kp < 4; ++kp) {
            const bf16x8 sf0 = pack8(S[2 * kp], S[2 * kp + 1]);
            const int c0 = 4 * kp + (fq >> 1), c1 = c0 + 2;
            union { bf16x8 v; uint2 u[2]; } qa, qb;
            qa.u[0] = *(const uint2*)(sQ + fr * 128 + ((c0 ^ fr) << 3) + (fq & 1) * 4);
            qa.u[1] = *(const uint2*)(sQ + fr * 128 + ((c1 ^ fr) << 3) + (fq & 1) * 4);
            qb.u[0] = *(const uint2*)(sQ + (16 + fr) * 128 + ((c0 ^ fr) << 3) + (fq & 1) * 4);
            qb.u[1] = *(const uint2*)(sQ + (16 + fr) * 128 + ((c1 ^ fr) << 3) + (fq & 1) * 4);
            o[0] = __builtin_amdgcn_mfma_f32_16x16x32_bf16(sf0, qa.v, o[0], 0, 0, 0);
            o[1] = __builtin_amdgcn_mfma_f32_16x16x32_bf16(sf0, qb.v, o[1], 0, 0, 0);
        }
        if (chunk >= 8) {
#pragma unroll
            for (int tb = 0; tb < 2; ++tb) {
                const int tok = scan_tok(z, b, chunk * 32 + tb * 16 + fr);
                *(f32x4*)(p.HO + ((size_t)z * NX + tok) * 1024 + h * 128 + wid * 16 + fq * 4) = o[tb];
            }
        }
        asm volatile("" ::: "memory");
        {
            const bf16x8 v0 = *(const bf16x8*)(sV + r0 * 32 + ((fq ^ ((r0 >> 2) & 3)) << 3));
#pragma unroll
            for (int mi = 0; mi < 8; ++mi) {
                const int r = mi * 16 + fr;
                const bf16x8 kl = *(const bf16x8*)(sKL + r * 32 + ((fq ^ ((r >> 2) & 3)) << 3));
                const f32x4 e = *(const f32x4*)(sEBL + mi * 16 + fq * 4);
                S[mi] = __builtin_amdgcn_mfma_f32_16x16x32_bf16(kl, v0, S[mi] * e, 0, 0, 0);
            }
        }
    };
    for (int chunk = 0; chunk < 72; chunk += 2) { body(chunk, qA, fA, iA); body(chunk + 1, qB, fB, iB); }
    __syncthreads();
}
__device__ __forceinline__ void phase_hgrn(const Params& p, int bid, int nblk, char* smem) {
    for (int it = bid; it < 128; it += nblk) hgrn_chain(p, it, smem);
    const int n_all = ((16384 + 8192) / 2) / CONV_GRP;
    for (;;) {
        const int it = q_next(p.counts + 65, smem);
        if (it >= n_all) break;
        conv_group<true>(p, it, smem);
    }
}
__device__ __forceinline__ void phase_hgrn_readout(const Params& p, int bid, int nblk) {
    const int lane = tidx() & 63, wid = tidx() >> 6;
    const int c0 = lane * 8;
    const f32x4 n0 = *(const f32x4*)(p.hg_norm + (c0 & 127)), n1 = *(const f32x4*)(p.hg_norm + (c0 & 127) + 4);
    for (int tok = bid * 8 + wid; tok < NX; tok += nblk * 8) {
#pragma unroll
        for (int q = 0; q < 2; ++q) {
            const size_t o = (size_t)tok * 1024 + q * 512 + c0, zo = (size_t)NX * 1024;
            const f32x4 y0 = *(const f32x4*)(p.HO + o) + *(const f32x4*)(p.HO + zo + o), y1 = *(const f32x4*)(p.HO + o + 4) + *(const f32x4*)(p.HO + zo + o + 4);
            const f32x4 g0 = *(const f32x4*)(p.P + (size_t)tok * ODC + 4096 + q * 512 + c0), g1 = *(const f32x4*)(p.P + (size_t)tok * ODC + 4096 + q * 512 + c0 + 4);
            float ss = sum8((y0[0] * y0[0] + y0[1] * y0[1]) + (y0[2] * y0[2] + y0[3] * y0[3]) + (y1[0] * y1[0] + y1[1] * y1[1]) + (y1[2] * y1[2] + y1[3] * y1[3]));
            ss += dpp_f<0x140>(ss);
            const float rstd = rsqrtf(ss * (1.0f / 128.0f) + 1e-6f);
            float r[8];
#pragma unroll
            for (int j = 0; j < 4; ++j) { r[j] = y0[j] * rstd * n0[j] * siluf_(g0[j]); r[4 + j] = y1[j] * rstd * n1[j] * siluf_(g1[j]); }
            *(u32x4*)(p.MG + o) = (u32x4){pack2(r[0], r[1]), pack2(r[2], r[3]), pack2(r[4], r[5]), pack2(r[6], r[7])};
        }
    }
}

#define N_PHASES 20
__device__ __forceinline__ void run_phase(const Params& p, int ph, int bid, int nblk, char* smem) {
    const float* mod0 = p.mod;
    const float* mod1 = p.mod + 9 * 6144;
    switch (ph) {
    case 0: phase0a(p, bid, nblk, smem); break;
    case 1: phase0b(p, bid, nblk); break;
    case 2: phase_norm(p, bid, nblk, p.x, p.ctx, p.norm1_g, mod0, 0, NT); break;
    case 3: phase_gemm8_store_bf(p.H, NT, p.wt_evin, EVC, (bf16_t*)p.P, bid, nblk, smem); break;
    case 4: phase_feat0(p, bid, nblk, smem); break;
    case 5: phase_lora(p, bid, nblk, smem); break;
    case 6: phase_scan_attn(p, bid, nblk, smem); break;
    case 7: phase_rw_readout(p, bid, nblk); break;
    case 8: phase_outproj8(p, bid, nblk, smem, p.wt_evout, NT, p.x, p.ctx, p.X1, mod0 + 2048); break;
    case 9: phase_router(p, bid, nblk, smem, 0, p.X1, NT); break;
    case 10: phase_moe_gu8(p, bid, nblk, smem, 0); break;
    case 11: phase_moe_dn8(p, bid, nblk, smem, 0); break;
    case 12: phase_combine(p, bid, nblk, p.X1, p.X2, mod0 + 5120, NT, true, p.norm1_g + DM, mod1); break;
    case 13: phase_gemm8_store_hg(p, bid, nblk, smem); break;
    case 14: phase_hgrn(p, bid, nblk, smem); break;
    case 15: phase_hgrn_readout(p, bid, nblk); break;
    case 16: phase_outproj8(p, bid, nblk, smem, p.wt_odout, NX, p.X2, p.X2 + (size_t)NX * DM, p.X1, mod1 + 2048); break;
    case 17: phase_router(p, bid, nblk, smem, 1, p.X1, NX); break;
    case 18: phase_moe_gu8(p, bid, nblk, smem, 1); break;
    case 19: phase_moe_dn8(p, bid, nblk, smem, 1); break;
    default: break;
    }
}
__device__ __forceinline__ void final_phase(const Params& p, int bid, int nblk) {
    phase_combine(p, bid, nblk, p.X1, p.out, p.mod + 9 * 6144 + 5120, NX, false, nullptr, nullptr);
}

struct KArgs { const float* in[35]; float* out; char* ws; };

__host__ __device__ __forceinline__ size_t make_params(Params& p, const KArgs& a) {
    const float** ins = (const float**)&p;
    for (int i = 0; i < 35; ++i) ins[i] = a.in[i];
    p.out = a.out;
    char* ws = a.ws;
    size_t off = 0;
#define TAKE(bytes) (ws + off); off += (((size_t)(bytes)) + 255) & ~(size_t)255
    p.bar = (unsigned*)TAKE(16384);
    p.counts = (int*)TAKE(1024);
    p.scal = (float*)TAKE(256);
    p.mod = (float*)TAKE((size_t)2 * 9 * 6144 * 4);
    p.mod_part = (float*)TAKE((size_t)16 * 2 * 9 * 6144 * 4);
    p.rope_cos = (float*)TAKE((size_t)65536 * 4);
    p.rope_sin = (float*)TAKE((size_t)65536 * 4);
    p.wt_evin = (bf16_t*)TAKE((size_t)EVC * 1024 * 2);
    p.wt_evout = (bf16_t*)TAKE((size_t)1024 * 1024 * 2);
    p.wt_odin = (bf16_t*)TAKE((size_t)ODC * 1024 * 2);
    p.wt_odout = (bf16_t*)TAKE((size_t)1024 * 1024 * 2);
    p.wt_w2 = (bf16_t*)TAKE((size_t)1024 * 64 * 2);
    p.wt_a2 = (bf16_t*)TAKE((size_t)1024 * 64 * 2);
    p.wt_g2 = (bf16_t*)TAKE((size_t)512 * 128 * 2);
    p.wt_gu = (bf16_t*)TAKE((size_t)64 * 2048 * 1024 * 2);
    p.wt_dn = (bf16_t*)TAKE((size_t)64 * 1024 * 1024 * 2);
    p.lists = (int*)TAKE((size_t)2 * NEXP * NT * 4);
    p.GATE = (float*)TAKE((size_t)NASG * 4);
    p.H = (bf16_t*)TAKE((size_t)NT * DM * 2);
    p.MG = (bf16_t*)TAKE((size_t)NT * DM * 2);
    p.X1 = (float*)TAKE((size_t)NT * DM * 4);
    p.X2 = (float*)TAKE((size_t)NT * DM * 4);
    const size_t scratch0 = off;
    p.P = (float*)TAKE((size_t)NT * ODC * 4);
    const size_t after_p = off;
    p.Q = (bf16_t*)TAKE((size_t)8 * 8 * SEQ * 64 * 2);
    p.Qc = (bf16_t*)TAKE((size_t)8 * 8 * CTXL * 64 * 2);
    p.Kd = (bf16_t*)TAKE((size_t)8 * 8 * NKEY * 64 * 2);
    p.Vd = (bf16_t*)TAKE((size_t)8 * 4 * NKEY * 128 * 2);
    p.rR = (float*)TAKE((size_t)NT * 512 * 4);
    p.rK = (float*)TAKE((size_t)NT * 512 * 4);
    p.rV = (float*)TAKE((size_t)NT * 512 * 4);
    p.rKK = (float*)TAKE((size_t)NT * 512 * 4);
    p.rG = (float*)TAKE((size_t)NT * 512 * 4);
    p.rW = (float*)TAKE((size_t)2 * NT * 512 * 4);
    p.rKD = (float*)TAKE((size_t)2 * NT * 512 * 4);
    p.rBV = (float*)TAKE((size_t)2 * NT * 512 * 4);
    p.rY = (float*)TAKE((size_t)2 * NT * 512 * 4);
    p.rTW = (bf16_t*)TAKE((size_t)NT * 64 * 2);
    p.rAD = (bf16_t*)TAKE((size_t)NT * 64 * 2);
    p.rSG = (bf16_t*)TAKE((size_t)NT * 128 * 2);
    const size_t end_l0 = off;
    off = after_p;
    p.HO = (float*)TAKE((size_t)2 * NX * 1024 * 4);
    const size_t end_l1 = off;
    off = scratch0;
    p.ACT = (bf16_t*)TAKE((size_t)NASG * 1024 * 2);
    p.YS = (bf16_t*)TAKE((size_t)NASG * 1024 * 2);
    const size_t end_moe = off;
#undef TAKE
    size_t total = end_l0 > end_l1 ? end_l0 : end_l1;
    if (end_moe > total) total = end_moe;
    return total;
}

#if MULTI_LAUNCH
template <int PH>
__global__ void __launch_bounds__(256, 2) k_phase(KArgs a) {
    Params p; make_params(p, a);
    __shared__ __attribute__((aligned(16))) char smem[SMEM_BYTES];
    if (PH < N_PHASES) run_phase(p, PH, blockIdx.x, gridDim.x, smem);
    else final_phase(p, blockIdx.x, gridDim.x);
}
template <int PH> static void launch_all(const KArgs& p, hipStream_t stream) {
    hipLaunchKernelGGL(k_phase<PH>, dim3(1024), dim3(256), 0, stream, p);
    if constexpr (PH < N_PHASES) launch_all<PH + 1>(p, stream);
}
#else
__global__ void __launch_bounds__(NTHR, 2) k_mega(KArgs a) {
    Params p; make_params(p, a);
    extern __shared__ __attribute__((aligned(16))) char smem[];
    cg::grid_group grid = cg::this_grid();
    const int bid = blockIdx.x, nblk = gridDim.x;
    volatile LAS unsigned* st = (volatile LAS unsigned*)(smem + SMEM_BYTES);
    if (tidx() == 0) { st[0] = 0u; st[1] = 0u; }
    __syncthreads();
    const XcdBarrier xb = xcd_barrier_post(p.bar, st);
    run_phase(p, 0, bid, nblk, smem);
    if (a.ws == nullptr) grid.sync();
    xcd_barrier(xb);
    if (EXTRA == 4) { run_phase(p, 0, bid, nblk, smem); xcd_barrier(xb); }
#ifndef REPMASK
#define REPMASK 0u
#endif
#define PH(n) run_phase(p, n, bid, nblk, smem); xcd_barrier(xb); if ((REPMASK >> n) & 1u) { run_phase(p, n, bid, nblk, smem); xcd_barrier(xb); } \
    if (EXTRA == 6 && n == 6) { if (bid == 0 && tidx() == 0) p.counts[64] = 0; xcd_barrier(xb); run_phase(p, 6, bid, nblk, smem); xcd_barrier(xb); } \
    if (EXTRA == 5 && n == 9) { phase_router(p, bid, nblk, smem, 0, p.X1, NT, true); xcd_barrier(xb); } if (EXTRA == 5 && n == 17) { phase_router(p, bid, nblk, smem, 1, p.X1, NX, true); xcd_barrier(xb); }
    PH(1) PH(2) PH(3) PH(4) PH(5) PH(6) PH(7) PH(8) PH(9) PH(10) PH(11) PH(12) PH(13) PH(14) PH(15) PH(16) PH(17) PH(18) PH(19)
#undef PH
    final_phase(p, bid, nblk);
}
#endif


extern "C" void kernel_launch(void* const* d_in, const int* in_sizes, int n_in, void* d_out, int out_size, void* d_ws, size_t ws_size, hipStream_t stream) {
    KArgs a{};
    for (int i = 0; i < 35; ++i) a.in[i] = (const float*)d_in[i];
    a.out = (float*)d_out;
    a.ws = (char*)d_ws;
    Params p{};
    const size_t total = make_params(p, a);
    if (total > ws_size) { fprintf(stderr, "workspace too small: need %zu have %zu\n", total, ws_size); return; }

#if MULTI_LAUNCH
    launch_all<0>(a, stream);
#else
    static int grid_blocks = 0;
    if (!grid_blocks) {
        int dev = 0, cus = 0, per_cu = 0;
        hipGetDevice(&dev);
        hipDeviceGetAttribute(&cus, hipDeviceAttributeMultiprocessorCount, dev);
        hipFuncSetAttribute((const void*)k_mega, hipFuncAttributeMaxDynamicSharedMemorySize, SMEM_BYTES + 16);
        hipOccupancyMaxActiveBlocksPerMultiprocessor(&per_cu, k_mega, NTHR, SMEM_BYTES + 16);
        if (per_cu > 1) per_cu = 1;
        if (per_cu < 1) per_cu = 1;
        grid_blocks = cus * per_cu;
    }
    hipMemsetAsync(p.bar, 0, XCD_BAR_WORDS * 4, stream);
    void* args[] = {(void*)&a};
    hipError_t e = hipLaunchCooperativeKernel((void*)k_mega, dim3(grid_blocks), dim3(NTHR), args, SMEM_BYTES + 16, stream);
    if (e != hipSuccess) fprintf(stderr, "cooperative launch failed: %s (grid %d)\n", hipGetErrorString(e), grid_blocks);
#endif
}
```

```cpp
#include <hip/hip_runtime.h>
#include <hip/hip_cooperative_groups.h>
#include <stdint.h>
#include <stdio.h>

namespace cg = cooperative_groups;

typedef unsigned short bf16_t;
typedef short bf16x8 __attribute__((ext_vector_type(8)));
typedef float f32x4 __attribute__((ext_vector_type(4)));
typedef unsigned u32x4 __attribute__((ext_vector_type(4)));

#define NX 16384
#define NC 2048
#define NT 18432
#define DM 1024
#define SEQ 2048
#define CTXL 256
#define NKEY 2304
#define EVC 3328
#define ODC 5120
#define NEXP 32
#define NASG (NT * 4)
#ifndef EXTRA
#define EXTRA 0
#endif
#define NTHR 512
#define SMEM_BYTES 131072
#define HLDS 65536

#ifndef MULTI_LAUNCH
#define MULTI_LAUNCH 0
#endif

struct Params {
    const float *x, *c, *ctx, *c_ctx, *ada_w, *ada_b, *norm1_g, *norm2_g, *ev_w_in, *ev_w_out, *da_q_norm, *da_k_norm,
        *da_lambda, *da_subln, *rw_mu, *rw_w0, *rw_w2, *rw_a0, *rw_a2, *rw_g2, *rw_k_k, *rw_k_a, *rw_r_k, *rw_ln_w,
        *rw_ln_b, *od_w_in, *od_w_out, *hg_norm, *hg_lb, *router_w, *router_b, *moe_w_gu, *moe_b_gu, *moe_w_dn, *moe_b_dn;
    float* out;
    bf16_t *wt_evin, *wt_evout, *wt_odin, *wt_odout, *wt_gu, *wt_dn, *wt_w2, *wt_a2, *wt_g2;
    float *mod_part, *mod, *rope_cos, *rope_sin, *scal;
    int *counts, *lists;
    unsigned* bar;
    bf16_t* H;
    float* P;
    bf16_t *Q, *Qc, *Kd, *Vd;
    bf16_t *rR, *rK, *rV, *rKK, *rKD, *rBV, *rG;
    float *rW, *rY;
    bf16_t *rTW, *rAD, *rSG;
    bf16_t* MG;
    float *X1, *X2;
    float* GATE;
    bf16_t* ACT;
    bf16_t* YS;
    float* HO;
};

typedef float f32x2_ __attribute__((ext_vector_type(2)));
typedef __bf16 bf16x2_ __attribute__((ext_vector_type(2)));
__device__ __forceinline__ unsigned pack2(float a, float b) {
    const f32x2_ v = {a, b};
    return __builtin_bit_cast(unsigned, __builtin_convertvector(v, bf16x2_));
}
__device__ __forceinline__ bf16_t f2bf(float f) { return (bf16_t)(pack2(f, 0.f) & 0xffffu); }
__device__ __forceinline__ int tidx() { int t = __builtin_amdgcn_workitem_id_x(); asm volatile("" : "+v"(t)); return t; }
__device__ __forceinline__ int uni(int v) { return __builtin_amdgcn_readfirstlane(v); }
template <class T> __device__ __forceinline__ T* uni_ptr(T* ptr) {
    const unsigned long long v = (unsigned long long)ptr;
    const unsigned lo = (unsigned)__builtin_amdgcn_readfirstlane((int)(unsigned)v), hi = (unsigned)__builtin_amdgcn_readfirstlane((int)(unsigned)(v >> 32));
    return (T*)(((unsigned long long)hi << 32) | lo);
}
__device__ __forceinline__ float bf2f(bf16_t h) { return __uint_as_float(((unsigned)h) << 16); }
template <int CTRL, int ROWMASK> __device__ __forceinline__ float dpp_zero(float x) {
    return __int_as_float(__builtin_amdgcn_update_dpp(0, __float_as_int(x), CTRL, ROWMASK, 0xf, false));
}
__device__ __forceinline__ float wave_sum(float v) {
    v += dpp_zero<0xB1, 0xf>(v);
    v += dpp_zero<0x4E, 0xf>(v);
    v += dpp_zero<0x141, 0xf>(v);
    v += dpp_zero<0x140, 0xf>(v);
    v += dpp_zero<0x142, 0xa>(v);
    v += dpp_zero<0x143, 0xc>(v);
    return __int_as_float(__builtin_amdgcn_readlane(__float_as_int(v), 63));
}
template <int CTRL> __device__ __forceinline__ float dpp_f(float x) {
    return __int_as_float(__builtin_amdgcn_mov_dpp(__float_as_int(x), CTRL, 0xf, 0xf, true));
}
__device__ __forceinline__ float sum8(float x) {
    x += dpp_f<0xB1>(x);
    x += dpp_f<0x4E>(x);
    x += dpp_f<0x141>(x);
    return x;
}
__device__ __forceinline__ float sigmoidf_(float x) { return __builtin_amdgcn_rcpf(1.0f + __expf(-x)); }
__device__ __forceinline__ float siluf_(float x) { return x * __builtin_amdgcn_rcpf(1.0f + __expf(-x)); }
__device__ __forceinline__ int modrow(int tok) { return tok < NX ? (tok >> 11) : 8; }


#define XB_TMO      128
#define XB_XCNT(j)  (256  + 64 * (j))
#define XB_XSUB(j)  (1280 + 64 * (j))
#define XB_XGEN(j)  (2304 + 64 * (j))
#define XB_TOP      3328
#define XB_TOPGEN   3392
#define XCD_BAR_WORDS 3456
#define XB_SPIN_CAP (1u << 27)
#define LAS __attribute__((address_space(3)))
__device__ __forceinline__ unsigned xb_ld(unsigned* p)              { return __hip_atomic_load(p, __ATOMIC_RELAXED, __HIP_MEMORY_SCOPE_AGENT); }
__device__ __forceinline__ unsigned xb_add(unsigned* p, unsigned v) { return __hip_atomic_fetch_add(p, v, __ATOMIC_RELAXED, __HIP_MEMORY_SCOPE_AGENT); }
__device__ __forceinline__ unsigned xb_xcc_id() { return (unsigned)__builtin_amdgcn_s_getreg((3 << 11) | 20) & 0xFu; }
#define XB_SPIN(cond, bar) do { unsigned _sp = 0; while (cond) { __builtin_amdgcn_s_sleep(1); \
    if ((++_sp & 255u) == 0u) { if (xb_ld(&(bar)[XB_TMO])) break; if (_sp > XB_SPIN_CAP) { atomicAdd(&(bar)[XB_TMO], 1u); break; } } } } while (0)
struct XcdBarrier { unsigned* bar; unsigned x; volatile LAS unsigned* st; };
__device__ __forceinline__ XcdBarrier xcd_barrier_post(unsigned* bar, volatile LAS unsigned* st) {
    XcdBarrier b; b.bar = bar; b.x = xb_xcc_id(); b.st = st;
    if (tidx() == 0) (void)xb_add(&bar[XB_XCNT(b.x)], 1u);
    return b;
}
__device__ __forceinline__ void xcd_barrier_complete(unsigned* bar, unsigned x, unsigned& nloc, unsigned& nx) {
    const unsigned G = gridDim.x * gridDim.y * gridDim.z;
    unsigned sum, cnt, mine, sp = 0u;
    for (;;) {
        sum = 0u; cnt = 0u; mine = 0u;
#pragma unroll
        for (unsigned j = 0; j < 16; ++j) { const unsigned c = xb_ld(&bar[XB_XCNT(j)]); sum += c; cnt += (c > 0u) ? 1u : 0u; mine = (j == x) ? c : mine; }
        if (sum == G) break;
        __builtin_amdgcn_s_sleep(1);
        if ((++sp & 255u) == 0u) { if (xb_ld(&bar[XB_TMO])) break; if (sp > XB_SPIN_CAP) { atomicAdd(&bar[XB_TMO], 1u); break; } }
    }
    nloc = mine > 0u ? mine : 1u; nx = cnt > 0u ? cnt : 1u;
}
__device__ __forceinline__ void xcd_barrier(const XcdBarrier& b) {
    asm volatile("s_waitcnt vmcnt(0)" ::: "memory");
    __syncthreads();
    if (tidx() == 0) {
        unsigned* bar = b.bar;
        __builtin_amdgcn_s_waitcnt(0);
        unsigned nloc = b.st[0], nx = b.st[1];
        if (nloc == 0u) { xcd_barrier_complete(bar, b.x, nloc, nx); b.st[0] = nloc; b.st[1] = nx; }
        const unsigned old = xb_add(&bar[XB_XSUB(b.x)], 1u);
        const unsigned gen = old / nloc;
        if (old + 1u == (gen + 1u) * nloc) {
            __builtin_amdgcn_fence(__ATOMIC_RELEASE, "agent");
            asm volatile("s_waitcnt vmcnt(0)" ::: "memory");
            const unsigned og = xb_add(&bar[XB_TOP], 1u);
            const unsigned tg = og / nx;
            if (og + 1u == (tg + 1u) * nx) xb_add(&bar[XB_TOPGEN], 1u);
            else XB_SPIN(xb_ld(&bar[XB_TOPGEN]) == tg, bar);
            __builtin_amdgcn_fence(__ATOMIC_ACQUIRE, "agent");
            xb_add(&bar[XB_XGEN(b.x)], 1u);
            asm volatile("s_waitcnt vmcnt(0)" ::: "memory");
        } else {
            XB_SPIN(xb_ld(&bar[XB_XGEN(b.x)]) == gen, bar);
            __builtin_amdgcn_fence(__ATOMIC_ACQUIRE, "agent");
            asm volatile("s_waitcnt vmcnt(0)" ::: "memory");
        }
    }
    __syncthreads();
}


__device__ __forceinline__ int q_next(int* ctr, char* smem) {
    volatile unsigned* slot = (volatile unsigned*)(smem + SMEM_BYTES + 8);
    __syncthreads();
    if (tidx() == 0) *slot = (unsigned)atomicAdd(ctr, 1);
    __syncthreads();
    return (int)*slot;
}

struct ARows {
    const bf16_t* base;
    int lda;
    const int* idx;
    int shift;
    int row0;
};

template <bool PAIRED, class Epi>
__device__ __forceinline__ void gemm_tile(const ARows ar, int mcount, const bf16_t* __restrict__ Bt, int ldb, int K, Epi& epi, char* smem) {
    const int tid = tidx() & 255, lane = tid & 63, wid = tid >> 6;
    const int wr = wid >> 1, wc = wid & 1, fr = lane & 15, fq = lane >> 4;
    bf16_t* sA = (bf16_t*)smem;
    bf16_t* sB = sA + 128 * 64;
    const int lrow = tid >> 3, lch = tid & 7;
    const bf16_t* aptr[4];
    const bf16_t* bptr[4];
#pragma unroll
    for (int i = 0; i < 4; ++i) {
        const int r = lrow + 32 * i;
        const int rr = r < mcount ? r : 0;
        const int rowid = ar.idx ? (ar.idx[rr] >> ar.shift) : (ar.row0 + rr);
        aptr[i] = ar.base + (size_t)rowid * ar.lda + lch * 8;
        bptr[i] = Bt + (size_t)r * ldb + lch * 8;
    }
    u32x4 ra[4], rb[4];
#pragma unroll
    for (int i = 0; i < 4; ++i) { ra[i] = *(const u32x4*)(aptr[i]); rb[i] = *(const u32x4*)(bptr[i]); }
    f32x4 acc[4][4];
#pragma unroll
    for (int m = 0; m < 4; ++m)
#pragma unroll
        for (int n = 0; n < 4; ++n) acc[m][n] = (f32x4){0.f, 0.f, 0.f, 0.f};
    const int nk = K >> 6;
    for (int kt = 0; kt < nk; ++kt) {
#pragma unroll
        for (int i = 0; i < 4; ++i) {
            const int r = lrow + 32 * i;
            const int off = r * 64 + ((lch ^ (r & 7)) << 3);
            *(u32x4*)(sA + off) = ra[i];
            *(u32x4*)(sB + off) = rb[i];
        }
        __syncthreads();
        if (kt + 1 < nk) {
#pragma unroll
            for (int i = 0; i < 4; ++i) { ra[i] = *(const u32x4*)(aptr[i] + (kt + 1) * 64); rb[i] = *(const u32x4*)(bptr[i] + (kt + 1) * 64); }
        }
#pragma unroll
        for (int ks = 0; ks < 2; ++ks) {
            bf16x8 af[4], bfr[4];
            const int ch = ks * 4 + fq;
#pragma unroll
            for (int m = 0; m < 4; ++m) { const int r = wr * 64 + m * 16 + fr; af[m] = *(const bf16x8*)(sA + r * 64 + ((ch ^ (r & 7)) << 3)); }
#pragma unroll
            for (int n = 0; n < 4; ++n) { const int r = wc * 64 + n * 16 + fr; bfr[n] = *(const bf16x8*)(sB + r * 64 + ((ch ^ (r & 7)) << 3)); }
#pragma unroll
            for (int m = 0; m < 4; ++m)
#pragma unroll
                for (int n = 0; n < 4; ++n) acc[m][n] = __builtin_amdgcn_mfma_f32_16x16x32_bf16(bfr[n], af[m], acc[m][n], 0, 0, 0);
        }
        __syncthreads();
    }
#pragma unroll
    for (int m = 0; m < 4; ++m) {
        const int r = wr * 64 + m * 16 + fr;
        if (r < mcount) {
            if constexpr (PAIRED) {
                epi.pair(r, wc * 32 + fq * 4, acc[m][0], acc[m][1]);
                epi.pair(r, wc * 32 + 16 + fq * 4, acc[m][2], acc[m][3]);
            } else {
#pragma unroll
                for (int n = 0; n < 4; ++n) epi.one(r, wc * 64 + n * 16 + fq * 4, acc[m][n]);
            }
        }
    }
}


namespace g8 {
#define G8_LAS __attribute__((address_space(3)))
constexpr int BM = 256, BK = 64, HALF = 128, HTB = HALF * BK * 2;
__device__ __forceinline__ int lds_byte(int r, int c) { const int st = (r >> 4) * 2 + (c >> 5), rr = r & 15, cc = c & 31, ob = rr * 64 + cc * 2; return st * 1024 + (ob ^ (((ob >> 9) & 1) << 5)); }
__device__ __forceinline__ void stage_rc(int b, int& R, int& C) { const int st = b / 1024, sb = b % 1024, swz = sb ^ (((sb >> 9) & 1) << 5); R = (st >> 1) * 16 + swz / 64; C = (st & 1) * 32 + (swz % 64) / 2; }
struct Unit {
    const char* a;
    const char* b;
    const int* gidx;
    const int* idx;
    int shift, rows;
    int i0, i1, i2;
};
template <class Epi, class Sched>
__device__ __forceinline__ void gemm_phase(G8_LAS unsigned char* lds, const int K, Sched& S, const Epi& E) {
    const int tid = tidx(), wid = __builtin_amdgcn_readfirstlane(tid >> 6), lane = tid & 63, wr = wid >> 2, wc = wid & 3, fr = lane & 15, fq = lane >> 4;
    const int nt = K / BK;
    int sR[2], sC[2];
    unsigned voffB[2];
#pragma unroll
    for (int i = 0; i < 2; ++i) { stage_rc(tid * 16 + i * 8192, sR[i], sC[i]); voffB[i] = (unsigned)(sR[i] * K + sC[i]) * 2u; }
    const size_t kstep = (size_t)(BK * 2);
    const size_t hstep = (size_t)HALF * K * 2;
    const unsigned ldsw = (unsigned)wid * 1024u;
    const int aoff = lds_byte(wr * 64 + fr, fq * 8), boff = lds_byte(wc * 32 + fr, fq * 8);
    auto a_offsets = [&](const Unit& u, unsigned (&o)[2][2]) {
#pragma unroll
        for (int h = 0; h < 2; ++h)
#pragma unroll
            for (int i = 0; i < 2; ++i) {
                int r = sR[i] + h * HALF;
                if (u.gidx) { r = r < u.rows ? r : (u.rows - 1); r = u.gidx[r] >> u.shift; }
                o[h][i] = (unsigned)(r * K + sC[i]) * 2u;
            }
    };
#define G8_SA(b, h) (((b) * 2 + (h)) * HTB)
#define G8_SB(b, h) ((4 + (b) * 2 + (h)) * HTB)
#define G8_STAGE2(bufoff, gbase, o0, o1) do { \
        __builtin_amdgcn_global_load_lds((const unsigned*)((const char*)(gbase) + (o0)), (G8_LAS unsigned*)(lds + (bufoff) + ldsw), 16, 0, 0); \
        __builtin_amdgcn_global_load_lds((const unsigned*)((const char*)(gbase) + (o1)), (G8_LAS unsigned*)(lds + (bufoff) + ldsw + 8192), 16, 0, 0); } while (0)
#define G8_STAGE_B(bufoff, gbase) G8_STAGE2(bufoff, gbase, voffB[0], voffB[1])
#define G8_LDA(dst, b, h) do { _Pragma("unroll") for (int m = 0; m < 4; ++m) _Pragma("unroll") for (int k = 0; k < 2; ++k) dst[m][k] = *(const G8_LAS bf16x8*)(lds + G8_SA(b, h) + aoff + m * 2048 + k * 1024); } while (0)
#define G8_LDB(dst, b, h) do { _Pragma("unroll") for (int n = 0; n < 2; ++n) _Pragma("unroll") for (int k = 0; k < 2; ++k) dst[n][k] = *(const G8_LAS bf16x8*)(lds + G8_SB(b, h) + boff + n * 2048 + k * 1024); } while (0)
#define G8_MMA(ai, bj, At, Bt) do { __builtin_amdgcn_s_setprio(1); _Pragma("unroll") for (int m = 0; m < 4; ++m) _Pragma("unroll") for (int n = 0; n < 2; ++n) _Pragma("unroll") for (int k = 0; k < 2; ++k) \
        acc[ai][bj][m][n] = __builtin_amdgcn_mfma_f32_16x16x32_bf16(Bt[n][k], At[m][k], acc[ai][bj][m][n], 0, 0, 0); __builtin_amdgcn_s_setprio(0); } while (0)
#define G8_WAIT_V(n) asm volatile("s_waitcnt vmcnt(" #n ")" ::: "memory")
#define G8_WAIT_L(n) asm volatile("s_waitcnt lgkmcnt(" #n ")" ::: "memory")
#define G8_BAR __builtin_amdgcn_s_barrier()
#define G8_SCHED __builtin_amdgcn_sched_barrier(0)
    Unit cur, nxt;
    if (!S.next(cur)) return;
    unsigned oc[2][2], on[2][2];
    a_offsets(cur, oc);
    f32x4 acc[2][2][4][2];
#pragma unroll
    for (int a = 0; a < 2; ++a)
#pragma unroll
        for (int b = 0; b < 2; ++b)
#pragma unroll
            for (int m = 0; m < 4; ++m)
#pragma unroll
                for (int n = 0; n < 2; ++n) acc[a][b][m][n] = (f32x4){0.f, 0.f, 0.f, 0.f};
    bf16x8 At[4][2], B0[2][2], B1[2][2];
    const char* cA = cur.a; const char* cB = cur.b;
    G8_STAGE_B(G8_SB(0, 0), cB); G8_STAGE_B(G8_SB(0, 1), cB + hstep); G8_STAGE2(G8_SA(0, 0), cA, oc[0][0], oc[0][1]); G8_STAGE2(G8_SA(0, 1), cA, oc[1][0], oc[1][1]);
    if (wr == 1) G8_BAR;
    G8_WAIT_V(2); G8_BAR;
    G8_STAGE_B(G8_SB(1, 0), cB + kstep); G8_STAGE2(G8_SA(1, 0), cA + kstep, oc[0][0], oc[0][1]); G8_STAGE_B(G8_SB(1, 1), cB + hstep + kstep);
    G8_WAIT_V(6); G8_BAR;
    for (;;) {
        const bool has_next = S.next(nxt);
        if (has_next) a_offsets(nxt, on);
        else {
#pragma unroll
            for (int h = 0; h < 2; ++h) { on[h][0] = oc[h][0]; on[h][1] = oc[h][1]; }
        }
        const char* nA = has_next ? nxt.a : cA; const char* nB = has_next ? nxt.b : cB;
        for (int t = 0; t < nt; t += 2) {
            const bool last = (t == nt - 2);
            const char* a1 = cA + (size_t)(t + 1) * kstep;
            const char* a2 = last ? nA : cA + (size_t)(t + 2) * kstep; const char* b2 = last ? nB : cB + (size_t)(t + 2) * kstep;
            const char* a3 = a2 + kstep; const char* b3 = b2 + kstep;
            const unsigned p00 = last ? on[0][0] : oc[0][0], p01 = last ? on[0][1] : oc[0][1], p10 = last ? on[1][0] : oc[1][0], p11 = last ? on[1][1] : oc[1][1];
            G8_LDB(B0, 0, 0); G8_LDB(B1, 0, 1); G8_SCHED; G8_LDA(At, 0, 0); G8_STAGE2(G8_SA(1, 1), a1, oc[1][0], oc[1][1]);
            G8_WAIT_V(8); G8_WAIT_L(0); G8_BAR; G8_MMA(0, 0, At, B0); G8_MMA(0, 1, At, B1); G8_BAR; G8_SCHED;
            G8_LDA(At, 0, 1); G8_STAGE_B(G8_SB(0, 0), b2); G8_STAGE_B(G8_SB(0, 1), b2 + hstep); G8_STAGE2(G8_SA(0, 0), a2, p00, p01);
            G8_WAIT_V(8); G8_WAIT_L(0); G8_BAR; G8_MMA(1, 0, At, B0); G8_MMA(1, 1, At, B1); G8_BAR; G8_SCHED;
            G8_LDB(B0, 1, 0); G8_LDB(B1, 1, 1); G8_SCHED; G8_LDA(At, 1, 0); G8_STAGE2(G8_SA(0, 1), a2, p10, p11);
            G8_WAIT_V(8); G8_WAIT_L(0); G8_BAR; G8_MMA(0, 0, At, B0); G8_MMA(0, 1, At, B1); G8_BAR; G8_SCHED;
            G8_LDA(At, 1, 1); G8_STAGE_B(G8_SB(1, 0), b3); G8_STAGE_B(G8_SB(1, 1), b3 + hstep); G8_STAGE2(G8_SA(1, 0), a3, p00, p01);
            G8_WAIT_V(8); G8_WAIT_L(0); G8_BAR; G8_MMA(1, 0, At, B0); G8_MMA(1, 1, At, B1); G8_BAR; G8_SCHED;
        }
        if (wr == 0) G8_BAR;
        E(acc, cur, wr, wc, fr, fq);
        if (!has_next) break;
#pragma unroll
        for (int a = 0; a < 2; ++a)
#pragma unroll
            for (int b = 0; b < 2; ++b)
#pragma unroll
                for (int m = 0; m < 4; ++m)
#pragma unroll
                    for (int n = 0; n < 2; ++n) acc[a][b][m][n] = (f32x4){0.f, 0.f, 0.f, 0.f};
        cur = nxt; cA = nA; cB = nB;
#pragma unroll
        for (int h = 0; h < 2; ++h) { oc[h][0] = on[h][0]; oc[h][1] = on[h][1]; }
        if (wr == 1) G8_BAR;
    }
    G8_WAIT_V(0);
    G8_BAR;
#undef G8_SA
#undef G8_SB
#undef G8_STAGE2
#undef G8_STAGE_B
#undef G8_LDA
#undef G8_LDB
#undef G8_MMA
#undef G8_WAIT_V
#undef G8_WAIT_L
#undef G8_BAR
#undef G8_SCHED
}
}

__device__ __forceinline__ int gu_row(int col) {
    const int half = col >> 10, unit = col & 1023, T = unit >> 7, ul = unit & 127, wc = ul >> 5, r = ul & 31, fq = r >> 3, bj = (r >> 2) & 1, jj = r & 3;
    return 256 * T + 128 * bj + 32 * wc + 16 * half + 4 * fq + jj;
}
__device__ __forceinline__ int p32_row(int col) {
    const int x = col & 31;
    return (col & ~31) + 16 * ((x >> 2) & 1) + 4 * (x >> 3) + (x & 3);
}
struct ConvDesc { const float* src; bf16_t* dst; int N, Kd, kt, nt, perm, pad; };
struct ConvRegs { f32x4 v0, v1, v2, v3; };
__device__ __forceinline__ ConvRegs conv_load(const ConvDesc& d) {
    const int tid = tidx() & 255, r = tid >> 4, c4 = (tid & 15) * 4;
    ConvRegs x;
    const float* b0 = d.src + (size_t)(d.kt * 64 + r) * d.N + d.nt * 64 + c4;
    x.v0 = *(const f32x4*)(b0); x.v1 = *(const f32x4*)(b0 + (size_t)16 * d.N); x.v2 = *(const f32x4*)(b0 + (size_t)32 * d.N); x.v3 = *(const f32x4*)(b0 + (size_t)48 * d.N);
    return x;
}
__device__ __forceinline__ void conv_store(const ConvRegs& x, const ConvDesc& d, float* lds) {
    const int tid = tidx() & 255;
    {
        const int r = tid >> 4, c4 = (tid & 15) * 4;
        float* q = lds + r * 65 + c4;
        q[0] = x.v0[0]; q[1] = x.v0[1]; q[2] = x.v0[2]; q[3] = x.v0[3];
        q[16 * 65 + 0] = x.v1[0]; q[16 * 65 + 1] = x.v1[1]; q[16 * 65 + 2] = x.v1[2]; q[16 * 65 + 3] = x.v1[3];
        q[32 * 65 + 0] = x.v2[0]; q[32 * 65 + 1] = x.v2[1]; q[32 * 65 + 2] = x.v2[2]; q[32 * 65 + 3] = x.v2[3];
        q[48 * 65 + 0] = x.v3[0]; q[48 * 65 + 1] = x.v3[1]; q[48 * 65 + 2] = x.v3[2]; q[48 * 65 + 3] = x.v3[3];
    }
    __syncthreads();
    {
        const int n = tid >> 2, kseg = (tid & 3) * 16;
        unsigned w[8];
#pragma unroll
        for (int j = 0; j < 8; ++j) w[j] = pack2(lds[(kseg + 2 * j) * 65 + n], lds[(kseg + 2 * j + 1) * 65 + n]);
        const int ncol = d.nt * 64 + n;
        const int row = d.perm == 1 ? gu_row(ncol) : (d.perm == 2 ? p32_row(ncol) : (d.perm == 3 ? ((ncol >> 6) * 128 + (ncol & 63)) : ncol));
        uint4* q = (uint4*)(d.dst + (size_t)row * d.Kd + d.kt * 64 + kseg);
        q[0] = make_uint4(w[0], w[1], w[2], w[3]);
        q[1] = make_uint4(w[4], w[5], w[6], w[7]);
    }
    __syncthreads();
}
__device__ __forceinline__ void conv_tile(const float* __restrict__ src, int N, bf16_t* __restrict__ dst, int Kd, int kt, int nt, int perm, float* lds) {
    const ConvDesc d{src, dst, N, Kd, kt, nt, perm, 0};
    const ConvRegs x = conv_load(d);
    conv_store(x, d, lds);
}

#define CONV_GRP 8
#define N_MODP 768
#define CV0 832
#define CV1 (CV0 + 16)
#define CV2 (CV1 + 16)
#define CV3 (CV2 + 16)
#define CV4 (CV3 + 256)
#define N_CONV CV4
#define N_ROPE 64
#define N_P0A (N_MODP + N_CONV + N_ROPE + 2)

__device__ __forceinline__ void phase0a(const Params& p, int bid, int nblk, char* smem) {
    const int half = tidx() >> 8, tid = tidx() & 255;
    float* lds = (float*)(smem + half * HLDS);
    for (int it0 = bid * 2; it0 < N_P0A; it0 += nblk * 2) {
        const int it = it0 + half;
        if (it < N_MODP) {
            const int l = it / 384, rem = it % 384, cb = rem / 16, kc = rem % 16;
            for (int e = tid; e < 9 * 64; e += 256) {
                const int r = e >> 6, k = e & 63;
                const float v = (r < 8) ? p.c[r * DM + kc * 64 + k] : p.c_ctx[kc * 64 + k];
                lds[e] = siluf_(v);
            }
            __syncthreads();
            const int col = cb * 256 + tid;
            const float* w = p.ada_w + (size_t)l * DM * 6144 + (size_t)(kc * 64) * 6144 + col;
            float acc[9];
#pragma unroll
            for (int r = 0; r < 9; ++r) acc[r] = 0.f;
#pragma unroll 1
            for (int k0 = 0; k0 < 64; k0 += 16) {
                float wv[16];
#pragma unroll
                for (int k = 0; k < 16; ++k) wv[k] = w[(size_t)(k0 + k) * 6144];
#pragma unroll
                for (int k = 0; k < 16; ++k)
#pragma unroll
                    for (int r = 0; r < 9; ++r) acc[r] += lds[r * 64 + k0 + k] * wv[k];
            }
#pragma unroll
            for (int r = 0; r < 9; ++r) p.mod_part[((size_t)(kc * 2 + l) * 9 + r) * 6144 + col] = acc[r];
            __syncthreads();
        } else if (it < N_MODP + N_CONV) {
            const int j = it - N_MODP;
            if (j < CV0) { conv_tile(p.ev_w_in, EVC, p.wt_evin, 1024, j / 52, j % 52, 2, lds); }
            else if (j < CV1) { const int q = j - CV0, z = q >> 3, nt = q & 7; conv_tile(p.rw_w2 + (size_t)z * 64 * 512, 512, p.wt_w2 + (size_t)z * 512 * 64, 64, 0, nt, 0, lds); }
            else if (j < CV2) { const int q = j - CV1, z = q >> 3, nt = q & 7; conv_tile(p.rw_a2 + (size_t)z * 64 * 512, 512, p.wt_a2 + (size_t)z * 64 * 64, 64, 0, nt, 3, lds); }
            else if (j < CV3) { const int q = j - CV2, kt = q >> 3, nt = q & 7; conv_tile(p.rw_g2, 512, p.wt_g2, 128, kt, nt, 0, lds); }
            else { const int q = j - CV3; conv_tile(p.ev_w_out, 1024, p.wt_evout, 1024, q >> 4, q & 15, 0, lds); }
        } else if (it < N_MODP + N_CONV + N_ROPE) {
            const int j = it - N_MODP - N_CONV;
#pragma unroll
            for (int i = 0; i < 4; ++i) {
                const int e = (j * 4 + i) * 256 + tid;
                const int t = e >> 5, a = (e >> 4) & 1, pp = e & 15;
                const float pos = (float)(a == 0 ? (t >> 6) : (t & 63));
                const float inv = powf(10000.0f, -(float)pp / 16.0f);
                const float ang = pos * inv;
                p.rope_cos[e] = cosf(ang);
                p.rope_sin[e] = sinf(ang);
            }
        } else if (it == N_MODP + N_CONV + N_ROPE) {
            if (tid < 64) {
                const float* lf = p.da_lambda;
                float a = lf[tid] * lf[64 + tid], b = lf[128 + tid] * lf[192 + tid];
                a = wave_sum(a); b = wave_sum(b);
                if (tid == 0) p.scal[0] = expf(a) - expf(b) + 0.2f;
            }
            if (tid < 128) p.counts[tid] = 0;
        }
    }
}

__device__ __forceinline__ void phase0b(const Params& p, int bid, int nblk) {
    for (int e = bid * NTHR + tidx(); e < 2 * 9 * 6144; e += nblk * NTHR) {
        const int l = e / (9 * 6144), rem = e % (9 * 6144);
        float s = p.ada_b[l * 6144 + rem % 6144];
#pragma unroll
        for (int kc = 0; kc < 16; ++kc) s += p.mod_part[(size_t)(kc * 2 + l) * 9 * 6144 + rem];
        p.mod[e] = s;
    }
}

__device__ __forceinline__ void phase_norm(const Params& p, int bid, int nblk, const float* xs_lat, const float* xs_ctx, const float* gain, const float* modl, int sh_off, int ntok) {
    const int lane = tidx() & 63, wid = tidx() >> 6;
    for (int tok = bid * 8 + wid; tok < ntok; tok += nblk * 8) {
        const float* xr = tok < NX ? xs_lat + (size_t)tok * DM : xs_ctx + (size_t)(tok - NX) * DM;
        const float* mr = modl + modrow(tok) * 6144 + sh_off;
        float4 v[4];
        float ss = 0.f;
#pragma unroll
        for (int i = 0; i < 4; ++i) { v[i] = *(const float4*)(xr + lane * 4 + 256 * i); ss += v[i].x * v[i].x + v[i].y * v[i].y + v[i].z * v[i].z + v[i].w * v[i].w; }
        ss = wave_sum(ss);
        const float rstd = rsqrtf(ss * (1.0f / 1024.0f) + 1e-6f);
#pragma unroll
        for (int i = 0; i < 4; ++i) {
            const int c = lane * 4 + 256 * i;
            const float4 g = *(const float4*)(gain + c), sh = *(const float4*)(mr + c), sc = *(const float4*)(mr + 1024 + c);
            const float a0 = v[i].x * rstd * g.x * (1.f + sc.x) + sh.x, a1 = v[i].y * rstd * g.y * (1.f + sc.y) + sh.y;
            const float a2 = v[i].z * rstd * g.z * (1.f + sc.z) + sh.z, a3 = v[i].w * rstd * g.w * (1.f + sc.w) + sh.w;
            *(uint2*)(p.H + (size_t)tok * DM + c) = make_uint2(pack2(a0, a1), pack2(a2, a3));
        }
    }
}

struct EpiStoreF32 {
    float* C; int ldc; int row0; int col0;
    __device__ __forceinline__ void one(int r, int c, f32x4 v) const { *(f32x4*)(C + (size_t)(row0 + r) * ldc + col0 + c) = v; }
};


struct TileIter {
    int mg0, mcnt, ntn, total, full, i, step;
    __device__ __forceinline__ void init(int MT, int NTN, int bid, int nblk) {
        const int g = bid & 7, lb = (bid >> 3) * 2 + (tidx() >> 8), nb = (nblk >> 3) * 2;
        mg0 = (MT * g) >> 3; mcnt = ((MT * (g + 1)) >> 3) - mg0; ntn = NTN; total = mcnt * NTN; full = mcnt >> 3; i = lb; step = nb;
    }
    __device__ __forceinline__ bool next(int& mt, int& nt) {
        if (i >= total) return false;
        const int band = 8 * ntn;
        if (i < full * band) { const int ms = i / band, r = i - ms * band; nt = r >> 3; mt = mg0 + ms * 8 + (r & 7); }
        else { const int rem = mcnt - full * 8, j = i - full * band; nt = j / rem; mt = mg0 + full * 8 + (j - nt * rem); }
        i += step;
        return true;
    }
};
__device__ __forceinline__ void phase_gemm_store(const bf16_t* A, int M, const bf16_t* Wt, int N, int K, float* C, int bid, int nblk, char* smem) {
    TileIter ti; ti.init(M / 128, N / 128, bid, nblk);
    char* hs = smem + (tidx() >> 8) * HLDS;
    for (;;) {
        int mt = 0, nt = 0;
        const bool v = ti.next(mt, nt);
        if (!__syncthreads_or(v ? 1 : 0)) break;
        if (!v) { mt = 0; nt = 0; }
        ARows ar{A, K, nullptr, 0, mt * 128};
        EpiStoreF32 epi{C, N, mt * 128, nt * 128};
        gemm_tile<false>(ar, v ? 128 : 0, Wt + (size_t)nt * 128 * K, K, K, epi, hs);
    }
}

struct EpiResid {
    const float* xin_lat; const float* xin_ctx; float* xout; const float* gmod; int row0; int col0;
    __device__ __forceinline__ void one(int r, int c, f32x4 v) const {
        const int tok = row0 + r, cc = col0 + c;
        const float* xr = tok < NX ? xin_lat + (size_t)tok * DM : xin_ctx + (size_t)(tok - NX) * DM;
        const f32x4 xi = *(const f32x4*)(xr + cc);
        const f32x4 g = *(const f32x4*)(gmod + modrow(tok) * 6144 + cc);
        *(f32x4*)(xout + (size_t)tok * DM + cc) = xi + g * v;
    }
};
__device__ __forceinline__ void phase_outproj(const Params& p, int bid, int nblk, char* smem, const bf16_t* Wt, int ntok, const float* xin_lat, const float* xin_ctx, float* xout, const float* gmod) {
    TileIter ti; ti.init(ntok / 128, 8, bid, nblk);
    char* hs = smem + (tidx() >> 8) * HLDS;
    for (;;) {
        int mt = 0, nt = 0;
        const bool v = ti.next(mt, nt);
        if (!__syncthreads_or(v ? 1 : 0)) break;
        if (!v) { mt = 0; nt = 0; }
        ARows ar{p.MG, DM, nullptr, 0, mt * 128};
        EpiResid epi{xin_lat, xin_ctx, xout, gmod, mt * 128, nt * 128};
        gemm_tile<false>(ar, v ? 128 : 0, Wt + (size_t)nt * 128 * DM, DM, DM, epi, hs);
    }
}

__device__ __forceinline__ void unpack8(const u32x4 w, float (&v)[8]) {
#pragma unroll
    for (int i = 0; i < 4; ++i) { v[2 * i] = __uint_as_float(w[i] << 16); v[2 * i + 1] = __uint_as_float(w[i] & 0xffff0000u); }
}
__device__ __forceinline__ u32x4 pack8f(const float (&v)[8]) { return (u32x4){pack2(v[0], v[1]), pack2(v[2], v[3]), pack2(v[4], v[5]), pack2(v[6], v[7])}; }
__device__ __forceinline__ void phase_feat0(const Params& p, int bid, int nblk, char* smem) {
    const int lane = tidx() & 63, wid = tidx() >> 6;
    const bf16_t* P16 = (const bf16_t*)p.P;
    const int l7 = lane & 7, g = lane >> 3;
    for (int tok = bid * 8 + wid; tok < NT; tok += nblk * 8) {
        const bool lat = tok < NX;
        const int b = lat ? (tok >> 11) : ((tok - NX) >> 8);
        const int t = lat ? (tok & 2047) : ((tok - NX) & 255);
        const int key = lat ? (CTXL + t) : t;
        const bf16_t* pr = P16 + (size_t)tok * EVC;
        {
            float cs[8], sn[8];
            if (lat) {
                const int a = l7 >> 2, ro = t * 32 + a * 16 + (l7 & 1) * 8;
                const f32x4 c0 = *(const f32x4*)(p.rope_cos + ro), c1 = *(const f32x4*)(p.rope_cos + ro + 4), s0 = *(const f32x4*)(p.rope_sin + ro), s1 = *(const f32x4*)(p.rope_sin + ro + 4);
#pragma unroll
                for (int j = 0; j < 4; ++j) { cs[j] = c0[j]; cs[4 + j] = c1[j]; sn[j] = s0[j]; sn[4 + j] = s1[j]; }
            }
            const bool hf = (l7 >> 1) & 1;
#pragma unroll
            for (int qk = 0; qk < 2; ++qk) {
                float v[8];
                unpack8(*(const u32x4*)(pr + qk * 512 + lane * 8), v);
                const float* nw = (qk == 0 ? p.da_q_norm : p.da_k_norm) + l7 * 8;
                const f32x4 n0 = *(const f32x4*)nw, n1 = *(const f32x4*)(nw + 4);
                float ss = 0.f;
#pragma unroll
                for (int j = 0; j < 8; ++j) ss += v[j] * v[j];
                ss = sum8(ss);
                const float rstd = rsqrtf(ss * (1.0f / 64.0f) + 1e-6f) * (qk == 0 ? 0.125f * 1.4426950408889634f : 1.0f);
#pragma unroll
                for (int j = 0; j < 8; ++j) v[j] = v[j] * rstd * (j < 4 ? n0[j] : n1[j - 4]);
                if (lat) {
#pragma unroll
                    for (int j = 0; j < 8; ++j) {
                        const float o = dpp_f<0x4E>(v[j]);
                        v[j] = hf ? (v[j] * cs[j] + o * sn[j]) : (v[j] * cs[j] - o * sn[j]);
                    }
                }
                const u32x4 w = pack8f(v);
                if (qk == 0) {
                    if (lat) *(u32x4*)(p.Q + (((size_t)b * 8 + g) * SEQ + t) * 64 + l7 * 8) = w;
                    else *(u32x4*)(p.Qc + (((size_t)b * 8 + g) * CTXL + t) * 64 + l7 * 8) = w;
                } else *(u32x4*)(p.Kd + (((size_t)b * 8 + g) * NKEY + key) * 64 + l7 * 8) = w;
            }
        }
        const int slen = lat ? SEQ : CTXL;
        const bool hasp = t > 0, hasn = t < slen - 1;
        const bf16_t* pw = pr + 1536;
        auto shifted = [&](int c0, float (&y)[8]) {
            float pv[8], nv[8];
            unpack8(*(const u32x4*)(pw + c0), y);
            if (hasp) unpack8(*(const u32x4*)(pw + c0 - EVC), pv); else {
#pragma unroll
                for (int j = 0; j < 8; ++j) pv[j] = 0.f; }
            if (hasn) unpack8(*(const u32x4*)(pw + c0 + EVC), nv); else {
#pragma unroll
                for (int j = 0; j < 8; ++j) nv[j] = 0.f; }
            const f32x4 m0 = *(const f32x4*)(p.rw_mu + c0), m1 = *(const f32x4*)(p.rw_mu + c0 + 4);
#pragma unroll
            for (int j = 0; j < 8; ++j) y[j] = y[j] + (j < 4 ? m0[j] : m1[j - 4]) * (0.5f * (pv[j] + nv[j]) - y[j]);
        };
        {
            float y[8];
            shifted(lane * 8, y);
            *(u32x4*)(p.rR + (size_t)tok * 512 + lane * 8) = pack8f(y);
        }
        {
            float y[8];
            shifted(512 + lane * 8, y);
            *(u32x4*)(p.rK + (size_t)tok * 512 + lane * 8) = pack8f(y);
            const f32x4 k0 = *(const f32x4*)(p.rw_k_k + lane * 8), k1 = *(const f32x4*)(p.rw_k_k + lane * 8 + 4);
            float ss = 0.f;
#pragma unroll
            for (int j = 0; j < 8; ++j) { y[j] *= (j < 4 ? k0[j] : k1[j - 4]); ss += y[j] * y[j]; }
            const float inv = 1.0f / fmaxf(sqrtf(sum8(ss)), 1e-12f);
#pragma unroll
            for (int j = 0; j < 8; ++j) y[j] *= inv;
            *(u32x4*)(p.rKK + (size_t)tok * 512 + lane * 8) = pack8f(y);
        }
        {
            float y[8];
            shifted(1024 + lane * 8, y);
            *(u32x4*)(p.rV + (size_t)tok * 512 + lane * 8) = pack8f(y);
        }
        if (lane < 32) {
            float y[8];
            shifted(1536 + lane * 8, y);
            if (lane < 8) {
#pragma unroll
                for (int j = 0; j < 8; ++j) y[j] = tanhf(y[j]);
                *(u32x4*)(p.rTW + (size_t)tok * 64 + lane * 8) = pack8f(y);
            } else if (lane < 16) {
                *(u32x4*)(p.rAD + (size_t)tok * 64 + (lane - 8) * 8) = pack8f(y);
            } else {
#pragma unroll
                for (int j = 0; j < 8; ++j) y[j] = sigmoidf_(y[j]);
                *(u32x4*)(p.rSG + (size_t)tok * 128 + (lane - 16) * 8) = pack8f(y);
            }
        }
    }
    {
        const int half = tidx() >> 8, tid = tidx() & 255;
        float* lds = (float*)(smem + half * HLDS);
        for (int it = bid * 2 + half; it < 8 * 36 * 4; it += nblk * 2) {
            const int b = it / 144, rem = it % 144, kt = rem >> 2, h = rem & 3;
            __syncthreads();
#pragma unroll
            for (int i = 0; i < 8; ++i) {
                const int e = i * 256 + tid, key = e >> 5, c4 = (e & 31) * 4;
                const int kg = kt * 64 + key;
                const int tok = kg < CTXL ? NX + b * CTXL + kg : b * SEQ + (kg - CTXL);
                const uint2 v = *(const uint2*)((const bf16_t*)p.P + (size_t)tok * EVC + 1024 + h * 128 + c4);
                float* d = lds + key * 129 + c4;
                d[0] = __uint_as_float(v.x << 16); d[1] = __uint_as_float(v.x & 0xffff0000u); d[2] = __uint_as_float(v.y << 16); d[3] = __uint_as_float(v.y & 0xffff0000u);
            }
            __syncthreads();
            {
                const int dv = tid >> 1, half = tid & 1;
                unsigned w[16];
#pragma unroll
                for (int j = 0; j < 16; ++j) { const int q = 2 * j, key = 16 * ((q >> 2) & 1) + 4 * (q >> 3) + (q & 3);
                    w[j] = pack2(lds[(half * 32 + key) * 129 + dv], lds[(half * 32 + key + 1) * 129 + dv]); }
                u32x4* dst = (u32x4*)(p.Vd + (((size_t)b * 4 + h) * 128 + dv) * NKEY + kt * 64 + half * 32);
#pragma unroll
                for (int j = 0; j < 4; ++j) dst[j] = (u32x4){w[4 * j], w[4 * j + 1], w[4 * j + 2], w[4 * j + 3]};
            }
        }
    }
}

struct EpiDecay {
    const float* w0; float* W; int row0; int col0;
    __device__ __forceinline__ void one(int r, int c, f32x4 v) const {
        const int tok = row0 + r, cc = col0 + c, z = cc >> 9, ch = cc & 511;
        f32x4 o;
        const f32x4 w0v = *(const f32x4*)(w0 + z * 512 + ch);
#pragma unroll
        for (int j = 0; j < 4; ++j) {
            const float x = w0v[j] + v[j];
            const float u = -x;
            const float sp = fmaxf(u, 0.f) + __logf(1.0f + __expf(-fabsf(u)));
            const float wlog = -sp - 0.5f;
            o[j] = __expf(-__expf(wlog));
        }
        *(f32x4*)(W + ((size_t)z * NT + tok) * 512 + ch) = o;
    }
};
struct EpiStoreBf16 {
    bf16_t* C; int ldc; int row0; int col0;
    __device__ __forceinline__ void one(int r, int c, f32x4 v) const { *(uint2*)(C + (size_t)(row0 + r) * ldc + col0 + c) = make_uint2(pack2(v[0], v[1]), pack2(v[2], v[3])); }
};
struct EpiArate {
    const float* a0; const float* k_a; const bf16_t* rK; const bf16_t* rKK; bf16_t* KD; bf16_t* BV; int row0; int col0;
    __device__ __forceinline__ void one(int r, int c, f32x4 v) const {
        const int tok = row0 + r, z = (c >> 6) & 1, ch = (col0 >> 1) + (c & 63);
        const uint2 ku = *(const uint2*)(rK + (size_t)tok * 512 + ch), kku = *(const uint2*)(rKK + (size_t)tok * 512 + ch);
        const f32x4 k = (f32x4){__uint_as_float(ku.x << 16), __uint_as_float(ku.x & 0xffff0000u), __uint_as_float(ku.y << 16), __uint_as_float(ku.y & 0xffff0000u)};
        const f32x4 kk = (f32x4){__uint_as_float(kku.x << 16), __uint_as_float(kku.x & 0xffff0000u), __uint_as_float(kku.y << 16), __uint_as_float(kku.y & 0xffff0000u)};
        f32x4 kd, bv;
        const f32x4 a0v = *(const f32x4*)(a0 + z * 512 + ch), kav = *(const f32x4*)(k_a + ch);
#pragma unroll
        for (int j = 0; j < 4; ++j) {
            const float arate = sigmoidf_(a0v[j] + v[j]);
            kd[j] = k[j] * (1.f + (arate - 1.f) * kav[j]);
            bv[j] = kk[j] * arate;
        }
        *(uint2*)(KD + ((size_t)z * NT + tok) * 512 + ch) = make_uint2(pack2(kd[0], kd[1]), pack2(kd[2], kd[3]));
        *(uint2*)(BV + ((size_t)z * NT + tok) * 512 + ch) = make_uint2(pack2(bv[0], bv[1]), pack2(bv[2], bv[3]));
    }
};
__device__ __forceinline__ void phase_lora(const Params& p, int bid, int nblk, char* smem) {
    const int half = tidx() >> 8;
    char* hs = smem + half * HLDS;
    for (int it0 = bid * 2; it0 < 144 * 20; it0 += nblk * 2) {
        const int it = it0 + half;
        if (it < 1152) {
            const int mt = it >> 3, q = it & 7;
            ARows ar{p.rTW, 64, nullptr, 0, mt * 128};
            EpiDecay epi{p.rw_w0, p.rW, mt * 128, q * 128};
            gemm_tile<false>(ar, 128, p.wt_w2 + (size_t)q * 128 * 64, 64, 64, epi, hs);
        } else if (it < 2304) {
            const int j = it - 1152, mt = j >> 3, q = j & 7;
            ARows ar{p.rAD, 64, nullptr, 0, mt * 128};
            EpiArate epi{p.rw_a0, p.rw_k_a, p.rK, p.rKK, p.rKD, p.rBV, mt * 128, q * 128};
            gemm_tile<false>(ar, 128, p.wt_a2 + (size_t)q * 128 * 64, 64, 64, epi, hs);
        } else {
            const int j = it - 2304, mt = j >> 2, q = j & 3;
            ARows ar{p.rSG, 128, nullptr, 0, mt * 128};
            EpiStoreBf16 epi{p.rG, 512, mt * 128, q * 128};
            gemm_tile<false>(ar, 128, p.wt_g2 + (size_t)q * 128 * 128, 128, 128, epi, hs);
        }
    }
}

__device__ __forceinline__ int scan_tok(int z, int b, int s) {
    if (s < CTXL) { const int tc = z == 0 ? s : (CTXL - 1 - s); return NX + b * CTXL + tc; }
    const int t = s - CTXL; return b * SEQ + (z == 0 ? t : (SEQ - 1 - t));
}
typedef float f32x2 __attribute__((ext_vector_type(2)));
__device__ __forceinline__ bf16x8 cvt8(const f32x4 a, const f32x4 b) {
    union { bf16x8 v; unsigned u[4]; } r;
    r.u[0] = pack2(a[0], a[1]); r.u[1] = pack2(a[2], a[3]); r.u[2] = pack2(b[0], b[1]); r.u[3] = pack2(b[2], b[3]);
    return r.v;
}
__device__ __forceinline__ void rwkv_chunk_chain(const Params& p, int chain, char* smem) {
    const int z = chain >> 6, b = (chain >> 3) & 7, h = chain & 7;
    const int tid = tidx(), lane = tid & 63, fr = lane & 15, fq = lane >> 4;
    const int wv_ = __builtin_amdgcn_readfirstlane(tid >> 6);
    bf16_t* AR = (bf16_t*)(smem + 43008);
    bf16_t* BK = (bf16_t*)(smem + 47104);
    bf16_t* BKT = (bf16_t*)(smem + 51200);
    bf16_t* VT = (bf16_t*)(smem + 55296);
    bf16_t* SB = (bf16_t*)(smem + 59392);
    float* AM = (float*)(smem + 67584);
    float* RH = (float*)(smem + 71680);
    float* GC = (float*)(smem + 75776);
    f32x4 S0 = (f32x4){0.f, 0.f, 0.f, 0.f}, S1 = S0;
    for (int i = tid; i < 2048; i += NTHR) ((unsigned*)SB)[i] = 0u;
    const size_t zoff = (size_t)z * NT * 512;
    const char* src1; const char* src2 = nullptr; unsigned dst1, dst2 = 0; int st1, st2 = 0;
    if (wv_ < 4) { src1 = (const char*)(p.rW + zoff + h * 64 + (lane & 15) * 4); st1 = 4 * wv_ + (lane >> 4); dst1 = wv_ * 1024; }
    else if (wv_ < 6) { src1 = (const char*)(p.rR + h * 64 + (lane & 7) * 8); st1 = 8 * (wv_ - 4) + (lane >> 3); dst1 = 4096 + (wv_ - 4) * 1024; }
    else { src1 = (const char*)(p.rKD + zoff + h * 64 + (lane & 7) * 8); st1 = 8 * (wv_ - 6) + (lane >> 3); dst1 = 6144 + (wv_ - 6) * 1024; }
    if (wv_ < 2) { src2 = (const char*)(p.rKK + h * 64 + (lane & 7) * 8); st2 = 8 * wv_ + (lane >> 3); dst2 = 8192 + wv_ * 1024; }
    else if (wv_ < 4) { src2 = (const char*)(p.rBV + zoff + h * 64 + (lane & 7) * 8); st2 = 8 * (wv_ - 2) + (lane >> 3); dst2 = 10240 + (wv_ - 2) * 1024; }
    else if (wv_ < 6) { src2 = (const char*)(p.rV + h * 64 + (lane & 7) * 8); st2 = 8 * (wv_ - 4) + (lane >> 3); dst2 = 12288 + (wv_ - 4) * 1024; }
    const int esz1 = wv_ < 4 ? 4 : 2;
    auto issue = [&](int chunk) {
        char* bb = smem + (chunk % 3) * 14336;
        const int tok1 = scan_tok(z, b, chunk * 16 + st1);
        __builtin_amdgcn_global_load_lds((const unsigned*)(src1 + (size_t)tok1 * 512 * esz1), (__attribute__((address_space(3))) unsigned*)(bb + dst1), 16, 0, 0);
        if (wv_ < 6) {
            const int tok2 = scan_tok(z, b, chunk * 16 + st2);
            __builtin_amdgcn_global_load_lds((const unsigned*)(src2 + (size_t)tok2 * 512 * 2), (__attribute__((address_space(3))) unsigned*)(bb + dst2), 16, 0, 0);
        }
    };
    issue(0); issue(1);
    const int ch = lane, t0 = 2 * wv_, t1 = t0 + 1;
    const int tokdir = z == 0 ? 1 : -1;
    for (int chunk = 0; chunk < 144; ++chunk) {
        if (chunk + 1 < 144) { if (wv_ < 6) asm volatile("s_waitcnt vmcnt(2)" ::: "memory"); else asm volatile("s_waitcnt vmcnt(1)" ::: "memory"); }
        else asm volatile("s_waitcnt vmcnt(0)" ::: "memory");
        __syncthreads();
        if (chunk + 2 < 144) issue(chunk + 2);
        const float* cbw = (const float*)(smem + (chunk % 3) * 14336);
        const bf16_t* cb = (const bf16_t*)(smem + (chunk % 3) * 14336 + 4096);
        const float w0 = cbw[t0 * 64 + ch], w1 = cbw[t1 * 64 + ch];
        {
            float gb = 1.f, gall = 1.f;
#pragma unroll
            for (int t = 0; t < 16; ++t) { const float wt = cbw[t * 64 + ch]; gall *= wt; if (t < t0) gb *= wt; }
            const float gt0 = gb * w0, gt1 = gt0 * w1;
            const float ig0 = __builtin_amdgcn_rcpf(gt0), ig1 = __builtin_amdgcn_rcpf(gt1);
            const float a0 = -gb * bf2f(cb[2048 + t0 * 64 + ch]), a1 = -gt0 * bf2f(cb[2048 + t1 * 64 + ch]);
            const float r0 = gt0 * bf2f(cb[t0 * 64 + ch]), r1 = gt1 * bf2f(cb[t1 * 64 + ch]);
            const float b0 = bf2f(cb[3072 + t0 * 64 + ch]) * ig0, b1 = bf2f(cb[3072 + t1 * 64 + ch]) * ig1;
            const float k0 = bf2f(cb[1024 + t0 * 64 + ch]) * ig0, k1 = bf2f(cb[1024 + t1 * 64 + ch]) * ig1;
            const float v0 = bf2f(cb[4096 + t0 * 64 + ch]), v1 = bf2f(cb[4096 + t1 * 64 + ch]);
            const int cc = ch >> 3, cw = ch & 7;
            AR[t0 * 64 + ((cc ^ (t0 & 7)) << 3) + cw] = f2bf(a0);
            AR[t1 * 64 + ((cc ^ (t1 & 7)) << 3) + cw] = f2bf(a1);
            AR[(16 + t0) * 64 + ((cc ^ (t0 & 7)) << 3) + cw] = f2bf(r0);
            AR[(16 + t1) * 64 + ((cc ^ (t1 & 7)) << 3) + cw] = f2bf(r1);
            BK[t0 * 64 + ((cc ^ (t0 & 7)) << 3) + cw] = f2bf(b0);
            BK[t1 * 64 + ((cc ^ (t1 & 7)) << 3) + cw] = f2bf(b1);
            BK[(16 + t0) * 64 + ((cc ^ (t0 & 7)) << 3) + cw] = f2bf(k0);
            BK[(16 + t1) * 64 + ((cc ^ (t1 & 7)) << 3) + cw] = f2bf(k1);
            const int sw = (ch >> 2) & 3;
            *(unsigned*)(BKT + ch * 32 + (((t0 >> 3) ^ sw) << 3) + (t0 & 7)) = pack2(b0, b1);
            *(unsigned*)(BKT + ch * 32 + ((((16 + t0) >> 3) ^ sw) << 3) + (t0 & 7)) = pack2(k0, k1);
            *(unsigned*)(VT + ch * 32 + ((((16 + t0) >> 3) ^ sw) << 3) + (t0 & 7)) = pack2(v0, v1);
            if (wv_ == 0) GC[ch] = gall;
        }
        __syncthreads();
        f32x4 G2 = (f32x4){0.f, 0.f, 0.f, 0.f};
        {
            const int rb = wv_ >> 2, vb = wv_ & 3;
            const int ra = 16 * rb + fr, rs = 16 * vb + fr;
#pragma unroll
            for (int ks = 0; ks < 2; ++ks) {
                const int c = ks * 4 + fq;
                const bf16x8 af = *(const bf16x8*)(AR + ra * 64 + ((c ^ (ra & 7)) << 3));
                const bf16x8 sf = *(const bf16x8*)(SB + rs * 64 + ((c ^ (rs & 7)) << 3));
                G2 = __builtin_amdgcn_mfma_f32_16x16x32_bf16(af, sf, G2, 0, 0, 0);
            }
        }
        if (wv_ < 4) {
            const int rb = wv_ >> 1, cbk = wv_ & 1;
            const int ra = 16 * rb + fr, rk = 16 * cbk + fr;
            f32x4 G1 = (f32x4){0.f, 0.f, 0.f, 0.f};
#pragma unroll
            for (int ks = 0; ks < 2; ++ks) {
                const int c = ks * 4 + fq;
                const bf16x8 af = *(const bf16x8*)(AR + ra * 64 + ((c ^ (ra & 7)) << 3));
                const bf16x8 bf = *(const bf16x8*)(BK + rk * 64 + ((c ^ (rk & 7)) << 3));
                G1 = __builtin_amdgcn_mfma_f32_16x16x32_bf16(af, bf, G1, 0, 0, 0);
            }
            if (wv_ == 0) {
                f32x4 m;
#pragma unroll
                for (int j = 0; j < 4; ++j) m[j] = (fr < 4 * fq + j) ? G1[j] : 0.f;
                *(f32x4*)(AM + fr * 16 + 4 * fq) = m;
            } else {
#pragma unroll
                for (int j = 0; j < 4; ++j) {
                    const int t = 4 * fq + j;
                    const bool keep = rb == 0 ? (fr < t) : (fr <= t);
                    AM[wv_ * 256 + t * 16 + fr] = keep ? G1[j] : 0.f;
                }
            }
        }
        __syncthreads();
        if (wv_ < 4) {
            union { bf16x8 v; unsigned u[4]; } af;
            if (fq < 2) {
                const f32x4 x0 = *(const f32x4*)(AM + 256 + fr * 16 + 8 * fq), x1 = *(const f32x4*)(AM + 256 + fr * 16 + 8 * fq + 4);
                af.v = cvt8(x0, x1);
            } else { af.u[0] = 0u; af.u[1] = 0u; af.u[2] = 0u; af.u[3] = 0u; }
            const int rv = 16 * wv_ + fr;
            const bf16x8 vf = *(const bf16x8*)(VT + rv * 32 + (((2 + (fq & 1)) ^ ((rv >> 2) & 3)) << 3));
            G2 = __builtin_amdgcn_mfma_f32_16x16x32_bf16(af.v, vf, G2, 0, 0, 0);
#pragma unroll
            for (int j = 0; j < 4; ++j) RH[(4 * fq + j) * 64 + rv] = G2[j];
        }
        __syncthreads();
        if (wv_ == 0) {
            float x[16];
#pragma unroll
            for (int t = 0; t < 16; ++t) x[t] = RH[t * 64 + lane];
#pragma unroll
            for (int i = 0; i < 15; ++i) {
                const float xi = x[i];
#pragma unroll
                for (int q = 0; q < 4; ++q) {
                    if (4 * q + 3 > i) {
                        const f32x4 acol = *(const f32x4*)(AM + i * 16 + 4 * q);
#pragma unroll
                        for (int j = 0; j < 4; ++j) if (4 * q + j > i) x[4 * q + j] += acol[j] * xi;
                    }
                }
            }
            const int sw = (lane >> 2) & 3;
            *(u32x4*)(VT + lane * 32 + ((0 ^ sw) << 3)) = (u32x4){pack2(x[0], x[1]), pack2(x[2], x[3]), pack2(x[4], x[5]), pack2(x[6], x[7])};
            *(u32x4*)(VT + lane * 32 + ((1 ^ sw) << 3)) = (u32x4){pack2(x[8], x[9]), pack2(x[10], x[11]), pack2(x[12], x[13]), pack2(x[14], x[15])};
        }
        __syncthreads();
        if (wv_ >= 4) {
            const int vb = wv_ & 3, rv = 16 * vb + fr;
            const float* am = AM + (fq < 2 ? 512 : 768) + fr * 16 + 8 * (fq & 1);
            const bf16x8 af = cvt8(*(const f32x4*)am, *(const f32x4*)(am + 4));
            const bf16x8 vf = *(const bf16x8*)(VT + rv * 32 + ((fq ^ ((rv >> 2) & 3)) << 3));
            G2 = __builtin_amdgcn_mfma_f32_16x16x32_bf16(af, vf, G2, 0, 0, 0);
            const int tokbase = scan_tok(z, b, chunk * 16);
#pragma unroll
            for (int j = 0; j < 4; ++j) p.rY[zoff + (size_t)(tokbase + tokdir * (4 * fq + j)) * 512 + h * 64 + rv] = G2[j];
        }
        {
            const int vb = wv_ >> 1, kb0 = 2 * (wv_ & 1);
            const int rv = 16 * vb + fr;
            const bf16x8 uf = *(const bf16x8*)(VT + rv * 32 + ((fq ^ ((rv >> 2) & 3)) << 3));
            const int rk0 = 16 * kb0 + fr, rk1 = rk0 + 16;
            const bf16x8 b0 = *(const bf16x8*)(BKT + rk0 * 32 + ((fq ^ ((rk0 >> 2) & 3)) << 3));
            const bf16x8 b1 = *(const bf16x8*)(BKT + rk1 * 32 + ((fq ^ ((rk1 >> 2) & 3)) << 3));
            S0 = __builtin_amdgcn_mfma_f32_16x16x32_bf16(uf, b0, S0, 0, 0, 0);
            S1 = __builtin_amdgcn_mfma_f32_16x16x32_bf16(uf, b1, S1, 0, 0, 0);
            const float gc0 = GC[rk0], gc1 = GC[rk1];
            S0 *= gc0; S1 *= gc1;
#pragma unroll
            for (int j = 0; j < 4; ++j) {
                const int v = 16 * vb + 4 * fq + j;
                SB[v * 64 + (((rk0 >> 3) ^ (v & 7)) << 3) + (rk0 & 7)] = f2bf(S0[j]);
                SB[v * 64 + (((rk1 >> 3) ^ (v & 7)) << 3) + (rk1 & 7)] = f2bf(S1[j]);
            }
        }
    }
    asm volatile("s_waitcnt vmcnt(0)" ::: "memory");
    __syncthreads();
}

__device__ __forceinline__ float max3_s(float a, float b, float c) { float r; asm("v_max3_f32 %0, %1, %2, %3" : "=v"(r) : "v"(a), "v"(b), "v"(c)); return r; }
__device__ __forceinline__ void attn_item(const Params& p, int b, int h, int q0, bool isctx, char* smem) {
    const int tid = tidx(), lane = tid & 63, wid = tid >> 6, fr = lane & 15, fq = lane >> 4;
    bf16_t* sKV = (bf16_t*)smem;
    const int ntiles = isctx ? (CTXL / 64) : (NKEY / 64);
    bf16x8 qf[2][2];
#pragma unroll
    for (int m = 0; m < 2; ++m) {
        const bf16_t* qp = isctx ? p.Qc + (((size_t)b * 8 + h * 2 + m) * CTXL + q0 + wid * 16 + fr) * 64
                                 : p.Q + (((size_t)b * 8 + h * 2 + m) * SEQ + q0 + wid * 16 + fr) * 64;
        qf[m][0] = *(const bf16x8*)(qp + fq * 8);
        qf[m][1] = *(const bf16x8*)(qp + 32 + fq * 8);
    }
    f32x4 o[2][8];
#pragma unroll
    for (int m = 0; m < 2; ++m)
#pragma unroll
        for (int mb = 0; mb < 8; ++mb) o[m][mb] = (f32x4){0.f, 0.f, 0.f, 0.f};
    float mrun[2] = {0.f, 0.f}, lrun[2] = {0.f, 0.f};
    const int lrow = tid >> 3, lch = tid & 7;
    const bf16_t* kbase = p.Kd + (((size_t)b * 8 + h * 2) * NKEY + lrow) * 64 + lch * 8;
    const bf16_t* vbase = p.Vd + (((size_t)b * 4 + h) * 128 + lrow) * NKEY + lch * 8;
    u32x4 rk[2], rv[2];
#pragma unroll
    for (int i = 0; i < 2; ++i) { rk[i] = *(const u32x4*)(kbase + i * (NKEY * 64)); rv[i] = *(const u32x4*)(vbase + i * (64 * NKEY)); }
    __syncthreads();
#pragma unroll
    for (int i = 0; i < 2; ++i) {
        const int r = lrow + 64 * i;
        const int off = r * 64 + ((lch ^ (r & 7)) << 3);
        *(u32x4*)(sKV + off) = rk[i];
        *(u32x4*)(sKV + 8192 + off) = rv[i];
    }
    if (ntiles > 1) {
#pragma unroll
        for (int i = 0; i < 2; ++i) { rk[i] = *(const u32x4*)(kbase + 4096 + i * (NKEY * 64)); rv[i] = *(const u32x4*)(vbase + 64 + i * (64 * NKEY)); }
    }
    for (int t = 0; t < ntiles; ++t) {
        __syncthreads();
        const bf16_t* sK = sKV + (t & 1) * 16384;
        const bf16_t* sV = sK + 8192;
        if (t + 1 < ntiles) {
            bf16_t* dK = sKV + ((t + 1) & 1) * 16384;
#pragma unroll
            for (int i = 0; i < 2; ++i) {
                const int r = lrow + 64 * i;
                const int off = r * 64 + ((lch ^ (r & 7)) << 3);
                *(u32x4*)(dK + off) = rk[i];
                *(u32x4*)(dK + 8192 + off) = rv[i];
            }
            if (t + 2 < ntiles) {
#pragma unroll
                for (int i = 0; i < 2; ++i) { rk[i] = *(const u32x4*)(kbase + (t + 2) * 4096 + i * (NKEY * 64)); rv[i] = *(const u32x4*)(vbase + (t + 2) * 64 + i * (64 * NKEY)); }
            }
        }
        bf16x8 pf[2][2];
#pragma unroll
        for (int m = 0; m < 2; ++m) {
            f32x4 sc[4];
            const float nm = -mrun[m];
#pragma unroll
            for (int kb = 0; kb < 4; ++kb) {
                sc[kb] = (f32x4){nm, nm, nm, nm};
                const int r = m * 64 + kb * 16 + fr;
#pragma unroll
                for (int ks = 0; ks < 2; ++ks) {
                    const bf16x8 kf = *(const bf16x8*)(sK + r * 64 + (((ks * 4 + fq) ^ (r & 7)) << 3));
                    sc[kb] = __builtin_amdgcn_mfma_f32_16x16x32_bf16(kf, qf[m][ks], sc[kb], 0, 0, 0);
                }
            }
            float mx = max3_s(sc[0][0], sc[0][1], sc[0][2]);
            mx = max3_s(mx, sc[0][3], sc[1][0]); mx = max3_s(mx, sc[1][1], sc[1][2]); mx = max3_s(mx, sc[1][3], sc[2][0]);
            mx = max3_s(mx, sc[2][1], sc[2][2]); mx = max3_s(mx, sc[2][3], sc[3][0]); mx = max3_s(mx, sc[3][1], sc[3][2]);
            mx = fmaxf(mx, sc[3][3]);
            mx = fmaxf(mx, __shfl_xor(mx, 16));
            mx = fmaxf(mx, __shfl_xor(mx, 32));
            if (!__all(mx <= 8.0f)) {
                const float d = mx > 8.0f ? mx : 0.f;
                const float scale = __builtin_amdgcn_exp2f(-d);
                mrun[m] += d;
                lrun[m] *= scale;
#pragma unroll
                for (int mb = 0; mb < 8; ++mb) o[m][mb] *= scale;
#pragma unroll
                for (int kb = 0; kb < 4; ++kb) sc[kb] -= d;
            }
            float ls = 0.f;
#pragma unroll
            for (int kb = 0; kb < 4; ++kb)
#pragma unroll
                for (int j = 0; j < 4; ++j) { const float e = __builtin_amdgcn_exp2f(sc[kb][j]); sc[kb][j] = e; ls += e; }
            lrun[m] += ls;
#pragma unroll
            for (int ksp = 0; ksp < 2; ++ksp) {
                const u32x4 pk = (u32x4){pack2(sc[2 * ksp][0], sc[2 * ksp][1]), pack2(sc[2 * ksp][2], sc[2 * ksp][3]), pack2(sc[2 * ksp + 1][0], sc[2 * ksp + 1][1]), pack2(sc[2 * ksp + 1][2], sc[2 * ksp + 1][3])};
                pf[m][ksp] = __builtin_bit_cast(bf16x8, pk);
            }
        }
#pragma unroll
        for (int ksp = 0; ksp < 2; ++ksp) {
#pragma unroll
            for (int mb = 0; mb < 8; ++mb) {
                const int r = mb * 16 + fr;
                const bf16x8 vfv = *(const bf16x8*)(sV + r * 64 + (((4 * ksp + fq) ^ (r & 7)) << 3));
                o[0][mb] = __builtin_amdgcn_mfma_f32_16x16x32_bf16(vfv, pf[0][ksp], o[0][mb], 0, 0, 0);
                o[1][mb] = __builtin_amdgcn_mfma_f32_16x16x32_bf16(vfv, pf[1][ksp], o[1][mb], 0, 0, 0);
                if ((mb & 3) == 3) asm volatile("" ::: "memory");
            }
        }
    }
    {
        float l0 = lrun[0], l1 = lrun[1];
        l0 += __shfl_xor(l0, 16); l0 += __shfl_xor(l0, 32);
        l1 += __shfl_xor(l1, 16); l1 += __shfl_xor(l1, 32);
        const float i0 = 1.0f / l0, i1 = p.scal[0] / l1;
        float ss = 0.f;
#pragma unroll
        for (int mb = 0; mb < 8; ++mb) {
            o[0][mb] = o[0][mb] * i0 - o[1][mb] * i1;
            ss += o[0][mb][0] * o[0][mb][0] + o[0][mb][1] * o[0][mb][1] + o[0][mb][2] * o[0][mb][2] + o[0][mb][3] * o[0][mb][3];
        }
        ss += __shfl_xor(ss, 16); ss += __shfl_xor(ss, 32);
        const float rstd = rsqrtf(ss * (1.0f / 128.0f) + 1e-6f) * 0.8f;
        const int tok = (isctx ? NX + b * CTXL : b * SEQ) + q0 + wid * 16 + fr;
        bf16_t* dst = p.MG + (size_t)tok * DM + h * 128 + fq * 4;
#pragma unroll
        for (int mb = 0; mb < 8; ++mb) {
            const f32x4 g = *(const f32x4*)(p.da_subln + mb * 16 + fq * 4);
            *(uint2*)(dst + mb * 16) = make_uint2(pack2(o[0][mb][0] * rstd * g[0], o[0][mb][1] * rstd * g[1]), pack2(o[0][mb][2] * rstd * g[2], o[0][mb][3] * rstd * g[3]));
        }
    }
}

#define N_ATT_LAT 512
#define N_ATT_CTX 64
#define N_CONV_LATE (1280 + 256 + 16384 + 8192)
__device__ __forceinline__ ConvDesc conv_late_desc(const Params& p, int pr) {
    const int j = pr * 2 + (tidx() >> 8);
    if (j < 1280) return ConvDesc{p.od_w_in, p.wt_odin, ODC, 1024, j / 80, j % 80, 0, 0};
    if (j < 1536) { const int q = j - 1280; return ConvDesc{p.od_w_out, p.wt_odout, 1024, 1024, q >> 4, q & 15, 0, 0}; }
    if (j < 1536 + 16384) { const int q = j - 1536, mat = q >> 9, t = q & 511; return ConvDesc{p.moe_w_gu + (size_t)mat * 1024 * 2048, p.wt_gu + (size_t)mat * 2048 * 1024, 2048, 1024, t >> 5, t & 31, 1, 0}; }
    const int q = j - 1536 - 16384, mat = q >> 8, t = q & 255;
    return ConvDesc{p.moe_w_dn + (size_t)mat * 1024 * 1024, p.wt_dn + (size_t)mat * 1024 * 1024, 1024, 1024, t >> 4, t & 15, 2, 0};
}
__device__ __forceinline__ ConvDesc conv_l1_desc(const Params& p, int pr) {
    const int j = pr * 2 + (tidx() >> 8);
    if (j < 16384) { const int mat = 32 + (j >> 9), t = j & 511; return ConvDesc{p.moe_w_gu + (size_t)mat * 1024 * 2048, p.wt_gu + (size_t)mat * 2048 * 1024, 2048, 1024, t >> 5, t & 31, 1, 0}; }
    const int q = j - 16384, mat = 32 + (q >> 8), t = q & 255;
    return ConvDesc{p.moe_w_dn + (size_t)mat * 1024 * 1024, p.wt_dn + (size_t)mat * 1024 * 1024, 1024, 1024, t >> 4, t & 15, 2, 0};
}
template <bool L1> __device__ __forceinline__ void conv_group(const Params& p, int g, char* smem) {
    float* lds = (float*)(smem + (tidx() >> 8) * HLDS);
    ConvDesc d = L1 ? conv_l1_desc(p, g * CONV_GRP) : conv_late_desc(p, g * CONV_GRP);
    ConvRegs x = conv_load(d);
#pragma unroll 1
    for (int q = 0; q < CONV_GRP; ++q) {
        ConvDesc dn = d; ConvRegs xn = x;
        if (q + 1 < CONV_GRP) { dn = L1 ? conv_l1_desc(p, g * CONV_GRP + q + 1) : conv_late_desc(p, g * CONV_GRP + q + 1); xn = conv_load(dn); }
        conv_store(x, d, lds);
        d = dn; x = xn;
    }
}
__device__ __forceinline__ void phase_scan_attn(const Params& p, int bid, int nblk, char* smem) {
    for (int it = bid; it < 128; it += nblk) rwkv_chunk_chain(p, it, smem);
    const int n_att = N_ATT_LAT + N_ATT_CTX, n_all = n_att + (N_CONV_LATE / 2) / CONV_GRP;
    for (;;) {
        const int it = q_next(p.counts + 64, smem);
        if (it >= n_all) break;
        if (it < N_ATT_LAT) attn_item(p, it >> 6, (it >> 4) & 3, (it & 15) * 128, false, smem);
        else if (it < n_att) { const int j = it - N_ATT_LAT; attn_item(p, j >> 3, (j >> 1) & 3, (j & 1) * 128, true, smem); }
        else {
            conv_group<false>(p, it - n_att, smem);
        }
    }
}

__device__ __forceinline__ void phase_rw_readout(const Params& p, int bid, int nblk) {
    const int lane = tidx() & 63, wid = tidx() >> 6;
    const int c0 = lane * 8;
    f32x4 rk0 = *(const f32x4*)(p.rw_r_k + c0), rk1 = *(const f32x4*)(p.rw_r_k + c0 + 4);
    f32x4 lw0 = *(const f32x4*)(p.rw_ln_w + c0), lw1 = *(const f32x4*)(p.rw_ln_w + c0 + 4);
    f32x4 lb0 = *(const f32x4*)(p.rw_ln_b + c0), lb1 = *(const f32x4*)(p.rw_ln_b + c0 + 4);
    for (int tok = bid * 8 + wid; tok < NT; tok += nblk * 8) {
        const size_t o = (size_t)tok * 512 + c0, zo = (size_t)NT * 512;
        const f32x4 ya0 = *(const f32x4*)(p.rY + o), ya1 = *(const f32x4*)(p.rY + o + 4), yb0 = *(const f32x4*)(p.rY + zo + o), yb1 = *(const f32x4*)(p.rY + zo + o + 4);
        float tr[8], tka[8], tkb[8], tv[8], tg[8];
        unpack8(*(const u32x4*)(p.rR + o), tr); unpack8(*(const u32x4*)(p.rKD + o), tka); unpack8(*(const u32x4*)(p.rKD + zo + o), tkb);
        unpack8(*(const u32x4*)(p.rV + o), tv); unpack8(*(const u32x4*)(p.rG + o), tg);
        const f32x4 r0 = (f32x4){tr[0], tr[1], tr[2], tr[3]}, r1 = (f32x4){tr[4], tr[5], tr[6], tr[7]};
        const f32x4 ka0 = (f32x4){tka[0], tka[1], tka[2], tka[3]}, ka1 = (f32x4){tka[4], tka[5], tka[6], tka[7]}, kb0 = (f32x4){tkb[0], tkb[1], tkb[2], tkb[3]}, kb1 = (f32x4){tkb[4], tkb[5], tkb[6], tkb[7]};
        const f32x4 v0 = (f32x4){tv[0], tv[1], tv[2], tv[3]}, v1 = (f32x4){tv[4], tv[5], tv[6], tv[7]}, g0 = (f32x4){tg[0], tg[1], tg[2], tg[3]}, g1 = (f32x4){tg[4], tg[5], tg[6], tg[7]};
        const f32x4 y0 = ya0 + yb0, y1 = ya1 + yb1;
        const float mean = sum8((y0[0] + y0[1]) + (y0[2] + y0[3]) + (y1[0] + y1[1]) + (y1[2] + y1[3])) * (1.0f / 64.0f);
        const f32x4 d0 = y0 - mean, d1 = y1 - mean;
        const float var = sum8((d0[0] * d0[0] + d0[1] * d0[1]) + (d0[2] * d0[2] + d0[3] * d0[3]) + (d1[0] * d1[0] + d1[1] * d1[1]) + (d1[2] * d1[2] + d1[3] * d1[3])) * (1.0f / 64.0f);
        const float rs = rsqrtf(var + 64e-5f);
        const f32x4 b0 = r0 * (ka0 + kb0) * rk0, b1 = r1 * (ka1 + kb1) * rk1;
        const float bon = sum8((b0[0] + b0[1]) + (b0[2] + b0[3]) + (b1[0] + b1[1]) + (b1[2] + b1[3]));
        const f32x4 o0 = (d0 * rs * lw0 + lb0 + bon * v0) * g0, o1 = (d1 * rs * lw1 + lb1 + bon * v1) * g1;
        *(u32x4*)(p.MG + (size_t)tok * DM + 512 + c0) = (u32x4){pack2(o0[0], o0[1]), pack2(o0[2], o0[3]), pack2(o1[0], o1[1]), pack2(o1[2], o1[3])};
    }
}

__device__ __forceinline__ void phase_router(const Params& p, int bid, int nblk, char* smem, int layer, const float* X, int ntok, bool dry = false) {
    const int tid = tidx(), lane = tid & 63, wid = tid >> 6;
    float* hrow = (float*)smem;
    float* part = hrow + 16 * 1028;
    float* logits = part + 8 * 512;
    const float* gain = p.norm2_g + layer * DM;
    const float* modl = p.mod + (size_t)layer * 9 * 6144;
    const float* wr = p.router_w + (size_t)layer * DM * NEXP;
    const float* br = p.router_b + layer * NEXP;
    int* counts = p.counts + layer * NEXP;
    int* lists = p.lists + (size_t)layer * NEXP * NT;
    for (int it = bid; it < ntok / 16; it += nblk) {
        __syncthreads();
#pragma unroll
        for (int u = 0; u < 2; ++u) {
            const int tl = wid * 2 + u, tok = it * 16 + tl;
            const float* xr = X + (size_t)tok * DM;
            const float* mr = modl + modrow(tok) * 6144 + 3072;
            float4 v[4];
            float ss = 0.f;
#pragma unroll
            for (int i = 0; i < 4; ++i) { v[i] = *(const float4*)(xr + lane * 4 + 256 * i); ss += v[i].x * v[i].x + v[i].y * v[i].y + v[i].z * v[i].z + v[i].w * v[i].w; }
            ss = wave_sum(ss);
            const float rstd = rsqrtf(ss * (1.0f / 1024.0f) + 1e-6f);
#pragma unroll
            for (int i = 0; i < 4; ++i) {
                const int c = lane * 4 + 256 * i;
                const float4 g = *(const float4*)(gain + c), sh = *(const float4*)(mr + c), sc = *(const float4*)(mr + 1024 + c);
                float4 a;
                a.x = v[i].x * rstd * g.x * (1.f + sc.x) + sh.x; a.y = v[i].y * rstd * g.y * (1.f + sc.y) + sh.y;
                a.z = v[i].z * rstd * g.z * (1.f + sc.z) + sh.z; a.w = v[i].w * rstd * g.w * (1.f + sc.w) + sh.w;
                *(uint2*)(p.H + (size_t)tok * DM + c) = make_uint2(pack2(a.x, a.y), pack2(a.z, a.w));
                *(float4*)(hrow + tl * 1028 + c) = a;
            }
        }
        __syncthreads();
        {
            const int tokl = lane & 15, kq = lane >> 4;
            f32x4 c0 = (f32x4){0.f, 0.f, 0.f, 0.f}, c1 = c0;
            const float* hp = hrow + tokl * 1028 + wid * 128 + kq;
            const float* wp = wr + (size_t)(wid * 128 + kq) * 32 + tokl;
#pragma unroll 8
            for (int ks = 0; ks < 32; ++ks) {
                const float a = hp[ks * 4];
                const float b0 = wp[ks * 128], b1 = wp[ks * 128 + 16];
                c0 = __builtin_amdgcn_mfma_f32_16x16x4f32(a, b0, c0, 0, 0, 0);
                c1 = __builtin_amdgcn_mfma_f32_16x16x4f32(a, b1, c1, 0, 0, 0);
            }
#pragma unroll
            for (int j = 0; j < 4; ++j) {
                part[wid * 512 + (4 * kq + j) * 32 + tokl] = c0[j];
                part[wid * 512 + (4 * kq + j) * 32 + 16 + tokl] = c1[j];
            }
        }
        __syncthreads();
        {
            const int tl = tid >> 5, e = tid & 31;
            float a = br[e];
#pragma unroll
            for (int w = 0; w < 8; ++w) a += part[w * 512 + tl * 32 + e];
            logits[tl * 32 + e] = a;
        }
        __syncthreads();
        if (tid < 16) {
            const int tok = it * 16 + tid;
            float lv[32];
#pragma unroll
            for (int e = 0; e < 32; ++e) lv[e] = logits[tid * 32 + e];
            float tv[4]; int te[4];
#pragma unroll
            for (int k = 0; k < 4; ++k) {
                float best = -3.0e38f; int bi = 0;
#pragma unroll
                for (int e = 0; e < 32; ++e) { if (lv[e] > best) { best = lv[e]; bi = e; } }
                tv[k] = best; te[k] = bi;
#pragma unroll
                for (int e = 0; e < 32; ++e) { if (e == bi) lv[e] = -3.0e38f; }
            }
            const float e1 = __expf(tv[1] - tv[0]), e2 = __expf(tv[2] - tv[0]), e3 = __expf(tv[3] - tv[0]);
            const float inv = 1.0f / (1.0f + e1 + e2 + e3);
            const float gt[4] = {inv, e1 * inv, e2 * inv, e3 * inv};
#pragma unroll
            for (int k = 0; k < 4; ++k) {
                p.GATE[(size_t)tok * 4 + k] = gt[k];
                if (!dry) {
                    const int pos = atomicAdd(&counts[te[k]], 1);
                    lists[(size_t)te[k] * NT + pos] = tok * 4 + k;
                }
            }
        }
    }
}

struct EpiGU {
    const float* bias; bf16_t* act; int pos0; int unit0;
    __device__ __forceinline__ void pair(int r, int cu, f32x4 g, f32x4 u) const {
        const int unit = unit0 + cu;
        unsigned w[2]; float o[4];
#pragma unroll
        for (int j = 0; j < 4; ++j) {
            const float gate = fminf(g[j] + bias[unit + j], 7.0f);
            const float up = fminf(fmaxf(u[j] + bias[1024 + unit + j], -7.0f), 7.0f);
            o[j] = (up + 1.0f) * gate * sigmoidf_(1.702f * gate);
        }
        w[0] = pack2(o[0], o[1]); w[1] = pack2(o[2], o[3]);
        *(uint2*)(act + (size_t)(pos0 + r) * 1024 + unit) = make_uint2(w[0], w[1]);
    }
};
struct MoeIter {
    int cnt[4], off[4], tiles[4], ntn, i, step, g;
    __device__ __forceinline__ void init(const int* counts, int NTN, int bid, int nblk) {
        g = bid & 7; i = (bid >> 3) * 2 + (tidx() >> 8); step = (nblk >> 3) * 2; ntn = NTN;
        int o = 0;
#pragma unroll
        for (int q = 0; q < 4; ++q) { cnt[q] = 0; off[q] = 0; tiles[q] = 0; }
        for (int e = 0; e < NEXP; ++e) {
            const int c = counts[e];
            if ((e & 7) == g) {
                const int q = e >> 3;
#pragma unroll
                for (int qq = 0; qq < 4; ++qq) if (qq == q) { cnt[qq] = c; off[qq] = o; tiles[qq] = ((c + 127) >> 7) * NTN; }
            }
            o += c;
        }
    }
    __device__ __forceinline__ bool next(int& e, int& mt, int& nt, int& eoff, int& ecnt) {
        int j = i, q = 0;
        if (j >= tiles[0]) { j -= tiles[0]; q = 1; if (j >= tiles[1]) { j -= tiles[1]; q = 2; if (j >= tiles[2]) { j -= tiles[2]; q = 3; if (j >= tiles[3]) return false; } } }
        int c = cnt[0], o = off[0];
        if (q == 1) { c = cnt[1]; o = off[1]; } else if (q == 2) { c = cnt[2]; o = off[2]; } else if (q == 3) { c = cnt[3]; o = off[3]; }
        const int mcnt = (c + 127) >> 7, full = mcnt >> 3, band = 8 * ntn;
        if (j < full * band) { const int ms = j / band, r = j - ms * band; nt = r >> 3; mt = ms * 8 + (r & 7); }
        else { const int rem = mcnt - full * 8, jj = j - full * band; nt = jj / rem; mt = full * 8 + (jj - nt * rem); }
        e = q * 8 + g; eoff = o; ecnt = c;
        i += step;
        return true;
    }
};

struct PlainOrder8 {
    const char* A; const char* Bt; int K;
    int mg0, mcnt, ntn, total, full, i, step;
    __device__ __forceinline__ void init(const bf16_t* A_, const bf16_t* Bt_, int K_, int MT, int NTN, int bid, int nblk) {
        A = (const char*)A_; Bt = (const char*)Bt_; K = K_;
        const int g = bid & 7;
        mg0 = (MT * g) >> 3; mcnt = ((MT * (g + 1)) >> 3) - mg0; ntn = NTN; total = mcnt * NTN; full = mcnt >> 3; i = bid >> 3; step = nblk >> 3;
    }
    __device__ __forceinline__ bool next(g8::Unit& u) {
        if (i >= total) return false;
        int mt, nt;
        const int band = 8 * ntn;
        if (i < full * band) { const int ms = i / band, r = i - ms * band; nt = r >> 3; mt = mg0 + ms * 8 + (r & 7); }
        else { const int rem = mcnt - full * 8, j = i - full * band; nt = j / rem; mt = mg0 + full * 8 + (j - nt * rem); }
        i += step;
        u.a = A + (size_t)mt * 256 * K * 2; u.b = Bt + (size_t)nt * 256 * K * 2; u.gidx = nullptr; u.idx = nullptr; u.shift = 0; u.rows = 256; u.i0 = mt * 256; u.i1 = nt * 256; u.i2 = 0;
        return true;
    }
};
struct Epi8Store {
    float* C; int ldc;
    __device__ __forceinline__ void operator()(const f32x4 (&acc)[2][2][4][2], const g8::Unit& u, int wr, int wc, int fr, int fq) const {
#pragma unroll
        for (int ai = 0; ai < 2; ++ai)
#pragma unroll
            for (int m = 0; m < 4; ++m) {
                float* rowp = C + (size_t)(u.i0 + ai * 128 + wr * 64 + m * 16 + fr) * ldc + u.i1 + wc * 32 + fq * 4;
#pragma unroll
                for (int bj = 0; bj < 2; ++bj)
#pragma unroll
                    for (int n = 0; n < 2; ++n) *(f32x4*)(rowp + bj * 128 + n * 16) = acc[ai][bj][m][n];
            }
    }
};
struct Epi8StoreBf {
    bf16_t* C; int ldc;
    __device__ __forceinline__ void operator()(const f32x4 (&acc)[2][2][4][2], const g8::Unit& u, int wr, int wc, int fr, int fq) const {
#pragma unroll
        for (int ai = 0; ai < 2; ++ai)
#pragma unroll
            for (int m = 0; m < 4; ++m) {
                bf16_t* rowp = C + (size_t)(u.i0 + ai * 128 + wr * 64 + m * 16 + fr) * ldc + u.i1 + wc * 32 + fq * 8;
#pragma unroll
                for (int bj = 0; bj < 2; ++bj) {
                    const f32x4 v0 = acc[ai][bj][m][0], v1 = acc[ai][bj][m][1];
                    *(u32x4*)(rowp + bj * 128) = (u32x4){pack2(v0[0], v0[1]), pack2(v0[2], v0[3]), pack2(v1[0], v1[1]), pack2(v1[2], v1[3])};
                }
            }
    }
};
struct Epi8StoreHg {
    float* C; const float* hg_lb;
    __device__ __forceinline__ void operator()(const f32x4 (&acc)[2][2][4][2], const g8::Unit& u, int wr, int wc, int fr, int fq) const {
        const int c0 = u.i1 + wc * 32 + fq * 4;
        const int kind = u.i1 < 1024 ? 0 : (u.i1 < 3072 ? 1 : 2);
        f32x4 lbv[2][2];
        if (kind == 1) {
#pragma unroll
            for (int bj = 0; bj < 2; ++bj)
#pragma unroll
                for (int n = 0; n < 2; ++n) {
                    const int ch = (c0 + bj * 128 + n * 16) & 1023;
                    const f32x4 h0 = *(const f32x4*)(hg_lb + ch), h1 = *(const f32x4*)(hg_lb + 1024 + ch);
#pragma unroll
                    for (int j = 0; j < 4; ++j) lbv[bj][n][j] = __builtin_amdgcn_rcpf(1.0f + __expf(h0[j] - h1[j]));
                }
        }
#pragma unroll
        for (int ai = 0; ai < 2; ++ai)
#pragma unroll
            for (int m = 0; m < 4; ++m) {
                float* rowp = C + (size_t)(u.i0 + ai * 128 + wr * 64 + m * 16 + fr) * ODC + c0;
#pragma unroll
                for (int bj = 0; bj < 2; ++bj)
#pragma unroll
                    for (int n = 0; n < 2; ++n) {
                        f32x4 v = acc[ai][bj][m][n];
                        if (kind == 0) {
#pragma unroll
                            for (int j = 0; j < 4; ++j) v[j] = siluf_(v[j]);
                        } else if (kind == 1) {
#pragma unroll
                            for (int j = 0; j < 4; ++j) { const float lb = lbv[bj][n][j]; v[j] = lb + (1.f - lb) * sigmoidf_(v[j]); }
                        }
                        *(f32x4*)(rowp + bj * 128 + n * 16) = v;
                    }
                asm volatile("" ::: "memory");
            }
    }
};
struct Epi8Resid {
    const float* xin_lat; const float* xin_ctx; float* xout; const float* gmod;
    __device__ __forceinline__ void operator()(const f32x4 (&acc)[2][2][4][2], const g8::Unit& u, int wr, int wc, int fr, int fq) const {
        const int c0 = u.i1 + wc * 32 + fq * 4;
        const float* gr = gmod + modrow(u.i0) * 6144 + c0;
        f32x4 g[2][2];
#pragma unroll
        for (int bj = 0; bj < 2; ++bj)
#pragma unroll
            for (int n = 0; n < 2; ++n) g[bj][n] = *(const f32x4*)(gr + bj * 128 + n * 16);
#pragma unroll
        for (int ai = 0; ai < 2; ++ai)
#pragma unroll
            for (int m = 0; m < 4; ++m) {
                const int tok = u.i0 + ai * 128 + wr * 64 + m * 16 + fr;
                const float* xr = (tok < NX ? xin_lat + (size_t)tok * DM : xin_ctx + (size_t)(tok - NX) * DM) + c0;
                float* orow = xout + (size_t)tok * DM + c0;
                f32x4 xi[2][2];
#pragma unroll
                for (int bj = 0; bj < 2; ++bj)
#pragma unroll
                    for (int n = 0; n < 2; ++n) xi[bj][n] = *(const f32x4*)(xr + bj * 128 + n * 16);
#pragma unroll
                for (int bj = 0; bj < 2; ++bj)
#pragma unroll
                    for (int n = 0; n < 2; ++n) *(f32x4*)(orow + bj * 128 + n * 16) = xi[bj][n] + g[bj][n] * acc[ai][bj][m][n];
                asm volatile("" ::: "memory");
            }
    }
};
struct MoeOrder8 {
    int cvec;
    const int* lists; const char* A; const char* W; int wrows, ntn, i, step, g;
    bool gather;
    __device__ __forceinline__ void init(const int* counts_, const int* lists_, const bf16_t* A_, const bf16_t* W_, int wrows_, bool gather_, int bid, int nblk) {
        cvec = counts_[tidx() & 31]; lists = lists_; A = (const char*)A_; W = (const char*)W_; wrows = wrows_; ntn = wrows_ / 256; gather = gather_;
        g = bid & 7; i = bid >> 3; step = nblk >> 3;
    }
    __device__ __forceinline__ bool next(g8::Unit& u) {
        int j = i, o = 0, fe = -1, fo = 0, fc = 0, fm = 1;
#pragma unroll
        for (int e = 0; e < NEXP; ++e) {
            const int c = __builtin_amdgcn_readlane(cvec, e);
            if ((e & 7) == g && fe < 0) {
                const int mcnt = (c + 255) >> 8, t = mcnt * ntn;
                if (j < t) { fe = e; fo = o; fc = c; fm = mcnt; }
                else j -= t;
            }
            o += c;
        }
        if (fe < 0) return false;
        const int nt = j / fm, mt = j - nt * fm;
        i += step;
        u.idx = lists + (size_t)fe * NT + mt * 256; u.gidx = gather ? u.idx : nullptr; u.rows = min(256, fc - mt * 256); u.shift = 2;
        u.a = gather ? A : A + (size_t)(fo + mt * 256) * 1024 * 2;
        u.b = W + ((size_t)fe * wrows + (size_t)nt * 256) * 1024 * 2;
        u.i0 = fo + mt * 256;
        u.i1 = nt;
        u.i2 = fe;
        return true;
    }
};
struct Epi8GU {
    const float* bias; bf16_t* act;
    __device__ __forceinline__ void operator()(const f32x4 (&acc)[2][2][4][2], const g8::Unit& u, int wr, int wc, int fr, int fq) const {
        const float* be = bias + (size_t)u.i2 * 2048;
        const int unit = u.i1 * 128 + wc * 32 + fq * 8;
        const f32x4 bg0 = *(const f32x4*)(be + unit), bg1 = *(const f32x4*)(be + unit + 4), bu0 = *(const f32x4*)(be + 1024 + unit), bu1 = *(const f32x4*)(be + 1024 + unit + 4);
#pragma unroll
        for (int ai = 0; ai < 2; ++ai)
#pragma unroll
            for (int m = 0; m < 4; ++m) {
                const int r = ai * 128 + wr * 64 + m * 16 + fr;
                if (r < u.rows) {
                    float o[8];
#pragma unroll
                    for (int bj = 0; bj < 2; ++bj) {
                        const f32x4 g = acc[ai][bj][m][0] + (bj ? bg1 : bg0), up = acc[ai][bj][m][1] + (bj ? bu1 : bu0);
#pragma unroll
                        for (int j = 0; j < 4; ++j) {
                            const float gate = fminf(g[j], 7.0f);
                            const float uu = fminf(fmaxf(up[j], -7.0f), 7.0f);
                            o[bj * 4 + j] = (uu + 1.0f) * gate * sigmoidf_(1.702f * gate);
                        }
                    }
                    *(u32x4*)(act + (size_t)(u.i0 + r) * 1024 + unit) = (u32x4){pack2(o[0], o[1]), pack2(o[2], o[3]), pack2(o[4], o[5]), pack2(o[6], o[7])};
                }
                asm volatile("" ::: "memory");
            }
    }
};
struct Epi8DN {
    const float* bias; bf16_t* ys;
    __device__ __forceinline__ void operator()(const f32x4 (&acc)[2][2][4][2], const g8::Unit& u, int wr, int wc, int fr, int fq) const {
        const int cb = u.i1 * 256 + wc * 32 + fq * 8;
        const float* be = bias + (size_t)u.i2 * 1024 + cb;
        const f32x4 b00 = *(const f32x4*)(be), b01 = *(const f32x4*)(be + 4), b10 = *(const f32x4*)(be + 128), b11 = *(const f32x4*)(be + 132);
#pragma unroll
        for (int ai = 0; ai < 2; ++ai)
#pragma unroll
            for (int m = 0; m < 4; ++m) {
                const int r = ai * 128 + wr * 64 + m * 16 + fr;
                if (r < u.rows) {
                    const int a = u.idx[r];
                    bf16_t* orow = ys + (size_t)a * 1024 + cb;
#pragma unroll
                    for (int bj = 0; bj < 2; ++bj) {
                        const f32x4 v0 = acc[ai][bj][m][0] + (bj ? b10 : b00), v1 = acc[ai][bj][m][1] + (bj ? b11 : b01);
                        *(u32x4*)(orow + bj * 128) = (u32x4){pack2(v0[0], v0[1]), pack2(v0[2], v0[3]), pack2(v1[0], v1[1]), pack2(v1[2], v1[3])};
                    }
                }
                asm volatile("" ::: "memory");
            }
    }
};
__device__ __forceinline__ void phase_gemm8_store(const bf16_t* A, int M, const bf16_t* Wt, int N, float* C, int bid, int nblk, char* smem) {
    PlainOrder8 S; S.init(A, Wt, DM, M / 256, N / 256, bid, nblk);
    Epi8Store E{C, N};
    g8::gemm_phase((G8_LAS unsigned char*)smem, DM, S, E);
}
__device__ __forceinline__ void phase_gemm8_store_bf(const bf16_t* A, int M, const bf16_t* Wt, int N, bf16_t* C, int bid, int nblk, char* smem) {
    PlainOrder8 S; S.init(A, Wt, DM, M / 256, N / 256, bid, nblk);
    Epi8StoreBf E{C, N};
    g8::gemm_phase((G8_LAS unsigned char*)smem, DM, S, E);
}
__device__ __forceinline__ void phase_gemm8_store_hg(const Params& p, int bid, int nblk, char* smem) {
    PlainOrder8 S; S.init(p.H, p.wt_odin, DM, NT / 256, ODC / 256, bid, nblk);
    Epi8StoreHg E{p.P, p.hg_lb};
    g8::gemm_phase((G8_LAS unsigned char*)smem, DM, S, E);
}
__device__ __forceinline__ void phase_outproj8(const Params& p, int bid, int nblk, char* smem, const bf16_t* Wt, int ntok, const float* xin_lat, const float* xin_ctx, float* xout, const float* gmod) {
    PlainOrder8 S; S.init(p.MG, Wt, DM, ntok / 256, 4, bid, nblk);
    Epi8Resid E{xin_lat, xin_ctx, xout, gmod};
    g8::gemm_phase((G8_LAS unsigned char*)smem, DM, S, E);
}
__device__ __forceinline__ void phase_moe_gu8(const Params& p, int bid, int nblk, char* smem, int layer) {
    MoeOrder8 S; S.init(p.counts + layer * NEXP, p.lists + (size_t)layer * NEXP * NT, p.H, p.wt_gu + (size_t)layer * NEXP * 2048 * 1024, 2048, true, bid, nblk);
    Epi8GU E{p.moe_b_gu + (size_t)layer * NEXP * 2048, p.ACT};
    g8::gemm_phase((G8_LAS unsigned char*)smem, DM, S, E);
}
__device__ __forceinline__ void phase_moe_dn8(const Params& p, int bid, int nblk, char* smem, int layer) {
    MoeOrder8 S; S.init(p.counts + layer * NEXP, p.lists + (size_t)layer * NEXP * NT, p.ACT, p.wt_dn + (size_t)layer * NEXP * 1024 * 1024, 1024, false, bid, nblk);
    Epi8DN E{p.moe_b_dn + (size_t)layer * NEXP * 1024, p.YS};
    g8::gemm_phase((G8_LAS unsigned char*)smem, DM, S, E);
}

__device__ __forceinline__ void phase_combine(const Params& p, int bid, int nblk, const float* Xin, float* Xout, const float* gmod  , int ntok,
                              bool do_norm, const float* gain, const float* modn) {
    const int lane = tidx() & 63, wid = tidx() >> 6;
    for (int tok = bid * 8 + wid; tok < ntok; tok += nblk * 8) {
        const float* gr = gmod + modrow(tok) * 6144;
        const float g0 = p.GATE[(size_t)tok * 4 + 0], g1 = p.GATE[(size_t)tok * 4 + 1], g2 = p.GATE[(size_t)tok * 4 + 2], g3 = p.GATE[(size_t)tok * 4 + 3];
        const bf16_t* ys = p.YS + (size_t)tok * 4 * 1024;
        float4 v[4];
        float ss = 0.f;
#pragma unroll
        for (int i = 0; i < 4; ++i) {
            const int c = lane * 4 + 256 * i;
            const float4 xi = *(const float4*)(Xin + (size_t)tok * DM + c), gg = *(const float4*)(gr + c);
            float4 y0, y1, y2, y3;
            { const uint2 u0 = *(const uint2*)(ys + c), u1 = *(const uint2*)(ys + 1024 + c), u2 = *(const uint2*)(ys + 2048 + c), u3 = *(const uint2*)(ys + 3072 + c);
              y0 = make_float4(__uint_as_float(u0.x << 16), __uint_as_float(u0.x & 0xffff0000u), __uint_as_float(u0.y << 16), __uint_as_float(u0.y & 0xffff0000u));
              y1 = make_float4(__uint_as_float(u1.x << 16), __uint_as_float(u1.x & 0xffff0000u), __uint_as_float(u1.y << 16), __uint_as_float(u1.y & 0xffff0000u));
              y2 = make_float4(__uint_as_float(u2.x << 16), __uint_as_float(u2.x & 0xffff0000u), __uint_as_float(u2.y << 16), __uint_as_float(u2.y & 0xffff0000u));
              y3 = make_float4(__uint_as_float(u3.x << 16), __uint_as_float(u3.x & 0xffff0000u), __uint_as_float(u3.y << 16), __uint_as_float(u3.y & 0xffff0000u)); }
            v[i].x = xi.x + gg.x * (g0 * y0.x + g1 * y1.x + g2 * y2.x + g3 * y3.x);
            v[i].y = xi.y + gg.y * (g0 * y0.y + g1 * y1.y + g2 * y2.y + g3 * y3.y);
            v[i].z = xi.z + gg.z * (g0 * y0.z + g1 * y1.z + g2 * y2.z + g3 * y3.z);
            v[i].w = xi.w + gg.w * (g0 * y0.w + g1 * y1.w + g2 * y2.w + g3 * y3.w);
            *(float4*)(Xout + (size_t)tok * DM + c) = v[i];
            ss += v[i].x * v[i].x + v[i].y * v[i].y + v[i].z * v[i].z + v[i].w * v[i].w;
        }
        if (do_norm) {
            ss = wave_sum(ss);
            const float rstd = rsqrtf(ss * (1.0f / 1024.0f) + 1e-6f);
            const float* mr = modn + modrow(tok) * 6144;
#pragma unroll
            for (int i = 0; i < 4; ++i) {
                const int c = lane * 4 + 256 * i;
                const float4 g = *(const float4*)(gain + c), sh = *(const float4*)(mr + c), sc = *(const float4*)(mr + 1024 + c);
                const float a0 = v[i].x * rstd * g.x * (1.f + sc.x) + sh.x, a1 = v[i].y * rstd * g.y * (1.f + sc.y) + sh.y;
                const float a2 = v[i].z * rstd * g.z * (1.f + sc.z) + sh.z, a3 = v[i].w * rstd * g.w * (1.f + sc.w) + sh.w;
                *(uint2*)(p.H + (size_t)tok * DM + c) = make_uint2(pack2(a0, a1), pack2(a2, a3));
            }
        }
    }
}

__device__ __forceinline__ bf16x8 pack8(const f32x4 a, const f32x4 b) {
    union { bf16x8 v; unsigned u[4]; } r;
    r.u[0] = pack2(a[0], a[1]); r.u[1] = pack2(a[2], a[3]); r.u[2] = pack2(b[0], b[1]); r.u[3] = pack2(b[2], b[3]);
    return r.v;
}
__device__ __forceinline__ void hgrn_chain(const Params& p, int chain, char* smem) {
    const int z = chain >> 6, b = (chain >> 3) & 7, h = chain & 7;
    const int tid = tidx(), lane = tid & 63, wid = tid >> 6, fr = lane & 15, fq = lane >> 4;
    bf16_t* sQ = (bf16_t*)smem;
    bf16_t* sK = sQ + 32 * 128;
    bf16_t* sKL = sK + 32 * 128;
    bf16_t* sV = sKL + 128 * 32;
    float* sT = (float*)(sV + 128 * 32);
    float* sEBL = sT + 512;
    const int ch = tid & 127, th = tid >> 7;
    f32x4 S[8];
#pragma unroll
    for (int mi = 0; mi < 8; ++mi) S[mi] = (f32x4){0.f, 0.f, 0.f, 0.f};
    float qA[8], fA[8], iA[8], qB[8], fB[8], iB[8];
    auto issue = [&](int chunk, float (&rq)[8], float (&rf)[8], float (&ri)[8]) {
        const int tok0 = scan_tok(z, b, chunk * 32 + th * 8);
        const float* pr = p.P + (size_t)tok0 * ODC + h * 128 + ch;
        const int stride = z == 0 ? ODC : -ODC;
#pragma unroll
        for (int i = 0; i < 8; ++i) {
            rq[i] = pr[0]; rf[i] = pr[1024 * (1 + z)]; ri[i] = pr[3072];
            pr += stride;
        }
    };
    issue(0, qA, fA, iA);
    issue(1, qB, fB, iB);
    auto body = [&](int chunk, float (&rq)[8], float (&rf)[8], float (&ri)[8]) {
        float bc[8];
        {
            float run = 1.f;
#pragma unroll
            for (int i = 0; i < 8; ++i) {
                const float f = rf[i];
                rf[i] = 1.f - f;
                run *= f;
                bc[i] = run;
            }
            sT[th * 128 + ch] = run;
        }
        __syncthreads();
        {
            const float t0 = sT[ch], t1 = sT[128 + ch], t2 = sT[256 + ch], t3 = sT[384 + ch];
            const float boff = th == 0 ? 1.f : (th == 1 ? t0 : (th == 2 ? t0 * t1 : t0 * t1 * t2));
            const float ebl = (t0 * t1) * (t2 * t3);
            if (th == 0) sEBL[ch] = ebl;
            unsigned wkl[4], wv[4];
            float klp = 0.f, vp = 0.f;
#pragma unroll
            for (int i = 0; i < 8; ++i) {
                const int t = th * 8 + i;
                const float eb = bc[i] * boff;
                const float emb = __builtin_amdgcn_rcpf(eb);
                const float qe = rq[i] * eb;
                const float ke = rf[i] * emb;
                const float kl = ke * ebl;
                const int off = t * 128 + (((ch >> 3) ^ (t & 15)) << 3) + (ch & 7);
                sQ[off] = f2bf(qe);
                sK[off] = f2bf(ke);
                if (i & 1) { wkl[i >> 1] = pack2(klp, kl); wv[i >> 1] = pack2(vp, ri[i]); } else { klp = kl; vp = ri[i]; }
            }
            const int sw = (ch >> 2) & 3;
            *(u32x4*)(sKL + ch * 32 + ((th ^ sw) << 3)) = (u32x4){wkl[0], wkl[1], wkl[2], wkl[3]};
            *(u32x4*)(sV + ch * 32 + ((th ^ sw) << 3)) = (u32x4){wv[0], wv[1], wv[2], wv[3]};
        }
        __syncthreads();
        if (chunk + 2 < 72) issue(chunk + 2, rq, rf, ri);
        f32x4 sc00 = (f32x4){0.f, 0.f, 0.f, 0.f}, sc01 = sc00, sc11 = sc00;
#pragma unroll
        for (int ks = 0; ks < 4; ++ks) {
            const int c = ks * 4 + fq;
            const bf16x8 k0 = *(const bf16x8*)(sK + fr * 128 + ((c ^ fr) << 3));
            const bf16x8 k1 = *(const bf16x8*)(sK + (16 + fr) * 128 + ((c ^ fr) << 3));
            const bf16x8 q0 = *(const bf16x8*)(sQ + fr * 128 + ((c ^ fr) << 3));
            const bf16x8 q1 = *(const bf16x8*)(sQ + (16 + fr) * 128 + ((c ^ fr) << 3));
            sc00 = __builtin_amdgcn_mfma_f32_16x16x32_bf16(k0, q0, sc00, 0, 0, 0);
            sc01 = __builtin_amdgcn_mfma_f32_16x16x32_bf16(k0, q1, sc01, 0, 0, 0);
            sc11 = __builtin_amdgcn_mfma_f32_16x16x32_bf16(k1, q1, sc11, 0, 0, 0);
        }
#pragma unroll
        for (int j = 0; j < 4; ++j) { if (4 * fq + j > fr) { sc00[j] = 0.f; sc11[j] = 0.f; } }
        const f32x4 zero4 = (f32x4){0.f, 0.f, 0.f, 0.f};
        const bf16x8 pf0 = pack8(sc00, zero4), pf1 = pack8(sc01, sc11);
        asm volatile("" ::: "memory");
        f32x4 o[2];
        o[0] = zero4; o[1] = zero4;
        const int r0 = wid * 16 + fr;
        {
            union { bf16x8 v; uint2 u[2]; } vp0;
            vp0.u[0] = *(const uint2*)(sV + r0 * 32 + ((((fq >> 1)) ^ ((r0 >> 2) & 3)) << 3) + (fq & 1) * 4);
            vp0.u[1] = *(const uint2*)(sV + r0 * 32 + (((2 + (fq >> 1)) ^ ((r0 >> 2) & 3)) << 3) + (fq & 1) * 4);
            o[0] = __builtin_amdgcn_mfma_f32_16x16x32_bf16(vp0.v, pf0, o[0], 0, 0, 0);
            o[1] = __builtin_amdgcn_mfma_f32_16x16x32_bf16(vp0.v, pf1, o[1], 0, 0, 0);
        }
#pragma unroll
        for (int kp = 0; kp < 4; ++kp) {
            const bf16x8 sf0 = pack8(S[2 * kp], S[2 * kp + 1]);
            const int c0 = 4 * kp + (fq >> 1), c1 = c0 + 2;
            union { bf16x8 v; uint2 u[2]; } qa, qb;
            qa.u[0] = *(const uint2*)(sQ + fr * 128 + ((c0 ^ fr) << 3) + (fq & 1) * 4);
            qa.u[1] = *(const uint2*)(sQ + fr * 128 + ((c1 ^ fr) << 3) + (fq & 1) * 4);
            qb.u[0] = *(const uint2*)(sQ + (16 + fr) * 128 + ((c0 ^ fr) << 3) + (fq & 1) * 4);
            qb.u[1] = *(const uint2*)(sQ + (16 + fr) * 128 + ((c1 ^ fr) << 3) + (fq & 1) * 4);
            o[0] = __builtin_amdgcn_mfma_f32_16x16x32_bf16(sf0, qa.v, o[0], 0, 0, 0);
            o[1] = __builtin_amdgcn_mfma_f32_16x16x32_bf16(sf0, qb.v, o[1], 0, 0, 0);
        }
        if (chunk >= 8) {
#pragma unroll
            for (int tb = 0; tb < 2; ++tb) {
                const int tok = scan_tok(z, b, chunk * 32 + tb * 16 + fr);
                *(f32x4*)(p.HO + ((size_t)z * NX + tok) * 1024 + h * 128 + wid * 16 + fq * 4) = o[tb];
            }
        }
        asm volatile("" ::: "memory");
        {
            const bf16x8 v0 = *(const bf16x8*)(sV + r0 * 32 + ((fq ^ ((r0 >> 2) & 3)) << 3));
#pragma unroll
            for (int mi = 0; mi < 8; ++mi) {
                const int r = mi * 16 + fr;
                const bf16x8 kl = *(const bf16x8*)(sKL + r * 32 + ((fq ^ ((r >> 2) & 3)) << 3));
                const f32x4 e = *(const f32x4*)(sEBL + mi * 16 + fq * 4);
                S[mi] = __builtin_amdgcn_mfma_f32_16x16x32_bf16(kl, v0, S[mi] * e, 0, 0, 0);
            }
        }
    };
    for (int chunk = 0; chunk < 72; chunk += 2) { body(chunk, qA, fA, iA); body(chunk + 1, qB, fB, iB); }
    __syncthreads();
}
__device__ __forceinline__ void phase_hgrn(const Params& p, int bid, int nblk, char* smem) {
    for (int it = bid; it < 128; it += nblk) hgrn_chain(p, it, smem);
    const int n_all = ((16384 + 8192) / 2) / CONV_GRP;
    for (;;) {
        const int it = q_next(p.counts + 65, smem);
        if (it >= n_all) break;
        conv_group<true>(p, it, smem);
    }
}
__device__ __forceinline__ void phase_hgrn_readout(const Params& p, int bid, int nblk) {
    const int lane = tidx() & 63, wid = tidx() >> 6;
    const int c0 = lane * 8;
    const f32x4 n0 = *(const f32x4*)(p.hg_norm + (c0 & 127)), n1 = *(const f32x4*)(p.hg_norm + (c0 & 127) + 4);
    for (int tok = bid * 8 + wid; tok < NX; tok += nblk * 8) {
#pragma unroll
        for (int q = 0; q < 2; ++q) {
            const size_t o = (size_t)tok * 1024 + q * 512 + c0, zo = (size_t)NX * 1024;
            const f32x4 y0 = *(const f32x4*)(p.HO + o) + *(const f32x4*)(p.HO + zo + o), y1 = *(const f32x4*)(p.HO + o + 4) + *(const f32x4*)(p.HO + zo + o + 4);
            const f32x4 g0 = *(const f32x4*)(p.P + (size_t)tok * ODC + 4096 + q * 512 + c0), g1 = *(const f32x4*)(p.P + (size_t)tok * ODC + 4096 + q * 512 + c0 + 4);
            float ss = sum8((y0[0] * y0[0] + y0[1] * y0[1]) + (y0[2] * y0[2] + y0[3] * y0[3]) + (y1[0] * y1[0] + y1[1] * y1[1]) + (y1[2] * y1[2] + y1[3] * y1[3]));
            ss += dpp_f<0x140>(ss);
            const float rstd = rsqrtf(ss * (1.0f / 128.0f) + 1e-6f);
            float r[8];
#pragma unroll
            for (int j = 0; j < 4; ++j) { r[j] = y0[j] * rstd * n0[j] * siluf_(g0[j]); r[4 + j] = y1[j] * rstd * n1[j] * siluf_(g1[j]); }
            *(u32x4*)(p.MG + o) = (u32x4){pack2(r[0], r[1]), pack2(r[2], r[3]), pack2(r[4], r[5]), pack2(r[6], r[7])};
        }
    }
}

#define N_PHASES 20
__device__ __forceinline__ void run_phase(const Params& p, int ph, int bid, int nblk, char* smem) {
    const float* mod0 = p.mod;
    const float* mod1 = p.mod + 9 * 6144;
    switch (ph) {
    case 0: phase0a(p, bid, nblk, smem); break;
    case 1: phase0b(p, bid, nblk); break;
    case 2: phase_norm(p, bid, nblk, p.x, p.ctx, p.norm1_g, mod0, 0, NT); break;
    case 3: phase_gemm8_store_bf(p.H, NT, p.wt_evin, EVC, (bf16_t*)p.P, bid, nblk, smem); break;
    case 4: phase_feat0(p, bid, nblk, smem); break;
    case 5: phase_lora(p, bid, nblk, smem); break;
    case 6: phase_scan_attn(p, bid, nblk, smem); break;
    case 7: phase_rw_readout(p, bid, nblk); break;
    case 8: phase_outproj8(p, bid, nblk, smem, p.wt_evout, NT, p.x, p.ctx, p.X1, mod0 + 2048); break;
    case 9: phase_router(p, bid, nblk, smem, 0, p.X1, NT); break;
    case 10: phase_moe_gu8(p, bid, nblk, smem, 0); break;
    case 11: phase_moe_dn8(p, bid, nblk, smem, 0); break;
    case 12: phase_combine(p, bid, nblk, p.X1, p.X2, mod0 + 5120, NT, true, p.norm1_g + DM, mod1); break;
    case 13: phase_gemm8_store_hg(p, bid, nblk, smem); break;
    case 14: phase_hgrn(p, bid, nblk, smem); break;
    case 15: phase_hgrn_readout(p, bid, nblk); break;
    case 16: phase_outproj8(p, bid, nblk, smem, p.wt_odout, NX, p.X2, p.X2 + (size_t)NX * DM, p.X1, mod1 + 2048); break;
    case 17: phase_router(p, bid, nblk, smem, 1, p.X1, NX); break;
    case 18: phase_moe_gu8(p, bid, nblk, smem, 1); break;
    case 19: phase_moe_dn8(p, bid, nblk, smem, 1); break;
    default: break;
    }
}
__device__ __forceinline__ void final_phase(const Params& p, int bid, int nblk) {
    phase_combine(p, bid, nblk, p.X1, p.out, p.mod + 9 * 6144 + 5120, NX, false, nullptr, nullptr);
}

struct KArgs { const float* in[35]; float* out; char* ws; };

__host__ __device__ __forceinline__ size_t make_params(Params& p, const KArgs& a) {
    const float** ins = (const float**)&p;
    for (int i = 0; i < 35; ++i) ins[i] = a.in[i];
    p.out = a.out;
    char* ws = a.ws;
    size_t off = 0;
#define TAKE(bytes) (ws + off); off += (((size_t)(bytes)) + 255) & ~(size_t)255
    p.bar = (unsigned*)TAKE(16384);
    p.counts = (int*)TAKE(1024);
    p.scal = (float*)TAKE(256);
    p.mod = (float*)TAKE((size_t)2 * 9 * 6144 * 4);
    p.mod_part = (float*)TAKE((size_t)16 * 2 * 9 * 6144 * 4);
    p.rope_cos = (float*)TAKE((size_t)65536 * 4);
    p.rope_sin = (float*)TAKE((size_t)65536 * 4);
    p.wt_evin = (bf16_t*)TAKE((size_t)EVC * 1024 * 2);
    p.wt_evout = (bf16_t*)TAKE((size_t)1024 * 1024 * 2);
    p.wt_odin = (bf16_t*)TAKE((size_t)ODC * 1024 * 2);
    p.wt_odout = (bf16_t*)TAKE((size_t)1024 * 1024 * 2);
    p.wt_w2 = (bf16_t*)TAKE((size_t)1024 * 64 * 2);
    p.wt_a2 = (bf16_t*)TAKE((size_t)1024 * 64 * 2);
    p.wt_g2 = (bf16_t*)TAKE((size_t)512 * 128 * 2);
    p.wt_gu = (bf16_t*)TAKE((size_t)64 * 2048 * 1024 * 2);
    p.wt_dn = (bf16_t*)TAKE((size_t)64 * 1024 * 1024 * 2);
    p.lists = (int*)TAKE((size_t)2 * NEXP * NT * 4);
    p.GATE = (float*)TAKE((size_t)NASG * 4);
    p.H = (bf16_t*)TAKE((size_t)NT * DM * 2);
    p.MG = (bf16_t*)TAKE((size_t)NT * DM * 2);
    p.X1 = (float*)TAKE((size_t)NT * DM * 4);
    p.X2 = (float*)TAKE((size_t)NT * DM * 4);
    const size_t scratch0 = off;
    p.P = (float*)TAKE((size_t)NT * ODC * 4);
    const size_t after_p = off;
    p.Q = (bf16_t*)TAKE((size_t)8 * 8 * SEQ * 64 * 2);
    p.Qc = (bf16_t*)TAKE((size_t)8 * 8 * CTXL * 64 * 2);
    p.Kd = (bf16_t*)TAKE((size_t)8 * 8 * NKEY * 64 * 2);
    p.Vd = (bf16_t*)TAKE((size_t)8 * 4 * NKEY * 128 * 2);
    p.rR = (bf16_t*)TAKE((size_t)NT * 512 * 2);
    p.rK = (bf16_t*)TAKE((size_t)NT * 512 * 2);
    p.rV = (bf16_t*)TAKE((size_t)NT * 512 * 2);
    p.rKK = (bf16_t*)TAKE((size_t)NT * 512 * 2);
    p.rG = (bf16_t*)TAKE((size_t)NT * 512 * 2);
    p.rW = (float*)TAKE((size_t)2 * NT * 512 * 4);
    p.rKD = (bf16_t*)TAKE((size_t)2 * NT * 512 * 2);
    p.rBV = (bf16_t*)TAKE((size_t)2 * NT * 512 * 2);
    p.rY = (float*)TAKE((size_t)2 * NT * 512 * 4);
    p.rTW = (bf16_t*)TAKE((size_t)NT * 64 * 2);
    p.rAD = (bf16_t*)TAKE((size_t)NT * 64 * 2);
    p.rSG = (bf16_t*)TAKE((size_t)NT * 128 * 2);
    const size_t end_l0 = off;
    off = after_p;
    p.HO = (float*)TAKE((size_t)2 * NX * 1024 * 4);
    const size_t end_l1 = off;
    off = scratch0;
    p.ACT = (bf16_t*)TAKE((size_t)NASG * 1024 * 2);
    p.YS = (bf16_t*)TAKE((size_t)NASG * 1024 * 2);
    const size_t end_moe = off;
#undef TAKE
    size_t total = end_l0 > end_l1 ? end_l0 : end_l1;
    if (end_moe > total) total = end_moe;
    return total;
}

#if MULTI_LAUNCH
template <int PH>
__global__ void __launch_bounds__(256, 2) k_phase(KArgs a) {
    Params p; make_params(p, a);
    __shared__ __attribute__((aligned(16))) char smem[SMEM_BYTES];
    if (PH < N_PHASES) run_phase(p, PH, blockIdx.x, gridDim.x, smem);
    else final_phase(p, blockIdx.x, gridDim.x);
}
template <int PH> static void launch_all(const KArgs& p, hipStream_t stream) {
    hipLaunchKernelGGL(k_phase<PH>, dim3(1024), dim3(256), 0, stream, p);
    if constexpr (PH < N_PHASES) launch_all<PH + 1>(p, stream);
}
#else
__global__ void __launch_bounds__(NTHR, 2) k_mega(KArgs a) {
    Params p; make_params(p, a);
    extern __shared__ __attribute__((aligned(16))) char smem[];
    cg::grid_group grid = cg::this_grid();
    const int bid = blockIdx.x, nblk = gridDim.x;
    volatile LAS unsigned* st = (volatile LAS unsigned*)(smem + SMEM_BYTES);
    if (tidx() == 0) { st[0] = 0u; st[1] = 0u; }
    __syncthreads();
    const XcdBarrier xb = xcd_barrier_post(p.bar, st);
    run_phase(p, 0, bid, nblk, smem);
    if (a.ws == nullptr) grid.sync();
    xcd_barrier(xb);
    if (EXTRA == 4) { run_phase(p, 0, bid, nblk, smem); xcd_barrier(xb); }
#ifndef REPMASK
#define REPMASK 0u
#endif
#define PH(n) run_phase(p, n, bid, nblk, smem); xcd_barrier(xb); if ((REPMASK >> n) & 1u) { run_phase(p, n, bid, nblk, smem); xcd_barrier(xb); } \
    if (EXTRA == 6 && n == 6) { if (bid == 0 && tidx() == 0) p.counts[64] = 0; xcd_barrier(xb); run_phase(p, 6, bid, nblk, smem); xcd_barrier(xb); } \
    if (EXTRA == 5 && n == 9) { phase_router(p, bid, nblk, smem, 0, p.X1, NT, true); xcd_barrier(xb); } if (EXTRA == 5 && n == 17) { phase_router(p, bid, nblk, smem, 1, p.X1, NX, true); xcd_barrier(xb); }
    PH(1) PH(2) PH(3) PH(4) PH(5) PH(6) PH(7) PH(8) PH(9) PH(10) PH(11) PH(12) PH(13) PH(14) PH(15) PH(16) PH(17) PH(18) PH(19)
#undef PH
    final_phase(p, bid, nblk);
}
#endif


extern "C" void kernel_launch(void* const* d_in, const int* in_sizes, int n_in, void* d_out, int out_size, void* d_ws, size_t ws_size, hipStream_t stream) {
    KArgs a{};
    for (int i = 0; i < 35; ++i) a.in[i] = (const float*)d_in[i];
    a.out = (float*)d_out;
    a.ws = (char*)d_ws;
    Params p{};
    const size_t total = make_params(p, a);
    if (total > ws_size) { fprintf(stderr, "workspace too small: need %zu have %zu\n", total, ws_size); return; }

#if MULTI_LAUNCH
    launch_all<0>(a, stream);
#else
    static int grid_blocks = 0;
    if (!grid_blocks) {
        int dev = 0, cus = 0, per_cu = 0;
        hipGetDevice(&dev);
        hipDeviceGetAttribute(&cus, hipDeviceAttributeMultiprocessorCount, dev);
        hipFuncSetAttribute((const void*)k_mega, hipFuncAttributeMaxDynamicSharedMemorySize, SMEM_BYTES + 16);
        hipOccupancyMaxActiveBlocksPerMultiprocessor(&per_cu, k_mega, NTHR, SMEM_BYTES + 16);
        if (per_cu > 1) per_cu = 1;
        if (per_cu < 1) per_cu = 1;
        grid_blocks = cus * per_cu;
    }
    hipMemsetAsync(p.bar, 0, XCD_BAR_WORDS * 4, stream);
    void* args[] = {(void*)&a};
    hipError_t e = hipLaunchCooperativeKernel((void*)k_mega, dim3(grid_blocks), dim3(NTHR), args, SMEM_BYTES + 16, stream);
    if (e != hipSuccess) fprintf(stderr, "cooperative launch failed: %s (grid %d)\n", hipGetErrorString(e), grid_blocks);
#endif
}
```

```cpp
#include <hip/hip_runtime.h>
#include <hip/hip_cooperative_groups.h>
#include <stdint.h>
#include <stdio.h>

namespace cg = cooperative_groups;

typedef unsigned short bf16_t;
typedef short bf16x8 __attribute__((ext_vector_type(8)));
typedef float f32x4 __attribute__((ext_vector_type(4)));
typedef unsigned u32x4 __attribute__((ext_vector_type(4)));

#define NX 16384
#define NC 2048
#define NT 18432
#define DM 1024
#define SEQ 2048
#define CTXL 256
#define NKEY 2304
#define EVC 3328
#define ODC 5120
#define NEXP 32
#define NASG (NT * 4)
#ifndef EXTRA
#define EXTRA 0
#endif
#define NTHR 512
#define SMEM_BYTES 131072
#define HLDS 65536

#ifndef MULTI_LAUNCH
#define MULTI_LAUNCH 0
#endif

struct Params {
    const float *x, *c, *ctx, *c_ctx, *ada_w, *ada_b, *norm1_g, *norm2_g, *ev_w_in, *ev_w_out, *da_q_norm, *da_k_norm,
        *da_lambda, *da_subln, *rw_mu, *rw_w0, *rw_w2, *rw_a0, *rw_a2, *rw_g2, *rw_k_k, *rw_k_a, *rw_r_k, *rw_ln_w,
        *rw_ln_b, *od_w_in, *od_w_out, *hg_norm, *hg_lb, *router_w, *router_b, *moe_w_gu, *moe_b_gu, *moe_w_dn, *moe_b_dn;
    float* out;
    bf16_t *wt_evin, *wt_evout, *wt_odin, *wt_odout, *wt_gu, *wt_dn, *wt_w2, *wt_a2, *wt_g2;
    float *mod_part, *mod, *rope_cos, *rope_sin, *scal;
    int *counts, *lists;
    unsigned* bar;
    bf16_t* H;
    float* P;
    bf16_t *Q, *Qc, *Kd, *Vd;
    bf16_t *rR, *rK, *rV, *rKK, *rKD, *rBV, *rG;
    float *rW, *rY;
    bf16_t *rTW, *rAD, *rSG;
    bf16_t* MG;
    float *X1, *X2;
    float* GATE;
    bf16_t* ACT;
    bf16_t* YS;
    float* HO;
};

typedef float f32x2_ __attribute__((ext_vector_type(2)));
typedef __bf16 bf16x2_ __attribute__((ext_vector_type(2)));
__device__ __forceinline__ unsigned pack2(float a, float b) {
    const f32x2_ v = {a, b};
    return __builtin_bit_cast(unsigned, __builtin_convertvector(v, bf16x2_));
}
__device__ __forceinline__ bf16_t f2bf(float f) { return (bf16_t)(pack2(f, 0.f) & 0xffffu); }
__device__ __forceinline__ int tidx() { int t = __builtin_amdgcn_workitem_id_x(); asm volatile("" : "+v"(t)); return t; }
__device__ __forceinline__ int uni(int v) { return __builtin_amdgcn_readfirstlane(v); }
template <class T> __device__ __forceinline__ T* uni_ptr(T* ptr) {
    const unsigned long long v = (unsigned long long)ptr;
    const unsigned lo = (unsigned)__builtin_amdgcn_readfirstlane((int)(unsigned)v), hi = (unsigned)__builtin_amdgcn_readfirstlane((int)(unsigned)(v >> 32));
    return (T*)(((unsigned long long)hi << 32) | lo);
}
__device__ __forceinline__ float bf2f(bf16_t h) { return __uint_as_float(((unsigned)h) << 16); }
template <int CTRL, int ROWMASK> __device__ __forceinline__ float dpp_zero(float x) {
    return __int_as_float(__builtin_amdgcn_update_dpp(0, __float_as_int(x), CTRL, ROWMASK, 0xf, false));
}
__device__ __forceinline__ float wave_sum(float v) {
    v += dpp_zero<0xB1, 0xf>(v);
    v += dpp_zero<0x4E, 0xf>(v);
    v += dpp_zero<0x141, 0xf>(v);
    v += dpp_zero<0x140, 0xf>(v);
    v += dpp_zero<0x142, 0xa>(v);
    v += dpp_zero<0x143, 0xc>(v);
    return __int_as_float(__builtin_amdgcn_readlane(__float_as_int(v), 63));
}
template <int CTRL> __device__ __forceinline__ float dpp_f(float x) {
    return __int_as_float(__builtin_amdgcn_mov_dpp(__float_as_int(x), CTRL, 0xf, 0xf, true));
}
__device__ __forceinline__ float sum8(float x) {
    x += dpp_f<0xB1>(x);
    x += dpp_f<0x4E>(x);
    x += dpp_f<0x141>(x);
    return x;
}
__device__ __forceinline__ float sigmoidf_(float x) { return __builtin_amdgcn_rcpf(1.0f + __expf(-x)); }
__device__ __forceinline__ float siluf_(float x) { return x * __builtin_amdgcn_rcpf(1.0f + __expf(-x)); }
__device__ __forceinline__ int modrow(int tok) { return tok < NX ? (tok >> 11) : 8; }


#define XB_TMO      128
#define XB_XCNT(j)  (256  + 64 * (j))
#define XB_XSUB(j)  (1280 + 64 * (j))
#define XB_XGEN(j)  (2304 + 64 * (j))
#define XB_TOP      3328
#define XB_TOPGEN   3392
#define XCD_BAR_WORDS 3456
#define XB_SPIN_CAP (1u << 27)
#define LAS __attribute__((address_space(3)))
__device__ __forceinline__ unsigned xb_ld(unsigned* p)              { return __hip_atomic_load(p, __ATOMIC_RELAXED, __HIP_MEMORY_SCOPE_AGENT); }
__device__ __forceinline__ unsigned xb_add(unsigned* p, unsigned v) { return __hip_atomic_fetch_add(p, v, __ATOMIC_RELAXED, __HIP_MEMORY_SCOPE_AGENT); }
__device__ __forceinline__ unsigned xb_xcc_id() { return (unsigned)__builtin_amdgcn_s_getreg((3 << 11) | 20) & 0xFu; }
#define XB_SPIN(cond, bar) do { unsigned _sp = 0; while (cond) { __builtin_amdgcn_s_sleep(1); \
    if ((++_sp & 255u) == 0u) { if (xb_ld(&(bar)[XB_TMO])) break; if (_sp > XB_SPIN_CAP) { atomicAdd(&(bar)[XB_TMO], 1u); break; } } } } while (0)
struct XcdBarrier { unsigned* bar; unsigned x; volatile LAS unsigned* st; };
__device__ __forceinline__ XcdBarrier xcd_barrier_post(unsigned* bar, volatile LAS unsigned* st) {
    XcdBarrier b; b.bar = bar; b.x = xb_xcc_id(); b.st = st;
    if (tidx() == 0) (void)xb_add(&bar[XB_XCNT(b.x)], 1u);
    return b;
}
__device__ __forceinline__ void xcd_barrier_complete(unsigned* bar, unsigned x, unsigned& nloc, unsigned& nx) {
    const unsigned G = gridDim.x * gridDim.y * gridDim.z;
    unsigned sum, cnt, mine, sp = 0u;
    for (;;) {
        sum = 0u; cnt = 0u; mine = 0u;
#pragma unroll
        for (unsigned j = 0; j < 16; ++j) { const unsigned c = xb_ld(&bar[XB_XCNT(j)]); sum += c; cnt += (c > 0u) ? 1u : 0u; mine = (j == x) ? c : mine; }
        if (sum == G) break;
        __builtin_amdgcn_s_sleep(1);
        if ((++sp & 255u) == 0u) { if (xb_ld(&bar[XB_TMO])) break; if (sp > XB_SPIN_CAP) { atomicAdd(&bar[XB_TMO], 1u); break; } }
    }
    nloc = mine > 0u ? mine : 1u; nx = cnt > 0u ? cnt : 1u;
}
__device__ __forceinline__ void xcd_barrier(const XcdBarrier& b) {
    asm volatile("s_waitcnt vmcnt(0)" ::: "memory");
    __syncthreads();
    if (tidx() == 0) {
        unsigned* bar = b.bar;
        __builtin_amdgcn_s_waitcnt(0);
        unsigned nloc = b.st[0], nx = b.st[1];
        if (nloc == 0u) { xcd_barrier_complete(bar, b.x, nloc, nx); b.st[0] = nloc; b.st[1] = nx; }
        const unsigned old = xb_add(&bar[XB_XSUB(b.x)], 1u);
        const unsigned gen = old / nloc;
        if (old + 1u == (gen + 1u) * nloc) {
            __builtin_amdgcn_fence(__ATOMIC_RELEASE, "agent");
            asm volatile("s_waitcnt vmcnt(0)" ::: "memory");
            const unsigned og = xb_add(&bar[XB_TOP], 1u);
            const unsigned tg = og / nx;
            if (og + 1u == (tg + 1u) * nx) xb_add(&bar[XB_TOPGEN], 1u);
            else XB_SPIN(xb_ld(&bar[XB_TOPGEN]) == tg, bar);
            __builtin_amdgcn_fence(__ATOMIC_ACQUIRE, "agent");
            xb_add(&bar[XB_XGEN(b.x)], 1u);
            asm volatile("s_waitcnt vmcnt(0)" ::: "memory");
        } else {
            XB_SPIN(xb_ld(&bar[XB_XGEN(b.x)]) == gen, bar);
            __builtin_amdgcn_fence(__ATOMIC_ACQUIRE, "agent");
            asm volatile("s_waitcnt vmcnt(0)" ::: "memory");
        }
    }
    __syncthreads();
}


__device__ __forceinline__ int q_next(int* ctr, char* smem) {
    volatile unsigned* slot = (volatile unsigned*)(smem + SMEM_BYTES + 8);
    __syncthreads();
    if (tidx() == 0) *slot = (unsigned)atomicAdd(ctr, 1);
    __syncthreads();
    return (int)*slot;
}

struct ARows {
    const bf16_t* base;
    int lda;
    const int* idx;
    int shift;
    int row0;
};

template <bool PAIRED, class Epi>
__device__ __forceinline__ void gemm_tile(const ARows ar, int mcount, const bf16_t* __restrict__ Bt, int ldb, int K, Epi& epi, char* smem) {
    const int tid = tidx() & 255, lane = tid & 63, wid = tid >> 6;
    const int wr = wid >> 1, wc = wid & 1, fr = lane & 15, fq = lane >> 4;
    bf16_t* sA = (bf16_t*)smem;
    bf16_t* sB = sA + 128 * 64;
    const int lrow = tid >> 3, lch = tid & 7;
    const bf16_t* aptr[4];
    const bf16_t* bptr[4];
#pragma unroll
    for (int i = 0; i < 4; ++i) {
        const int r = lrow + 32 * i;
        const int rr = r < mcount ? r : 0;
        const int rowid = ar.idx ? (ar.idx[rr] >> ar.shift) : (ar.row0 + rr);
        aptr[i] = ar.base + (size_t)rowid * ar.lda + lch * 8;
        bptr[i] = Bt + (size_t)r * ldb + lch * 8;
    }
    u32x4 ra[4], rb[4];
#pragma unroll
    for (int i = 0; i < 4; ++i) { ra[i] = *(const u32x4*)(aptr[i]); rb[i] = *(const u32x4*)(bptr[i]); }
    f32x4 acc[4][4];
#pragma unroll
    for (int m = 0; m < 4; ++m)
#pragma unroll
        for (int n = 0; n < 4; ++n) acc[m][n] = (f32x4){0.f, 0.f, 0.f, 0.f};
    const int nk = K >> 6;
    for (int kt = 0; kt < nk; ++kt) {
#pragma unroll
        for (int i = 0; i < 4; ++i) {
            const int r = lrow + 32 * i;
            const int off = r * 64 + ((lch ^ (r & 7)) << 3);
            *(u32x4*)(sA + off) = ra[i];
            *(u32x4*)(sB + off) = rb[i];
        }
        __syncthreads();
        if (kt + 1 < nk) {
#pragma unroll
            for (int i = 0; i < 4; ++i) { ra[i] = *(const u32x4*)(aptr[i] + (kt + 1) * 64); rb[i] = *(const u32x4*)(bptr[i] + (kt + 1) * 64); }
        }
#pragma unroll
        for (int ks = 0; ks < 2; ++ks) {
            bf16x8 af[4], bfr[4];
            const int ch = ks * 4 + fq;
#pragma unroll
            for (int m = 0; m < 4; ++m) { const int r = wr * 64 + m * 16 + fr; af[m] = *(const bf16x8*)(sA + r * 64 + ((ch ^ (r & 7)) << 3)); }
#pragma unroll
            for (int n = 0; n < 4; ++n) { const int r = wc * 64 + n * 16 + fr; bfr[n] = *(const bf16x8*)(sB + r * 64 + ((ch ^ (r & 7)) << 3)); }
#pragma unroll
            for (int m = 0; m < 4; ++m)
#pragma unroll
                for (int n = 0; n < 4; ++n) acc[m][n] = __builtin_amdgcn_mfma_f32_16x16x32_bf16(bfr[n], af[m], acc[m][n], 0, 0, 0);
        }
        __syncthreads();
    }
#pragma unroll
    for (int m = 0; m < 4; ++m) {
        const int r = wr * 64 + m * 16 + fr;
        if (r < mcount) {
            if constexpr (PAIRED) {
                epi.pair(r, wc * 32 + fq * 4, acc[m][0], acc[m][1]);
                epi.pair(r, wc * 32 + 16 + fq * 4, acc[m][2], acc[m][3]);
            } else {
#pragma unroll
                for (int n = 0; n < 4; ++n) epi.one(r, wc * 64 + n * 16 + fq * 4, acc[m][n]);
            }
        }
    }
}


namespace g8 {
#define G8_LAS __attribute__((address_space(3)))
constexpr int BM = 256, BK = 64, HALF = 128, HTB = HALF * BK * 2;
__device__ __forceinline__ int lds_byte(int r, int c) { const int st = (r >> 4) * 2 + (c >> 5), rr = r & 15, cc = c & 31, ob = rr * 64 + cc * 2; return st * 1024 + (ob ^ (((ob >> 9) & 1) << 5)); }
__device__ __forceinline__ void stage_rc(int b, int& R, int& C) { const int st = b / 1024, sb = b % 1024, swz = sb ^ (((sb >> 9) & 1) << 5); R = (st >> 1) * 16 + swz / 64; C = (st & 1) * 32 + (swz % 64) / 2; }
struct Unit {
    const char* a;
    const char* b;
    const int* gidx;
    const int* idx;
    int shift, rows;
    int i0, i1, i2;
};
template <class Epi, class Sched>
__device__ __forceinline__ void gemm_phase(G8_LAS unsigned char* lds, const int K, Sched& S, const Epi& E) {
    const int tid = tidx(), wid = __builtin_amdgcn_readfirstlane(tid >> 6), lane = tid & 63, wr = wid >> 2, wc = wid & 3, fr = lane & 15, fq = lane >> 4;
    const int nt = K / BK;
    int sR[2], sC[2];
    unsigned voffB[2];
#pragma unroll
    for (int i = 0; i < 2; ++i) { stage_rc(tid * 16 + i * 8192, sR[i], sC[i]); voffB[i] = (unsigned)(sR[i] * K + sC[i]) * 2u; }
    const size_t kstep = (size_t)(BK * 2);
    const size_t hstep = (size_t)HALF * K * 2;
    const unsigned ldsw = (unsigned)wid * 1024u;
    const int aoff = lds_byte(wr * 64 + fr, fq * 8), boff = lds_byte(wc * 32 + fr, fq * 8);
    auto a_offsets = [&](const Unit& u, unsigned (&o)[2][2]) {
#pragma unroll
        for (int h = 0; h < 2; ++h)
#pragma unroll
            for (int i = 0; i < 2; ++i) {
                int r = sR[i] + h * HALF;
                if (u.gidx) { r = r < u.rows ? r : (u.rows - 1); r = u.gidx[r] >> u.shift; }
                o[h][i] = (unsigned)(r * K + sC[i]) * 2u;
            }
    };
#define G8_SA(b, h) (((b) * 2 + (h)) * HTB)
#define G8_SB(b, h) ((4 + (b) * 2 + (h)) * HTB)
#define G8_STAGE2(bufoff, gbase, o0, o1) do { \
        __builtin_amdgcn_global_load_lds((const unsigned*)((const char*)(gbase) + (o0)), (G8_LAS unsigned*)(lds + (bufoff) + ldsw), 16, 0, 0); \
        __builtin_amdgcn_global_load_lds((const unsigned*)((const char*)(gbase) + (o1)), (G8_LAS unsigned*)(lds + (bufoff) + ldsw + 8192), 16, 0, 0); } while (0)
#define G8_STAGE_B(bufoff, gbase) G8_STAGE2(bufoff, gbase, voffB[0], voffB[1])
#define G8_LDA(dst, b, h) do { _Pragma("unroll") for (int m = 0; m < 4; ++m) _Pragma("unroll") for (int k = 0; k < 2; ++k) dst[m][k] = *(const G8_LAS bf16x8*)(lds + G8_SA(b, h) + aoff + m * 2048 + k * 1024); } while (0)
#define G8_LDB(dst, b, h) do { _Pragma("unroll") for (int n = 0; n < 2; ++n) _Pragma("unroll") for (int k = 0; k < 2; ++k) dst[n][k] = *(const G8_LAS bf16x8*)(lds + G8_SB(b, h) + boff + n * 2048 + k * 1024); } while (0)
#define G8_MMA(ai, bj, At, Bt) do { __builtin_amdgcn_s_setprio(1); _Pragma("unroll") for (int m = 0; m < 4; ++m) _Pragma("unroll") for (int n = 0; n < 2; ++n) _Pragma("unroll") for (int k = 0; k < 2; ++k) \
        acc[ai][bj][m][n] = __builtin_amdgcn_mfma_f32_16x16x32_bf16(Bt[n][k], At[m][k], acc[ai][bj][m][n], 0, 0, 0); __builtin_amdgcn_s_setprio(0); } while (0)
#define G8_WAIT_V(n) asm volatile("s_waitcnt vmcnt(" #n ")" ::: "memory")
#define G8_WAIT_L(n) asm volatile("s_waitcnt lgkmcnt(" #n ")" ::: "memory")
#define G8_BAR __builtin_amdgcn_s_barrier()
#define G8_SCHED __builtin_amdgcn_sched_barrier(0)
    Unit cur, nxt;
    if (!S.next(cur)) return;
    unsigned oc[2][2], on[2][2];
    a_offsets(cur, oc);
    f32x4 acc[2][2][4][2];
#pragma unroll
    for (int a = 0; a < 2; ++a)
#pragma unroll
        for (int b = 0; b < 2; ++b)
#pragma unroll
            for (int m = 0; m < 4; ++m)
#pragma unroll
                for (int n = 0; n < 2; ++n) acc[a][b][m][n] = (f32x4){0.f, 0.f, 0.f, 0.f};
    bf16x8 At[4][2], B0[2][2], B1[2][2];
    const char* cA = cur.a; const char* cB = cur.b;
    G8_STAGE_B(G8_SB(0, 0), cB); G8_STAGE_B(G8_SB(0, 1), cB + hstep); G8_STAGE2(G8_SA(0, 0), cA, oc[0][0], oc[0][1]); G8_STAGE2(G8_SA(0, 1), cA, oc[1][0], oc[1][1]);
    if (wr == 1) G8_BAR;
    G8_WAIT_V(2); G8_BAR;
    G8_STAGE_B(G8_SB(1, 0), cB + kstep); G8_STAGE2(G8_SA(1, 0), cA + kstep, oc[0][0], oc[0][1]); G8_STAGE_B(G8_SB(1, 1), cB + hstep + kstep);
    G8_WAIT_V(6); G8_BAR;
    for (;;) {
        const bool has_next = S.next(nxt);
        if (has_next) a_offsets(nxt, on);
        else {
#pragma unroll
            for (int h = 0; h < 2; ++h) { on[h][0] = oc[h][0]; on[h][1] = oc[h][1]; }
        }
        const char* nA = has_next ? nxt.a : cA; const char* nB = has_next ? nxt.b : cB;
        for (int t = 0; t < nt; t += 2) {
            const bool last = (t == nt - 2);
            const char* a1 = cA + (size_t)(t + 1) * kstep;
            const char* a2 = last ? nA : cA + (size_t)(t + 2) * kstep; const char* b2 = last ? nB : cB + (size_t)(t + 2) * kstep;
            const char* a3 = a2 + kstep; const char* b3 = b2 + kstep;
            const unsigned p00 = last ? on[0][0] : oc[0][0], p01 = last ? on[0][1] : oc[0][1], p10 = last ? on[1][0] : oc[1][0], p11 = last ? on[1][1] : oc[1][1];
            G8_LDB(B0, 0, 0); G8_LDB(B1, 0, 1); G8_SCHED; G8_LDA(At, 0, 0); G8_STAGE2(G8_SA(1, 1), a1, oc[1][0], oc[1][1]);
            G8_WAIT_V(8); G8_WAIT_L(0); G8_BAR; G8_MMA(0, 0, At, B0); G8_MMA(0, 1, At, B1); G8_BAR; G8_SCHED;
            G8_LDA(At, 0, 1); G8_STAGE_B(G8_SB(0, 0), b2); G8_STAGE_B(G8_SB(0, 1), b2 + hstep); G8_STAGE2(G8_SA(0, 0), a2, p00, p01);
            G8_WAIT_V(8); G8_WAIT_L(0); G8_BAR; G8_MMA(1, 0, At, B0); G8_MMA(1, 1, At, B1); G8_BAR; G8_SCHED;
            G8_LDB(B0, 1, 0); G8_LDB(B1, 1, 1); G8_SCHED; G8_LDA(At, 1, 0); G8_STAGE2(G8_SA(0, 1), a2, p10, p11);
            G8_WAIT_V(8); G8_WAIT_L(0); G8_BAR; G8_MMA(0, 0, At, B0); G8_MMA(0, 1, At, B1); G8_BAR; G8_SCHED;
            G8_LDA(At, 1, 1); G8_STAGE_B(G8_SB(1, 0), b3); G8_STAGE_B(G8_SB(1, 1), b3 + hstep); G8_STAGE2(G8_SA(1, 0), a3, p00, p01);
            G8_WAIT_V(8); G8_WAIT_L(0); G8_BAR; G8_MMA(1, 0, At, B0); G8_MMA(1, 1, At, B1); G8_BAR; G8_SCHED;
        }
        if (wr == 0) G8_BAR;
        E(acc, cur, wr, wc, fr, fq);
        if (!has_next) break;
#pragma unroll
        for (int a = 0; a < 2; ++a)
#pragma unroll
            for (int b = 0; b < 2; ++b)
#pragma unroll
                for (int m = 0; m < 4; ++m)
#pragma unroll
                    for (int n = 0; n < 2; ++n) acc[a][b][m][n] = (f32x4){0.f, 0.f, 0.f, 0.f};
        cur = nxt; cA = nA; cB = nB;
#pragma unroll
        for (int h = 0; h < 2; ++h) { oc[h][0] = on[h][0]; oc[h][1] = on[h][1]; }
        if (wr == 1) G8_BAR;
    }
    G8_WAIT_V(0);
    G8_BAR;
#undef G8_SA
#undef G8_SB
#undef G8_STAGE2
#undef G8_STAGE_B
#undef G8_LDA
#undef G8_LDB
#undef G8_MMA
#undef G8_WAIT_V
#undef G8_WAIT_L
#undef G8_BAR
#undef G8_SCHED
}
}

__device__ __forceinline__ int gu_row(int col) {
    const int half = col >> 10, unit = col & 1023, T = unit >> 7, ul = unit & 127, wc = ul >> 5, r = ul & 31, fq = r >> 3, bj = (r >> 2) & 1, jj = r & 3;
    return 256 * T + 128 * bj + 32 * wc + 16 * half + 4 * fq + jj;
}
__device__ __forceinline__ int p32_row(int col) {
    const int x = col & 31;
    return (col & ~31) + 16 * ((x >> 2) & 1) + 4 * (x >> 3) + (x & 3);
}
struct ConvDesc { const float* src; bf16_t* dst; int N, Kd, kt, nt, perm, pad; };
struct ConvRegs { f32x4 v0, v1, v2, v3; };
__device__ __forceinline__ ConvRegs conv_load(const ConvDesc& d) {
    const int tid = tidx() & 255, r = tid >> 4, c4 = (tid & 15) * 4;
    ConvRegs x;
    const float* b0 = d.src + (size_t)(d.kt * 64 + r) * d.N + d.nt * 64 + c4;
    x.v0 = *(const f32x4*)(b0); x.v1 = *(const f32x4*)(b0 + (size_t)16 * d.N); x.v2 = *(const f32x4*)(b0 + (size_t)32 * d.N); x.v3 = *(const f32x4*)(b0 + (size_t)48 * d.N);
    return x;
}
__device__ __forceinline__ void conv_store(const ConvRegs& x, const ConvDesc& d, float* lds) {
    const int tid = tidx() & 255;
    {
        const int r = tid >> 4, c4 = (tid & 15) * 4;
        float* q = lds + r * 65 + c4;
        q[0] = x.v0[0]; q[1] = x.v0[1]; q[2] = x.v0[2]; q[3] = x.v0[3];
        q[16 * 65 + 0] = x.v1[0]; q[16 * 65 + 1] = x.v1[1]; q[16 * 65 + 2] = x.v1[2]; q[16 * 65 + 3] = x.v1[3];
        q[32 * 65 + 0] = x.v2[0]; q[32 * 65 + 1] = x.v2[1]; q[32 * 65 + 2] = x.v2[2]; q[32 * 65 + 3] = x.v2[3];
        q[48 * 65 + 0] = x.v3[0]; q[48 * 65 + 1] = x.v3[1]; q[48 * 65 + 2] = x.v3[2]; q[48 * 65 + 3] = x.v3[3];
    }
    __syncthreads();
    {
        const int n = tid >> 2, kseg = (tid & 3) * 16;
        unsigned w[8];
#pragma unroll
        for (int j = 0; j < 8; ++j) w[j] = pack2(lds[(kseg + 2 * j) * 65 + n], lds[(kseg + 2 * j + 1) * 65 + n]);
        const int ncol = d.nt * 64 + n;
        const int row = d.perm == 1 ? gu_row(ncol) : (d.perm == 2 ? p32_row(ncol) : (d.perm == 3 ? ((ncol >> 6) * 128 + (ncol & 63)) : ncol));
        uint4* q = (uint4*)(d.dst + (size_t)row * d.Kd + d.kt * 64 + kseg);
        q[0] = make_uint4(w[0], w[1], w[2], w[3]);
        q[1] = make_uint4(w[4], w[5], w[6], w[7]);
    }
    __syncthreads();
}
__device__ __forceinline__ void conv_tile(const float* __restrict__ src, int N, bf16_t* __restrict__ dst, int Kd, int kt, int nt, int perm, float* lds) {
    const ConvDesc d{src, dst, N, Kd, kt, nt, perm, 0};
    const ConvRegs x = conv_load(d);
    conv_store(x, d, lds);
}

#define CONV_GRP 8
#define N_MODP 768
#define CV0 832
#define CV1 (CV0 + 16)
#define CV2 (CV1 + 16)
#define CV3 (CV2 + 16)
#define CV4 (CV3 + 256)
#define N_CONV CV4
#define N_ROPE 64
#define N_P0A (N_MODP + N_CONV + N_ROPE + 2)

__device__ __forceinline__ void phase0a(const Params& p, int bid, int nblk, char* smem) {
    const int half = tidx() >> 8, tid = tidx() & 255;
    float* lds = (float*)(smem + half * HLDS);
    for (int it0 = bid * 2; it0 < N_P0A; it0 += nblk * 2) {
        const int it = it0 + half;
        if (it < N_MODP) {
            const int l = it / 384, rem = it % 384, cb = rem / 16, kc = rem % 16;
            for (int e = tid; e < 9 * 64; e += 256) {
                const int r = e >> 6, k = e & 63;
                const float v = (r < 8) ? p.c[r * DM + kc * 64 + k] : p.c_ctx[kc * 64 + k];
                lds[e] = siluf_(v);
            }
            __syncthreads();
            const int col = cb * 256 + tid;
            const float* w = p.ada_w + (size_t)l * DM * 6144 + (size_t)(kc * 64) * 6144 + col;
            float acc[9];
#pragma unroll
            for (int r = 0; r < 9; ++r) acc[r] = 0.f;
#pragma unroll 1
            for (int k0 = 0; k0 < 64; k0 += 16) {
                float wv[16];
#pragma unroll
                for (int k = 0; k < 16; ++k) wv[k] = w[(size_t)(k0 + k) * 6144];
#pragma unroll
                for (int k = 0; k < 16; ++k)
#pragma unroll
                    for (int r = 0; r < 9; ++r) acc[r] += lds[r * 64 + k0 + k] * wv[k];
            }
#pragma unroll
            for (int r = 0; r < 9; ++r) p.mod_part[((size_t)(kc * 2 + l) * 9 + r) * 6144 + col] = acc[r];
            __syncthreads();
        } else if (it < N_MODP + N_CONV) {
            const int j = it - N_MODP;
            if (j < CV0) { conv_tile(p.ev_w_in, EVC, p.wt_evin, 1024, j / 52, j % 52, 2, lds); }
            else if (j < CV1) { const int q = j - CV0, z = q >> 3, nt = q & 7; conv_tile(p.rw_w2 + (size_t)z * 64 * 512, 512, p.wt_w2 + (size_t)z * 512 * 64, 64, 0, nt, 0, lds); }
            else if (j < CV2) { const int q = j - CV1, z = q >> 3, nt = q & 7; conv_tile(p.rw_a2 + (size_t)z * 64 * 512, 512, p.wt_a2 + (size_t)z * 64 * 64, 64, 0, nt, 3, lds); }
            else if (j < CV3) { const int q = j - CV2, kt = q >> 3, nt = q & 7; conv_tile(p.rw_g2, 512, p.wt_g2, 128, kt, nt, 0, lds); }
            else { const int q = j - CV3; conv_tile(p.ev_w_out, 1024, p.wt_evout, 1024, q >> 4, q & 15, 0, lds); }
        } else if (it < N_MODP + N_CONV + N_ROPE) {
            const int j = it - N_MODP - N_CONV;
#pragma unroll
            for (int i = 0; i < 4; ++i) {
                const int e = (j * 4 + i) * 256 + tid;
                const int t = e >> 5, a = (e >> 4) & 1, pp = e & 15;
                const float pos = (float)(a == 0 ? (t >> 6) : (t & 63));
                const float inv = powf(10000.0f, -(float)pp / 16.0f);
                const float ang = pos * inv;
                p.rope_cos[e] = cosf(ang);
                p.rope_sin[e] = sinf(ang);
            }
        } else if (it == N_MODP + N_CONV + N_ROPE) {
            if (tid < 64) {
                const float* lf = p.da_lambda;
                float a = lf[tid] * lf[64 + tid], b = lf[128 + tid] * lf[192 + tid];
                a = wave_sum(a); b = wave_sum(b);
                if (tid == 0) p.scal[0] = expf(a) - expf(b) + 0.2f;
            }
            if (tid < 128) p.counts[tid] = 0;
        }
    }
}

__device__ __forceinline__ void phase0b(const Params& p, int bid, int nblk) {
    for (int e = bid * NTHR + tidx(); e < 2 * 9 * 6144; e += nblk * NTHR) {
        const int l = e / (9 * 6144), rem = e % (9 * 6144);
        float s = p.ada_b[l * 6144 + rem % 6144];
#pragma unroll
        for (int kc = 0; kc < 16; ++kc) s += p.mod_part[(size_t)(kc * 2 + l) * 9 * 6144 + rem];
        p.mod[e] = s;
    }
}

__device__ __forceinline__ void phase_norm(const Params& p, int bid, int nblk, const float* xs_lat, const float* xs_ctx, const float* gain, const float* modl, int sh_off, int ntok) {
    const int lane = tidx() & 63, wid = tidx() >> 6;
    for (int tok = bid * 8 + wid; tok < ntok; tok += nblk * 8) {
        const float* xr = tok < NX ? xs_lat + (size_t)tok * DM : xs_ctx + (size_t)(tok - NX) * DM;
        const float* mr = modl + modrow(tok) * 6144 + sh_off;
        float4 v[4];
        float ss = 0.f;
#pragma unroll
        for (int i = 0; i < 4; ++i) { v[i] = *(const float4*)(xr + lane * 4 + 256 * i); ss += v[i].x * v[i].x + v[i].y * v[i].y + v[i].z * v[i].z + v[i].w * v[i].w; }
        ss = wave_sum(ss);
        const float rstd = rsqrtf(ss * (1.0f / 1024.0f) + 1e-6f);
#pragma unroll
        for (int i = 0; i < 4; ++i) {
            const int c = lane * 4 + 256 * i;
            const float4 g = *(const float4*)(gain + c), sh = *(const float4*)(mr + c), sc = *(const float4*)(mr + 1024 + c);
            const float a0 = v[i].x * rstd * g.x * (1.f + sc.x) + sh.x, a1 = v[i].y * rstd * g.y * (1.f + sc.y) + sh.y;
            const float a2 = v[i].z * rstd * g.z * (1.f + sc.z) + sh.z, a3 = v[i].w * rstd * g.w * (1.f + sc.w) + sh.w;
            *(uint2*)(p.H + (size_t)tok * DM + c) = make_uint2(pack2(a0, a1), pack2(a2, a3));
        }
    }
}

struct EpiStoreF32 {
    float* C; int ldc; int row0; int col0;
    __device__ __forceinline__ void one(int r, int c, f32x4 v) const { *(f32x4*)(C + (size_t)(row0 + r) * ldc + col0 + c) = v; }
};


struct TileIter {
    int mg0, mcnt, ntn, total, full, i, step;
    __device__ __forceinline__ void init(int MT, int NTN, int bid, int nblk) {
        const int g = bid & 7, lb = (bid >> 3) * 2 + (tidx() >> 8), nb = (nblk >> 3) * 2;
        mg0 = (MT * g) >> 3; mcnt = ((MT * (g + 1)) >> 3) - mg0; ntn = NTN; total = mcnt * NTN; full = mcnt >> 3; i = lb; step = nb;
    }
    __device__ __forceinline__ bool next(int& mt, int& nt) {
        if (i >= total) return false;
        const int band = 8 * ntn;
        if (i < full * band) { const int ms = i / band, r = i - ms * band; nt = r >> 3; mt = mg0 + ms * 8 + (r & 7); }
        else { const int rem = mcnt - full * 8, j = i - full * band; nt = j / rem; mt = mg0 + full * 8 + (j - nt * rem); }
        i += step;
        return true;
    }
};
__device__ __forceinline__ void phase_gemm_store(const bf16_t* A, int M, const bf16_t* Wt, int N, int K, float* C, int bid, int nblk, char* smem) {
    TileIter ti; ti.init(M / 128, N / 128, bid, nblk);
    char* hs = smem + (tidx() >> 8) * HLDS;
    for (;;) {
        int mt = 0, nt = 0;
        const bool v = ti.next(mt, nt);
        if (!__syncthreads_or(v ? 1 : 0)) break;
        if (!v) { mt = 0; nt = 0; }
        ARows ar{A, K, nullptr, 0, mt * 128};
        EpiStoreF32 epi{C, N, mt * 128, nt * 128};
        gemm_tile<false>(ar, v ? 128 : 0, Wt + (size_t)nt * 128 * K, K, K, epi, hs);
    }
}

struct EpiResid {
    const float* xin_lat; const float* xin_ctx; float* xout; const float* gmod; int row0; int col0;
    __device__ __forceinline__ void one(int r, int c, f32x4 v) const {
        const int tok = row0 + r, cc = col0 + c;
        const float* xr = tok < NX ? xin_lat + (size_t)tok * DM : xin_ctx + (size_t)(tok - NX) * DM;
        const f32x4 xi = *(const f32x4*)(xr + cc);
        const f32x4 g = *(const f32x4*)(gmod + modrow(tok) * 6144 + cc);
        *(f32x4*)(xout + (size_t)tok * DM + cc) = xi + g * v;
    }
};
__device__ __forceinline__ void phase_outproj(const Params& p, int bid, int nblk, char* smem, const bf16_t* Wt, int ntok, const float* xin_lat, const float* xin_ctx, float* xout, const float* gmod) {
    TileIter ti; ti.init(ntok / 128, 8, bid, nblk);
    char* hs = smem + (tidx() >> 8) * HLDS;
    for (;;) {
        int mt = 0, nt = 0;
        const bool v = ti.next(mt, nt);
        if (!__syncthreads_or(v ? 1 : 0)) break;
        if (!v) { mt = 0; nt = 0; }
        ARows ar{p.MG, DM, nullptr, 0, mt * 128};
        EpiResid epi{xin_lat, xin_ctx, xout, gmod, mt * 128, nt * 128};
        gemm_tile<false>(ar, v ? 128 : 0, Wt + (size_t)nt * 128 * DM, DM, DM, epi, hs);
    }
}

__device__ __forceinline__ void unpack8(const u32x4 w, float (&v)[8]) {
#pragma unroll
    for (int i = 0; i < 4; ++i) { v[2 * i] = __uint_as_float(w[i] << 16); v[2 * i + 1] = __uint_as_float(w[i] & 0xffff0000u); }
}
__device__ __forceinline__ u32x4 pack8f(const float (&v)[8]) { return (u32x4){pack2(v[0], v[1]), pack2(v[2], v[3]), pack2(v[4], v[5]), pack2(v[6], v[7])}; }
__device__ __forceinline__ void phase_feat0(const Params& p, int bid, int nblk, char* smem) {
    const int lane = tidx() & 63, wid = tidx() >> 6;
    const bf16_t* P16 = (const bf16_t*)p.P;
    const int l7 = lane & 7, g = lane >> 3;
    for (int tok = bid * 8 + wid; tok < NT; tok += nblk * 8) {
        const bool lat = tok < NX;
        const int b = lat ? (tok >> 11) : ((tok - NX) >> 8);
        const int t = lat ? (tok & 2047) : ((tok - NX) & 255);
        const int key = lat ? (CTXL + t) : t;
        const bf16_t* pr = P16 + (size_t)tok * EVC;
        {
            float cs[8], sn[8];
            if (lat) {
                const int a = l7 >> 2, ro = t * 32 + a * 16 + (l7 & 1) * 8;
                const f32x4 c0 = *(const f32x4*)(p.rope_cos + ro), c1 = *(const f32x4*)(p.rope_cos + ro + 4), s0 = *(const f32x4*)(p.rope_sin + ro), s1 = *(const f32x4*)(p.rope_sin + ro + 4);
#pragma unroll
                for (int j = 0; j < 4; ++j) { cs[j] = c0[j]; cs[4 + j] = c1[j]; sn[j] = s0[j]; sn[4 + j] = s1[j]; }
            }
            const bool hf = (l7 >> 1) & 1;
#pragma unroll
            for (int qk = 0; qk < 2; ++qk) {
                float v[8];
                unpack8(*(const u32x4*)(pr + qk * 512 + lane * 8), v);
                const float* nw = (qk == 0 ? p.da_q_norm : p.da_k_norm) + l7 * 8;
                const f32x4 n0 = *(const f32x4*)nw, n1 = *(const f32x4*)(nw + 4);
                float ss = 0.f;
#pragma unroll
                for (int j = 0; j < 8; ++j) ss += v[j] * v[j];
                ss = sum8(ss);
                const float rstd = rsqrtf(ss * (1.0f / 64.0f) + 1e-6f) * (qk == 0 ? 0.125f * 1.4426950408889634f : 1.0f);
#pragma unroll
                for (int j = 0; j < 8; ++j) v[j] = v[j] * rstd * (j < 4 ? n0[j] : n1[j - 4]);
                if (lat) {
#pragma unroll
                    for (int j = 0; j < 8; ++j) {
                        const float o = dpp_f<0x4E>(v[j]);
                        v[j] = hf ? (v[j] * cs[j] + o * sn[j]) : (v[j] * cs[j] - o * sn[j]);
                    }
                }
                const u32x4 w = pack8f(v);
                if (qk == 0) {
                    if (lat) *(u32x4*)(p.Q + (((size_t)b * 8 + g) * SEQ + t) * 64 + l7 * 8) = w;
                    else *(u32x4*)(p.Qc + (((size_t)b * 8 + g) * CTXL + t) * 64 + l7 * 8) = w;
                } else *(u32x4*)(p.Kd + (((size_t)b * 8 + g) * NKEY + key) * 64 + l7 * 8) = w;
            }
        }
        const int slen = lat ? SEQ : CTXL;
        const bool hasp = t > 0, hasn = t < slen - 1;
        const bf16_t* pw = pr + 1536;
        auto shifted = [&](int c0, float (&y)[8]) {
            float pv[8], nv[8];
            unpack8(*(const u32x4*)(pw + c0), y);
            if (hasp) unpack8(*(const u32x4*)(pw + c0 - EVC), pv); else {
#pragma unroll
                for (int j = 0; j < 8; ++j) pv[j] = 0.f; }
            if (hasn) unpack8(*(const u32x4*)(pw + c0 + EVC), nv); else {
#pragma unroll
                for (int j = 0; j < 8; ++j) nv[j] = 0.f; }
            const f32x4 m0 = *(const f32x4*)(p.rw_mu + c0), m1 = *(const f32x4*)(p.rw_mu + c0 + 4);
#pragma unroll
            for (int j = 0; j < 8; ++j) y[j] = y[j] + (j < 4 ? m0[j] : m1[j - 4]) * (0.5f * (pv[j] + nv[j]) - y[j]);
        };
        {
            float y[8];
            shifted(lane * 8, y);
            *(u32x4*)(p.rR + (size_t)tok * 512 + lane * 8) = pack8f(y);
        }
        {
            float y[8];
            shifted(512 + lane * 8, y);
            *(u32x4*)(p.rK + (size_t)tok * 512 + lane * 8) = pack8f(y);
            const f32x4 k0 = *(const f32x4*)(p.rw_k_k + lane * 8), k1 = *(const f32x4*)(p.rw_k_k + lane * 8 + 4);
            float ss = 0.f;
#pragma unroll
            for (int j = 0; j < 8; ++j) { y[j] *= (j < 4 ? k0[j] : k1[j - 4]); ss += y[j] * y[j]; }
            const float inv = 1.0f / fmaxf(sqrtf(sum8(ss)), 1e-12f);
#pragma unroll
            for (int j = 0; j < 8; ++j) y[j] *= inv;
            *(u32x4*)(p.rKK + (size_t)tok * 512 + lane * 8) = pack8f(y);
        }
        {
            float y[8];
            shifted(1024 + lane * 8, y);
            *(u32x4*)(p.rV + (size_t)tok * 512 + lane * 8) = pack8f(y);
        }
        if (lane < 32) {
            float y[8];
            shifted(1536 + lane * 8, y);
            if (lane < 8) {
#pragma unroll
                for (int j = 0; j < 8; ++j) y[j] = tanhf(y[j]);
                *(u32x4*)(p.rTW + (size_t)tok * 64 + lane * 8) = pack8f(y);
            } else if (lane < 16) {
                *(u32x4*)(p.rAD + (size_t)tok * 64 + (lane - 8) * 8) = pack8f(y);
            } else {
#pragma unroll
                for (int j = 0; j < 8; ++j) y[j] = sigmoidf_(y[j]);
                *(u32x4*)(p.rSG + (size_t)tok * 128 + (lane - 16) * 8) = pack8f(y);
            }
        }
    }
    {
        const int half = tidx() >> 8, tid = tidx() & 255;
        float* lds = (float*)(smem + half * HLDS);
        for (int it = bid * 2 + half; it < 8 * 36 * 4; it += nblk * 2) {
            const int b = it / 144, rem = it % 144, kt = rem >> 2, h = rem & 3;
            __syncthreads();
#pragma unroll
            for (int i = 0; i < 8; ++i) {
                const int e = i * 256 + tid, key = e >> 5, c4 = (e & 31) * 4;
                const int kg = kt * 64 + key;
                const int tok = kg < CTXL ? NX + b * CTXL + kg : b * SEQ + (kg - CTXL);
                const uint2 v = *(const uint2*)((const bf16_t*)p.P + (size_t)tok * EVC + 1024 + h * 128 + c4);
                float* d = lds + key * 129 + c4;
                d[0] = __uint_as_float(v.x << 16); d[1] = __uint_as_float(v.x & 0xffff0000u); d[2] = __uint_as_float(v.y << 16); d[3] = __uint_as_float(v.y & 0xffff0000u);
            }
            __syncthreads();
            {
                const int dv = tid >> 1, half = tid & 1;
                unsigned w[16];
#pragma unroll
                for (int j = 0; j < 16; ++j) { const int q = 2 * j, key = 16 * ((q >> 2) & 1) + 4 * (q >> 3) + (q & 3);
                    w[j] = pack2(lds[(half * 32 + key) * 129 + dv], lds[(half * 32 + key + 1) * 129 + dv]); }
                u32x4* dst = (u32x4*)(p.Vd + (((size_t)b * 4 + h) * 128 + dv) * NKEY + kt * 64 + half * 32);
#pragma unroll
                for (int j = 0; j < 4; ++j) dst[j] = (u32x4){w[4 * j], w[4 * j + 1], w[4 * j + 2], w[4 * j + 3]};
            }
        }
    }
}

struct EpiDecay {
    const float* w0; float* W; int row0; int col0;
    __device__ __forceinline__ void one(int r, int c, f32x4 v) const {
        const int tok = row0 + r, cc = col0 + c, z = cc >> 9, ch = cc & 511;
        f32x4 o;
        const f32x4 w0v = *(const f32x4*)(w0 + z * 512 + ch);
#pragma unroll
        for (int j = 0; j < 4; ++j) {
            const float x = w0v[j] + v[j];
            const float u = -x;
            const float sp = fmaxf(u, 0.f) + __logf(1.0f + __expf(-fabsf(u)));
            const float wlog = -sp - 0.5f;
            o[j] = __expf(-__expf(wlog));
        }
        *(f32x4*)(W + ((size_t)z * NT + tok) * 512 + ch) = o;
    }
};
struct EpiStoreBf16 {
    bf16_t* C; int ldc; int row0; int col0;
    __device__ __forceinline__ void one(int r, int c, f32x4 v) const { *(uint2*)(C + (size_t)(row0 + r) * ldc + col0 + c) = make_uint2(pack2(v[0], v[1]), pack2(v[2], v[3])); }
};
struct EpiArate {
    const float* a0; const float* k_a; const bf16_t* rK; const bf16_t* rKK; bf16_t* KD; bf16_t* BV; int row0; int col0;
    __device__ __forceinline__ void one(int r, int c, f32x4 v) const {
        const int tok = row0 + r, z = (c >> 6) & 1, ch = (col0 >> 1) + (c & 63);
        const uint2 ku = *(const uint2*)(rK + (size_t)tok * 512 + ch), kku = *(const uint2*)(rKK + (size_t)tok * 512 + ch);
        const f32x4 k = (f32x4){__uint_as_float(ku.x << 16), __uint_as_float(ku.x & 0xffff0000u), __uint_as_float(ku.y << 16), __uint_as_float(ku.y & 0xffff0000u)};
        const f32x4 kk = (f32x4){__uint_as_float(kku.x << 16), __uint_as_float(kku.x & 0xffff0000u), __uint_as_float(kku.y << 16), __uint_as_float(kku.y & 0xffff0000u)};
        f32x4 kd, bv;
        const f32x4 a0v = *(const f32x4*)(a0 + z * 512 + ch), kav = *(const f32x4*)(k_a + ch);
#pragma unroll
        for (int j = 0; j < 4; ++j) {
            const float arate = sigmoidf_(a0v[j] + v[j]);
            kd[j] = k[j] * (1.f + (arate - 1.f) * kav[j]);
            bv[j] = kk[j] * arate;
        }
        *(uint2*)(KD + ((size_t)z * NT + tok) * 512 + ch) = make_uint2(pack2(kd[0], kd[1]), pack2(kd[2], kd[3]));
        *(uint2*)(BV + ((size_t)z * NT + tok) * 512 + ch) = make_uint2(pack2(bv[0], bv[1]), pack2(bv[2], bv[3]));
    }
};
__device__ __forceinline__ void phase_lora(const Params& p, int bid, int nblk, char* smem) {
    const int half = tidx() >> 8;
    char* hs = smem + half * HLDS;
    for (int it0 = bid * 2; it0 < 144 * 20; it0 += nblk * 2) {
        const int it = it0 + half;
        if (it < 1152) {
            const int mt = it >> 3, q = it & 7;
            ARows ar{p.rTW, 64, nullptr, 0, mt * 128};
            EpiDecay epi{p.rw_w0, p.rW, mt * 128, q * 128};
            gemm_tile<false>(ar, 128, p.wt_w2 + (size_t)q * 128 * 64, 64, 64, epi, hs);
        } else if (it < 2304) {
            const int j = it - 1152, mt = j >> 3, q = j & 7;
            ARows ar{p.rAD, 64, nullptr, 0, mt * 128};
            EpiArate epi{p.rw_a0, p.rw_k_a, p.rK, p.rKK, p.rKD, p.rBV, mt * 128, q * 128};
            gemm_tile<false>(ar, 128, p.wt_a2 + (size_t)q * 128 * 64, 64, 64, epi, hs);
        } else {
            const int j = it - 2304, mt = j >> 2, q = j & 3;
            ARows ar{p.rSG, 128, nullptr, 0, mt * 128};
            EpiStoreBf16 epi{p.rG, 512, mt * 128, q * 128};
            gemm_tile<false>(ar, 128, p.wt_g2 + (size_t)q * 128 * 128, 128, 128, epi, hs);
        }
    }
}

__device__ __forceinline__ int scan_tok(int z, int b, int s) {
    if (s < CTXL) { const int tc = z == 0 ? s : (CTXL - 1 - s); return NX + b * CTXL + tc; }
    const int t = s - CTXL; return b * SEQ + (z == 0 ? t : (SEQ - 1 - t));
}
typedef float f32x2 __attribute__((ext_vector_type(2)));
__device__ __forceinline__ bf16x8 cvt8(const f32x4 a, const f32x4 b) {
    union { bf16x8 v; unsigned u[4]; } r;
    r.u[0] = pack2(a[0], a[1]); r.u[1] = pack2(a[2], a[3]); r.u[2] = pack2(b[0], b[1]); r.u[3] = pack2(b[2], b[3]);
    return r.v;
}
__device__ __forceinline__ void rwkv_chunk_chain(const Params& p, int chain, char* smem) {
    const int z = chain >> 6, b = (chain >> 3) & 7, h = chain & 7;
    const int tid = tidx(), lane = tid & 63, fr = lane & 15, fq = lane >> 4;
    const int wv_ = __builtin_amdgcn_readfirstlane(tid >> 6);
    bf16_t* AR = (bf16_t*)(smem + 43008);
    bf16_t* BK = (bf16_t*)(smem + 47104);
    bf16_t* BKT = (bf16_t*)(smem + 51200);
    bf16_t* VT = (bf16_t*)(smem + 55296);
    bf16_t* SB = (bf16_t*)(smem + 59392);
    float* AM = (float*)(smem + 67584);
    float* RH = (float*)(smem + 71680);
    float* GC = (float*)(smem + 75776);
    f32x4 S0 = (f32x4){0.f, 0.f, 0.f, 0.f}, S1 = S0;
    for (int i = tid; i < 2048; i += NTHR) ((unsigned*)SB)[i] = 0u;
    const size_t zoff = (size_t)z * NT * 512;
    const char* src1; const char* src2 = nullptr; unsigned dst1, dst2 = 0; int st1, st2 = 0;
    if (wv_ < 4) { src1 = (const char*)(p.rW + zoff + h * 64 + (lane & 15) * 4); st1 = 4 * wv_ + (lane >> 4); dst1 = wv_ * 1024; }
    else if (wv_ < 6) { src1 = (const char*)(p.rR + h * 64 + (lane & 7) * 8); st1 = 8 * (wv_ - 4) + (lane >> 3); dst1 = 4096 + (wv_ - 4) * 1024; }
    else { src1 = (const char*)(p.rKD + zoff + h * 64 + (lane & 7) * 8); st1 = 8 * (wv_ - 6) + (lane >> 3); dst1 = 6144 + (wv_ - 6) * 1024; }
    if (wv_ < 2) { src2 = (const char*)(p.rKK + h * 64 + (lane & 7) * 8); st2 = 8 * wv_ + (lane >> 3); dst2 = 8192 + wv_ * 1024; }
    else if (wv_ < 4) { src2 = (const char*)(p.rBV + zoff + h * 64 + (lane & 7) * 8); st2 = 8 * (wv_ - 2) + (lane >> 3); dst2 = 10240 + (wv_ - 2) * 1024; }
    else if (wv_ < 6) { src2 = (const char*)(p.rV + h * 64 + (lane & 7) * 8); st2 = 8 * (wv_ - 4) + (lane >> 3); dst2 = 12288 + (wv_ - 4) * 1024; }
    const int esz1 = wv_ < 4 ? 4 : 2;
    auto issue = [&](int chunk) {
        char* bb = smem + (chunk % 3) * 14336;
        const int tok1 = scan_tok(z, b, chunk * 16 + st1);
        __builtin_amdgcn_global_load_lds((const unsigned*)(src1 + (size_t)tok1 * 512 * esz1), (__attribute__((address_space(3))) unsigned*)(bb + dst1), 16, 0, 0);
        if (wv_ < 6) {
            const int tok2 = scan_tok(z, b, chunk * 16 + st2);
            __builtin_amdgcn_global_load_lds((const unsigned*)(src2 + (size_t)tok2 * 512 * 2), (__attribute__((address_space(3))) unsigned*)(bb + dst2), 16, 0, 0);
        }
    };
    issue(0); issue(1);
    const int ch = lane, t0 = 2 * wv_, t1 = t0 + 1;
    const int tokdir = z == 0 ? 1 : -1;
    for (int chunk = 0; chunk < 144; ++chunk) {
        if (chunk + 1 < 144) { if (wv_ < 6) asm volatile("s_waitcnt vmcnt(2)" ::: "memory"); else asm volatile("s_waitcnt vmcnt(1)" ::: "memory"); }
        else asm volatile("s_waitcnt vmcnt(0)" ::: "memory");
        __syncthreads();
        if (chunk + 2 < 144) issue(chunk + 2);
        const float* cbw = (const float*)(smem + (chunk % 3) * 14336);
        const bf16_t* cb = (const bf16_t*)(smem + (chunk % 3) * 14336 + 4096);
        const float w0 = cbw[t0 * 64 + ch], w1 = cbw[t1 * 64 + ch];
        {
            float gb = 1.f, gall = 1.f;
#pragma unroll
            for (int t = 0; t < 16; ++t) { const float wt = cbw[t * 64 + ch]; gall *= wt; if (t < t0) gb *= wt; }
            const float gt0 = gb * w0, gt1 = gt0 * w1;
            const float ig0 = __builtin_amdgcn_rcpf(gt0), ig1 = __builtin_amdgcn_rcpf(gt1);
            const float a0 = -gb * bf2f(cb[2048 + t0 * 64 + ch]), a1 = -gt0 * bf2f(cb[2048 + t1 * 64 + ch]);
            const float r0 = gt0 * bf2f(cb[t0 * 64 + ch]), r1 = gt1 * bf2f(cb[t1 * 64 + ch]);
            const float b0 = bf2f(cb[3072 + t0 * 64 + ch]) * ig0, b1 = bf2f(cb[3072 + t1 * 64 + ch]) * ig1;
            const float k0 = bf2f(cb[1024 + t0 * 64 + ch]) * ig0, k1 = bf2f(cb[1024 + t1 * 64 + ch]) * ig1;
            const float v0 = bf2f(cb[4096 + t0 * 64 + ch]), v1 = bf2f(cb[4096 + t1 * 64 + ch]);
            const int cc = ch >> 3, cw = ch & 7;
            AR[t0 * 64 + ((cc ^ (t0 & 7)) << 3) + cw] = f2bf(a0);
            AR[t1 * 64 + ((cc ^ (t1 & 7)) << 3) + cw] = f2bf(a1);
            AR[(16 + t0) * 64 + ((cc ^ (t0 & 7)) << 3) + cw] = f2bf(r0);
            AR[(16 + t1) * 64 + ((cc ^ (t1 & 7)) << 3) + cw] = f2bf(r1);
            BK[t0 * 64 + ((cc ^ (t0 & 7)) << 3) + cw] = f2bf(b0);
            BK[t1 * 64 + ((cc ^ (t1 & 7)) << 3) + cw] = f2bf(b1);
            BK[(16 + t0) * 64 + ((cc ^ (t0 & 7)) << 3) + cw] = f2bf(k0);
            BK[(16 + t1) * 64 + ((cc ^ (t1 & 7)) << 3) + cw] = f2bf(k1);
            const int sw = (ch >> 2) & 3;
            *(unsigned*)(BKT + ch * 32 + (((t0 >> 3) ^ sw) << 3) + (t0 & 7)) = pack2(b0, b1);
            *(unsigned*)(BKT + ch * 32 + ((((16 + t0) >> 3) ^ sw) << 3) + (t0 & 7)) = pack2(k0, k1);
            *(unsigned*)(VT + ch * 32 + ((((16 + t0) >> 3) ^ sw) << 3) + (t0 & 7)) = pack2(v0, v1);
            if (wv_ == 0) GC[ch] = gall;
        }
        __syncthreads();
        f32x4 G2 = (f32x4){0.f, 0.f, 0.f, 0.f};
        {
            const int rb = wv_ >> 2, vb = wv_ & 3;
            const int ra = 16 * rb + fr, rs = 16 * vb + fr;
#pragma unroll
            for (int ks = 0; ks < 2; ++ks) {
                const int c = ks * 4 + fq;
                const bf16x8 af = *(const bf16x8*)(AR + ra * 64 + ((c ^ (ra & 7)) << 3));
                const bf16x8 sf = *(const bf16x8*)(SB + rs * 64 + ((c ^ (rs & 7)) << 3));
                G2 = __builtin_amdgcn_mfma_f32_16x16x32_bf16(af, sf, G2, 0, 0, 0);
            }
        }
        if (wv_ < 4) {
            const int rb = wv_ >> 1, cbk = wv_ & 1;
            const int ra = 16 * rb + fr, rk = 16 * cbk + fr;
            f32x4 G1 = (f32x4){0.f, 0.f, 0.f, 0.f};
#pragma unroll
            for (int ks = 0; ks < 2; ++ks) {
                const int c = ks * 4 + fq;
                const bf16x8 af = *(const bf16x8*)(AR + ra * 64 + ((c ^ (ra & 7)) << 3));
                const bf16x8 bf = *(const bf16x8*)(BK + rk * 64 + ((c ^ (rk & 7)) << 3));
                G1 = __builtin_amdgcn_mfma_f32_16x16x32_bf16(af, bf, G1, 0, 0, 0);
            }
            if (wv_ == 0) {
                f32x4 m;
#pragma unroll
                for (int j = 0; j < 4; ++j) m[j] = (fr < 4 * fq + j) ? G1[j] : 0.f;
                *(f32x4*)(AM + fr * 16 + 4 * fq) = m;
            } else {
#pragma unroll
                for (int j = 0; j < 4; ++j) {
                    const int t = 4 * fq + j;
                    const bool keep = rb == 0 ? (fr < t) : (fr <= t);
                    AM[wv_ * 256 + t * 16 + fr] = keep ? G1[j] : 0.f;
                }
            }
        }
        __syncthreads();
        if (wv_ < 4) {
            union { bf16x8 v; unsigned u[4]; } af;
            if (fq < 2) {
                const f32x4 x0 = *(const f32x4*)(AM + 256 + fr * 16 + 8 * fq), x1 = *(const f32x4*)(AM + 256 + fr * 16 + 8 * fq + 4);
                af.v = cvt8(x0, x1);
            } else { af.u[0] = 0u; af.u[1] = 0u; af.u[2] = 0u; af.u[3] = 0u; }
            const int rv = 16 * wv_ + fr;
            const bf16x8 vf = *(const bf16x8*)(VT + rv * 32 + (((2 + (fq & 1)) ^ ((rv >> 2) & 3)) << 3));
            G2 = __builtin_amdgcn_mfma_f32_16x16x32_bf16(af.v, vf, G2, 0, 0, 0);
#pragma unroll
            for (int j = 0; j < 4; ++j) RH[(4 * fq + j) * 64 + rv] = G2[j];
        }
        __syncthreads();
        if (wv_ == 0) {
            float x[16];
#pragma unroll
            for (int t = 0; t < 16; ++t) x[t] = RH[t * 64 + lane];
#pragma unroll
            for (int i = 0; i < 15; ++i) {
                const float xi = x[i];
#pragma unroll
                for (int q = 0; q < 4; ++q) {
                    if (4 * q + 3 > i) {
                        const f32x4 acol = *(const f32x4*)(AM + i * 16 + 4 * q);
#pragma unroll
                        for (int j = 0; j < 4; ++j) if (4 * q + j > i) x[4 * q + j] += acol[j] * xi;
                    }
                }
            }
            const int sw = (lane >> 2) & 3;
            *(u32x4*)(VT + lane * 32 + ((0 ^ sw) << 3)) = (u32x4){pack2(x[0], x[1]), pack2(x[2], x[3]), pack2(x[4], x[5]), pack2(x[6], x[7])};
            *(u32x4*)(VT + lane * 32 + ((1 ^ sw) << 3)) = (u32x4){pack2(x[8], x[9]), pack2(x[10], x[11]), pack2(x[12], x[13]), pack2(x[14], x[15])};
        }
        __syncthreads();
        if (wv_ >= 4) {
            const int vb = wv_ & 3, rv = 16 * vb + fr;
            const float* am = AM + (fq < 2 ? 512 : 768) + fr * 16 + 8 * (fq & 1);
            const bf16x8 af = cvt8(*(const f32x4*)am, *(const f32x4*)(am + 4));
            const bf16x8 vf = *(const bf16x8*)(VT + rv * 32 + ((fq ^ ((rv >> 2) & 3)) << 3));
            G2 = __builtin_amdgcn_mfma_f32_16x16x32_bf16(af, vf, G2, 0, 0, 0);
            const int tokbase = scan_tok(z, b, chunk * 16);
#pragma unroll
            for (int j = 0; j < 4; ++j) p.rY[zoff + (size_t)(tokbase + tokdir * (4 * fq + j)) * 512 + h * 64 + rv] = G2[j];
        }
        {
            const int vb = wv_ >> 1, kb0 = 2 * (wv_ & 1);
            const int rv = 16 * vb + fr;
            const bf16x8 uf = *(const bf16x8*)(VT + rv * 32 + ((fq ^ ((rv >> 2) & 3)) << 3));
            const int rk0 = 16 * kb0 + fr, rk1 = rk0 + 16;
            const bf16x8 b0 = *(const bf16x8*)(BKT + rk0 * 32 + ((fq ^ ((rk0 >> 2) & 3)) << 3));
            const bf16x8 b1 = *(const bf16x8*)(BKT + rk1 * 32 + ((fq ^ ((rk1 >> 2) & 3)) << 3));
            S0 = __builtin_amdgcn_mfma_f32_16x16x32_bf16(uf, b0, S0, 0, 0, 0);
            S1 = __builtin_amdgcn_mfma_f32_16x16x32_bf16(uf, b1, S1, 0, 0, 0);
            const float gc0 = GC[rk0], gc1 = GC[rk1];
            S0 *= gc0; S1 *= gc1;
#pragma unroll
            for (int j = 0; j < 4; ++j) {
                const int v = 16 * vb + 4 * fq + j;
                SB[v * 64 + (((rk0 >> 3) ^ (v & 7)) << 3) + (rk0 & 7)] = f2bf(S0[j]);
                SB[v * 64 + (((rk1 >> 3) ^ (v & 7)) << 3) + (rk1 & 7)] = f2bf(S1[j]);
            }
        }
    }
    asm volatile("s_waitcnt vmcnt(0)" ::: "memory");
    __syncthreads();
}

__device__ __forceinline__ float max3_s(float a, float b, float c) { float r; asm("v_max3_f32 %0, %1, %2, %3" : "=v"(r) : "v"(a), "v"(b), "v"(c)); return r; }
__device__ __forceinline__ void attn_item(const Params& p, int b, int h, int q0, bool isctx, char* smem) {
    const int tid = tidx(), lane = tid & 63, wid = tid >> 6, fr = lane & 15, fq = lane >> 4;
    bf16_t* sKV = (bf16_t*)smem;
    const int ntiles = isctx ? (CTXL / 64) : (NKEY / 64);
    bf16x8 qf[2][2];
#pragma unroll
    for (int m = 0; m < 2; ++m) {
        const bf16_t* qp = isctx ? p.Qc + (((size_t)b * 8 + h * 2 + m) * CTXL + q0 + wid * 16 + fr) * 64
                                 : p.Q + (((size_t)b * 8 + h * 2 + m) * SEQ + q0 + wid * 16 + fr) * 64;
        qf[m][0] = *(const bf16x8*)(qp + fq * 8);
        qf[m][1] = *(const bf16x8*)(qp + 32 + fq * 8);
    }
    f32x4 o[2][8];
#pragma unroll
    for (int m = 0; m < 2; ++m)
#pragma unroll
        for (int mb = 0; mb < 8; ++mb) o[m][mb] = (f32x4){0.f, 0.f, 0.f, 0.f};
    float mrun[2] = {0.f, 0.f}, lrun[2] = {0.f, 0.f};
    const int lrow = tid >> 3, lch = tid & 7;
    const bf16_t* kbase = p.Kd + (((size_t)b * 8 + h * 2) * NKEY + lrow) * 64 + lch * 8;
    const bf16_t* vbase = p.Vd + (((size_t)b * 4 + h) * 128 + lrow) * NKEY + lch * 8;
    u32x4 rk[2], rv[2];
#pragma unroll
    for (int i = 0; i < 2; ++i) { rk[i] = *(const u32x4*)(kbase + i * (NKEY * 64)); rv[i] = *(const u32x4*)(vbase + i * (64 * NKEY)); }
    __syncthreads();
#pragma unroll
    for (int i = 0; i < 2; ++i) {
        const int r = lrow + 64 * i;
        const int off = r * 64 + ((lch ^ (r & 7)) << 3);
        *(u32x4*)(sKV + off) = rk[i];
        *(u32x4*)(sKV + 8192 + off) = rv[i];
    }
    if (ntiles > 1) {
#pragma unroll
        for (int i = 0; i < 2; ++i) { rk[i] = *(const u32x4*)(kbase + 4096 + i * (NKEY * 64)); rv[i] = *(const u32x4*)(vbase + 64 + i * (64 * NKEY)); }
    }
    for (int t = 0; t < ntiles; ++t) {
        __syncthreads();
        const bf16_t* sK = sKV + (t & 1) * 16384;
        const bf16_t* sV = sK + 8192;
        if (t + 1 < ntiles) {
            bf16_t* dK = sKV + ((t + 1) & 1) * 16384;
#pragma unroll
            for (int i = 0; i < 2; ++i) {
                const int r = lrow + 64 * i;
                const int off = r * 64 + ((lch ^ (r & 7)) << 3);
                *(u32x4*)(dK + off) = rk[i];
                *(u32x4*)(dK + 8192 + off) = rv[i];
            }
            if (t + 2 < ntiles) {
#pragma unroll
                for (int i = 0; i < 2; ++i) { rk[i] = *(const u32x4*)(kbase + (t + 2) * 4096 + i * (NKEY * 64)); rv[i] = *(const u32x4*)(vbase + (t + 2) * 64 + i * (64 * NKEY)); }
            }
        }
        bf16x8 pf[2][2];
#pragma unroll
        for (int m = 0; m < 2; ++m) {
            f32x4 sc[4];
            const float nm = -mrun[m];
#pragma unroll
            for (int kb = 0; kb < 4; ++kb) {
                sc[kb] = (f32x4){nm, nm, nm, nm};
                const int r = m * 64 + kb * 16 + fr;
#pragma unroll
                for (int ks = 0; ks < 2; ++ks) {
                    const bf16x8 kf = *(const bf16x8*)(sK + r * 64 + (((ks * 4 + fq) ^ (r & 7)) << 3));
                    sc[kb] = __builtin_amdgcn_mfma_f32_16x16x32_bf16(kf, qf[m][ks], sc[kb], 0, 0, 0);
                }
            }
            float mx = max3_s(sc[0][0], sc[0][1], sc[0][2]);
            mx = max3_s(mx, sc[0][3], sc[1][0]); mx = max3_s(mx, sc[1][1], sc[1][2]); mx = max3_s(mx, sc[1][3], sc[2][0]);
            mx = max3_s(mx, sc[2][1], sc[2][2]); mx = max3_s(mx, sc[2][3], sc[3][0]); mx = max3_s(mx, sc[3][1], sc[3][2]);
            mx = fmaxf(mx, sc[3][3]);
            mx = fmaxf(mx, __shfl_xor(mx, 16));
            mx = fmaxf(mx, __shfl_xor(mx, 32));
            if (!__all(mx <= 8.0f)) {
                const float d = mx > 8.0f ? mx : 0.f;
                const float scale = __builtin_amdgcn_exp2f(-d);
                mrun[m] += d;
                lrun[m] *= scale;
#pragma unroll
                for (int mb = 0; mb < 8; ++mb) o[m][mb] *= scale;
#pragma unroll
                for (int kb = 0; kb < 4; ++kb) sc[kb] -= d;
            }
            float ls = 0.f;
#pragma unroll
            for (int kb = 0; kb < 4; ++kb)
#pragma unroll
                for (int j = 0; j < 4; ++j) { const float e = __builtin_amdgcn_exp2f(sc[kb][j]); sc[kb][j] = e; ls += e; }
            lrun[m] += ls;
#pragma unroll
            for (int ksp = 0; ksp < 2; ++ksp) {
                const u32x4 pk = (u32x4){pack2(sc[2 * ksp][0], sc[2 * ksp][1]), pack2(sc[2 * ksp][2], sc[2 * ksp][3]), pack2(sc[2 * ksp + 1][0], sc[2 * ksp + 1][1]), pack2(sc[2 * ksp + 1][2], sc[2 * ksp + 1][3])};
                pf[m][ksp] = __builtin_bit_cast(bf16x8, pk);
            }
        }
#pragma unroll
        for (int ksp = 0; ksp < 2; ++ksp) {
#pragma unroll
            for (int mb = 0; mb < 8; ++mb) {
                const int r = mb * 16 + fr;
                const bf16x8 vfv = *(const bf16x8*)(sV + r * 64 + (((4 * ksp + fq) ^ (r & 7)) << 3));
                o[0][mb] = __builtin_amdgcn_mfma_f32_16x16x32_bf16(vfv, pf[0][ksp], o[0][mb], 0, 0, 0);
                o[1][mb] = __builtin_amdgcn_mfma_f32_16x16x32_bf16(vfv, pf[1][ksp], o[1][mb], 0, 0, 0);
                if ((mb & 3) == 3) asm volatile("" ::: "memory");
            }
        }
    }
    {
        float l0 = lrun[0], l1 = lrun[1];
        l0 += __shfl_xor(l0, 16); l0 += __shfl_xor(l0, 32);
        l1 += __shfl_xor(l1, 16); l1 += __shfl_xor(l1, 32);
        const float i0 = 1.0f / l0, i1 = p.scal[0] / l1;
        float ss = 0.f;
#pragma unroll
        for (int mb = 0; mb < 8; ++mb) {
            o[0][mb] = o[0][mb] * i0 - o[1][mb] * i1;
            ss += o[0][mb][0] * o[0][mb][0] + o[0][mb][1] * o[0][mb][1] + o[0][mb][2] * o[0][mb][2] + o[0][mb][3] * o[0][mb][3];
        }
        ss += __shfl_xor(ss, 16); ss += __shfl_xor(ss, 32);
        const float rstd = rsqrtf(ss * (1.0f / 128.0f) + 1e-6f) * 0.8f;
        const int tok = (isctx ? NX + b * CTXL : b * SEQ) + q0 + wid * 16 + fr;
        bf16_t* dst = p.MG + (size_t)tok * DM + h * 128 + fq * 4;
#pragma unroll
        for (int mb = 0; mb < 8; ++mb) {
            const f32x4 g = *(const f32x4*)(p.da_subln + mb * 16 + fq * 4);
            *(uint2*)(dst + mb * 16) = make_uint2(pack2(o[0][mb][0] * rstd * g[0], o[0][mb][1] * rstd * g[1]), pack2(o[0][mb][2] * rstd * g[2], o[0][mb][3] * rstd * g[3]));
        }
    }
}

#define N_ATT_LAT 512
#define N_ATT_CTX 64
#define N_CONV_LATE (1280 + 256 + 16384 + 8192)
__device__ __forceinline__ ConvDesc conv_late_desc(const Params& p, int pr) {
    const int j = pr * 2 + (tidx() >> 8);
    if (j < 1280) return ConvDesc{p.od_w_in, p.wt_odin, ODC, 1024, j / 80, j % 80, 2, 0};
    if (j < 1536) { const int q = j - 1280; return ConvDesc{p.od_w_out, p.wt_odout, 1024, 1024, q >> 4, q & 15, 0, 0}; }
    if (j < 1536 + 16384) { const int q = j - 1536, mat = q >> 9, t = q & 511; return ConvDesc{p.moe_w_gu + (size_t)mat * 1024 * 2048, p.wt_gu + (size_t)mat * 2048 * 1024, 2048, 1024, t >> 5, t & 31, 1, 0}; }
    const int q = j - 1536 - 16384, mat = q >> 8, t = q & 255;
    return ConvDesc{p.moe_w_dn + (size_t)mat * 1024 * 1024, p.wt_dn + (size_t)mat * 1024 * 1024, 1024, 1024, t >> 4, t & 15, 2, 0};
}
__device__ __forceinline__ ConvDesc conv_l1_desc(const Params& p, int pr) {
    const int j = pr * 2 + (tidx() >> 8);
    if (j < 16384) { const int mat = 32 + (j >> 9), t = j & 511; return ConvDesc{p.moe_w_gu + (size_t)mat * 1024 * 2048, p.wt_gu + (size_t)mat * 2048 * 1024, 2048, 1024, t >> 5, t & 31, 1, 0}; }
    const int q = j - 16384, mat = 32 + (q >> 8), t = q & 255;
    return ConvDesc{p.moe_w_dn + (size_t)mat * 1024 * 1024, p.wt_dn + (size_t)mat * 1024 * 1024, 1024, 1024, t >> 4, t & 15, 2, 0};
}
template <bool L1> __device__ __forceinline__ void conv_group(const Params& p, int g, char* smem) {
    float* lds = (float*)(smem + (tidx() >> 8) * HLDS);
    ConvDesc d = L1 ? conv_l1_desc(p, g * CONV_GRP) : conv_late_desc(p, g * CONV_GRP);
    ConvRegs x = conv_load(d);
#pragma unroll 1
    for (int q = 0; q < CONV_GRP; ++q) {
        ConvDesc dn = d; ConvRegs xn = x;
        if (q + 1 < CONV_GRP) { dn = L1 ? conv_l1_desc(p, g * CONV_GRP + q + 1) : conv_late_desc(p, g * CONV_GRP + q + 1); xn = conv_load(dn); }
        conv_store(x, d, lds);
        d = dn; x = xn;
    }
}
__device__ __forceinline__ void phase_scan_attn(const Params& p, int bid, int nblk, char* smem) {
    for (int it = bid; it < 128; it += nblk) rwkv_chunk_chain(p, it, smem);
    const int n_att = N_ATT_LAT + N_ATT_CTX, n_all = n_att + (N_CONV_LATE / 2) / CONV_GRP;
    for (;;) {
        const int it = q_next(p.counts + 64, smem);
        if (it >= n_all) break;
        if (it < N_ATT_LAT) attn_item(p, it >> 6, (it >> 4) & 3, (it & 15) * 128, false, smem);
        else if (it < n_att) { const int j = it - N_ATT_LAT; attn_item(p, j >> 3, (j >> 1) & 3, (j & 1) * 128, true, smem); }
        else {
            conv_group<false>(p, it - n_att, smem);
        }
    }
}

__device__ __forceinline__ void phase_rw_readout(const Params& p, int bid, int nblk) {
    const int lane = tidx() & 63, wid = tidx() >> 6;
    const int c0 = lane * 8;
    f32x4 rk0 = *(const f32x4*)(p.rw_r_k + c0), rk1 = *(const f32x4*)(p.rw_r_k + c0 + 4);
    f32x4 lw0 = *(const f32x4*)(p.rw_ln_w + c0), lw1 = *(const f32x4*)(p.rw_ln_w + c0 + 4);
    f32x4 lb0 = *(const f32x4*)(p.rw_ln_b + c0), lb1 = *(const f32x4*)(p.rw_ln_b + c0 + 4);
    for (int tok = bid * 8 + wid; tok < NT; tok += nblk * 8) {
        const size_t o = (size_t)tok * 512 + c0, zo = (size_t)NT * 512;
        const f32x4 ya0 = *(const f32x4*)(p.rY + o), ya1 = *(const f32x4*)(p.rY + o + 4), yb0 = *(const f32x4*)(p.rY + zo + o), yb1 = *(const f32x4*)(p.rY + zo + o + 4);
        float tr[8], tka[8], tkb[8], tv[8], tg[8];
        unpack8(*(const u32x4*)(p.rR + o), tr); unpack8(*(const u32x4*)(p.rKD + o), tka); unpack8(*(const u32x4*)(p.rKD + zo + o), tkb);
        unpack8(*(const u32x4*)(p.rV + o), tv); unpack8(*(const u32x4*)(p.rG + o), tg);
        const f32x4 r0 = (f32x4){tr[0], tr[1], tr[2], tr[3]}, r1 = (f32x4){tr[4], tr[5], tr[6], tr[7]};
        const f32x4 ka0 = (f32x4){tka[0], tka[1], tka[2], tka[3]}, ka1 = (f32x4){tka[4], tka[5], tka[6], tka[7]}, kb0 = (f32x4){tkb[0], tkb[1], tkb[2], tkb[3]}, kb1 = (f32x4){tkb[4], tkb[5], tkb[6], tkb[7]};
        const f32x4 v0 = (f32x4){tv[0], tv[1], tv[2], tv[3]}, v1 = (f32x4){tv[4], tv[5], tv[6], tv[7]}, g0 = (f32x4){tg[0], tg[1], tg[2], tg[3]}, g1 = (f32x4){tg[4], tg[5], tg[6], tg[7]};
        const f32x4 y0 = ya0 + yb0, y1 = ya1 + yb1;
        const float mean = sum8((y0[0] + y0[1]) + (y0[2] + y0[3]) + (y1[0] + y1[1]) + (y1[2] + y1[3])) * (1.0f / 64.0f);
        const f32x4 d0 = y0 - mean, d1 = y1 - mean;
        const float var = sum8((d0[0] * d0[0] + d0[1] * d0[1]) + (d0[2] * d0[2] + d0[3] * d0[3]) + (d1[0] * d1[0] + d1[1] * d1[1]) + (d1[2] * d1[2] + d1[3] * d1[3])) * (1.0f / 64.0f);
        const float rs = rsqrtf(var + 64e-5f);
        const f32x4 b0 = r0 * (ka0 + kb0) * rk0, b1 = r1 * (ka1 + kb1) * rk1;
        const float bon = sum8((b0[0] + b0[1]) + (b0[2] + b0[3]) + (b1[0] + b1[1]) + (b1[2] + b1[3]));
        const f32x4 o0 = (d0 * rs * lw0 + lb0 + bon * v0) * g0, o1 = (d1 * rs * lw1 + lb1 + bon * v1) * g1;
        *(u32x4*)(p.MG + (size_t)tok * DM + 512 + c0) = (u32x4){pack2(o0[0], o0[1]), pack2(o0[2], o0[3]), pack2(o1[0], o1[1]), pack2(o1[2], o1[3])};
    }
}

__device__ __forceinline__ void phase_router(const Params& p, int bid, int nblk, char* smem, int layer, const float* X, int ntok, bool dry = false) {
    const int tid = tidx(), lane = tid & 63, wid = tid >> 6;
    float* hrow = (float*)smem;
    float* part = hrow + 16 * 1028;
    float* logits = part + 8 * 512;
    const float* gain = p.norm2_g + layer * DM;
    const float* modl = p.mod + (size_t)layer * 9 * 6144;
    const float* wr = p.router_w + (size_t)layer * DM * NEXP;
    const float* br = p.router_b + layer * NEXP;
    int* counts = p.counts + layer * NEXP;
    int* lists = p.lists + (size_t)layer * NEXP * NT;
    for (int it = bid; it < ntok / 16; it += nblk) {
        __syncthreads();
#pragma unroll
        for (int u = 0; u < 2; ++u) {
            const int tl = wid * 2 + u, tok = it * 16 + tl;
            const float* xr = X + (size_t)tok * DM;
            const float* mr = modl + modrow(tok) * 6144 + 3072;
            float4 v[4];
            float ss = 0.f;
#pragma unroll
            for (int i = 0; i < 4; ++i) { v[i] = *(const float4*)(xr + lane * 4 + 256 * i); ss += v[i].x * v[i].x + v[i].y * v[i].y + v[i].z * v[i].z + v[i].w * v[i].w; }
            ss = wave_sum(ss);
            const float rstd = rsqrtf(ss * (1.0f / 1024.0f) + 1e-6f);
#pragma unroll
            for (int i = 0; i < 4; ++i) {
                const int c = lane * 4 + 256 * i;
                const float4 g = *(const float4*)(gain + c), sh = *(const float4*)(mr + c), sc = *(const float4*)(mr + 1024 + c);
                float4 a;
                a.x = v[i].x * rstd * g.x * (1.f + sc.x) + sh.x; a.y = v[i].y * rstd * g.y * (1.f + sc.y) + sh.y;
                a.z = v[i].z * rstd * g.z * (1.f + sc.z) + sh.z; a.w = v[i].w * rstd * g.w * (1.f + sc.w) + sh.w;
                *(uint2*)(p.H + (size_t)tok * DM + c) = make_uint2(pack2(a.x, a.y), pack2(a.z, a.w));
                *(float4*)(hrow + tl * 1028 + c) = a;
            }
        }
        __syncthreads();
        {
            const int tokl = lane & 15, kq = lane >> 4;
            f32x4 c0 = (f32x4){0.f, 0.f, 0.f, 0.f}, c1 = c0;
            const float* hp = hrow + tokl * 1028 + wid * 128 + kq;
            const float* wp = wr + (size_t)(wid * 128 + kq) * 32 + tokl;
#pragma unroll 8
            for (int ks = 0; ks < 32; ++ks) {
                const float a = hp[ks * 4];
                const float b0 = wp[ks * 128], b1 = wp[ks * 128 + 16];
                c0 = __builtin_amdgcn_mfma_f32_16x16x4f32(a, b0, c0, 0, 0, 0);
                c1 = __builtin_amdgcn_mfma_f32_16x16x4f32(a, b1, c1, 0, 0, 0);
            }
#pragma unroll
            for (int j = 0; j < 4; ++j) {
                part[wid * 512 + (4 * kq + j) * 32 + tokl] = c0[j];
                part[wid * 512 + (4 * kq + j) * 32 + 16 + tokl] = c1[j];
            }
        }
        __syncthreads();
        {
            const int tl = tid >> 5, e = tid & 31;
            float a = br[e];
#pragma unroll
            for (int w = 0; w < 8; ++w) a += part[w * 512 + tl * 32 + e];
            logits[tl * 32 + e] = a;
        }
        __syncthreads();
        if (tid < 16) {
            const int tok = it * 16 + tid;
            float lv[32];
#pragma unroll
            for (int e = 0; e < 32; ++e) lv[e] = logits[tid * 32 + e];
            float tv[4]; int te[4];
#pragma unroll
            for (int k = 0; k < 4; ++k) {
                float best = -3.0e38f; int bi = 0;
#pragma unroll
                for (int e = 0; e < 32; ++e) { if (lv[e] > best) { best = lv[e]; bi = e; } }
                tv[k] = best; te[k] = bi;
#pragma unroll
                for (int e = 0; e < 32; ++e) { if (e == bi) lv[e] = -3.0e38f; }
            }
            const float e1 = __expf(tv[1] - tv[0]), e2 = __expf(tv[2] - tv[0]), e3 = __expf(tv[3] - tv[0]);
            const float inv = 1.0f / (1.0f + e1 + e2 + e3);
            const float gt[4] = {inv, e1 * inv, e2 * inv, e3 * inv};
#pragma unroll
            for (int k = 0; k < 4; ++k) {
                p.GATE[(size_t)tok * 4 + k] = gt[k];
                if (!dry) {
                    const int pos = atomicAdd(&counts[te[k]], 1);
                    lists[(size_t)te[k] * NT + pos] = tok * 4 + k;
                }
            }
        }
    }
}

struct EpiGU {
    const float* bias; bf16_t* act; int pos0; int unit0;
    __device__ __forceinline__ void pair(int r, int cu, f32x4 g, f32x4 u) const {
        const int unit = unit0 + cu;
        unsigned w[2]; float o[4];
#pragma unroll
        for (int j = 0; j < 4; ++j) {
            const float gate = fminf(g[j] + bias[unit + j], 7.0f);
            const float up = fminf(fmaxf(u[j] + bias[1024 + unit + j], -7.0f), 7.0f);
            o[j] = (up + 1.0f) * gate * sigmoidf_(1.702f * gate);
        }
        w[0] = pack2(o[0], o[1]); w[1] = pack2(o[2], o[3]);
        *(uint2*)(act + (size_t)(pos0 + r) * 1024 + unit) = make_uint2(w[0], w[1]);
    }
};
struct MoeIter {
    int cnt[4], off[4], tiles[4], ntn, i, step, g;
    __device__ __forceinline__ void init(const int* counts, int NTN, int bid, int nblk) {
        g = bid & 7; i = (bid >> 3) * 2 + (tidx() >> 8); step = (nblk >> 3) * 2; ntn = NTN;
        int o = 0;
#pragma unroll
        for (int q = 0; q < 4; ++q) { cnt[q] = 0; off[q] = 0; tiles[q] = 0; }
        for (int e = 0; e < NEXP; ++e) {
            const int c = counts[e];
            if ((e & 7) == g) {
                const int q = e >> 3;
#pragma unroll
                for (int qq = 0; qq < 4; ++qq) if (qq == q) { cnt[qq] = c; off[qq] = o; tiles[qq] = ((c + 127) >> 7) * NTN; }
            }
            o += c;
        }
    }
    __device__ __forceinline__ bool next(int& e, int& mt, int& nt, int& eoff, int& ecnt) {
        int j = i, q = 0;
        if (j >= tiles[0]) { j -= tiles[0]; q = 1; if (j >= tiles[1]) { j -= tiles[1]; q = 2; if (j >= tiles[2]) { j -= tiles[2]; q = 3; if (j >= tiles[3]) return false; } } }
        int c = cnt[0], o = off[0];
        if (q == 1) { c = cnt[1]; o = off[1]; } else if (q == 2) { c = cnt[2]; o = off[2]; } else if (q == 3) { c = cnt[3]; o = off[3]; }
        const int mcnt = (c + 127) >> 7, full = mcnt >> 3, band = 8 * ntn;
        if (j < full * band) { const int ms = j / band, r = j - ms * band; nt = r >> 3; mt = ms * 8 + (r & 7); }
        else { const int rem = mcnt - full * 8, jj = j - full * band; nt = jj / rem; mt = full * 8 + (jj - nt * rem); }
        e = q * 8 + g; eoff = o; ecnt = c;
        i += step;
        return true;
    }
};

struct PlainOrder8 {
    const char* A; const char* Bt; int K;
    int mg0, mcnt, ntn, total, full, i, step;
    __device__ __forceinline__ void init(const bf16_t* A_, const bf16_t* Bt_, int K_, int MT, int NTN, int bid, int nblk) {
        A = (const char*)A_; Bt = (const char*)Bt_; K = K_;
        const int g = bid & 7;
        mg0 = (MT * g) >> 3; mcnt = ((MT * (g + 1)) >> 3) - mg0; ntn = NTN; total = mcnt * NTN; full = mcnt >> 3; i = bid >> 3; step = nblk >> 3;
    }
    __device__ __forceinline__ bool next(g8::Unit& u) {
        if (i >= total) return false;
        int mt, nt;
        const int band = 8 * ntn;
        if (i < full * band) { const int ms = i / band, r = i - ms * band; nt = r >> 3; mt = mg0 + ms * 8 + (r & 7); }
        else { const int rem = mcnt - full * 8, j = i - full * band; nt = j / rem; mt = mg0 + full * 8 + (j - nt * rem); }
        i += step;
        u.a = A + (size_t)mt * 256 * K * 2; u.b = Bt + (size_t)nt * 256 * K * 2; u.gidx = nullptr; u.idx = nullptr; u.shift = 0; u.rows = 256; u.i0 = mt * 256; u.i1 = nt * 256; u.i2 = 0;
        return true;
    }
};
struct Epi8Store {
    float* C; int ldc;
    __device__ __forceinline__ void operator()(const f32x4 (&acc)[2][2][4][2], const g8::Unit& u, int wr, int wc, int fr, int fq) const {
#pragma unroll
        for (int ai = 0; ai < 2; ++ai)
#pragma unroll
            for (int m = 0; m < 4; ++m) {
                float* rowp = C + (size_t)(u.i0 + ai * 128 + wr * 64 + m * 16 + fr) * ldc + u.i1 + wc * 32 + fq * 4;
#pragma unroll
                for (int bj = 0; bj < 2; ++bj)
#pragma unroll
                    for (int n = 0; n < 2; ++n) *(f32x4*)(rowp + bj * 128 + n * 16) = acc[ai][bj][m][n];
            }
    }
};
struct Epi8StoreBf {
    bf16_t* C; int ldc;
    __device__ __forceinline__ void operator()(const f32x4 (&acc)[2][2][4][2], const g8::Unit& u, int wr, int wc, int fr, int fq) const {
#pragma unroll
        for (int ai = 0; ai < 2; ++ai)
#pragma unroll
            for (int m = 0; m < 4; ++m) {
                bf16_t* rowp = C + (size_t)(u.i0 + ai * 128 + wr * 64 + m * 16 + fr) * ldc + u.i1 + wc * 32 + fq * 8;
#pragma unroll
                for (int bj = 0; bj < 2; ++bj) {
                    const f32x4 v0 = acc[ai][bj][m][0], v1 = acc[ai][bj][m][1];
                    *(u32x4*)(rowp + bj * 128) = (u32x4){pack2(v0[0], v0[1]), pack2(v0[2], v0[3]), pack2(v1[0], v1[1]), pack2(v1[2], v1[3])};
                }
            }
    }
};
struct Epi8StoreHg {
    bf16_t* C; const float* hg_lb;
    __device__ __forceinline__ void operator()(const f32x4 (&acc)[2][2][4][2], const g8::Unit& u, int wr, int wc, int fr, int fq) const {
        const int c0 = u.i1 + wc * 32 + fq * 8;
        const int kind = u.i1 < 1024 ? 0 : (u.i1 < 3072 ? 1 : 2);
        f32x4 lbv[2][2];
        if (kind == 1) {
#pragma unroll
            for (int bj = 0; bj < 2; ++bj)
#pragma unroll
                for (int n = 0; n < 2; ++n) {
                    const int ch = (c0 + bj * 128 + n * 4) & 1023;
                    const f32x4 h0 = *(const f32x4*)(hg_lb + ch), h1 = *(const f32x4*)(hg_lb + 1024 + ch);
#pragma unroll
                    for (int j = 0; j < 4; ++j) lbv[bj][n][j] = 1.f - __builtin_amdgcn_rcpf(1.0f + __expf(h0[j] - h1[j]));
                }
        }
#pragma unroll
        for (int ai = 0; ai < 2; ++ai)
#pragma unroll
            for (int m = 0; m < 4; ++m) {
                bf16_t* rowp = C + (size_t)(u.i0 + ai * 128 + wr * 64 + m * 16 + fr) * ODC + c0;
#pragma unroll
                for (int bj = 0; bj < 2; ++bj) {
                    f32x4 v0 = acc[ai][bj][m][0], v1 = acc[ai][bj][m][1];
                    if (kind == 0) {
#pragma unroll
                        for (int j = 0; j < 4; ++j) { v0[j] = siluf_(v0[j]); v1[j] = siluf_(v1[j]); }
                    } else if (kind == 1) {
#pragma unroll
                        for (int j = 0; j < 4; ++j) {
                            v0[j] = lbv[bj][0][j] * __builtin_amdgcn_rcpf(1.0f + __expf(v0[j]));
                            v1[j] = lbv[bj][1][j] * __builtin_amdgcn_rcpf(1.0f + __expf(v1[j]));
                        }
                    }
                    *(u32x4*)(rowp + bj * 128) = (u32x4){pack2(v0[0], v0[1]), pack2(v0[2], v0[3]), pack2(v1[0], v1[1]), pack2(v1[2], v1[3])};
                }
                asm volatile("" ::: "memory");
            }
    }
};
struct Epi8Resid {
    const float* xin_lat; const float* xin_ctx; float* xout; const float* gmod;
    __device__ __forceinline__ void operator()(const f32x4 (&acc)[2][2][4][2], const g8::Unit& u, int wr, int wc, int fr, int fq) const {
        const int c0 = u.i1 + wc * 32 + fq * 4;
        const float* gr = gmod + modrow(u.i0) * 6144 + c0;
        f32x4 g[2][2];
#pragma unroll
        for (int bj = 0; bj < 2; ++bj)
#pragma unroll
            for (int n = 0; n < 2; ++n) g[bj][n] = *(const f32x4*)(gr + bj * 128 + n * 16);
#pragma unroll
        for (int ai = 0; ai < 2; ++ai)
#pragma unroll
            for (int m = 0; m < 4; ++m) {
                const int tok = u.i0 + ai * 128 + wr * 64 + m * 16 + fr;
                const float* xr = (tok < NX ? xin_lat + (size_t)tok * DM : xin_ctx + (size_t)(tok - NX) * DM) + c0;
                float* orow = xout + (size_t)tok * DM + c0;
                f32x4 xi[2][2];
#pragma unroll
                for (int bj = 0; bj < 2; ++bj)
#pragma unroll
                    for (int n = 0; n < 2; ++n) xi[bj][n] = *(const f32x4*)(xr + bj * 128 + n * 16);
#pragma unroll
                for (int bj = 0; bj < 2; ++bj)
#pragma unroll
                    for (int n = 0; n < 2; ++n) *(f32x4*)(orow + bj * 128 + n * 16) = xi[bj][n] + g[bj][n] * acc[ai][bj][m][n];
                asm volatile("" ::: "memory");
            }
    }
};
struct MoeOrder8 {
    int cvec;
    const int* lists; const char* A; const char* W; int wrows, ntn, i, step, g;
    bool gather;
    __device__ __forceinline__ void init(const int* counts_, const int* lists_, const bf16_t* A_, const bf16_t* W_, int wrows_, bool gather_, int bid, int nblk) {
        cvec = counts_[tidx() & 31]; lists = lists_; A = (const char*)A_; W = (const char*)W_; wrows = wrows_; ntn = wrows_ / 256; gather = gather_;
        g = bid & 7; i = bid >> 3; step = nblk >> 3;
    }
    __device__ __forceinline__ bool next(g8::Unit& u) {
        int j = i, o = 0, fe = -1, fo = 0, fc = 0, fm = 1;
#pragma unroll
        for (int e = 0; e < NEXP; ++e) {
            const int c = __builtin_amdgcn_readlane(cvec, e);
            if ((e & 7) == g && fe < 0) {
                const int mcnt = (c + 255) >> 8, t = mcnt * ntn;
                if (j < t) { fe = e; fo = o; fc = c; fm = mcnt; }
                else j -= t;
            }
            o += c;
        }
        if (fe < 0) return false;
        const int nt = j / fm, mt = j - nt * fm;
        i += step;
        u.idx = lists + (size_t)fe * NT + mt * 256; u.gidx = gather ? u.idx : nullptr; u.rows = min(256, fc - mt * 256); u.shift = 2;
        u.a = gather ? A : A + (size_t)(fo + mt * 256) * 1024 * 2;
        u.b = W + ((size_t)fe * wrows + (size_t)nt * 256) * 1024 * 2;
        u.i0 = fo + mt * 256;
        u.i1 = nt;
        u.i2 = fe;
        return true;
    }
};
struct Epi8GU {
    const float* bias; bf16_t* act;
    __device__ __forceinline__ void operator()(const f32x4 (&acc)[2][2][4][2], const g8::Unit& u, int wr, int wc, int fr, int fq) const {
        const float* be = bias + (size_t)u.i2 * 2048;
        const int unit = u.i1 * 128 + wc * 32 + fq * 8;
        const f32x4 bg0 = *(const f32x4*)(be + unit), bg1 = *(const f32x4*)(be + unit + 4), bu0 = *(const f32x4*)(be + 1024 + unit), bu1 = *(const f32x4*)(be + 1024 + unit + 4);
#pragma unroll
        for (int ai = 0; ai < 2; ++ai)
#pragma unroll
            for (int m = 0; m < 4; ++m) {
                const int r = ai * 128 + wr * 64 + m * 16 + fr;
                if (r < u.rows) {
                    float o[8];
#pragma unroll
                    for (int bj = 0; bj < 2; ++bj) {
                        const f32x4 g = acc[ai][bj][m][0] + (bj ? bg1 : bg0), up = acc[ai][bj][m][1] + (bj ? bu1 : bu0);
#pragma unroll
                        for (int j = 0; j < 4; ++j) {
                            const float gate = fminf(g[j], 7.0f);
                            const float uu = fminf(fmaxf(up[j], -7.0f), 7.0f);
                            o[bj * 4 + j] = (uu + 1.0f) * gate * sigmoidf_(1.702f * gate);
                        }
                    }
                    *(u32x4*)(act + (size_t)(u.i0 + r) * 1024 + unit) = (u32x4){pack2(o[0], o[1]), pack2(o[2], o[3]), pack2(o[4], o[5]), pack2(o[6], o[7])};
                }
                asm volatile("" ::: "memory");
            }
    }
};
struct Epi8DN {
    const float* bias; bf16_t* ys;
    __device__ __forceinline__ void operator()(const f32x4 (&acc)[2][2][4][2], const g8::Unit& u, int wr, int wc, int fr, int fq) const {
        const int cb = u.i1 * 256 + wc * 32 + fq * 8;
        const float* be = bias + (size_t)u.i2 * 1024 + cb;
        const f32x4 b00 = *(const f32x4*)(be), b01 = *(const f32x4*)(be + 4), b10 = *(const f32x4*)(be + 128), b11 = *(const f32x4*)(be + 132);
#pragma unroll
        for (int ai = 0; ai < 2; ++ai)
#pragma unroll
            for (int m = 0; m < 4; ++m) {
                const int r = ai * 128 + wr * 64 + m * 16 + fr;
                if (r < u.rows) {
                    const int a = u.idx[r];
                    bf16_t* orow = ys + (size_t)a * 1024 + cb;
#pragma unroll
                    for (int bj = 0; bj < 2; ++bj) {
                        const f32x4 v0 = acc[ai][bj][m][0] + (bj ? b10 : b00), v1 = acc[ai][bj][m][1] + (bj ? b11 : b01);
                        *(u32x4*)(orow + bj * 128) = (u32x4){pack2(v0[0], v0[1]), pack2(v0[2], v0[3]), pack2(v1[0], v1[1]), pack2(v1[2], v1[3])};
                    }
                }
                asm volatile("" ::: "memory");
            }
    }
};
__device__ __forceinline__ void phase_gemm8_store(const bf16_t* A, int M, const bf16_t* Wt, int N, float* C, int bid, int nblk, char* smem) {
    PlainOrder8 S; S.init(A, Wt, DM, M / 256, N / 256, bid, nblk);
    Epi8Store E{C, N};
    g8::gemm_phase((G8_LAS unsigned char*)smem, DM, S, E);
}
__device__ __forceinline__ void phase_gemm8_store_bf(const bf16_t* A, int M, const bf16_t* Wt, int N, bf16_t* C, int bid, int nblk, char* smem) {
    PlainOrder8 S; S.init(A, Wt, DM, M / 256, N / 256, bid, nblk);
    Epi8StoreBf E{C, N};
    g8::gemm_phase((G8_LAS unsigned char*)smem, DM, S, E);
}
__device__ __forceinline__ void phase_gemm8_store_hg(const Params& p, int bid, int nblk, char* smem) {
    PlainOrder8 S; S.init(p.H, p.wt_odin, DM, NT / 256, ODC / 256, bid, nblk);
    Epi8StoreHg E{(bf16_t*)p.P, p.hg_lb};
    g8::gemm_phase((G8_LAS unsigned char*)smem, DM, S, E);
}
__device__ __forceinline__ void phase_outproj8(const Params& p, int bid, int nblk, char* smem, const bf16_t* Wt, int ntok, const float* xin_lat, const float* xin_ctx, float* xout, const float* gmod) {
    PlainOrder8 S; S.init(p.MG, Wt, DM, ntok / 256, 4, bid, nblk);
    Epi8Resid E{xin_lat, xin_ctx, xout, gmod};
    g8::gemm_phase((G8_LAS unsigned char*)smem, DM, S, E);
}
__device__ __forceinline__ void phase_moe_gu8(const Params& p, int bid, int nblk, char* smem, int layer) {
    MoeOrder8 S; S.init(p.counts + layer * NEXP, p.lists + (size_t)layer * NEXP * NT, p.H, p.wt_gu + (size_t)layer * NEXP * 2048 * 1024, 2048, true, bid, nblk);
    Epi8GU E{p.moe_b_gu + (size_t)layer * NEXP * 2048, p.ACT};
    g8::gemm_phase((G8_LAS unsigned char*)smem, DM, S, E);
}
__device__ __forceinline__ void phase_moe_dn8(const Params& p, int bid, int nblk, char* smem, int layer) {
    MoeOrder8 S; S.init(p.counts + layer * NEXP, p.lists + (size_t)layer * NEXP * NT, p.ACT, p.wt_dn + (size_t)layer * NEXP * 1024 * 1024, 1024, false, bid, nblk);
    Epi8DN E{p.moe_b_dn + (size_t)layer * NEXP * 1024, p.YS};
    g8::gemm_phase((G8_LAS unsigned char*)smem, DM, S, E);
}

__device__ __forceinline__ void phase_combine(const Params& p, int bid, int nblk, const float* Xin, float* Xout, const float* gmod  , int ntok,
                              bool do_norm, const float* gain, const float* modn) {
    const int lane = tidx() & 63, wid = tidx() >> 6;
    for (int tok = bid * 8 + wid; tok < ntok; tok += nblk * 8) {
        const float* gr = gmod + modrow(tok) * 6144;
        const float g0 = p.GATE[(size_t)tok * 4 + 0], g1 = p.GATE[(size_t)tok * 4 + 1], g2 = p.GATE[(size_t)tok * 4 + 2], g3 = p.GATE[(size_t)tok * 4 + 3];
        const bf16_t* ys = p.YS + (size_t)tok * 4 * 1024;
        float4 v[4];
        float ss = 0.f;
#pragma unroll
        for (int i = 0; i < 4; ++i) {
            const int c = lane * 4 + 256 * i;
            const float4 xi = *(const float4*)(Xin + (size_t)tok * DM + c), gg = *(const float4*)(gr + c);
            float4 y0, y1, y2, y3;
            { const uint2 u0 = *(const uint2*)(ys + c), u1 = *(const uint2*)(ys + 1024 + c), u2 = *(const uint2*)(ys + 2048 + c), u3 = *(const uint2*)(ys + 3072 + c);
              y0 = make_float4(__uint_as_float(u0.x << 16), __uint_as_float(u0.x & 0xffff0000u), __uint_as_float(u0.y << 16), __uint_as_float(u0.y & 0xffff0000u));
              y1 = make_float4(__uint_as_float(u1.x << 16), __uint_as_float(u1.x & 0xffff0000u), __uint_as_float(u1.y << 16), __uint_as_float(u1.y & 0xffff0000u));
              y2 = make_float4(__uint_as_float(u2.x << 16), __uint_as_float(u2.x & 0xffff0000u), __uint_as_float(u2.y << 16), __uint_as_float(u2.y & 0xffff0000u));
              y3 = make_float4(__uint_as_float(u3.x << 16), __uint_as_float(u3.x & 0xffff0000u), __uint_as_float(u3.y << 16), __uint_as_float(u3.y & 0xffff0000u)); }
            v[i].x = xi.x + gg.x * (g0 * y0.x + g1 * y1.x + g2 * y2.x + g3 * y3.x);
            v[i].y = xi.y + gg.y * (g0 * y0.y + g1 * y1.y + g2 * y2.y + g3 * y3.y);
            v[i].z = xi.z + gg.z * (g0 * y0.z + g1 * y1.z + g2 * y2.z + g3 * y3.z);
            v[i].w = xi.w + gg.w * (g0 * y0.w + g1 * y1.w + g2 * y2.w + g3 * y3.w);
            *(float4*)(Xout + (size_t)tok * DM + c) = v[i];
            ss += v[i].x * v[i].x + v[i].y * v[i].y + v[i].z * v[i].z + v[i].w * v[i].w;
        }
        if (do_norm) {
            ss = wave_sum(ss);
            const float rstd = rsqrtf(ss * (1.0f / 1024.0f) + 1e-6f);
            const float* mr = modn + modrow(tok) * 6144;
#pragma unroll
            for (int i = 0; i < 4; ++i) {
                const int c = lane * 4 + 256 * i;
                const float4 g = *(const float4*)(gain + c), sh = *(const float4*)(mr + c), sc = *(const float4*)(mr + 1024 + c);
                const float a0 = v[i].x * rstd * g.x * (1.f + sc.x) + sh.x, a1 = v[i].y * rstd * g.y * (1.f + sc.y) + sh.y;
                const float a2 = v[i].z * rstd * g.z * (1.f + sc.z) + sh.z, a3 = v[i].w * rstd * g.w * (1.f + sc.w) + sh.w;
                *(uint2*)(p.H + (size_t)tok * DM + c) = make_uint2(pack2(a0, a1), pack2(a2, a3));
            }
        }
    }
}

__device__ __forceinline__ bf16x8 pack8(const f32x4 a, const f32x4 b) {
    union { bf16x8 v; unsigned u[4]; } r;
    r.u[0] = pack2(a[0], a[1]); r.u[1] = pack2(a[2], a[3]); r.u[2] = pack2(b[0], b[1]); r.u[3] = pack2(b[2], b[3]);
    return r.v;
}
__device__ __forceinline__ void hgrn_chain(const Params& p, int chain, char* smem) {
    const int z = chain >> 6, b = (chain >> 3) & 7, h = chain & 7;
    const int tid = tidx(), lane = tid & 63, wid = tid >> 6, fr = lane & 15, fq = lane >> 4;
    bf16_t* sQ = (bf16_t*)smem;
    bf16_t* sK = sQ + 32 * 128;
    bf16_t* sKL = sK + 32 * 128;
    bf16_t* sV = sKL + 128 * 32;
    float* sT = (float*)(sV + 128 * 32);
    float* sEBL = sT + 1024;
    const int cp = tid & 63, g4 = tid >> 6;
    f32x4 S[8];
#pragma unroll
    for (int mi = 0; mi < 8; ++mi) S[mi] = (f32x4){0.f, 0.f, 0.f, 0.f};
    unsigned qA[4], fA[4], iA[4], qB[4], fB[4], iB[4];
    auto issue = [&](int chunk, unsigned (&rq)[4], unsigned (&rf)[4], unsigned (&ri)[4]) {
        const int tok0 = scan_tok(z, b, chunk * 32 + g4 * 4);
        const unsigned* pr = (const unsigned*)((const bf16_t*)p.P + (size_t)tok0 * ODC + h * 128) + cp;
        const int stride = z == 0 ? ODC / 2 : -(ODC / 2);
#pragma unroll
        for (int i = 0; i < 4; ++i) {
            rq[i] = pr[0]; rf[i] = pr[512 * (1 + z)]; ri[i] = pr[1536];
            pr += stride;
        }
    };
    issue(0, qA, fA, iA);
    issue(1, qB, fB, iB);
    auto body = [&](int chunk, unsigned (&rq)[4], unsigned (&rf)[4], unsigned (&ri)[4]) {
        float bc0[4], bc1[4], k0[4], k1[4];
        {
            float run0 = 1.f, run1 = 1.f;
#pragma unroll
            for (int i = 0; i < 4; ++i) {
                k0[i] = __uint_as_float(rf[i] << 16); k1[i] = __uint_as_float(rf[i] & 0xffff0000u);
                run0 *= 1.f - k0[i]; run1 *= 1.f - k1[i];
                bc0[i] = run0; bc1[i] = run1;
            }
            *(f32x2_*)(sT + g4 * 128 + 2 * cp) = (f32x2_){run0, run1};
        }
        __syncthreads();
        {
            float boff0 = 1.f, boff1 = 1.f, ebl0 = 1.f, ebl1 = 1.f;
#pragma unroll
            for (int j = 0; j < 8; ++j) {
                const f32x2_ t = *(const f32x2_*)(sT + j * 128 + 2 * cp);
                if (j < g4) { boff0 *= t[0]; boff1 *= t[1]; }
                ebl0 *= t[0]; ebl1 *= t[1];
            }
            if (g4 == 0) *(f32x2_*)(sEBL + 2 * cp) = (f32x2_){ebl0, ebl1};
            float kl0[4], kl1[4];
#pragma unroll
            for (int i = 0; i < 4; ++i) {
                const int t = g4 * 4 + i;
                const float eb0 = bc0[i] * boff0, eb1 = bc1[i] * boff1;
                const float emb0 = __builtin_amdgcn_rcpf(eb0), emb1 = __builtin_amdgcn_rcpf(eb1);
                const float qe0 = __uint_as_float(rq[i] << 16) * eb0, qe1 = __uint_as_float(rq[i] & 0xffff0000u) * eb1;
                const float ke0 = k0[i] * emb0, ke1 = k1[i] * emb1;
                kl0[i] = ke0 * ebl0; kl1[i] = ke1 * ebl1;
                const int off = t * 128 + (((cp >> 2) ^ (t & 15)) << 3) + ((cp & 3) << 1);
                *(unsigned*)(sQ + off) = pack2(qe0, qe1);
                *(unsigned*)(sK + off) = pack2(ke0, ke1);
            }
            const int ch0 = 2 * cp;
            const int o2 = ch0 * 32 + (((g4 >> 1) ^ ((ch0 >> 2) & 3)) << 3) + (g4 & 1) * 4;
            *(uint2*)(sKL + o2) = make_uint2(pack2(kl0[0], kl0[1]), pack2(kl0[2], kl0[3]));
            *(uint2*)(sKL + o2 + 32) = make_uint2(pack2(kl1[0], kl1[1]), pack2(kl1[2], kl1[3]));
            *(uint2*)(sV + o2) = make_uint2((ri[0] & 0xffffu) | (ri[1] << 16), (ri[2] & 0xffffu) | (ri[3] << 16));
            *(uint2*)(sV + o2 + 32) = make_uint2((ri[0] >> 16) | (ri[1] & 0xffff0000u), (ri[2] >> 16) | (ri[3] & 0xffff0000u));
        }
        __syncthreads();
        if (chunk + 2 < 72) issue(chunk + 2, rq, rf, ri);
        f32x4 sc00 = (f32x4){0.f, 0.f, 0.f, 0.f}, sc01 = sc00, sc11 = sc00;
#pragma unroll
        for (int ks = 0; ks < 4; ++ks) {
            const int c = ks * 4 + fq;
            const bf16x8 k0 = *(const bf16x8*)(sK + fr * 128 + ((c ^ fr) << 3));
            const bf16x8 k1 = *(const bf16x8*)(sK + (16 + fr) * 128 + ((c ^ fr) << 3));
            const bf16x8 q0 = *(const bf16x8*)(sQ + fr * 128 + ((c ^ fr) << 3));
            const bf16x8 q1 = *(const bf16x8*)(sQ + (16 + fr) * 128 + ((c ^ fr) << 3));
            sc00 = __builtin_amdgcn_mfma_f32_16x16x32_bf16(k0, q0, sc00, 0, 0, 0);
            sc01 = __builtin_amdgcn_mfma_f32_16x16x32_bf16(k0, q1, sc01, 0, 0, 0);
            sc11 = __builtin_amdgcn_mfma_f32_16x16x32_bf16(k1, q1, sc11, 0, 0, 0);
        }
#pragma unroll
        for (int j = 0; j < 4; ++j) { if (4 * fq + j > fr) { sc00[j] = 0.f; sc11[j] = 0.f; } }
        const f32x4 zero4 = (f32x4){0.f, 0.f, 0.f, 0.f};
        const bf16x8 pf0 = pack8(sc00, zero4), pf1 = pack8(sc01, sc11);
        asm volatile("" ::: "memory");
        f32x4 o[2];
        o[0] = zero4; o[1] = zero4;
        const int r0 = wid * 16 + fr;
        {
            union { bf16x8 v; uint2 u[2]; } vp0;
            vp0.u[0] = *(const uint2*)(sV + r0 * 32 + ((((fq >> 1)) ^ ((r0 >> 2) & 3)) << 3) + (fq & 1) * 4);
            vp0.u[1] = *(const uint2*)(sV + r0 * 32 + (((2 + (fq >> 1)) ^ ((r0 >> 2) & 3)) << 3) + (fq & 1) * 4);
            o[0] = __builtin_amdgcn_mfma_f32_16x16x32_bf16(vp0.v, pf0, o[0], 0, 0, 0);
            o[1] = __builtin_amdgcn_mfma_f32_16x16x32_bf16(vp0.v, pf1, o[1], 0, 0, 0);
        }
#pragma unroll
        for (int kp = 0; kp < 4; ++kp) {
            const bf16x8 sf0 = pack8(S[2 * kp], S[2 * kp + 1]);
            const int c0 = 4 * kp + (fq >> 1), c1 = c0 + 2;
            union { bf16x8 v; uint2 u[2]; } qa, qb;
            qa.u[0] = *(const uint2*)(sQ + fr * 128 + ((c0 ^ fr) << 3) + (fq & 1) * 4);
            qa.u[1] = *(const uint2*)(sQ + fr * 128 + ((c1 ^ fr) << 3) + (fq & 1) * 4);
            qb.u[0] = *(const uint2*)(sQ + (16 + fr) * 128 + ((c0 ^ fr) << 3) + (fq & 1) * 4);
            qb.u[1] = *(const uint2*)(sQ + (16 + fr) * 128 + ((c1 ^ fr) << 3) + (fq & 1) * 4);
            o[0] = __builtin_amdgcn_mfma_f32_16x16x32_bf16(sf0, qa.v, o[0], 0, 0, 0);
            o[1] = __builtin_amdgcn_mfma_f32_16x16x32_bf16(sf0, qb.v, o[1], 0, 0, 0);
        }
        if (chunk >= 8) {
#pragma unroll
            for (int tb = 0; tb < 2; ++tb) {
                const int tok = scan_tok(z, b, chunk * 32 + tb * 16 + fr);
                *(uint2*)((bf16_t*)p.HO + ((size_t)z * NX + tok) * 1024 + h * 128 + wid * 16 + fq * 4) = make_uint2(pack2(o[tb][0], o[tb][1]), pack2(o[tb][2], o[tb][3]));
            }
        }
        asm volatile("" ::: "memory");
        {
            const bf16x8 v0 = *(const bf16x8*)(sV + r0 * 32 + ((fq ^ ((r0 >> 2) & 3)) << 3));
#pragma unroll
            for (int mi = 0; mi < 8; ++mi) {
                const int r = mi * 16 + fr;
                const bf16x8 kl = *(const bf16x8*)(sKL + r * 32 + ((fq ^ ((r >> 2) & 3)) << 3));
                const f32x4 e = *(const f32x4*)(sEBL + mi * 16 + fq * 4);
                S[mi] = __builtin_amdgcn_mfma_f32_16x16x32_bf16(kl, v0, S[mi] * e, 0, 0, 0);
            }
        }
    };
    for (int chunk = 0; chunk < 72; chunk += 2) { body(chunk, qA, fA, iA); body(chunk + 1, qB, fB, iB); }
    __syncthreads();
}
__device__ __forceinline__ void phase_hgrn(const Params& p, int bid, int nblk, char* smem) {
    for (int it = bid; it < 128; it += nblk) hgrn_chain(p, it, smem);
    const int n_all = ((16384 + 8192) / 2) / CONV_GRP;
    for (;;) {
        const int it = q_next(p.counts + 65, smem);
        if (it >= n_all) break;
        conv_group<true>(p, it, smem);
    }
}
__device__ __forceinline__ void phase_hgrn_readout(const Params& p, int bid, int nblk) {
    const int lane = tidx() & 63, wid = tidx() >> 6;
    const int c0 = lane * 8;
    const f32x4 n0 = *(const f32x4*)(p.hg_norm + (c0 & 127)), n1 = *(const f32x4*)(p.hg_norm + (c0 & 127) + 4);
    for (int tok = bid * 8 + wid; tok < NX; tok += nblk * 8) {
#pragma unroll
        for (int q = 0; q < 2; ++q) {
            const size_t o = (size_t)tok * 1024 + q * 512 + c0, zo = (size_t)NX * 1024;
            float ta[8], tb[8], tg[8];
            unpack8(*(const u32x4*)((const bf16_t*)p.HO + o), ta); unpack8(*(const u32x4*)((const bf16_t*)p.HO + zo + o), tb);
            unpack8(*(const u32x4*)((const bf16_t*)p.P + (size_t)tok * ODC + 4096 + q * 512 + c0), tg);
            const f32x4 y0 = (f32x4){ta[0] + tb[0], ta[1] + tb[1], ta[2] + tb[2], ta[3] + tb[3]}, y1 = (f32x4){ta[4] + tb[4], ta[5] + tb[5], ta[6] + tb[6], ta[7] + tb[7]};
            const f32x4 g0 = (f32x4){tg[0], tg[1], tg[2], tg[3]}, g1 = (f32x4){tg[4], tg[5], tg[6], tg[7]};
            float ss = sum8((y0[0] * y0[0] + y0[1] * y0[1]) + (y0[2] * y0[2] + y0[3] * y0[3]) + (y1[0] * y1[0] + y1[1] * y1[1]) + (y1[2] * y1[2] + y1[3] * y1[3]));
            ss += dpp_f<0x140>(ss);
            const float rstd = rsqrtf(ss * (1.0f / 128.0f) + 1e-6f);
            float r[8];
#pragma unroll
            for (int j = 0; j < 4; ++j) { r[j] = y0[j] * rstd * n0[j] * siluf_(g0[j]); r[4 + j] = y1[j] * rstd * n1[j] * siluf_(g1[j]); }
            *(u32x4*)(p.MG + o) = (u32x4){pack2(r[0], r[1]), pack2(r[2], r[3]), pack2(r[4], r[5]), pack2(r[6], r[7])};
        }
    }
}

#define N_PHASES 20
__device__ __forceinline__ void run_phase(const Params& p, int ph, int bid, int nblk, char* smem) {
    const float* mod0 = p.mod;
    const float* mod1 = p.mod + 9 * 6144;
    switch (ph) {
    case 0: phase0a(p, bid, nblk, smem); break;
    case 1: phase0b(p, bid, nblk); break;
    case 2: phase_norm(p, bid, nblk, p.x, p.ctx, p.norm1_g, mod0, 0, NT); break;
    case 3: phase_gemm8_store_bf(p.H, NT, p.wt_evin, EVC, (bf16_t*)p.P, bid, nblk, smem); break;
    case 4: phase_feat0(p, bid, nblk, smem); break;
    case 5: phase_lora(p, bid, nblk, smem); break;
    case 6: phase_scan_attn(p, bid, nblk, smem); break;
    case 7: phase_rw_readout(p, bid, nblk); break;
    case 8: phase_outproj8(p, bid, nblk, smem, p.wt_evout, NT, p.x, p.ctx, p.X1, mod0 + 2048); break;
    case 9: phase_router(p, bid, nblk, smem, 0, p.X1, NT); break;
    case 10: phase_moe_gu8(p, bid, nblk, smem, 0); break;
    case 11: phase_moe_dn8(p, bid, nblk, smem, 0); break;
    case 12: phase_combine(p, bid, nblk, p.X1, p.X2, mod0 + 5120, NT, true, p.norm1_g + DM, mod1); break;
    case 13: phase_gemm8_store_hg(p, bid, nblk, smem); break;
    case 14: phase_hgrn(p, bid, nblk, smem); break;
    case 15: phase_hgrn_readout(p, bid, nblk); break;
    case 16: phase_outproj8(p, bid, nblk, smem, p.wt_odout, NX, p.X2, p.X2 + (size_t)NX * DM, p.X1, mod1 + 2048); break;
    case 17: phase_router(p, bid, nblk, smem, 1, p.X1, NX); break;
    case 18: phase_moe_gu8(p, bid, nblk, smem, 1); break;
    case 19: phase_moe_dn8(p, bid, nblk, smem, 1); break;
    default: break;
    }
}
__device__ __forceinline__ void final_phase(const Params& p, int bid, int nblk) {
    phase_combine(p, bid, nblk, p.X1, p.out, p.mod + 9 * 6144 + 5120, NX, false, nullptr, nullptr);
}

struct KArgs { const float* in[35]; float* out; char* ws; };

__host__ __device__ __forceinline__ size_t make_params(Params& p, const KArgs& a) {
    const float** ins = (const float**)&p;
    for (int i = 0; i < 35; ++i) ins[i] = a.in[i];
    p.out = a.out;
    char* ws = a.ws;
    size_t off = 0;
#define TAKE(bytes) (ws + off); off += (((size_t)(bytes)) + 255) & ~(size_t)255
    p.bar = (unsigned*)TAKE(16384);
    p.counts = (int*)TAKE(1024);
    p.scal = (float*)TAKE(256);
    p.mod = (float*)TAKE((size_t)2 * 9 * 6144 * 4);
    p.mod_part = (float*)TAKE((size_t)16 * 2 * 9 * 6144 * 4);
    p.rope_cos = (float*)TAKE((size_t)65536 * 4);
    p.rope_sin = (float*)TAKE((size_t)65536 * 4);
    p.wt_evin = (bf16_t*)TAKE((size_t)EVC * 1024 * 2);
    p.wt_evout = (bf16_t*)TAKE((size_t)1024 * 1024 * 2);
    p.wt_odin = (bf16_t*)TAKE((size_t)ODC * 1024 * 2);
    p.wt_odout = (bf16_t*)TAKE((size_t)1024 * 1024 * 2);
    p.wt_w2 = (bf16_t*)TAKE((size_t)1024 * 64 * 2);
    p.wt_a2 = (bf16_t*)TAKE((size_t)1024 * 64 * 2);
    p.wt_g2 = (bf16_t*)TAKE((size_t)512 * 128 * 2);
    p.wt_gu = (bf16_t*)TAKE((size_t)64 * 2048 * 1024 * 2);
    p.wt_dn = (bf16_t*)TAKE((size_t)64 * 1024 * 1024 * 2);
    p.lists = (int*)TAKE((size_t)2 * NEXP * NT * 4);
    p.GATE = (float*)TAKE((size_t)NASG * 4);
    p.H = (bf16_t*)TAKE((size_t)NT * DM * 2);
    p.MG = (bf16_t*)TAKE((size_t)NT * DM * 2);
    p.X1 = (float*)TAKE((size_t)NT * DM * 4);
    p.X2 = (float*)TAKE((size_t)NT * DM * 4);
    const size_t scratch0 = off;
    p.P = (float*)TAKE((size_t)NT * ODC * 4);
    const size_t after_p = off;
    p.Q = (bf16_t*)TAKE((size_t)8 * 8 * SEQ * 64 * 2);
    p.Qc = (bf16_t*)TAKE((size_t)8 * 8 * CTXL * 64 * 2);
    p.Kd = (bf16_t*)TAKE((size_t)8 * 8 * NKEY * 64 * 2);
    p.Vd = (bf16_t*)TAKE((size_t)8 * 4 * NKEY * 128 * 2);
    p.rR = (bf16_t*)TAKE((size_t)NT * 512 * 2);
    p.rK = (bf16_t*)TAKE((size_t)NT * 512 * 2);
    p.rV = (bf16_t*)TAKE((size_t)NT * 512 * 2);
    p.rKK = (bf16_t*)TAKE((size_t)NT * 512 * 2);
    p.rG = (bf16_t*)TAKE((size_t)NT * 512 * 2);
    p.rW = (float*)TAKE((size_t)2 * NT * 512 * 4);
    p.rKD = (bf16_t*)TAKE((size_t)2 * NT * 512 * 2);
    p.rBV = (bf16_t*)TAKE((size_t)2 * NT * 512 * 2);
    p.rY = (float*)TAKE((size_t)2 * NT * 512 * 4);
    p.rTW = (bf16_t*)TAKE((size_t)NT * 64 * 2);
    p.rAD = (bf16_t*)TAKE((size_t)NT * 64 * 2);
    p.rSG = (bf16_t*)TAKE((size_t)NT * 128 * 2);
    const size_t end_l0 = off;
    off = after_p;
    p.HO = (float*)TAKE((size_t)2 * NX * 1024 * 4);
    const size_t end_l1 = off;
    off = scratch0;
    p.ACT = (bf16_t*)TAKE((size_t)NASG * 1024 * 2);
    p.YS = (bf16_t*)TAKE((size_t)NASG * 1024 * 2);
    const size_t end_moe = off;
#undef TAKE
    size_t total = end_l0 > end_l1 ? end_l0 : end_l1;
    if (end_moe > total) total = end_moe;
    return total;
}

#if MULTI_LAUNCH
template <int PH>
__global__ void __launch_bounds__(256, 2) k_phase(KArgs a) {
    Params p; make_params(p, a);
    __shared__ __attribute__((aligned(16))) char smem[SMEM_BYTES];
    if (PH < N_PHASES) run_phase(p, PH, blockIdx.x, gridDim.x, smem);
    else final_phase(p, blockIdx.x, gridDim.x);
}
template <int PH> static void launch_all(const KArgs& p, hipStream_t stream) {
    hipLaunchKernelGGL(k_phase<PH>, dim3(1024), dim3(256), 0, stream, p);
    if constexpr (PH < N_PHASES) launch_all<PH + 1>(p, stream);
}
#else
__global__ void __launch_bounds__(NTHR, 2) k_mega(KArgs a) {
    Params p; make_params(p, a);
    extern __shared__ __attribute__((aligned(16))) char smem[];
    cg::grid_group grid = cg::this_grid();
    const int bid = blockIdx.x, nblk = gridDim.x;
    volatile LAS unsigned* st = (volatile LAS unsigned*)(smem + SMEM_BYTES);
    if (tidx() == 0) { st[0] = 0u; st[1] = 0u; }
    __syncthreads();
    const XcdBarrier xb = xcd_barrier_post(p.bar, st);
    run_phase(p, 0, bid, nblk, smem);
    if (a.ws == nullptr) grid.sync();
    xcd_barrier(xb);
    if (EXTRA == 4) { run_phase(p, 0, bid, nblk, smem); xcd_barrier(xb); }
#ifndef REPMASK
#define REPMASK 0u
#endif
#define PH(n) run_phase(p, n, bid, nblk, smem); xcd_barrier(xb); if ((REPMASK >> n) & 1u) { run_phase(p, n, bid, nblk, smem); xcd_barrier(xb); } \
    if (EXTRA == 6 && n == 6) { if (bid == 0 && tidx() == 0) p.counts[64] = 0; xcd_barrier(xb); run_phase(p, 6, bid, nblk, smem); xcd_barrier(xb); } \
    if (EXTRA == 5 && n == 9) { phase_router(p, bid, nblk, smem, 0, p.X1, NT, true); xcd_barrier(xb); } if (EXTRA == 5 && n == 17) { phase_router(p, bid, nblk, smem, 1, p.X1, NX, true); xcd_barrier(xb); }
    PH(1) PH(2) PH(3) PH(4) PH(5) PH(6) PH(7) PH(8) PH(9) PH(10) PH(11) PH(12) PH(13) PH(14) PH(15) PH(16) PH(17) PH(18) PH(19)
#undef PH
    final_phase(p, bid, nblk);
}
#endif


extern "C" void kernel_launch(void* const* d_in, const int* in_sizes, int n_in, void* d_out, int out_size, void* d_ws, size_t ws_size, hipStream_t stream) {
    KArgs a{};
    for (int i = 0; i < 35; ++i) a.in[i] = (const float*)d_in[i];
    a.out = (float*)d_out;
    a.ws = (char*)d_ws;
    Params p{};
    const size_t total = make_params(p, a);
    if (total > ws_size) { fprintf(stderr, "workspace too small: need %zu have %zu\n", total, ws_size); return; }

#if MULTI_LAUNCH
    launch_all<0>(a, stream);
#else
    static int grid_blocks = 0;
    if (!grid_blocks) {
        int dev = 0, cus = 0, per_cu = 0;
        hipGetDevice(&dev);
        hipDeviceGetAttribute(&cus, hipDeviceAttributeMultiprocessorCount, dev);
        hipFuncSetAttribute((const void*)k_mega, hipFuncAttributeMaxDynamicSharedMemorySize, SMEM_BYTES + 16);
        hipOccupancyMaxActiveBlocksPerMultiprocessor(&per_cu, k_mega, NTHR, SMEM_BYTES + 16);
        if (per_cu > 1) per_cu = 1;
        if (per_cu < 1) per_cu = 1;
        grid_blocks = cus * per_cu;
    }
    hipMemsetAsync(p.bar, 0, XCD_BAR_WORDS * 4, stream);
    void* args[] = {(void*)&a};
    hipError_t e = hipLaunchCooperativeKernel((void*)k_mega, dim3(grid_blocks), dim3(NTHR), args, SMEM_BYTES + 16, stream);
    if (e != hipSuccess) fprintf(stderr, "cooperative launch failed: %s (grid %d)\n", hipGetErrorString(e), grid_blocks);
#endif
}
```

```cpp
#include <hip/hip_runtime.h>
#include <hip/hip_cooperative_groups.h>
#include <stdint.h>
#include <stdio.h>

namespace cg = cooperative_groups;

typedef unsigned short bf16_t;
typedef short bf16x8 __attribute__((ext_vector_type(8)));
typedef float f32x4 __attribute__((ext_vector_type(4)));
typedef unsigned u32x4 __attribute__((ext_vector_type(4)));

#define NX 16384
#define NC 2048
#define NT 18432
#define DM 1024
#define SEQ 2048
#define CTXL 256
#define NKEY 2304
#define EVC 3328
#define ODC 5120
#define NEXP 32
#define NASG (NT * 4)
#ifndef EXTRA
#define EXTRA 0
#endif
#define NTHR 512
#define SMEM_BYTES 131072
#define HLDS 65536

#ifndef MULTI_LAUNCH
#define MULTI_LAUNCH 0
#endif

struct Params {
    const float *x, *c, *ctx, *c_ctx, *ada_w, *ada_b, *norm1_g, *norm2_g, *ev_w_in, *ev_w_out, *da_q_norm, *da_k_norm,
        *da_lambda, *da_subln, *rw_mu, *rw_w0, *rw_w2, *rw_a0, *rw_a2, *rw_g2, *rw_k_k, *rw_k_a, *rw_r_k, *rw_ln_w,
        *rw_ln_b, *od_w_in, *od_w_out, *hg_norm, *hg_lb, *router_w, *router_b, *moe_w_gu, *moe_b_gu, *moe_w_dn, *moe_b_dn;
    float* out;
    bf16_t *wt_evin, *wt_evout, *wt_odin, *wt_odout, *wt_gu, *wt_dn, *wt_w2, *wt_a2, *wt_g2;
    float *mod_part, *mod, *rope_cos, *rope_sin, *scal;
    int *counts, *lists;
    unsigned* bar;
    bf16_t* H;
    float* P;
    bf16_t *Q, *Qc, *Kd, *Vd;
    bf16_t *rR, *rK, *rV, *rKK, *rKD, *rBV, *rG;
    float *rW, *rY;
    bf16_t *rTW, *rAD, *rSG;
    bf16_t* MG;
    bf16_t *X1, *X2;
    float* GATE;
    bf16_t* ACT;
    bf16_t* YS;
    float* HO;
};

typedef float f32x2_ __attribute__((ext_vector_type(2)));
typedef __bf16 bf16x2_ __attribute__((ext_vector_type(2)));
__device__ __forceinline__ unsigned pack2(float a, float b) {
    const f32x2_ v = {a, b};
    return __builtin_bit_cast(unsigned, __builtin_convertvector(v, bf16x2_));
}
__device__ __forceinline__ bf16_t f2bf(float f) { return (bf16_t)(pack2(f, 0.f) & 0xffffu); }
__device__ __forceinline__ int tidx() { int t = __builtin_amdgcn_workitem_id_x(); asm volatile("" : "+v"(t)); return t; }
__device__ __forceinline__ int uni(int v) { return __builtin_amdgcn_readfirstlane(v); }
template <class T> __device__ __forceinline__ T* uni_ptr(T* ptr) {
    const unsigned long long v = (unsigned long long)ptr;
    const unsigned lo = (unsigned)__builtin_amdgcn_readfirstlane((int)(unsigned)v), hi = (unsigned)__builtin_amdgcn_readfirstlane((int)(unsigned)(v >> 32));
    return (T*)(((unsigned long long)hi << 32) | lo);
}
__device__ __forceinline__ float bf2f(bf16_t h) { return __uint_as_float(((unsigned)h) << 16); }
template <int CTRL, int ROWMASK> __device__ __forceinline__ float dpp_zero(float x) {
    return __int_as_float(__builtin_amdgcn_update_dpp(0, __float_as_int(x), CTRL, ROWMASK, 0xf, false));
}
__device__ __forceinline__ float wave_sum(float v) {
    v += dpp_zero<0xB1, 0xf>(v);
    v += dpp_zero<0x4E, 0xf>(v);
    v += dpp_zero<0x141, 0xf>(v);
    v += dpp_zero<0x140, 0xf>(v);
    v += dpp_zero<0x142, 0xa>(v);
    v += dpp_zero<0x143, 0xc>(v);
    return __int_as_float(__builtin_amdgcn_readlane(__float_as_int(v), 63));
}
template <int CTRL> __device__ __forceinline__ float dpp_f(float x) {
    return __int_as_float(__builtin_amdgcn_mov_dpp(__float_as_int(x), CTRL, 0xf, 0xf, true));
}
__device__ __forceinline__ float sum8(float x) {
    x += dpp_f<0xB1>(x);
    x += dpp_f<0x4E>(x);
    x += dpp_f<0x141>(x);
    return x;
}
__device__ __forceinline__ float sigmoidf_(float x) { return __builtin_amdgcn_rcpf(1.0f + __expf(-x)); }
__device__ __forceinline__ float siluf_(float x) { return x * __builtin_amdgcn_rcpf(1.0f + __expf(-x)); }
__device__ __forceinline__ int modrow(int tok) { return tok < NX ? (tok >> 11) : 8; }


#define XB_TMO      128
#define XB_XCNT(j)  (256  + 64 * (j))
#define XB_XSUB(j)  (1280 + 64 * (j))
#define XB_XGEN(j)  (2304 + 64 * (j))
#define XB_TOP      3328
#define XB_TOPGEN   3392
#define XCD_BAR_WORDS 3456
#define XB_SPIN_CAP (1u << 27)
#define LAS __attribute__((address_space(3)))
__device__ __forceinline__ unsigned xb_ld(unsigned* p)              { return __hip_atomic_load(p, __ATOMIC_RELAXED, __HIP_MEMORY_SCOPE_AGENT); }
__device__ __forceinline__ unsigned xb_add(unsigned* p, unsigned v) { return __hip_atomic_fetch_add(p, v, __ATOMIC_RELAXED, __HIP_MEMORY_SCOPE_AGENT); }
__device__ __forceinline__ unsigned xb_xcc_id() { return (unsigned)__builtin_amdgcn_s_getreg((3 << 11) | 20) & 0xFu; }
#define XB_SPIN(cond, bar) do { unsigned _sp = 0; while (cond) { __builtin_amdgcn_s_sleep(1); \
    if ((++_sp & 255u) == 0u) { if (xb_ld(&(bar)[XB_TMO])) break; if (_sp > XB_SPIN_CAP) { atomicAdd(&(bar)[XB_TMO], 1u); break; } } } } while (0)
struct XcdBarrier { unsigned* bar; unsigned x; volatile LAS unsigned* st; };
__device__ __forceinline__ XcdBarrier xcd_barrier_post(unsigned* bar, volatile LAS unsigned* st) {
    XcdBarrier b; b.bar = bar; b.x = xb_xcc_id(); b.st = st;
    if (tidx() == 0) (void)xb_add(&bar[XB_XCNT(b.x)], 1u);
    return b;
}
__device__ __forceinline__ void xcd_barrier_complete(unsigned* bar, unsigned x, unsigned& nloc, unsigned& nx) {
    const unsigned G = gridDim.x * gridDim.y * gridDim.z;
    unsigned sum, cnt, mine, sp = 0u;
    for (;;) {
        sum = 0u; cnt = 0u; mine = 0u;
#pragma unroll
        for (unsigned j = 0; j < 16; ++j) { const unsigned c = xb_ld(&bar[XB_XCNT(j)]); sum += c; cnt += (c > 0u) ? 1u : 0u; mine = (j == x) ? c : mine; }
        if (sum == G) break;
        __builtin_amdgcn_s_sleep(1);
        if ((++sp & 255u) == 0u) { if (xb_ld(&bar[XB_TMO])) break; if (sp > XB_SPIN_CAP) { atomicAdd(&bar[XB_TMO], 1u); break; } }
    }
    nloc = mine > 0u ? mine : 1u; nx = cnt > 0u ? cnt : 1u;
}
__device__ __forceinline__ void xcd_barrier(const XcdBarrier& b) {
    asm volatile("s_waitcnt vmcnt(0)" ::: "memory");
    __syncthreads();
    if (tidx() == 0) {
        unsigned* bar = b.bar;
        __builtin_amdgcn_s_waitcnt(0);
        unsigned nloc = b.st[0], nx = b.st[1];
        if (nloc == 0u) { xcd_barrier_complete(bar, b.x, nloc, nx); b.st[0] = nloc; b.st[1] = nx; }
        const unsigned old = xb_add(&bar[XB_XSUB(b.x)], 1u);
        const unsigned gen = old / nloc;
        if (old + 1u == (gen + 1u) * nloc) {
            __builtin_amdgcn_fence(__ATOMIC_RELEASE, "agent");
            asm volatile("s_waitcnt vmcnt(0)" ::: "memory");
            const unsigned og = xb_add(&bar[XB_TOP], 1u);
            const unsigned tg = og / nx;
            if (og + 1u == (tg + 1u) * nx) xb_add(&bar[XB_TOPGEN], 1u);
            else XB_SPIN(xb_ld(&bar[XB_TOPGEN]) == tg, bar);
            __builtin_amdgcn_fence(__ATOMIC_ACQUIRE, "agent");
            xb_add(&bar[XB_XGEN(b.x)], 1u);
            asm volatile("s_waitcnt vmcnt(0)" ::: "memory");
        } else {
            XB_SPIN(xb_ld(&bar[XB_XGEN(b.x)]) == gen, bar);
            __builtin_amdgcn_fence(__ATOMIC_ACQUIRE, "agent");
            asm volatile("s_waitcnt vmcnt(0)" ::: "memory");
        }
    }
    __syncthreads();
}


__device__ __forceinline__ int q_next(int* ctr, char* smem) {
    volatile unsigned* slot = (volatile unsigned*)(smem + SMEM_BYTES + 8);
    __syncthreads();
    if (tidx() == 0) *slot = (unsigned)atomicAdd(ctr, 1);
    __syncthreads();
    return (int)*slot;
}

struct ARows {
    const bf16_t* base;
    int lda;
    const int* idx;
    int shift;
    int row0;
};

template <bool PAIRED, class Epi>
__device__ __forceinline__ void gemm_tile(const ARows ar, int mcount, const bf16_t* __restrict__ Bt, int ldb, int K, Epi& epi, char* smem) {
    const int tid = tidx() & 255, lane = tid & 63, wid = tid >> 6;
    const int wr = wid >> 1, wc = wid & 1, fr = lane & 15, fq = lane >> 4;
    bf16_t* sA = (bf16_t*)smem;
    bf16_t* sB = sA + 128 * 64;
    const int lrow = tid >> 3, lch = tid & 7;
    const bf16_t* aptr[4];
    const bf16_t* bptr[4];
#pragma unroll
    for (int i = 0; i < 4; ++i) {
        const int r = lrow + 32 * i;
        const int rr = r < mcount ? r : 0;
        const int rowid = ar.idx ? (ar.idx[rr] >> ar.shift) : (ar.row0 + rr);
        aptr[i] = ar.base + (size_t)rowid * ar.lda + lch * 8;
        bptr[i] = Bt + (size_t)r * ldb + lch * 8;
    }
    u32x4 ra[4], rb[4];
#pragma unroll
    for (int i = 0; i < 4; ++i) { ra[i] = *(const u32x4*)(aptr[i]); rb[i] = *(const u32x4*)(bptr[i]); }
    f32x4 acc[4][4];
#pragma unroll
    for (int m = 0; m < 4; ++m)
#pragma unroll
        for (int n = 0; n < 4; ++n) acc[m][n] = (f32x4){0.f, 0.f, 0.f, 0.f};
    const int nk = K >> 6;
    for (int kt = 0; kt < nk; ++kt) {
#pragma unroll
        for (int i = 0; i < 4; ++i) {
            const int r = lrow + 32 * i;
            const int off = r * 64 + ((lch ^ (r & 7)) << 3);
            *(u32x4*)(sA + off) = ra[i];
            *(u32x4*)(sB + off) = rb[i];
        }
        __syncthreads();
        if (kt + 1 < nk) {
#pragma unroll
            for (int i = 0; i < 4; ++i) { ra[i] = *(const u32x4*)(aptr[i] + (kt + 1) * 64); rb[i] = *(const u32x4*)(bptr[i] + (kt + 1) * 64); }
        }
#pragma unroll
        for (int ks = 0; ks < 2; ++ks) {
            bf16x8 af[4], bfr[4];
            const int ch = ks * 4 + fq;
#pragma unroll
            for (int m = 0; m < 4; ++m) { const int r = wr * 64 + m * 16 + fr; af[m] = *(const bf16x8*)(sA + r * 64 + ((ch ^ (r & 7)) << 3)); }
#pragma unroll
            for (int n = 0; n < 4; ++n) { const int r = wc * 64 + n * 16 + fr; bfr[n] = *(const bf16x8*)(sB + r * 64 + ((ch ^ (r & 7)) << 3)); }
#pragma unroll
            for (int m = 0; m < 4; ++m)
#pragma unroll
                for (int n = 0; n < 4; ++n) acc[m][n] = __builtin_amdgcn_mfma_f32_16x16x32_bf16(bfr[n], af[m], acc[m][n], 0, 0, 0);
        }
        __syncthreads();
    }
#pragma unroll
    for (int m = 0; m < 4; ++m) {
        const int r = wr * 64 + m * 16 + fr;
        if (r < mcount) {
            if constexpr (PAIRED) {
                epi.pair(r, wc * 32 + fq * 4, acc[m][0], acc[m][1]);
                epi.pair(r, wc * 32 + 16 + fq * 4, acc[m][2], acc[m][3]);
            } else {
#pragma unroll
                for (int n = 0; n < 4; ++n) epi.one(r, wc * 64 + n * 16 + fq * 4, acc[m][n]);
            }
        }
    }
}


namespace g8 {
#define G8_LAS __attribute__((address_space(3)))
constexpr int BM = 256, BK = 64, HALF = 128, HTB = HALF * BK * 2;
__device__ __forceinline__ int lds_byte(int r, int c) { const int st = (r >> 4) * 2 + (c >> 5), rr = r & 15, cc = c & 31, ob = rr * 64 + cc * 2; return st * 1024 + (ob ^ (((ob >> 9) & 1) << 5)); }
__device__ __forceinline__ void stage_rc(int b, int& R, int& C) { const int st = b / 1024, sb = b % 1024, swz = sb ^ (((sb >> 9) & 1) << 5); R = (st >> 1) * 16 + swz / 64; C = (st & 1) * 32 + (swz % 64) / 2; }
struct Unit {
    const char* a;
    const char* b;
    const int* gidx;
    const int* idx;
    int shift, rows;
    int i0, i1, i2;
};
template <class Epi, class Sched>
__device__ __forceinline__ void gemm_phase(G8_LAS unsigned char* lds, const int K, Sched& S, const Epi& E) {
    const int tid = tidx(), wid = __builtin_amdgcn_readfirstlane(tid >> 6), lane = tid & 63, wr = wid >> 2, wc = wid & 3, fr = lane & 15, fq = lane >> 4;
    const int nt = K / BK;
    int sR[2], sC[2];
    unsigned voffB[2];
#pragma unroll
    for (int i = 0; i < 2; ++i) { stage_rc(tid * 16 + i * 8192, sR[i], sC[i]); voffB[i] = (unsigned)(sR[i] * K + sC[i]) * 2u; }
    const size_t kstep = (size_t)(BK * 2);
    const size_t hstep = (size_t)HALF * K * 2;
    const unsigned ldsw = (unsigned)wid * 1024u;
    const int aoff = lds_byte(wr * 64 + fr, fq * 8), boff = lds_byte(wc * 32 + fr, fq * 8);
    auto a_offsets = [&](const Unit& u, unsigned (&o)[2][2]) {
#pragma unroll
        for (int h = 0; h < 2; ++h)
#pragma unroll
            for (int i = 0; i < 2; ++i) {
                int r = sR[i] + h * HALF;
                if (u.gidx) { r = r < u.rows ? r : (u.rows - 1); r = u.gidx[r] >> u.shift; }
                o[h][i] = (unsigned)(r * K + sC[i]) * 2u;
            }
    };
#define G8_SA(b, h) (((b) * 2 + (h)) * HTB)
#define G8_SB(b, h) ((4 + (b) * 2 + (h)) * HTB)
#define G8_STAGE2(bufoff, gbase, o0, o1) do { \
        __builtin_amdgcn_global_load_lds((const unsigned*)((const char*)(gbase) + (o0)), (G8_LAS unsigned*)(lds + (bufoff) + ldsw), 16, 0, 0); \
        __builtin_amdgcn_global_load_lds((const unsigned*)((const char*)(gbase) + (o1)), (G8_LAS unsigned*)(lds + (bufoff) + ldsw + 8192), 16, 0, 0); } while (0)
#define G8_STAGE_B(bufoff, gbase) G8_STAGE2(bufoff, gbase, voffB[0], voffB[1])
#define G8_LDA(dst, b, h) do { _Pragma("unroll") for (int m = 0; m < 4; ++m) _Pragma("unroll") for (int k = 0; k < 2; ++k) dst[m][k] = *(const G8_LAS bf16x8*)(lds + G8_SA(b, h) + aoff + m * 2048 + k * 1024); } while (0)
#define G8_LDB(dst, b, h) do { _Pragma("unroll") for (int n = 0; n < 2; ++n) _Pragma("unroll") for (int k = 0; k < 2; ++k) dst[n][k] = *(const G8_LAS bf16x8*)(lds + G8_SB(b, h) + boff + n * 2048 + k * 1024); } while (0)
#define G8_MMA(ai, bj, At, Bt) do { __builtin_amdgcn_s_setprio(1); _Pragma("unroll") for (int m = 0; m < 4; ++m) _Pragma("unroll") for (int n = 0; n < 2; ++n) _Pragma("unroll") for (int k = 0; k < 2; ++k) \
        acc[ai][bj][m][n] = __builtin_amdgcn_mfma_f32_16x16x32_bf16(Bt[n][k], At[m][k], acc[ai][bj][m][n], 0, 0, 0); __builtin_amdgcn_s_setprio(0); } while (0)
#define G8_WAIT_V(n) asm volatile("s_waitcnt vmcnt(" #n ")" ::: "memory")
#define G8_WAIT_L(n) asm volatile("s_waitcnt lgkmcnt(" #n ")" ::: "memory")
#define G8_BAR __builtin_amdgcn_s_barrier()
#define G8_SCHED __builtin_amdgcn_sched_barrier(0)
    Unit cur, nxt;
    if (!S.next(cur)) return;
    unsigned oc[2][2], on[2][2];
    a_offsets(cur, oc);
    f32x4 acc[2][2][4][2];
#pragma unroll
    for (int a = 0; a < 2; ++a)
#pragma unroll
        for (int b = 0; b < 2; ++b)
#pragma unroll
            for (int m = 0; m < 4; ++m)
#pragma unroll
                for (int n = 0; n < 2; ++n) acc[a][b][m][n] = (f32x4){0.f, 0.f, 0.f, 0.f};
    bf16x8 At[4][2], B0[2][2], B1[2][2];
    const char* cA = cur.a; const char* cB = cur.b;
    G8_STAGE_B(G8_SB(0, 0), cB); G8_STAGE_B(G8_SB(0, 1), cB + hstep); G8_STAGE2(G8_SA(0, 0), cA, oc[0][0], oc[0][1]); G8_STAGE2(G8_SA(0, 1), cA, oc[1][0], oc[1][1]);
    if (wr == 1) G8_BAR;
    G8_WAIT_V(2); G8_BAR;
    G8_STAGE_B(G8_SB(1, 0), cB + kstep); G8_STAGE2(G8_SA(1, 0), cA + kstep, oc[0][0], oc[0][1]); G8_STAGE_B(G8_SB(1, 1), cB + hstep + kstep);
    G8_WAIT_V(6); G8_BAR;
    for (;;) {
        const bool has_next = S.next(nxt);
        if (has_next) a_offsets(nxt, on);
        else {
#pragma unroll
            for (int h = 0; h < 2; ++h) { on[h][0] = oc[h][0]; on[h][1] = oc[h][1]; }
        }
        const char* nA = has_next ? nxt.a : cA; const char* nB = has_next ? nxt.b : cB;
        for (int t = 0; t < nt; t += 2) {
            const bool last = (t == nt - 2);
            const char* a1 = cA + (size_t)(t + 1) * kstep;
            const char* a2 = last ? nA : cA + (size_t)(t + 2) * kstep; const char* b2 = last ? nB : cB + (size_t)(t + 2) * kstep;
            const char* a3 = a2 + kstep; const char* b3 = b2 + kstep;
            const unsigned p00 = last ? on[0][0] : oc[0][0], p01 = last ? on[0][1] : oc[0][1], p10 = last ? on[1][0] : oc[1][0], p11 = last ? on[1][1] : oc[1][1];
            G8_LDB(B0, 0, 0); G8_LDB(B1, 0, 1); G8_SCHED; G8_LDA(At, 0, 0); G8_STAGE2(G8_SA(1, 1), a1, oc[1][0], oc[1][1]);
            G8_WAIT_V(8); G8_WAIT_L(0); G8_BAR; G8_MMA(0, 0, At, B0); G8_MMA(0, 1, At, B1); G8_BAR; G8_SCHED;
            G8_LDA(At, 0, 1); G8_STAGE_B(G8_SB(0, 0), b2); G8_STAGE_B(G8_SB(0, 1), b2 + hstep); G8_STAGE2(G8_SA(0, 0), a2, p00, p01);
            G8_WAIT_V(8); G8_WAIT_L(0); G8_BAR; G8_MMA(1, 0, At, B0); G8_MMA(1, 1, At, B1); G8_BAR; G8_SCHED;
            G8_LDB(B0, 1, 0); G8_LDB(B1, 1, 1); G8_SCHED; G8_LDA(At, 1, 0); G8_STAGE2(G8_SA(0, 1), a2, p10, p11);
            G8_WAIT_V(8); G8_WAIT_L(0); G8_BAR; G8_MMA(0, 0, At, B0); G8_MMA(0, 1, At, B1); G8_BAR; G8_SCHED;
            G8_LDA(At, 1, 1); G8_STAGE_B(G8_SB(1, 0), b3); G8_STAGE_B(G8_SB(1, 1), b3 + hstep); G8_STAGE2(G8_SA(1, 0), a3, p00, p01);
            G8_WAIT_V(8); G8_WAIT_L(0); G8_BAR; G8_MMA(1, 0, At, B0); G8_MMA(1, 1, At, B1); G8_BAR; G8_SCHED;
        }
        if (wr == 0) G8_BAR;
        E(acc, cur, wr, wc, fr, fq);
        if (!has_next) break;
#pragma unroll
        for (int a = 0; a < 2; ++a)
#pragma unroll
            for (int b = 0; b < 2; ++b)
#pragma unroll
                for (int m = 0; m < 4; ++m)
#pragma unroll
                    for (int n = 0; n < 2; ++n) acc[a][b][m][n] = (f32x4){0.f, 0.f, 0.f, 0.f};
        cur = nxt; cA = nA; cB = nB;
#pragma unroll
        for (int h = 0; h < 2; ++h) { oc[h][0] = on[h][0]; oc[h][1] = on[h][1]; }
        if (wr == 1) G8_BAR;
    }
    G8_WAIT_V(0);
    G8_BAR;
#undef G8_SA
#undef G8_SB
#undef G8_STAGE2
#undef G8_STAGE_B
#undef G8_LDA
#undef G8_LDB
#undef G8_MMA
#undef G8_WAIT_V
#undef G8_WAIT_L
#undef G8_BAR
#undef G8_SCHED
}
}

__device__ __forceinline__ int gu_row(int col) {
    const int half = col >> 10, unit = col & 1023, T = unit >> 7, ul = unit & 127, wc = ul >> 5, r = ul & 31, fq = r >> 3, bj = (r >> 2) & 1, jj = r & 3;
    return 256 * T + 128 * bj + 32 * wc + 16 * half + 4 * fq + jj;
}
__device__ __forceinline__ int p32_row(int col) {
    const int x = col & 31;
    return (col & ~31) + 16 * ((x >> 2) & 1) + 4 * (x >> 3) + (x & 3);
}
struct ConvDesc { const float* src; bf16_t* dst; int N, Kd, kt, nt, perm, pad; };
struct ConvRegs { f32x4 v0, v1, v2, v3; };
__device__ __forceinline__ ConvRegs conv_load(const ConvDesc& d) {
    const int tid = tidx() & 255, r = tid >> 4, c4 = (tid & 15) * 4;
    ConvRegs x;
    const float* b0 = d.src + (size_t)(d.kt * 64 + r) * d.N + d.nt * 64 + c4;
    x.v0 = *(const f32x4*)(b0); x.v1 = *(const f32x4*)(b0 + (size_t)16 * d.N); x.v2 = *(const f32x4*)(b0 + (size_t)32 * d.N); x.v3 = *(const f32x4*)(b0 + (size_t)48 * d.N);
    return x;
}
__device__ __forceinline__ void conv_store(const ConvRegs& x, const ConvDesc& d, float* lds) {
    const int tid = tidx() & 255;
    {
        const int r = tid >> 4, c4 = (tid & 15) * 4;
        float* q = lds + r * 65 + c4;
        q[0] = x.v0[0]; q[1] = x.v0[1]; q[2] = x.v0[2]; q[3] = x.v0[3];
        q[16 * 65 + 0] = x.v1[0]; q[16 * 65 + 1] = x.v1[1]; q[16 * 65 + 2] = x.v1[2]; q[16 * 65 + 3] = x.v1[3];
        q[32 * 65 + 0] = x.v2[0]; q[32 * 65 + 1] = x.v2[1]; q[32 * 65 + 2] = x.v2[2]; q[32 * 65 + 3] = x.v2[3];
        q[48 * 65 + 0] = x.v3[0]; q[48 * 65 + 1] = x.v3[1]; q[48 * 65 + 2] = x.v3[2]; q[48 * 65 + 3] = x.v3[3];
    }
    __syncthreads();
    {
        const int n = tid >> 2, kseg = (tid & 3) * 16;
        unsigned w[8];
#pragma unroll
        for (int j = 0; j < 8; ++j) w[j] = pack2(lds[(kseg + 2 * j) * 65 + n], lds[(kseg + 2 * j + 1) * 65 + n]);
        const int ncol = d.nt * 64 + n;
        const int row = d.perm == 1 ? gu_row(ncol) : (d.perm == 2 ? p32_row(ncol) : (d.perm == 3 ? ((ncol >> 6) * 128 + (ncol & 63)) : ncol));
        uint4* q = (uint4*)(d.dst + (size_t)row * d.Kd + d.kt * 64 + kseg);
        q[0] = make_uint4(w[0], w[1], w[2], w[3]);
        q[1] = make_uint4(w[4], w[5], w[6], w[7]);
    }
    __syncthreads();
}
__device__ __forceinline__ void conv_tile(const float* __restrict__ src, int N, bf16_t* __restrict__ dst, int Kd, int kt, int nt, int perm, float* lds) {
    const ConvDesc d{src, dst, N, Kd, kt, nt, perm, 0};
    const ConvRegs x = conv_load(d);
    conv_store(x, d, lds);
}

#define CONV_GRP 8
#define N_MODP 768
#define CV0 832
#define CV1 (CV0 + 16)
#define CV2 (CV1 + 16)
#define CV3 (CV2 + 16)
#define CV4 (CV3 + 256)
#define N_CONV CV4
#define N_ROPE 64
#define N_P0A (N_MODP + N_CONV + N_ROPE + 2)

__device__ __forceinline__ void phase0a(const Params& p, int bid, int nblk, char* smem) {
    const int half = tidx() >> 8, tid = tidx() & 255;
    float* lds = (float*)(smem + half * HLDS);
    for (int it0 = bid * 2; it0 < N_P0A; it0 += nblk * 2) {
        const int it = it0 + half;
        if (it < N_MODP) {
            const int l = it / 384, rem = it % 384, cb = rem / 16, kc = rem % 16;
            for (int e = tid; e < 9 * 64; e += 256) {
                const int r = e >> 6, k = e & 63;
                const float v = (r < 8) ? p.c[r * DM + kc * 64 + k] : p.c_ctx[kc * 64 + k];
                lds[e] = siluf_(v);
            }
            __syncthreads();
            const int col = cb * 256 + tid;
            const float* w = p.ada_w + (size_t)l * DM * 6144 + (size_t)(kc * 64) * 6144 + col;
            float acc[9];
#pragma unroll
            for (int r = 0; r < 9; ++r) acc[r] = 0.f;
#pragma unroll 1
            for (int k0 = 0; k0 < 64; k0 += 16) {
                float wv[16];
#pragma unroll
                for (int k = 0; k < 16; ++k) wv[k] = w[(size_t)(k0 + k) * 6144];
#pragma unroll
                for (int k = 0; k < 16; ++k)
#pragma unroll
                    for (int r = 0; r < 9; ++r) acc[r] += lds[r * 64 + k0 + k] * wv[k];
            }
#pragma unroll
            for (int r = 0; r < 9; ++r) p.mod_part[((size_t)(kc * 2 + l) * 9 + r) * 6144 + col] = acc[r];
            __syncthreads();
        } else if (it < N_MODP + N_CONV) {
            const int j = it - N_MODP;
            if (j < CV0) { conv_tile(p.ev_w_in, EVC, p.wt_evin, 1024, j / 52, j % 52, 2, lds); }
            else if (j < CV1) { const int q = j - CV0, z = q >> 3, nt = q & 7; conv_tile(p.rw_w2 + (size_t)z * 64 * 512, 512, p.wt_w2 + (size_t)z * 512 * 64, 64, 0, nt, 0, lds); }
            else if (j < CV2) { const int q = j - CV1, z = q >> 3, nt = q & 7; conv_tile(p.rw_a2 + (size_t)z * 64 * 512, 512, p.wt_a2 + (size_t)z * 64 * 64, 64, 0, nt, 3, lds); }
            else if (j < CV3) { const int q = j - CV2, kt = q >> 3, nt = q & 7; conv_tile(p.rw_g2, 512, p.wt_g2, 128, kt, nt, 0, lds); }
            else { const int q = j - CV3; conv_tile(p.ev_w_out, 1024, p.wt_evout, 1024, q >> 4, q & 15, 2, lds); }
        } else if (it < N_MODP + N_CONV + N_ROPE) {
            const int j = it - N_MODP - N_CONV;
#pragma unroll
            for (int i = 0; i < 4; ++i) {
                const int e = (j * 4 + i) * 256 + tid;
                const int t = e >> 5, a = (e >> 4) & 1, pp = e & 15;
                const float pos = (float)(a == 0 ? (t >> 6) : (t & 63));
                const float inv = powf(10000.0f, -(float)pp / 16.0f);
                const float ang = pos * inv;
                p.rope_cos[e] = cosf(ang);
                p.rope_sin[e] = sinf(ang);
            }
        } else if (it == N_MODP + N_CONV + N_ROPE) {
            if (tid < 64) {
                const float* lf = p.da_lambda;
                float a = lf[tid] * lf[64 + tid], b = lf[128 + tid] * lf[192 + tid];
                a = wave_sum(a); b = wave_sum(b);
                if (tid == 0) p.scal[0] = expf(a) - expf(b) + 0.2f;
            }
            if (tid < 128) p.counts[tid] = 0;
        }
    }
}

__device__ __forceinline__ void phase0b(const Params& p, int bid, int nblk) {
    for (int e = bid * NTHR + tidx(); e < 2 * 9 * 6144; e += nblk * NTHR) {
        const int l = e / (9 * 6144), rem = e % (9 * 6144);
        float s = p.ada_b[l * 6144 + rem % 6144];
#pragma unroll
        for (int kc = 0; kc < 16; ++kc) s += p.mod_part[(size_t)(kc * 2 + l) * 9 * 6144 + rem];
        p.mod[e] = s;
    }
}

__device__ __forceinline__ void phase_norm(const Params& p, int bid, int nblk, const float* xs_lat, const float* xs_ctx, const float* gain, const float* modl, int sh_off, int ntok) {
    const int lane = tidx() & 63, wid = tidx() >> 6;
    for (int tok = bid * 8 + wid; tok < ntok; tok += nblk * 8) {
        const float* xr = tok < NX ? xs_lat + (size_t)tok * DM : xs_ctx + (size_t)(tok - NX) * DM;
        const float* mr = modl + modrow(tok) * 6144 + sh_off;
        float4 v[4];
        float ss = 0.f;
#pragma unroll
        for (int i = 0; i < 4; ++i) { v[i] = *(const float4*)(xr + lane * 4 + 256 * i); ss += v[i].x * v[i].x + v[i].y * v[i].y + v[i].z * v[i].z + v[i].w * v[i].w; }
        ss = wave_sum(ss);
        const float rstd = rsqrtf(ss * (1.0f / 1024.0f) + 1e-6f);
#pragma unroll
        for (int i = 0; i < 4; ++i) {
            const int c = lane * 4 + 256 * i;
            const float4 g = *(const float4*)(gain + c), sh = *(const float4*)(mr + c), sc = *(const float4*)(mr + 1024 + c);
            const float a0 = v[i].x * rstd * g.x * (1.f + sc.x) + sh.x, a1 = v[i].y * rstd * g.y * (1.f + sc.y) + sh.y;
            const float a2 = v[i].z * rstd * g.z * (1.f + sc.z) + sh.z, a3 = v[i].w * rstd * g.w * (1.f + sc.w) + sh.w;
            *(uint2*)(p.H + (size_t)tok * DM + c) = make_uint2(pack2(a0, a1), pack2(a2, a3));
        }
    }
}

struct EpiStoreF32 {
    float* C; int ldc; int row0; int col0;
    __device__ __forceinline__ void one(int r, int c, f32x4 v) const { *(f32x4*)(C + (size_t)(row0 + r) * ldc + col0 + c) = v; }
};


struct TileIter {
    int mg0, mcnt, ntn, total, full, i, step;
    __device__ __forceinline__ void init(int MT, int NTN, int bid, int nblk) {
        const int g = bid & 7, lb = (bid >> 3) * 2 + (tidx() >> 8), nb = (nblk >> 3) * 2;
        mg0 = (MT * g) >> 3; mcnt = ((MT * (g + 1)) >> 3) - mg0; ntn = NTN; total = mcnt * NTN; full = mcnt >> 3; i = lb; step = nb;
    }
    __device__ __forceinline__ bool next(int& mt, int& nt) {
        if (i >= total) return false;
        const int band = 8 * ntn;
        if (i < full * band) { const int ms = i / band, r = i - ms * band; nt = r >> 3; mt = mg0 + ms * 8 + (r & 7); }
        else { const int rem = mcnt - full * 8, j = i - full * band; nt = j / rem; mt = mg0 + full * 8 + (j - nt * rem); }
        i += step;
        return true;
    }
};
__device__ __forceinline__ void phase_gemm_store(const bf16_t* A, int M, const bf16_t* Wt, int N, int K, float* C, int bid, int nblk, char* smem) {
    TileIter ti; ti.init(M / 128, N / 128, bid, nblk);
    char* hs = smem + (tidx() >> 8) * HLDS;
    for (;;) {
        int mt = 0, nt = 0;
        const bool v = ti.next(mt, nt);
        if (!__syncthreads_or(v ? 1 : 0)) break;
        if (!v) { mt = 0; nt = 0; }
        ARows ar{A, K, nullptr, 0, mt * 128};
        EpiStoreF32 epi{C, N, mt * 128, nt * 128};
        gemm_tile<false>(ar, v ? 128 : 0, Wt + (size_t)nt * 128 * K, K, K, epi, hs);
    }
}

struct EpiResid {
    const float* xin_lat; const float* xin_ctx; float* xout; const float* gmod; int row0; int col0;
    __device__ __forceinline__ void one(int r, int c, f32x4 v) const {
        const int tok = row0 + r, cc = col0 + c;
        const float* xr = tok < NX ? xin_lat + (size_t)tok * DM : xin_ctx + (size_t)(tok - NX) * DM;
        const f32x4 xi = *(const f32x4*)(xr + cc);
        const f32x4 g = *(const f32x4*)(gmod + modrow(tok) * 6144 + cc);
        *(f32x4*)(xout + (size_t)tok * DM + cc) = xi + g * v;
    }
};
__device__ __forceinline__ void phase_outproj(const Params& p, int bid, int nblk, char* smem, const bf16_t* Wt, int ntok, const float* xin_lat, const float* xin_ctx, float* xout, const float* gmod) {
    TileIter ti; ti.init(ntok / 128, 8, bid, nblk);
    char* hs = smem + (tidx() >> 8) * HLDS;
    for (;;) {
        int mt = 0, nt = 0;
        const bool v = ti.next(mt, nt);
        if (!__syncthreads_or(v ? 1 : 0)) break;
        if (!v) { mt = 0; nt = 0; }
        ARows ar{p.MG, DM, nullptr, 0, mt * 128};
        EpiResid epi{xin_lat, xin_ctx, xout, gmod, mt * 128, nt * 128};
        gemm_tile<false>(ar, v ? 128 : 0, Wt + (size_t)nt * 128 * DM, DM, DM, epi, hs);
    }
}

__device__ __forceinline__ void unpack8(const u32x4 w, float (&v)[8]) {
#pragma unroll
    for (int i = 0; i < 4; ++i) { v[2 * i] = __uint_as_float(w[i] << 16); v[2 * i + 1] = __uint_as_float(w[i] & 0xffff0000u); }
}
__device__ __forceinline__ u32x4 pack8f(const float (&v)[8]) { return (u32x4){pack2(v[0], v[1]), pack2(v[2], v[3]), pack2(v[4], v[5]), pack2(v[6], v[7])}; }
__device__ __forceinline__ void phase_feat0(const Params& p, int bid, int nblk, char* smem) {
    const int lane = tidx() & 63, wid = tidx() >> 6;
    const bf16_t* P16 = (const bf16_t*)p.P;
    const int l7 = lane & 7, g = lane >> 3;
    for (int tok = bid * 8 + wid; tok < NT; tok += nblk * 8) {
        const bool lat = tok < NX;
        const int b = lat ? (tok >> 11) : ((tok - NX) >> 8);
        const int t = lat ? (tok & 2047) : ((tok - NX) & 255);
        const int key = lat ? (CTXL + t) : t;
        const bf16_t* pr = P16 + (size_t)tok * EVC;
        {
            float cs[8], sn[8];
            if (lat) {
                const int a = l7 >> 2, ro = t * 32 + a * 16 + (l7 & 1) * 8;
                const f32x4 c0 = *(const f32x4*)(p.rope_cos + ro), c1 = *(const f32x4*)(p.rope_cos + ro + 4), s0 = *(const f32x4*)(p.rope_sin + ro), s1 = *(const f32x4*)(p.rope_sin + ro + 4);
#pragma unroll
                for (int j = 0; j < 4; ++j) { cs[j] = c0[j]; cs[4 + j] = c1[j]; sn[j] = s0[j]; sn[4 + j] = s1[j]; }
            }
            const bool hf = (l7 >> 1) & 1;
#pragma unroll
            for (int qk = 0; qk < 2; ++qk) {
                float v[8];
                unpack8(*(const u32x4*)(pr + qk * 512 + lane * 8), v);
                const float* nw = (qk == 0 ? p.da_q_norm : p.da_k_norm) + l7 * 8;
                const f32x4 n0 = *(const f32x4*)nw, n1 = *(const f32x4*)(nw + 4);
                float ss = 0.f;
#pragma unroll
                for (int j = 0; j < 8; ++j) ss += v[j] * v[j];
                ss = sum8(ss);
                const float rstd = rsqrtf(ss * (1.0f / 64.0f) + 1e-6f) * (qk == 0 ? 0.125f * 1.4426950408889634f : 1.0f);
#pragma unroll
                for (int j = 0; j < 8; ++j) v[j] = v[j] * rstd * (j < 4 ? n0[j] : n1[j - 4]);
                if (lat) {
#pragma unroll
                    for (int j = 0; j < 8; ++j) {
                        const float o = dpp_f<0x4E>(v[j]);
                        v[j] = hf ? (v[j] * cs[j] + o * sn[j]) : (v[j] * cs[j] - o * sn[j]);
                    }
                }
                const u32x4 w = pack8f(v);
                if (qk == 0) {
                    if (lat) *(u32x4*)(p.Q + (((size_t)b * 8 + g) * SEQ + t) * 64 + l7 * 8) = w;
                    else *(u32x4*)(p.Qc + (((size_t)b * 8 + g) * CTXL + t) * 64 + l7 * 8) = w;
                } else *(u32x4*)(p.Kd + (((size_t)b * 8 + g) * NKEY + key) * 64 + l7 * 8) = w;
            }
        }
        const int slen = lat ? SEQ : CTXL;
        const bool hasp = t > 0, hasn = t < slen - 1;
        const bf16_t* pw = pr + 1536;
        auto shifted = [&](int c0, float (&y)[8]) {
            float pv[8], nv[8];
            unpack8(*(const u32x4*)(pw + c0), y);
            if (hasp) unpack8(*(const u32x4*)(pw + c0 - EVC), pv); else {
#pragma unroll
                for (int j = 0; j < 8; ++j) pv[j] = 0.f; }
            if (hasn) unpack8(*(const u32x4*)(pw + c0 + EVC), nv); else {
#pragma unroll
                for (int j = 0; j < 8; ++j) nv[j] = 0.f; }
            const f32x4 m0 = *(const f32x4*)(p.rw_mu + c0), m1 = *(const f32x4*)(p.rw_mu + c0 + 4);
#pragma unroll
            for (int j = 0; j < 8; ++j) y[j] = y[j] + (j < 4 ? m0[j] : m1[j - 4]) * (0.5f * (pv[j] + nv[j]) - y[j]);
        };
        {
            float y[8];
            shifted(lane * 8, y);
            *(u32x4*)(p.rR + (size_t)tok * 512 + lane * 8) = pack8f(y);
        }
        {
            float y[8];
            shifted(512 + lane * 8, y);
            *(u32x4*)(p.rK + (size_t)tok * 512 + lane * 8) = pack8f(y);
            const f32x4 k0 = *(const f32x4*)(p.rw_k_k + lane * 8), k1 = *(const f32x4*)(p.rw_k_k + lane * 8 + 4);
            float ss = 0.f;
#pragma unroll
            for (int j = 0; j < 8; ++j) { y[j] *= (j < 4 ? k0[j] : k1[j - 4]); ss += y[j] * y[j]; }
            const float inv = 1.0f / fmaxf(sqrtf(sum8(ss)), 1e-12f);
#pragma unroll
            for (int j = 0; j < 8; ++j) y[j] *= inv;
            *(u32x4*)(p.rKK + (size_t)tok * 512 + lane * 8) = pack8f(y);
        }
        {
            float y[8];
            shifted(1024 + lane * 8, y);
            *(u32x4*)(p.rV + (size_t)tok * 512 + lane * 8) = pack8f(y);
        }
        if (lane < 32) {
            float y[8];
            shifted(1536 + lane * 8, y);
            if (lane < 8) {
#pragma unroll
                for (int j = 0; j < 8; ++j) y[j] = tanhf(y[j]);
                *(u32x4*)(p.rTW + (size_t)tok * 64 + lane * 8) = pack8f(y);
            } else if (lane < 16) {
                *(u32x4*)(p.rAD + (size_t)tok * 64 + (lane - 8) * 8) = pack8f(y);
            } else {
#pragma unroll
                for (int j = 0; j < 8; ++j) y[j] = sigmoidf_(y[j]);
                *(u32x4*)(p.rSG + (size_t)tok * 128 + (lane - 16) * 8) = pack8f(y);
            }
        }
    }
    {
        const int half = tidx() >> 8, tid = tidx() & 255;
        float* lds = (float*)(smem + half * HLDS);
        for (int it = bid * 2 + half; it < 8 * 36 * 4; it += nblk * 2) {
            const int b = it / 144, rem = it % 144, kt = rem >> 2, h = rem & 3;
            __syncthreads();
#pragma unroll
            for (int i = 0; i < 8; ++i) {
                const int e = i * 256 + tid, key = e >> 5, c4 = (e & 31) * 4;
                const int kg = kt * 64 + key;
                const int tok = kg < CTXL ? NX + b * CTXL + kg : b * SEQ + (kg - CTXL);
                const uint2 v = *(const uint2*)((const bf16_t*)p.P + (size_t)tok * EVC + 1024 + h * 128 + c4);
                float* d = lds + key * 129 + c4;
                d[0] = __uint_as_float(v.x << 16); d[1] = __uint_as_float(v.x & 0xffff0000u); d[2] = __uint_as_float(v.y << 16); d[3] = __uint_as_float(v.y & 0xffff0000u);
            }
            __syncthreads();
            {
                const int dv = tid >> 1, half = tid & 1;
                unsigned w[16];
#pragma unroll
                for (int j = 0; j < 16; ++j) { const int q = 2 * j, key = 16 * ((q >> 2) & 1) + 4 * (q >> 3) + (q & 3);
                    w[j] = pack2(lds[(half * 32 + key) * 129 + dv], lds[(half * 32 + key + 1) * 129 + dv]); }
                u32x4* dst = (u32x4*)(p.Vd + (((size_t)b * 4 + h) * 128 + dv) * NKEY + kt * 64 + half * 32);
#pragma unroll
                for (int j = 0; j < 4; ++j) dst[j] = (u32x4){w[4 * j], w[4 * j + 1], w[4 * j + 2], w[4 * j + 3]};
            }
        }
    }
}

struct EpiDecay {
    const float* w0; float* W; int row0; int col0;
    __device__ __forceinline__ void one(int r, int c, f32x4 v) const {
        const int tok = row0 + r, cc = col0 + c, z = cc >> 9, ch = cc & 511;
        f32x4 o;
        const f32x4 w0v = *(const f32x4*)(w0 + z * 512 + ch);
#pragma unroll
        for (int j = 0; j < 4; ++j) {
            const float x = w0v[j] + v[j];
            const float u = -x;
            const float sp = fmaxf(u, 0.f) + __logf(1.0f + __expf(-fabsf(u)));
            const float wlog = -sp - 0.5f;
            o[j] = __expf(-__expf(wlog));
        }
        *(f32x4*)(W + ((size_t)z * NT + tok) * 512 + ch) = o;
    }
};
struct EpiStoreBf16 {
    bf16_t* C; int ldc; int row0; int col0;
    __device__ __forceinline__ void one(int r, int c, f32x4 v) const { *(uint2*)(C + (size_t)(row0 + r) * ldc + col0 + c) = make_uint2(pack2(v[0], v[1]), pack2(v[2], v[3])); }
};
struct EpiArate {
    const float* a0; const float* k_a; const bf16_t* rK; const bf16_t* rKK; bf16_t* KD; bf16_t* BV; int row0; int col0;
    __device__ __forceinline__ void one(int r, int c, f32x4 v) const {
        const int tok = row0 + r, z = (c >> 6) & 1, ch = (col0 >> 1) + (c & 63);
        const uint2 ku = *(const uint2*)(rK + (size_t)tok * 512 + ch), kku = *(const uint2*)(rKK + (size_t)tok * 512 + ch);
        const f32x4 k = (f32x4){__uint_as_float(ku.x << 16), __uint_as_float(ku.x & 0xffff0000u), __uint_as_float(ku.y << 16), __uint_as_float(ku.y & 0xffff0000u)};
        const f32x4 kk = (f32x4){__uint_as_float(kku.x << 16), __uint_as_float(kku.x & 0xffff0000u), __uint_as_float(kku.y << 16), __uint_as_float(kku.y & 0xffff0000u)};
        f32x4 kd, bv;
        const f32x4 a0v = *(const f32x4*)(a0 + z * 512 + ch), kav = *(const f32x4*)(k_a + ch);
#pragma unroll
        for (int j = 0; j < 4; ++j) {
            const float arate = sigmoidf_(a0v[j] + v[j]);
            kd[j] = k[j] * (1.f + (arate - 1.f) * kav[j]);
            bv[j] = kk[j] * arate;
        }
        *(uint2*)(KD + ((size_t)z * NT + tok) * 512 + ch) = make_uint2(pack2(kd[0], kd[1]), pack2(kd[2], kd[3]));
        *(uint2*)(BV + ((size_t)z * NT + tok) * 512 + ch) = make_uint2(pack2(bv[0], bv[1]), pack2(bv[2], bv[3]));
    }
};
__device__ __forceinline__ void phase_lora(const Params& p, int bid, int nblk, char* smem) {
    const int half = tidx() >> 8;
    char* hs = smem + half * HLDS;
    for (int it0 = bid * 2; it0 < 144 * 20; it0 += nblk * 2) {
        const int it = it0 + half;
        if (it < 1152) {
            const int mt = it >> 3, q = it & 7;
            ARows ar{p.rTW, 64, nullptr, 0, mt * 128};
            EpiDecay epi{p.rw_w0, p.rW, mt * 128, q * 128};
            gemm_tile<false>(ar, 128, p.wt_w2 + (size_t)q * 128 * 64, 64, 64, epi, hs);
        } else if (it < 2304) {
            const int j = it - 1152, mt = j >> 3, q = j & 7;
            ARows ar{p.rAD, 64, nullptr, 0, mt * 128};
            EpiArate epi{p.rw_a0, p.rw_k_a, p.rK, p.rKK, p.rKD, p.rBV, mt * 128, q * 128};
            gemm_tile<false>(ar, 128, p.wt_a2 + (size_t)q * 128 * 64, 64, 64, epi, hs);
        } else {
            const int j = it - 2304, mt = j >> 2, q = j & 3;
            ARows ar{p.rSG, 128, nullptr, 0, mt * 128};
            EpiStoreBf16 epi{p.rG, 512, mt * 128, q * 128};
            gemm_tile<false>(ar, 128, p.wt_g2 + (size_t)q * 128 * 128, 128, 128, epi, hs);
        }
    }
}

__device__ __forceinline__ int scan_tok(int z, int b, int s) {
    if (s < CTXL) { const int tc = z == 0 ? s : (CTXL - 1 - s); return NX + b * CTXL + tc; }
    const int t = s - CTXL; return b * SEQ + (z == 0 ? t : (SEQ - 1 - t));
}
typedef float f32x2 __attribute__((ext_vector_type(2)));
__device__ __forceinline__ bf16x8 cvt8(const f32x4 a, const f32x4 b) {
    union { bf16x8 v; unsigned u[4]; } r;
    r.u[0] = pack2(a[0], a[1]); r.u[1] = pack2(a[2], a[3]); r.u[2] = pack2(b[0], b[1]); r.u[3] = pack2(b[2], b[3]);
    return r.v;
}
__device__ __forceinline__ void rwkv_chunk_chain(const Params& p, int chain, char* smem) {
    const int z = chain >> 6, b = (chain >> 3) & 7, h = chain & 7;
    const int tid = tidx(), lane = tid & 63, fr = lane & 15, fq = lane >> 4;
    const int wv_ = __builtin_amdgcn_readfirstlane(tid >> 6);
    bf16_t* AR = (bf16_t*)(smem + 43008);
    bf16_t* BK = (bf16_t*)(smem + 47104);
    bf16_t* BKT = (bf16_t*)(smem + 51200);
    bf16_t* VT = (bf16_t*)(smem + 55296);
    bf16_t* SB = (bf16_t*)(smem + 59392);
    float* AM = (float*)(smem + 67584);
    float* RH = (float*)(smem + 71680);
    float* GC = (float*)(smem + 75776);
    f32x4 S0 = (f32x4){0.f, 0.f, 0.f, 0.f}, S1 = S0;
    for (int i = tid; i < 2048; i += NTHR) ((unsigned*)SB)[i] = 0u;
    const size_t zoff = (size_t)z * NT * 512;
    const char* src1; const char* src2 = nullptr; unsigned dst1, dst2 = 0; int st1, st2 = 0;
    if (wv_ < 4) { src1 = (const char*)(p.rW + zoff + h * 64 + (lane & 15) * 4); st1 = 4 * wv_ + (lane >> 4); dst1 = wv_ * 1024; }
    else if (wv_ < 6) { src1 = (const char*)(p.rR + h * 64 + (lane & 7) * 8); st1 = 8 * (wv_ - 4) + (lane >> 3); dst1 = 4096 + (wv_ - 4) * 1024; }
    else { src1 = (const char*)(p.rKD + zoff + h * 64 + (lane & 7) * 8); st1 = 8 * (wv_ - 6) + (lane >> 3); dst1 = 6144 + (wv_ - 6) * 1024; }
    if (wv_ < 2) { src2 = (const char*)(p.rKK + h * 64 + (lane & 7) * 8); st2 = 8 * wv_ + (lane >> 3); dst2 = 8192 + wv_ * 1024; }
    else if (wv_ < 4) { src2 = (const char*)(p.rBV + zoff + h * 64 + (lane & 7) * 8); st2 = 8 * (wv_ - 2) + (lane >> 3); dst2 = 10240 + (wv_ - 2) * 1024; }
    else if (wv_ < 6) { src2 = (const char*)(p.rV + h * 64 + (lane & 7) * 8); st2 = 8 * (wv_ - 4) + (lane >> 3); dst2 = 12288 + (wv_ - 4) * 1024; }
    const int esz1 = wv_ < 4 ? 4 : 2;
    auto issue = [&](int chunk) {
        char* bb = smem + (chunk % 3) * 14336;
        const int tok1 = scan_tok(z, b, chunk * 16 + st1);
        __builtin_amdgcn_global_load_lds((const unsigned*)(src1 + (size_t)tok1 * 512 * esz1), (__attribute__((address_space(3))) unsigned*)(bb + dst1), 16, 0, 0);
        if (wv_ < 6) {
            const int tok2 = scan_tok(z, b, chunk * 16 + st2);
            __builtin_amdgcn_global_load_lds((const unsigned*)(src2 + (size_t)tok2 * 512 * 2), (__attribute__((address_space(3))) unsigned*)(bb + dst2), 16, 0, 0);
        }
    };
    issue(0); issue(1);
    const int ch = lane, t0 = 2 * wv_, t1 = t0 + 1;
    const int tokdir = z == 0 ? 1 : -1;
    for (int chunk = 0; chunk < 144; ++chunk) {
        if (chunk + 1 < 144) { if (wv_ < 6) asm volatile("s_waitcnt vmcnt(2)" ::: "memory"); else asm volatile("s_waitcnt vmcnt(1)" ::: "memory"); }
        else asm volatile("s_waitcnt vmcnt(0)" ::: "memory");
        __syncthreads();
        if (chunk + 2 < 144) issue(chunk + 2);
        const float* cbw = (const float*)(smem + (chunk % 3) * 14336);
        const bf16_t* cb = (const bf16_t*)(smem + (chunk % 3) * 14336 + 4096);
        const float w0 = cbw[t0 * 64 + ch], w1 = cbw[t1 * 64 + ch];
        {
            float gb = 1.f, gall = 1.f;
#pragma unroll
            for (int t = 0; t < 16; ++t) { const float wt = cbw[t * 64 + ch]; gall *= wt; if (t < t0) gb *= wt; }
            const float gt0 = gb * w0, gt1 = gt0 * w1;
            const float ig0 = __builtin_amdgcn_rcpf(gt0), ig1 = __builtin_amdgcn_rcpf(gt1);
            const float a0 = -gb * bf2f(cb[2048 + t0 * 64 + ch]), a1 = -gt0 * bf2f(cb[2048 + t1 * 64 + ch]);
            const float r0 = gt0 * bf2f(cb[t0 * 64 + ch]), r1 = gt1 * bf2f(cb[t1 * 64 + ch]);
            const float b0 = bf2f(cb[3072 + t0 * 64 + ch]) * ig0, b1 = bf2f(cb[3072 + t1 * 64 + ch]) * ig1;
            const float k0 = bf2f(cb[1024 + t0 * 64 + ch]) * ig0, k1 = bf2f(cb[1024 + t1 * 64 + ch]) * ig1;
            const float v0 = bf2f(cb[4096 + t0 * 64 + ch]), v1 = bf2f(cb[4096 + t1 * 64 + ch]);
            const int cc = ch >> 3, cw = ch & 7;
            AR[t0 * 64 + ((cc ^ (t0 & 7)) << 3) + cw] = f2bf(a0);
            AR[t1 * 64 + ((cc ^ (t1 & 7)) << 3) + cw] = f2bf(a1);
            AR[(16 + t0) * 64 + ((cc ^ (t0 & 7)) << 3) + cw] = f2bf(r0);
            AR[(16 + t1) * 64 + ((cc ^ (t1 & 7)) << 3) + cw] = f2bf(r1);
            BK[t0 * 64 + ((cc ^ (t0 & 7)) << 3) + cw] = f2bf(b0);
            BK[t1 * 64 + ((cc ^ (t1 & 7)) << 3) + cw] = f2bf(b1);
            BK[(16 + t0) * 64 + ((cc ^ (t0 & 7)) << 3) + cw] = f2bf(k0);
            BK[(16 + t1) * 64 + ((cc ^ (t1 & 7)) << 3) + cw] = f2bf(k1);
            const int sw = (ch >> 2) & 3;
            *(unsigned*)(BKT + ch * 32 + (((t0 >> 3) ^ sw) << 3) + (t0 & 7)) = pack2(b0, b1);
            *(unsigned*)(BKT + ch * 32 + ((((16 + t0) >> 3) ^ sw) << 3) + (t0 & 7)) = pack2(k0, k1);
            *(unsigned*)(VT + ch * 32 + ((((16 + t0) >> 3) ^ sw) << 3) + (t0 & 7)) = pack2(v0, v1);
            if (wv_ == 0) GC[ch] = gall;
        }
        __syncthreads();
        f32x4 G2 = (f32x4){0.f, 0.f, 0.f, 0.f};
        {
            const int rb = wv_ >> 2, vb = wv_ & 3;
            const int ra = 16 * rb + fr, rs = 16 * vb + fr;
#pragma unroll
            for (int ks = 0; ks < 2; ++ks) {
                const int c = ks * 4 + fq;
                const bf16x8 af = *(const bf16x8*)(AR + ra * 64 + ((c ^ (ra & 7)) << 3));
                const bf16x8 sf = *(const bf16x8*)(SB + rs * 64 + ((c ^ (rs & 7)) << 3));
                G2 = __builtin_amdgcn_mfma_f32_16x16x32_bf16(af, sf, G2, 0, 0, 0);
            }
        }
        if (wv_ < 4) {
            const int rb = wv_ >> 1, cbk = wv_ & 1;
            const int ra = 16 * rb + fr, rk = 16 * cbk + fr;
            f32x4 G1 = (f32x4){0.f, 0.f, 0.f, 0.f};
#pragma unroll
            for (int ks = 0; ks < 2; ++ks) {
                const int c = ks * 4 + fq;
                const bf16x8 af = *(const bf16x8*)(AR + ra * 64 + ((c ^ (ra & 7)) << 3));
                const bf16x8 bf = *(const bf16x8*)(BK + rk * 64 + ((c ^ (rk & 7)) << 3));
                G1 = __builtin_amdgcn_mfma_f32_16x16x32_bf16(af, bf, G1, 0, 0, 0);
            }
            if (wv_ == 0) {
                f32x4 m;
#pragma unroll
                for (int j = 0; j < 4; ++j) m[j] = (fr < 4 * fq + j) ? G1[j] : 0.f;
                *(f32x4*)(AM + fr * 16 + 4 * fq) = m;
            } else {
#pragma unroll
                for (int j = 0; j < 4; ++j) {
                    const int t = 4 * fq + j;
                    const bool keep = rb == 0 ? (fr < t) : (fr <= t);
                    AM[wv_ * 256 + t * 16 + fr] = keep ? G1[j] : 0.f;
                }
            }
        }
        __syncthreads();
        if (wv_ < 4) {
            union { bf16x8 v; unsigned u[4]; } af;
            if (fq < 2) {
                const f32x4 x0 = *(const f32x4*)(AM + 256 + fr * 16 + 8 * fq), x1 = *(const f32x4*)(AM + 256 + fr * 16 + 8 * fq + 4);
                af.v = cvt8(x0, x1);
            } else { af.u[0] = 0u; af.u[1] = 0u; af.u[2] = 0u; af.u[3] = 0u; }
            const int rv = 16 * wv_ + fr;
            const bf16x8 vf = *(const bf16x8*)(VT + rv * 32 + (((2 + (fq & 1)) ^ ((rv >> 2) & 3)) << 3));
            G2 = __builtin_amdgcn_mfma_f32_16x16x32_bf16(af.v, vf, G2, 0, 0, 0);
#pragma unroll
            for (int j = 0; j < 4; ++j) RH[(4 * fq + j) * 64 + rv] = G2[j];
        }
        __syncthreads();
        if (wv_ == 0) {
            float x[16];
#pragma unroll
            for (int t = 0; t < 16; ++t) x[t] = RH[t * 64 + lane];
#pragma unroll
            for (int i = 0; i < 15; ++i) {
                const float xi = x[i];
#pragma unroll
                for (int q = 0; q < 4; ++q) {
                    if (4 * q + 3 > i) {
                        const f32x4 acol = *(const f32x4*)(AM + i * 16 + 4 * q);
#pragma unroll
                        for (int j = 0; j < 4; ++j) if (4 * q + j > i) x[4 * q + j] += acol[j] * xi;
                    }
                }
            }
            const int sw = (lane >> 2) & 3;
            *(u32x4*)(VT + lane * 32 + ((0 ^ sw) << 3)) = (u32x4){pack2(x[0], x[1]), pack2(x[2], x[3]), pack2(x[4], x[5]), pack2(x[6], x[7])};
            *(u32x4*)(VT + lane * 32 + ((1 ^ sw) << 3)) = (u32x4){pack2(x[8], x[9]), pack2(x[10], x[11]), pack2(x[12], x[13]), pack2(x[14], x[15])};
        }
        __syncthreads();
        if (wv_ >= 4) {
            const int vb = wv_ & 3, rv = 16 * vb + fr;
            const float* am = AM + (fq < 2 ? 512 : 768) + fr * 16 + 8 * (fq & 1);
            const bf16x8 af = cvt8(*(const f32x4*)am, *(const f32x4*)(am + 4));
            const bf16x8 vf = *(const bf16x8*)(VT + rv * 32 + ((fq ^ ((rv >> 2) & 3)) << 3));
            G2 = __builtin_amdgcn_mfma_f32_16x16x32_bf16(af, vf, G2, 0, 0, 0);
            const int tokbase = scan_tok(z, b, chunk * 16);
#pragma unroll
            for (int j = 0; j < 4; ++j) p.rY[zoff + (size_t)(tokbase + tokdir * (4 * fq + j)) * 512 + h * 64 + rv] = G2[j];
        }
        {
            const int vb = wv_ >> 1, kb0 = 2 * (wv_ & 1);
            const int rv = 16 * vb + fr;
            const bf16x8 uf = *(const bf16x8*)(VT + rv * 32 + ((fq ^ ((rv >> 2) & 3)) << 3));
            const int rk0 = 16 * kb0 + fr, rk1 = rk0 + 16;
            const bf16x8 b0 = *(const bf16x8*)(BKT + rk0 * 32 + ((fq ^ ((rk0 >> 2) & 3)) << 3));
            const bf16x8 b1 = *(const bf16x8*)(BKT + rk1 * 32 + ((fq ^ ((rk1 >> 2) & 3)) << 3));
            S0 = __builtin_amdgcn_mfma_f32_16x16x32_bf16(uf, b0, S0, 0, 0, 0);
            S1 = __builtin_amdgcn_mfma_f32_16x16x32_bf16(uf, b1, S1, 0, 0, 0);
            const float gc0 = GC[rk0], gc1 = GC[rk1];
            S0 *= gc0; S1 *= gc1;
#pragma unroll
            for (int j = 0; j < 4; ++j) {
                const int v = 16 * vb + 4 * fq + j;
                SB[v * 64 + (((rk0 >> 3) ^ (v & 7)) << 3) + (rk0 & 7)] = f2bf(S0[j]);
                SB[v * 64 + (((rk1 >> 3) ^ (v & 7)) << 3) + (rk1 & 7)] = f2bf(S1[j]);
            }
        }
    }
    asm volatile("s_waitcnt vmcnt(0)" ::: "memory");
    __syncthreads();
}

__device__ __forceinline__ float max3_s(float a, float b, float c) { float r; asm("v_max3_f32 %0, %1, %2, %3" : "=v"(r) : "v"(a), "v"(b), "v"(c)); return r; }
__device__ __forceinline__ void attn_item(const Params& p, int b, int h, int q0, bool isctx, char* smem) {
    const int tid = tidx(), lane = tid & 63, wid = tid >> 6, fr = lane & 15, fq = lane >> 4;
    bf16_t* sKV = (bf16_t*)smem;
    const int ntiles = isctx ? (CTXL / 64) : (NKEY / 64);
    bf16x8 qf[2][2];
#pragma unroll
    for (int m = 0; m < 2; ++m) {
        const bf16_t* qp = isctx ? p.Qc + (((size_t)b * 8 + h * 2 + m) * CTXL + q0 + wid * 16 + fr) * 64
                                 : p.Q + (((size_t)b * 8 + h * 2 + m) * SEQ + q0 + wid * 16 + fr) * 64;
        qf[m][0] = *(const bf16x8*)(qp + fq * 8);
        qf[m][1] = *(const bf16x8*)(qp + 32 + fq * 8);
    }
    f32x4 o[2][8];
#pragma unroll
    for (int m = 0; m < 2; ++m)
#pragma unroll
        for (int mb = 0; mb < 8; ++mb) o[m][mb] = (f32x4){0.f, 0.f, 0.f, 0.f};
    float mrun[2] = {0.f, 0.f}, lrun[2] = {0.f, 0.f};
    const int lrow = tid >> 3, lch = tid & 7;
    const bf16_t* kbase = p.Kd + (((size_t)b * 8 + h * 2) * NKEY + lrow) * 64 + lch * 8;
    const bf16_t* vbase = p.Vd + (((size_t)b * 4 + h) * 128 + lrow) * NKEY + lch * 8;
    u32x4 rk[2], rv[2];
#pragma unroll
    for (int i = 0; i < 2; ++i) { rk[i] = *(const u32x4*)(kbase + i * (NKEY * 64)); rv[i] = *(const u32x4*)(vbase + i * (64 * NKEY)); }
    __syncthreads();
#pragma unroll
    for (int i = 0; i < 2; ++i) {
        const int r = lrow + 64 * i;
        const int off = r * 64 + ((lch ^ (r & 7)) << 3);
        *(u32x4*)(sKV + off) = rk[i];
        *(u32x4*)(sKV + 8192 + off) = rv[i];
    }
    if (ntiles > 1) {
#pragma unroll
        for (int i = 0; i < 2; ++i) { rk[i] = *(const u32x4*)(kbase + 4096 + i * (NKEY * 64)); rv[i] = *(const u32x4*)(vbase + 64 + i * (64 * NKEY)); }
    }
    for (int t = 0; t < ntiles; ++t) {
        __syncthreads();
        const bf16_t* sK = sKV + (t & 1) * 16384;
        const bf16_t* sV = sK + 8192;
        if (t + 1 < ntiles) {
            bf16_t* dK = sKV + ((t + 1) & 1) * 16384;
#pragma unroll
            for (int i = 0; i < 2; ++i) {
                const int r = lrow + 64 * i;
                const int off = r * 64 + ((lch ^ (r & 7)) << 3);
                *(u32x4*)(dK + off) = rk[i];
                *(u32x4*)(dK + 8192 + off) = rv[i];
            }
            if (t + 2 < ntiles) {
#pragma unroll
                for (int i = 0; i < 2; ++i) { rk[i] = *(const u32x4*)(kbase + (t + 2) * 4096 + i * (NKEY * 64)); rv[i] = *(const u32x4*)(vbase + (t + 2) * 64 + i * (64 * NKEY)); }
            }
        }
        bf16x8 pf[2][2];
#pragma unroll
        for (int m = 0; m < 2; ++m) {
            f32x4 sc[4];
            const float nm = -mrun[m];
#pragma unroll
            for (int kb = 0; kb < 4; ++kb) {
                sc[kb] = (f32x4){nm, nm, nm, nm};
                const int r = m * 64 + kb * 16 + fr;
#pragma unroll
                for (int ks = 0; ks < 2; ++ks) {
                    const bf16x8 kf = *(const bf16x8*)(sK + r * 64 + (((ks * 4 + fq) ^ (r & 7)) << 3));
                    sc[kb] = __builtin_amdgcn_mfma_f32_16x16x32_bf16(kf, qf[m][ks], sc[kb], 0, 0, 0);
                }
            }
            float mx = max3_s(sc[0][0], sc[0][1], sc[0][2]);
            mx = max3_s(mx, sc[0][3], sc[1][0]); mx = max3_s(mx, sc[1][1], sc[1][2]); mx = max3_s(mx, sc[1][3], sc[2][0]);
            mx = max3_s(mx, sc[2][1], sc[2][2]); mx = max3_s(mx, sc[2][3], sc[3][0]); mx = max3_s(mx, sc[3][1], sc[3][2]);
            mx = fmaxf(mx, sc[3][3]);
            mx = fmaxf(mx, __shfl_xor(mx, 16));
            mx = fmaxf(mx, __shfl_xor(mx, 32));
            if (!__all(mx <= 8.0f)) {
                const float d = mx > 8.0f ? mx : 0.f;
                const float scale = __builtin_amdgcn_exp2f(-d);
                mrun[m] += d;
                lrun[m] *= scale;
#pragma unroll
                for (int mb = 0; mb < 8; ++mb) o[m][mb] *= scale;
#pragma unroll
                for (int kb = 0; kb < 4; ++kb) sc[kb] -= d;
            }
            float ls = 0.f;
#pragma unroll
            for (int kb = 0; kb < 4; ++kb)
#pragma unroll
                for (int j = 0; j < 4; ++j) { const float e = __builtin_amdgcn_exp2f(sc[kb][j]); sc[kb][j] = e; ls += e; }
            lrun[m] += ls;
#pragma unroll
            for (int ksp = 0; ksp < 2; ++ksp) {
                const u32x4 pk = (u32x4){pack2(sc[2 * ksp][0], sc[2 * ksp][1]), pack2(sc[2 * ksp][2], sc[2 * ksp][3]), pack2(sc[2 * ksp + 1][0], sc[2 * ksp + 1][1]), pack2(sc[2 * ksp + 1][2], sc[2 * ksp + 1][3])};
                pf[m][ksp] = __builtin_bit_cast(bf16x8, pk);
            }
        }
#pragma unroll
        for (int ksp = 0; ksp < 2; ++ksp) {
#pragma unroll
            for (int mb = 0; mb < 8; ++mb) {
                const int r = mb * 16 + fr;
                const bf16x8 vfv = *(const bf16x8*)(sV + r * 64 + (((4 * ksp + fq) ^ (r & 7)) << 3));
                o[0][mb] = __builtin_amdgcn_mfma_f32_16x16x32_bf16(vfv, pf[0][ksp], o[0][mb], 0, 0, 0);
                o[1][mb] = __builtin_amdgcn_mfma_f32_16x16x32_bf16(vfv, pf[1][ksp], o[1][mb], 0, 0, 0);
                if ((mb & 3) == 3) asm volatile("" ::: "memory");
            }
        }
    }
    {
        float l0 = lrun[0], l1 = lrun[1];
        l0 += __shfl_xor(l0, 16); l0 += __shfl_xor(l0, 32);
        l1 += __shfl_xor(l1, 16); l1 += __shfl_xor(l1, 32);
        const float i0 = 1.0f / l0, i1 = p.scal[0] / l1;
        float ss = 0.f;
#pragma unroll
        for (int mb = 0; mb < 8; ++mb) {
            o[0][mb] = o[0][mb] * i0 - o[1][mb] * i1;
            ss += o[0][mb][0] * o[0][mb][0] + o[0][mb][1] * o[0][mb][1] + o[0][mb][2] * o[0][mb][2] + o[0][mb][3] * o[0][mb][3];
        }
        ss += __shfl_xor(ss, 16); ss += __shfl_xor(ss, 32);
        const float rstd = rsqrtf(ss * (1.0f / 128.0f) + 1e-6f) * 0.8f;
        const int tok = (isctx ? NX + b * CTXL : b * SEQ) + q0 + wid * 16 + fr;
        bf16_t* dst = p.MG + (size_t)tok * DM + h * 128 + fq * 4;
#pragma unroll
        for (int mb = 0; mb < 8; ++mb) {
            const f32x4 g = *(const f32x4*)(p.da_subln + mb * 16 + fq * 4);
            *(uint2*)(dst + mb * 16) = make_uint2(pack2(o[0][mb][0] * rstd * g[0], o[0][mb][1] * rstd * g[1]), pack2(o[0][mb][2] * rstd * g[2], o[0][mb][3] * rstd * g[3]));
        }
    }
}

#define N_ATT_LAT 512
#define N_ATT_CTX 64
#define N_CONV_LATE (1280 + 256 + 16384 + 8192)
__device__ __forceinline__ ConvDesc conv_late_desc(const Params& p, int pr) {
    const int j = pr * 2 + (tidx() >> 8);
    if (j < 1280) return ConvDesc{p.od_w_in, p.wt_odin, ODC, 1024, j / 80, j % 80, 2, 0};
    if (j < 1536) { const int q = j - 1280; return ConvDesc{p.od_w_out, p.wt_odout, 1024, 1024, q >> 4, q & 15, 2, 0}; }
    if (j < 1536 + 16384) { const int q = j - 1536, mat = q >> 9, t = q & 511; return ConvDesc{p.moe_w_gu + (size_t)mat * 1024 * 2048, p.wt_gu + (size_t)mat * 2048 * 1024, 2048, 1024, t >> 5, t & 31, 1, 0}; }
    const int q = j - 1536 - 16384, mat = q >> 8, t = q & 255;
    return ConvDesc{p.moe_w_dn + (size_t)mat * 1024 * 1024, p.wt_dn + (size_t)mat * 1024 * 1024, 1024, 1024, t >> 4, t & 15, 2, 0};
}
__device__ __forceinline__ ConvDesc conv_l1_desc(const Params& p, int pr) {
    const int j = pr * 2 + (tidx() >> 8);
    if (j < 16384) { const int mat = 32 + (j >> 9), t = j & 511; return ConvDesc{p.moe_w_gu + (size_t)mat * 1024 * 2048, p.wt_gu + (size_t)mat * 2048 * 1024, 2048, 1024, t >> 5, t & 31, 1, 0}; }
    const int q = j - 16384, mat = 32 + (q >> 8), t = q & 255;
    return ConvDesc{p.moe_w_dn + (size_t)mat * 1024 * 1024, p.wt_dn + (size_t)mat * 1024 * 1024, 1024, 1024, t >> 4, t & 15, 2, 0};
}
template <bool L1> __device__ __forceinline__ void conv_group(const Params& p, int g, char* smem) {
    float* lds = (float*)(smem + (tidx() >> 8) * HLDS);
    ConvDesc d = L1 ? conv_l1_desc(p, g * CONV_GRP) : conv_late_desc(p, g * CONV_GRP);
    ConvRegs x = conv_load(d);
#pragma unroll 1
    for (int q = 0; q < CONV_GRP; ++q) {
        ConvDesc dn = d; ConvRegs xn = x;
        if (q + 1 < CONV_GRP) { dn = L1 ? conv_l1_desc(p, g * CONV_GRP + q + 1) : conv_late_desc(p, g * CONV_GRP + q + 1); xn = conv_load(dn); }
        conv_store(x, d, lds);
        d = dn; x = xn;
    }
}
__device__ __forceinline__ void phase_scan_attn(const Params& p, int bid, int nblk, char* smem) {
    for (int it = bid; it < 128; it += nblk) rwkv_chunk_chain(p, it, smem);
    const int n_att = N_ATT_LAT + N_ATT_CTX, n_all = n_att + (N_CONV_LATE / 2) / CONV_GRP;
    for (;;) {
        const int it = q_next(p.counts + 64, smem);
        if (it >= n_all) break;
        if (it < N_ATT_LAT) attn_item(p, it >> 6, (it >> 4) & 3, (it & 15) * 128, false, smem);
        else if (it < n_att) { const int j = it - N_ATT_LAT; attn_item(p, j >> 3, (j >> 1) & 3, (j & 1) * 128, true, smem); }
        else {
            conv_group<false>(p, it - n_att, smem);
        }
    }
}

__device__ __forceinline__ void phase_rw_readout(const Params& p, int bid, int nblk) {
    const int lane = tidx() & 63, wid = tidx() >> 6;
    const int c0 = lane * 8;
    f32x4 rk0 = *(const f32x4*)(p.rw_r_k + c0), rk1 = *(const f32x4*)(p.rw_r_k + c0 + 4);
    f32x4 lw0 = *(const f32x4*)(p.rw_ln_w + c0), lw1 = *(const f32x4*)(p.rw_ln_w + c0 + 4);
    f32x4 lb0 = *(const f32x4*)(p.rw_ln_b + c0), lb1 = *(const f32x4*)(p.rw_ln_b + c0 + 4);
    for (int tok = bid * 8 + wid; tok < NT; tok += nblk * 8) {
        const size_t o = (size_t)tok * 512 + c0, zo = (size_t)NT * 512;
        const f32x4 ya0 = *(const f32x4*)(p.rY + o), ya1 = *(const f32x4*)(p.rY + o + 4), yb0 = *(const f32x4*)(p.rY + zo + o), yb1 = *(const f32x4*)(p.rY + zo + o + 4);
        float tr[8], tka[8], tkb[8], tv[8], tg[8];
        unpack8(*(const u32x4*)(p.rR + o), tr); unpack8(*(const u32x4*)(p.rKD + o), tka); unpack8(*(const u32x4*)(p.rKD + zo + o), tkb);
        unpack8(*(const u32x4*)(p.rV + o), tv); unpack8(*(const u32x4*)(p.rG + o), tg);
        const f32x4 r0 = (f32x4){tr[0], tr[1], tr[2], tr[3]}, r1 = (f32x4){tr[4], tr[5], tr[6], tr[7]};
        const f32x4 ka0 = (f32x4){tka[0], tka[1], tka[2], tka[3]}, ka1 = (f32x4){tka[4], tka[5], tka[6], tka[7]}, kb0 = (f32x4){tkb[0], tkb[1], tkb[2], tkb[3]}, kb1 = (f32x4){tkb[4], tkb[5], tkb[6], tkb[7]};
        const f32x4 v0 = (f32x4){tv[0], tv[1], tv[2], tv[3]}, v1 = (f32x4){tv[4], tv[5], tv[6], tv[7]}, g0 = (f32x4){tg[0], tg[1], tg[2], tg[3]}, g1 = (f32x4){tg[4], tg[5], tg[6], tg[7]};
        const f32x4 y0 = ya0 + yb0, y1 = ya1 + yb1;
        const float mean = sum8((y0[0] + y0[1]) + (y0[2] + y0[3]) + (y1[0] + y1[1]) + (y1[2] + y1[3])) * (1.0f / 64.0f);
        const f32x4 d0 = y0 - mean, d1 = y1 - mean;
        const float var = sum8((d0[0] * d0[0] + d0[1] * d0[1]) + (d0[2] * d0[2] + d0[3] * d0[3]) + (d1[0] * d1[0] + d1[1] * d1[1]) + (d1[2] * d1[2] + d1[3] * d1[3])) * (1.0f / 64.0f);
        const float rs = rsqrtf(var + 64e-5f);
        const f32x4 b0 = r0 * (ka0 + kb0) * rk0, b1 = r1 * (ka1 + kb1) * rk1;
        const float bon = sum8((b0[0] + b0[1]) + (b0[2] + b0[3]) + (b1[0] + b1[1]) + (b1[2] + b1[3]));
        const f32x4 o0 = (d0 * rs * lw0 + lb0 + bon * v0) * g0, o1 = (d1 * rs * lw1 + lb1 + bon * v1) * g1;
        *(u32x4*)(p.MG + (size_t)tok * DM + 512 + c0) = (u32x4){pack2(o0[0], o0[1]), pack2(o0[2], o0[3]), pack2(o1[0], o1[1]), pack2(o1[2], o1[3])};
    }
}

__device__ __forceinline__ void phase_router(const Params& p, int bid, int nblk, char* smem, int layer, const bf16_t* X, int ntok, bool dry = false) {
    const int tid = tidx(), lane = tid & 63, wid = tid >> 6;
    float* hrow = (float*)smem;
    float* part = hrow + 16 * 1028;
    float* logits = part + 8 * 512;
    const float* gain = p.norm2_g + layer * DM;
    const float* modl = p.mod + (size_t)layer * 9 * 6144;
    const float* wr = p.router_w + (size_t)layer * DM * NEXP;
    const float* br = p.router_b + layer * NEXP;
    int* counts = p.counts + layer * NEXP;
    int* lists = p.lists + (size_t)layer * NEXP * NT;
    for (int it = bid; it < ntok / 16; it += nblk) {
        __syncthreads();
#pragma unroll
        for (int u = 0; u < 2; ++u) {
            const int tl = wid * 2 + u, tok = it * 16 + tl;
            const bf16_t* xr = X + (size_t)tok * DM;
            const float* mr = modl + modrow(tok) * 6144 + 3072;
            float v0[8], v1[8];
            unpack8(*(const u32x4*)(xr + lane * 8), v0); unpack8(*(const u32x4*)(xr + 512 + lane * 8), v1);
            float ss = 0.f;
#pragma unroll
            for (int j = 0; j < 8; ++j) ss += v0[j] * v0[j] + v1[j] * v1[j];
            ss = wave_sum(ss);
            const float rstd = rsqrtf(ss * (1.0f / 1024.0f) + 1e-6f);
#pragma unroll
            for (int i = 0; i < 2; ++i) {
                const int c = lane * 8 + 512 * i;
                const f32x4 g0 = *(const f32x4*)(gain + c), g1 = *(const f32x4*)(gain + c + 4), sh0 = *(const f32x4*)(mr + c), sh1 = *(const f32x4*)(mr + c + 4);
                const f32x4 sc0 = *(const f32x4*)(mr + 1024 + c), sc1 = *(const f32x4*)(mr + 1024 + c + 4);
                float a[8];
#pragma unroll
                for (int j = 0; j < 4; ++j) {
                    a[j] = (i == 0 ? v0[j] : v1[j]) * rstd * g0[j] * (1.f + sc0[j]) + sh0[j];
                    a[4 + j] = (i == 0 ? v0[4 + j] : v1[4 + j]) * rstd * g1[j] * (1.f + sc1[j]) + sh1[j];
                }
                *(u32x4*)(p.H + (size_t)tok * DM + c) = pack8f(a);
                *(f32x4*)(hrow + tl * 1028 + c) = (f32x4){a[0], a[1], a[2], a[3]};
                *(f32x4*)(hrow + tl * 1028 + c + 4) = (f32x4){a[4], a[5], a[6], a[7]};
            }
        }
        __syncthreads();
        {
            const int tokl = lane & 15, kq = lane >> 4;
            f32x4 c0 = (f32x4){0.f, 0.f, 0.f, 0.f}, c1 = c0;
            const float* hp = hrow + tokl * 1028 + wid * 128 + kq;
            const float* wp = wr + (size_t)(wid * 128 + kq) * 32 + tokl;
#pragma unroll 8
            for (int ks = 0; ks < 32; ++ks) {
                const float a = hp[ks * 4];
                const float b0 = wp[ks * 128], b1 = wp[ks * 128 + 16];
                c0 = __builtin_amdgcn_mfma_f32_16x16x4f32(a, b0, c0, 0, 0, 0);
                c1 = __builtin_amdgcn_mfma_f32_16x16x4f32(a, b1, c1, 0, 0, 0);
            }
#pragma unroll
            for (int j = 0; j < 4; ++j) {
                part[wid * 512 + (4 * kq + j) * 32 + tokl] = c0[j];
                part[wid * 512 + (4 * kq + j) * 32 + 16 + tokl] = c1[j];
            }
        }
        __syncthreads();
        {
            const int tl = tid >> 5, e = tid & 31;
            float a = br[e];
#pragma unroll
            for (int w = 0; w < 8; ++w) a += part[w * 512 + tl * 32 + e];
            logits[tl * 32 + e] = a;
        }
        __syncthreads();
        if (tid < 16) {
            const int tok = it * 16 + tid;
            float lv[32];
#pragma unroll
            for (int e = 0; e < 32; ++e) lv[e] = logits[tid * 32 + e];
            float tv[4]; int te[4];
#pragma unroll
            for (int k = 0; k < 4; ++k) {
                float best = -3.0e38f; int bi = 0;
#pragma unroll
                for (int e = 0; e < 32; ++e) { if (lv[e] > best) { best = lv[e]; bi = e; } }
                tv[k] = best; te[k] = bi;
#pragma unroll
                for (int e = 0; e < 32; ++e) { if (e == bi) lv[e] = -3.0e38f; }
            }
            const float e1 = __expf(tv[1] - tv[0]), e2 = __expf(tv[2] - tv[0]), e3 = __expf(tv[3] - tv[0]);
            const float inv = 1.0f / (1.0f + e1 + e2 + e3);
            const float gt[4] = {inv, e1 * inv, e2 * inv, e3 * inv};
#pragma unroll
            for (int k = 0; k < 4; ++k) {
                p.GATE[(size_t)tok * 4 + k] = gt[k];
                if (!dry) {
                    const int pos = atomicAdd(&counts[te[k]], 1);
                    lists[(size_t)te[k] * NT + pos] = tok * 4 + k;
                }
            }
        }
    }
}

struct EpiGU {
    const float* bias; bf16_t* act; int pos0; int unit0;
    __device__ __forceinline__ void pair(int r, int cu, f32x4 g, f32x4 u) const {
        const int unit = unit0 + cu;
        unsigned w[2]; float o[4];
#pragma unroll
        for (int j = 0; j < 4; ++j) {
            const float gate = fminf(g[j] + bias[unit + j], 7.0f);
            const float up = fminf(fmaxf(u[j] + bias[1024 + unit + j], -7.0f), 7.0f);
            o[j] = (up + 1.0f) * gate * sigmoidf_(1.702f * gate);
        }
        w[0] = pack2(o[0], o[1]); w[1] = pack2(o[2], o[3]);
        *(uint2*)(act + (size_t)(pos0 + r) * 1024 + unit) = make_uint2(w[0], w[1]);
    }
};
struct MoeIter {
    int cnt[4], off[4], tiles[4], ntn, i, step, g;
    __device__ __forceinline__ void init(const int* counts, int NTN, int bid, int nblk) {
        g = bid & 7; i = (bid >> 3) * 2 + (tidx() >> 8); step = (nblk >> 3) * 2; ntn = NTN;
        int o = 0;
#pragma unroll
        for (int q = 0; q < 4; ++q) { cnt[q] = 0; off[q] = 0; tiles[q] = 0; }
        for (int e = 0; e < NEXP; ++e) {
            const int c = counts[e];
            if ((e & 7) == g) {
                const int q = e >> 3;
#pragma unroll
                for (int qq = 0; qq < 4; ++qq) if (qq == q) { cnt[qq] = c; off[qq] = o; tiles[qq] = ((c + 127) >> 7) * NTN; }
            }
            o += c;
        }
    }
    __device__ __forceinline__ bool next(int& e, int& mt, int& nt, int& eoff, int& ecnt) {
        int j = i, q = 0;
        if (j >= tiles[0]) { j -= tiles[0]; q = 1; if (j >= tiles[1]) { j -= tiles[1]; q = 2; if (j >= tiles[2]) { j -= tiles[2]; q = 3; if (j >= tiles[3]) return false; } } }
        int c = cnt[0], o = off[0];
        if (q == 1) { c = cnt[1]; o = off[1]; } else if (q == 2) { c = cnt[2]; o = off[2]; } else if (q == 3) { c = cnt[3]; o = off[3]; }
        const int mcnt = (c + 127) >> 7, full = mcnt >> 3, band = 8 * ntn;
        if (j < full * band) { const int ms = j / band, r = j - ms * band; nt = r >> 3; mt = ms * 8 + (r & 7); }
        else { const int rem = mcnt - full * 8, jj = j - full * band; nt = jj / rem; mt = full * 8 + (jj - nt * rem); }
        e = q * 8 + g; eoff = o; ecnt = c;
        i += step;
        return true;
    }
};

struct PlainOrder8 {
    const char* A; const char* Bt; int K;
    int mg0, mcnt, ntn, total, full, i, step;
    __device__ __forceinline__ void init(const bf16_t* A_, const bf16_t* Bt_, int K_, int MT, int NTN, int bid, int nblk) {
        A = (const char*)A_; Bt = (const char*)Bt_; K = K_;
        const int g = bid & 7;
        mg0 = (MT * g) >> 3; mcnt = ((MT * (g + 1)) >> 3) - mg0; ntn = NTN; total = mcnt * NTN; full = mcnt >> 3; i = bid >> 3; step = nblk >> 3;
    }
    __device__ __forceinline__ bool next(g8::Unit& u) {
        if (i >= total) return false;
        int mt, nt;
        const int band = 8 * ntn;
        if (i < full * band) { const int ms = i / band, r = i - ms * band; nt = r >> 3; mt = mg0 + ms * 8 + (r & 7); }
        else { const int rem = mcnt - full * 8, j = i - full * band; nt = j / rem; mt = mg0 + full * 8 + (j - nt * rem); }
        i += step;
        u.a = A + (size_t)mt * 256 * K * 2; u.b = Bt + (size_t)nt * 256 * K * 2; u.gidx = nullptr; u.idx = nullptr; u.shift = 0; u.rows = 256; u.i0 = mt * 256; u.i1 = nt * 256; u.i2 = 0;
        return true;
    }
};
struct Epi8Store {
    float* C; int ldc;
    __device__ __forceinline__ void operator()(const f32x4 (&acc)[2][2][4][2], const g8::Unit& u, int wr, int wc, int fr, int fq) const {
#pragma unroll
        for (int ai = 0; ai < 2; ++ai)
#pragma unroll
            for (int m = 0; m < 4; ++m) {
                float* rowp = C + (size_t)(u.i0 + ai * 128 + wr * 64 + m * 16 + fr) * ldc + u.i1 + wc * 32 + fq * 4;
#pragma unroll
                for (int bj = 0; bj < 2; ++bj)
#pragma unroll
                    for (int n = 0; n < 2; ++n) *(f32x4*)(rowp + bj * 128 + n * 16) = acc[ai][bj][m][n];
            }
    }
};
struct Epi8StoreBf {
    bf16_t* C; int ldc;
    __device__ __forceinline__ void operator()(const f32x4 (&acc)[2][2][4][2], const g8::Unit& u, int wr, int wc, int fr, int fq) const {
#pragma unroll
        for (int ai = 0; ai < 2; ++ai)
#pragma unroll
            for (int m = 0; m < 4; ++m) {
                bf16_t* rowp = C + (size_t)(u.i0 + ai * 128 + wr * 64 + m * 16 + fr) * ldc + u.i1 + wc * 32 + fq * 8;
#pragma unroll
                for (int bj = 0; bj < 2; ++bj) {
                    const f32x4 v0 = acc[ai][bj][m][0], v1 = acc[ai][bj][m][1];
                    *(u32x4*)(rowp + bj * 128) = (u32x4){pack2(v0[0], v0[1]), pack2(v0[2], v0[3]), pack2(v1[0], v1[1]), pack2(v1[2], v1[3])};
                }
            }
    }
};
struct Epi8StoreHg {
    bf16_t* C; const float* hg_lb;
    __device__ __forceinline__ void operator()(const f32x4 (&acc)[2][2][4][2], const g8::Unit& u, int wr, int wc, int fr, int fq) const {
        const int c0 = u.i1 + wc * 32 + fq * 8;
        const int kind = u.i1 < 1024 ? 0 : (u.i1 < 3072 ? 1 : 2);
        f32x4 lbv[2][2];
        if (kind == 1) {
#pragma unroll
            for (int bj = 0; bj < 2; ++bj)
#pragma unroll
                for (int n = 0; n < 2; ++n) {
                    const int ch = (c0 + bj * 128 + n * 4) & 1023;
                    const f32x4 h0 = *(const f32x4*)(hg_lb + ch), h1 = *(const f32x4*)(hg_lb + 1024 + ch);
#pragma unroll
                    for (int j = 0; j < 4; ++j) lbv[bj][n][j] = 1.f - __builtin_amdgcn_rcpf(1.0f + __expf(h0[j] - h1[j]));
                }
        }
#pragma unroll
        for (int ai = 0; ai < 2; ++ai)
#pragma unroll
            for (int m = 0; m < 4; ++m) {
                bf16_t* rowp = C + (size_t)(u.i0 + ai * 128 + wr * 64 + m * 16 + fr) * ODC + c0;
#pragma unroll
                for (int bj = 0; bj < 2; ++bj) {
                    f32x4 v0 = acc[ai][bj][m][0], v1 = acc[ai][bj][m][1];
                    if (kind == 0) {
#pragma unroll
                        for (int j = 0; j < 4; ++j) { v0[j] = siluf_(v0[j]); v1[j] = siluf_(v1[j]); }
                    } else if (kind == 1) {
#pragma unroll
                        for (int j = 0; j < 4; ++j) {
                            v0[j] = lbv[bj][0][j] * __builtin_amdgcn_rcpf(1.0f + __expf(v0[j]));
                            v1[j] = lbv[bj][1][j] * __builtin_amdgcn_rcpf(1.0f + __expf(v1[j]));
                        }
                    }
                    *(u32x4*)(rowp + bj * 128) = (u32x4){pack2(v0[0], v0[1]), pack2(v0[2], v0[3]), pack2(v1[0], v1[1]), pack2(v1[2], v1[3])};
                }
                asm volatile("" ::: "memory");
            }
    }
};
template <bool IN_BF16>
struct Epi8Resid {
    const void* xin_lat; const void* xin_ctx; bf16_t* xout; const float* gmod;
    __device__ __forceinline__ void operator()(const f32x4 (&acc)[2][2][4][2], const g8::Unit& u, int wr, int wc, int fr, int fq) const {
        const int c0 = u.i1 + wc * 32 + fq * 8;
        const float* gr = gmod + modrow(u.i0) * 6144 + c0;
        f32x4 g[2][2];
#pragma unroll
        for (int bj = 0; bj < 2; ++bj)
#pragma unroll
            for (int n = 0; n < 2; ++n) g[bj][n] = *(const f32x4*)(gr + bj * 128 + n * 4);
#pragma unroll
        for (int ai = 0; ai < 2; ++ai)
#pragma unroll
            for (int m = 0; m < 4; ++m) {
                const int tok = u.i0 + ai * 128 + wr * 64 + m * 16 + fr;
                const size_t ro = (tok < NX ? (size_t)tok * DM : (size_t)(tok - NX) * DM) + c0;
                bf16_t* orow = xout + (size_t)tok * DM + c0;
                if constexpr (IN_BF16) {
                    const bf16_t* xr = (tok < NX ? (const bf16_t*)xin_lat : (const bf16_t*)xin_ctx) + ro;
                    const u32x4 xw0 = *(const u32x4*)(xr), xw1 = *(const u32x4*)(xr + 128);
#pragma unroll
                    for (int bj = 0; bj < 2; ++bj) {
                        float xf[8], o[8];
                        unpack8(bj == 0 ? xw0 : xw1, xf);
                        const f32x4 v0 = acc[ai][bj][m][0], v1 = acc[ai][bj][m][1];
#pragma unroll
                        for (int j = 0; j < 4; ++j) { o[j] = xf[j] + g[bj][0][j] * v0[j]; o[4 + j] = xf[4 + j] + g[bj][1][j] * v1[j]; }
                        *(u32x4*)(orow + bj * 128) = pack8f(o);
                    }
                } else {
                    const float* xr = (tok < NX ? (const float*)xin_lat : (const float*)xin_ctx) + ro;
                    f32x4 xi[2][2];
#pragma unroll
                    for (int bj = 0; bj < 2; ++bj)
#pragma unroll
                        for (int n = 0; n < 2; ++n) xi[bj][n] = *(const f32x4*)(xr + bj * 128 + n * 4);
#pragma unroll
                    for (int bj = 0; bj < 2; ++bj) {
                        const f32x4 o0 = xi[bj][0] + g[bj][0] * acc[ai][bj][m][0], o1 = xi[bj][1] + g[bj][1] * acc[ai][bj][m][1];
                        *(u32x4*)(orow + bj * 128) = (u32x4){pack2(o0[0], o0[1]), pack2(o0[2], o0[3]), pack2(o1[0], o1[1]), pack2(o1[2], o1[3])};
                    }
                }
                asm volatile("" ::: "memory");
            }
    }
};
struct MoeOrder8 {
    int cvec;
    const int* lists; const char* A; const char* W; int wrows, ntn, i, step, g;
    bool gather;
    __device__ __forceinline__ void init(const int* counts_, const int* lists_, const bf16_t* A_, const bf16_t* W_, int wrows_, bool gather_, int bid, int nblk) {
        cvec = counts_[tidx() & 31]; lists = lists_; A = (const char*)A_; W = (const char*)W_; wrows = wrows_; ntn = wrows_ / 256; gather = gather_;
        g = bid & 7; i = bid >> 3; step = nblk >> 3;
    }
    __device__ __forceinline__ bool next(g8::Unit& u) {
        int j = i, o = 0, fe = -1, fo = 0, fc = 0, fm = 1;
#pragma unroll
        for (int e = 0; e < NEXP; ++e) {
            const int c = __builtin_amdgcn_readlane(cvec, e);
            if ((e & 7) == g && fe < 0) {
                const int mcnt = (c + 255) >> 8, t = mcnt * ntn;
                if (j < t) { fe = e; fo = o; fc = c; fm = mcnt; }
                else j -= t;
            }
            o += c;
        }
        if (fe < 0) return false;
        const int nt = j / fm, mt = j - nt * fm;
        i += step;
        u.idx = lists + (size_t)fe * NT + mt * 256; u.gidx = gather ? u.idx : nullptr; u.rows = min(256, fc - mt * 256); u.shift = 2;
        u.a = gather ? A : A + (size_t)(fo + mt * 256) * 1024 * 2;
        u.b = W + ((size_t)fe * wrows + (size_t)nt * 256) * 1024 * 2;
        u.i0 = fo + mt * 256;
        u.i1 = nt;
        u.i2 = fe;
        return true;
    }
};
struct Epi8GU {
    const float* bias; bf16_t* act;
    __device__ __forceinline__ void operator()(const f32x4 (&acc)[2][2][4][2], const g8::Unit& u, int wr, int wc, int fr, int fq) const {
        const float* be = bias + (size_t)u.i2 * 2048;
        const int unit = u.i1 * 128 + wc * 32 + fq * 8;
        const f32x4 bg0 = *(const f32x4*)(be + unit), bg1 = *(const f32x4*)(be + unit + 4), bu0 = *(const f32x4*)(be + 1024 + unit), bu1 = *(const f32x4*)(be + 1024 + unit + 4);
#pragma unroll
        for (int ai = 0; ai < 2; ++ai)
#pragma unroll
            for (int m = 0; m < 4; ++m) {
                const int r = ai * 128 + wr * 64 + m * 16 + fr;
                if (r < u.rows) {
                    float o[8];
#pragma unroll
                    for (int bj = 0; bj < 2; ++bj) {
                        const f32x4 g = acc[ai][bj][m][0] + (bj ? bg1 : bg0), up = acc[ai][bj][m][1] + (bj ? bu1 : bu0);
#pragma unroll
                        for (int j = 0; j < 4; ++j) {
                            const float gate = fminf(g[j], 7.0f);
                            const float uu = fminf(fmaxf(up[j], -7.0f), 7.0f);
                            o[bj * 4 + j] = (uu + 1.0f) * gate * sigmoidf_(1.702f * gate);
                        }
                    }
                    *(u32x4*)(act + (size_t)(u.i0 + r) * 1024 + unit) = (u32x4){pack2(o[0], o[1]), pack2(o[2], o[3]), pack2(o[4], o[5]), pack2(o[6], o[7])};
                }
                asm volatile("" ::: "memory");
            }
    }
};
struct Epi8DN {
    const float* bias; bf16_t* ys;
    __device__ __forceinline__ void operator()(const f32x4 (&acc)[2][2][4][2], const g8::Unit& u, int wr, int wc, int fr, int fq) const {
        const int cb = u.i1 * 256 + wc * 32 + fq * 8;
        const float* be = bias + (size_t)u.i2 * 1024 + cb;
        const f32x4 b00 = *(const f32x4*)(be), b01 = *(const f32x4*)(be + 4), b10 = *(const f32x4*)(be + 128), b11 = *(const f32x4*)(be + 132);
#pragma unroll
        for (int ai = 0; ai < 2; ++ai)
#pragma unroll
            for (int m = 0; m < 4; ++m) {
                const int r = ai * 128 + wr * 64 + m * 16 + fr;
                if (r < u.rows) {
                    const int a = u.idx[r];
                    bf16_t* orow = ys + (size_t)a * 1024 + cb;
#pragma unroll
                    for (int bj = 0; bj < 2; ++bj) {
                        const f32x4 v0 = acc[ai][bj][m][0] + (bj ? b10 : b00), v1 = acc[ai][bj][m][1] + (bj ? b11 : b01);
                        *(u32x4*)(orow + bj * 128) = (u32x4){pack2(v0[0], v0[1]), pack2(v0[2], v0[3]), pack2(v1[0], v1[1]), pack2(v1[2], v1[3])};
                    }
                }
                asm volatile("" ::: "memory");
            }
    }
};
__device__ __forceinline__ void phase_gemm8_store(const bf16_t* A, int M, const bf16_t* Wt, int N, float* C, int bid, int nblk, char* smem) {
    PlainOrder8 S; S.init(A, Wt, DM, M / 256, N / 256, bid, nblk);
    Epi8Store E{C, N};
    g8::gemm_phase((G8_LAS unsigned char*)smem, DM, S, E);
}
__device__ __forceinline__ void phase_gemm8_store_bf(const bf16_t* A, int M, const bf16_t* Wt, int N, bf16_t* C, int bid, int nblk, char* smem) {
    PlainOrder8 S; S.init(A, Wt, DM, M / 256, N / 256, bid, nblk);
    Epi8StoreBf E{C, N};
    g8::gemm_phase((G8_LAS unsigned char*)smem, DM, S, E);
}
__device__ __forceinline__ void phase_gemm8_store_hg(const Params& p, int bid, int nblk, char* smem) {
    PlainOrder8 S; S.init(p.H, p.wt_odin, DM, NT / 256, ODC / 256, bid, nblk);
    Epi8StoreHg E{(bf16_t*)p.P, p.hg_lb};
    g8::gemm_phase((G8_LAS unsigned char*)smem, DM, S, E);
}
template <bool IN_BF16>
__device__ __forceinline__ void phase_outproj8(const Params& p, int bid, int nblk, char* smem, const bf16_t* Wt, int ntok, const void* xin_lat, const void* xin_ctx, bf16_t* xout, const float* gmod) {
    PlainOrder8 S; S.init(p.MG, Wt, DM, ntok / 256, 4, bid, nblk);
    Epi8Resid<IN_BF16> E{xin_lat, xin_ctx, xout, gmod};
    g8::gemm_phase((G8_LAS unsigned char*)smem, DM, S, E);
}
__device__ __forceinline__ void phase_moe_gu8(const Params& p, int bid, int nblk, char* smem, int layer) {
    MoeOrder8 S; S.init(p.counts + layer * NEXP, p.lists + (size_t)layer * NEXP * NT, p.H, p.wt_gu + (size_t)layer * NEXP * 2048 * 1024, 2048, true, bid, nblk);
    Epi8GU E{p.moe_b_gu + (size_t)layer * NEXP * 2048, p.ACT};
    g8::gemm_phase((G8_LAS unsigned char*)smem, DM, S, E);
}
__device__ __forceinline__ void phase_moe_dn8(const Params& p, int bid, int nblk, char* smem, int layer) {
    MoeOrder8 S; S.init(p.counts + layer * NEXP, p.lists + (size_t)layer * NEXP * NT, p.ACT, p.wt_dn + (size_t)layer * NEXP * 1024 * 1024, 1024, false, bid, nblk);
    Epi8DN E{p.moe_b_dn + (size_t)layer * NEXP * 1024, p.YS};
    g8::gemm_phase((G8_LAS unsigned char*)smem, DM, S, E);
}

template <bool OUT_BF16>
__device__ __forceinline__ void phase_combine(const Params& p, int bid, int nblk, const bf16_t* Xin, void* Xout, const float* gmod  , int ntok,
                              bool do_norm, const float* gain, const float* modn) {
    const int lane = tidx() & 63, wid = tidx() >> 6;
    for (int tok = bid * 8 + wid; tok < ntok; tok += nblk * 8) {
        const float* gr = gmod + modrow(tok) * 6144;
        const f32x4 gt = *(const f32x4*)(p.GATE + (size_t)tok * 4);
        const bf16_t* ys = p.YS + (size_t)tok * 4 * 1024;
        float v0[8], v1[8];
        float ss = 0.f;
#pragma unroll
        for (int i = 0; i < 2; ++i) {
            const int c = lane * 8 + 512 * i;
            float xi[8], y0[8], y1[8], y2[8], y3[8];
            unpack8(*(const u32x4*)(Xin + (size_t)tok * DM + c), xi);
            unpack8(*(const u32x4*)(ys + c), y0); unpack8(*(const u32x4*)(ys + 1024 + c), y1); unpack8(*(const u32x4*)(ys + 2048 + c), y2); unpack8(*(const u32x4*)(ys + 3072 + c), y3);
            const f32x4 ga = *(const f32x4*)(gr + c), gb = *(const f32x4*)(gr + c + 4);
            float o[8];
#pragma unroll
            for (int j = 0; j < 8; ++j) {
                o[j] = xi[j] + (j < 4 ? ga[j & 3] : gb[j & 3]) * (gt[0] * y0[j] + gt[1] * y1[j] + gt[2] * y2[j] + gt[3] * y3[j]);
                ss += o[j] * o[j];
                if (i == 0) v0[j] = o[j]; else v1[j] = o[j];
            }
            if constexpr (OUT_BF16) *(u32x4*)((bf16_t*)Xout + (size_t)tok * DM + c) = pack8f(o);
            else {
                *(f32x4*)((float*)Xout + (size_t)tok * DM + c) = (f32x4){o[0], o[1], o[2], o[3]};
                *(f32x4*)((float*)Xout + (size_t)tok * DM + c + 4) = (f32x4){o[4], o[5], o[6], o[7]};
            }
        }
        if (do_norm) {
            ss = wave_sum(ss);
            const float rstd = rsqrtf(ss * (1.0f / 1024.0f) + 1e-6f);
            const float* mr = modn + modrow(tok) * 6144;
#pragma unroll
            for (int i = 0; i < 2; ++i) {
                const int c = lane * 8 + 512 * i;
                const f32x4 g0 = *(const f32x4*)(gain + c), g1 = *(const f32x4*)(gain + c + 4), sh0 = *(const f32x4*)(mr + c), sh1 = *(const f32x4*)(mr + c + 4);
                const f32x4 sc0 = *(const f32x4*)(mr + 1024 + c), sc1 = *(const f32x4*)(mr + 1024 + c + 4);
                float a[8];
#pragma unroll
                for (int j = 0; j < 4; ++j) {
                    a[j] = (i == 0 ? v0[j] : v1[j]) * rstd * g0[j] * (1.f + sc0[j]) + sh0[j];
                    a[4 + j] = (i == 0 ? v0[4 + j] : v1[4 + j]) * rstd * g1[j] * (1.f + sc1[j]) + sh1[j];
                }
                *(u32x4*)(p.H + (size_t)tok * DM + c) = pack8f(a);
            }
        }
    }
}

__device__ __forceinline__ bf16x8 pack8(const f32x4 a, const f32x4 b) {
    union { bf16x8 v; unsigned u[4]; } r;
    r.u[0] = pack2(a[0], a[1]); r.u[1] = pack2(a[2], a[3]); r.u[2] = pack2(b[0], b[1]); r.u[3] = pack2(b[2], b[3]);
    return r.v;
}
__device__ __forceinline__ void hgrn_chain(const Params& p, int chain, char* smem) {
    const int z = chain >> 6, b = (chain >> 3) & 7, h = chain & 7;
    const int tid = tidx(), lane = tid & 63, wid = tid >> 6, fr = lane & 15, fq = lane >> 4;
    bf16_t* sQ = (bf16_t*)smem;
    bf16_t* sK = sQ + 32 * 128;
    bf16_t* sKL = sK + 32 * 128;
    bf16_t* sV = sKL + 128 * 32;
    float* sT = (float*)(sV + 128 * 32);
    float* sEBL = sT + 1024;
    const int cp = tid & 63, g4 = tid >> 6;
    f32x4 S[8];
#pragma unroll
    for (int mi = 0; mi < 8; ++mi) S[mi] = (f32x4){0.f, 0.f, 0.f, 0.f};
    unsigned qA[4], fA[4], iA[4], qB[4], fB[4], iB[4];
    auto issue = [&](int chunk, unsigned (&rq)[4], unsigned (&rf)[4], unsigned (&ri)[4]) {
        const int tok0 = scan_tok(z, b, chunk * 32 + g4 * 4);
        const unsigned* pr = (const unsigned*)((const bf16_t*)p.P + (size_t)tok0 * ODC + h * 128) + cp;
        const int stride = z == 0 ? ODC / 2 : -(ODC / 2);
#pragma unroll
        for (int i = 0; i < 4; ++i) {
            rq[i] = pr[0]; rf[i] = pr[512 * (1 + z)]; ri[i] = pr[1536];
            pr += stride;
        }
    };
    issue(0, qA, fA, iA);
    issue(1, qB, fB, iB);
    auto body = [&](int chunk, unsigned (&rq)[4], unsigned (&rf)[4], unsigned (&ri)[4]) {
        float bc0[4], bc1[4], k0[4], k1[4];
        {
            float run0 = 1.f, run1 = 1.f;
#pragma unroll
            for (int i = 0; i < 4; ++i) {
                k0[i] = __uint_as_float(rf[i] << 16); k1[i] = __uint_as_float(rf[i] & 0xffff0000u);
                run0 *= 1.f - k0[i]; run1 *= 1.f - k1[i];
                bc0[i] = run0; bc1[i] = run1;
            }
            *(f32x2_*)(sT + g4 * 128 + 2 * cp) = (f32x2_){run0, run1};
        }
        __syncthreads();
        {
            float boff0 = 1.f, boff1 = 1.f, ebl0 = 1.f, ebl1 = 1.f;
#pragma unroll
            for (int j = 0; j < 8; ++j) {
                const f32x2_ t = *(const f32x2_*)(sT + j * 128 + 2 * cp);
                if (j < g4) { boff0 *= t[0]; boff1 *= t[1]; }
                ebl0 *= t[0]; ebl1 *= t[1];
            }
            if (g4 == 0) *(f32x2_*)(sEBL + 2 * cp) = (f32x2_){ebl0, ebl1};
            float kl0[4], kl1[4];
#pragma unroll
            for (int i = 0; i < 4; ++i) {
                const int t = g4 * 4 + i;
                const float eb0 = bc0[i] * boff0, eb1 = bc1[i] * boff1;
                const float emb0 = __builtin_amdgcn_rcpf(eb0), emb1 = __builtin_amdgcn_rcpf(eb1);
                const float qe0 = __uint_as_float(rq[i] << 16) * eb0, qe1 = __uint_as_float(rq[i] & 0xffff0000u) * eb1;
                const float ke0 = k0[i] * emb0, ke1 = k1[i] * emb1;
                kl0[i] = ke0 * ebl0; kl1[i] = ke1 * ebl1;
                const int off = t * 128 + (((cp >> 2) ^ (t & 15)) << 3) + ((cp & 3) << 1);
                *(unsigned*)(sQ + off) = pack2(qe0, qe1);
                *(unsigned*)(sK + off) = pack2(ke0, ke1);
            }
            const int ch0 = 2 * cp;
            const int o2 = ch0 * 32 + (((g4 >> 1) ^ ((ch0 >> 2) & 3)) << 3) + (g4 & 1) * 4;
            *(uint2*)(sKL + o2) = make_uint2(pack2(kl0[0], kl0[1]), pack2(kl0[2], kl0[3]));
            *(uint2*)(sKL + o2 + 32) = make_uint2(pack2(kl1[0], kl1[1]), pack2(kl1[2], kl1[3]));
            *(uint2*)(sV + o2) = make_uint2((ri[0] & 0xffffu) | (ri[1] << 16), (ri[2] & 0xffffu) | (ri[3] << 16));
            *(uint2*)(sV + o2 + 32) = make_uint2((ri[0] >> 16) | (ri[1] & 0xffff0000u), (ri[2] >> 16) | (ri[3] & 0xffff0000u));
        }
        __syncthreads();
        if (chunk + 2 < 72) issue(chunk + 2, rq, rf, ri);
        f32x4 sc00 = (f32x4){0.f, 0.f, 0.f, 0.f}, sc01 = sc00, sc11 = sc00;
#pragma unroll
        for (int ks = 0; ks < 4; ++ks) {
            const int c = ks * 4 + fq;
            const bf16x8 k0 = *(const bf16x8*)(sK + fr * 128 + ((c ^ fr) << 3));
            const bf16x8 k1 = *(const bf16x8*)(sK + (16 + fr) * 128 + ((c ^ fr) << 3));
            const bf16x8 q0 = *(const bf16x8*)(sQ + fr * 128 + ((c ^ fr) << 3));
            const bf16x8 q1 = *(const bf16x8*)(sQ + (16 + fr) * 128 + ((c ^ fr) << 3));
            sc00 = __builtin_amdgcn_mfma_f32_16x16x32_bf16(k0, q0, sc00, 0, 0, 0);
            sc01 = __builtin_amdgcn_mfma_f32_16x16x32_bf16(k0, q1, sc01, 0, 0, 0);
            sc11 = __builtin_amdgcn_mfma_f32_16x16x32_bf16(k1, q1, sc11, 0, 0, 0);
        }
#pragma unroll
        for (int j = 0; j < 4; ++j) { if (4 * fq + j > fr) { sc00[j] = 0.f; sc11[j] = 0.f; } }
        const f32x4 zero4 = (f32x4){0.f, 0.f, 0.f, 0.f};
        const bf16x8 pf0 = pack8(sc00, zero4), pf1 = pack8(sc01, sc11);
        asm volatile("" ::: "memory");
        f32x4 o[2];
        o[0] = zero4; o[1] = zero4;
        const int r0 = wid * 16 + fr;
        {
            union { bf16x8 v; uint2 u[2]; } vp0;
            vp0.u[0] = *(const uint2*)(sV + r0 * 32 + ((((fq >> 1)) ^ ((r0 >> 2) & 3)) << 3) + (fq & 1) * 4);
            vp0.u[1] = *(const uint2*)(sV + r0 * 32 + (((2 + (fq >> 1)) ^ ((r0 >> 2) & 3)) << 3) + (fq & 1) * 4);
            o[0] = __builtin_amdgcn_mfma_f32_16x16x32_bf16(vp0.v, pf0, o[0], 0, 0, 0);
            o[1] = __builtin_amdgcn_mfma_f32_16x16x32_bf16(vp0.v, pf1, o[1], 0, 0, 0);
        }
#pragma unroll
        for (int kp = 0; kp < 4; ++kp) {
            const bf16x8 sf0 = pack8(S[2 * kp], S[2 * kp + 1]);
            const int c0 = 4 * kp + (fq >> 1), c1 = c0 + 2;
            union { bf16x8 v; uint2 u[2]; } qa, qb;
            qa.u[0] = *(const uint2*)(sQ + fr * 128 + ((c0 ^ fr) << 3) + (fq & 1) * 4);
            qa.u[1] = *(const uint2*)(sQ + fr * 128 + ((c1 ^ fr) << 3) + (fq & 1) * 4);
            qb.u[0] = *(const uint2*)(sQ + (16 + fr) * 128 + ((c0 ^ fr) << 3) + (fq & 1) * 4);
            qb.u[1] = *(const uint2*)(sQ + (16 + fr) * 128 + ((c1 ^ fr) << 3) + (fq & 1) * 4);
            o[0] = __builtin_amdgcn_mfma_f32_16x16x32_bf16(sf0, qa.v, o[0], 0, 0, 0);
            o[1] = __builtin_amdgcn_mfma_f32_16x16x32_bf16(sf0, qb.v, o[1], 0, 0, 0);
        }
        if (chunk >= 8) {
#pragma unroll
            for (int tb = 0; tb < 2; ++tb) {
                const int tok = scan_tok(z, b, chunk * 32 + tb * 16 + fr);
                *(uint2*)((bf16_t*)p.HO + ((size_t)z * NX + tok) * 1024 + h * 128 + wid * 16 + fq * 4) = make_uint2(pack2(o[tb][0], o[tb][1]), pack2(o[tb][2], o[tb][3]));
            }
        }
        asm volatile("" ::: "memory");
        {
            const bf16x8 v0 = *(const bf16x8*)(sV + r0 * 32 + ((fq ^ ((r0 >> 2) & 3)) << 3));
#pragma unroll
            for (int mi = 0; mi < 8; ++mi) {
                const int r = mi * 16 + fr;
                const bf16x8 kl = *(const bf16x8*)(sKL + r * 32 + ((fq ^ ((r >> 2) & 3)) << 3));
                const f32x4 e = *(const f32x4*)(sEBL + mi * 16 + fq * 4);
                S[mi] = __builtin_amdgcn_mfma_f32_16x16x32_bf16(kl, v0, S[mi] * e, 0, 0, 0);
            }
        }
    };
    for (int chunk = 0; chunk < 72; chunk += 2) { body(chunk, qA, fA, iA); body(chunk + 1, qB, fB, iB); }
    __syncthreads();
}
__device__ __forceinline__ void phase_hgrn(const Params& p, int bid, int nblk, char* smem) {
    for (int it = bid; it < 128; it += nblk) hgrn_chain(p, it, smem);
    const int n_all = ((16384 + 8192) / 2) / CONV_GRP;
    for (;;) {
        const int it = q_next(p.counts + 65, smem);
        if (it >= n_all) break;
        conv_group<true>(p, it, smem);
    }
}
__device__ __forceinline__ void phase_hgrn_readout(const Params& p, int bid, int nblk) {
    const int lane = tidx() & 63, wid = tidx() >> 6;
    const int c0 = lane * 8;
    const f32x4 n0 = *(const f32x4*)(p.hg_norm + (c0 & 127)), n1 = *(const f32x4*)(p.hg_norm + (c0 & 127) + 4);
    for (int tok = bid * 8 + wid; tok < NX; tok += nblk * 8) {
#pragma unroll
        for (int q = 0; q < 2; ++q) {
            const size_t o = (size_t)tok * 1024 + q * 512 + c0, zo = (size_t)NX * 1024;
            float ta[8], tb[8], tg[8];
            unpack8(*(const u32x4*)((const bf16_t*)p.HO + o), ta); unpack8(*(const u32x4*)((const bf16_t*)p.HO + zo + o), tb);
            unpack8(*(const u32x4*)((const bf16_t*)p.P + (size_t)tok * ODC + 4096 + q * 512 + c0), tg);
            const f32x4 y0 = (f32x4){ta[0] + tb[0], ta[1] + tb[1], ta[2] + tb[2], ta[3] + tb[3]}, y1 = (f32x4){ta[4] + tb[4], ta[5] + tb[5], ta[6] + tb[6], ta[7] + tb[7]};
            const f32x4 g0 = (f32x4){tg[0], tg[1], tg[2], tg[3]}, g1 = (f32x4){tg[4], tg[5], tg[6], tg[7]};
            float ss = sum8((y0[0] * y0[0] + y0[1] * y0[1]) + (y0[2] * y0[2] + y0[3] * y0[3]) + (y1[0] * y1[0] + y1[1] * y1[1]) + (y1[2] * y1[2] + y1[3] * y1[3]));
            ss += dpp_f<0x140>(ss);
            const float rstd = rsqrtf(ss * (1.0f / 128.0f) + 1e-6f);
            float r[8];
#pragma unroll
            for (int j = 0; j < 4; ++j) { r[j] = y0[j] * rstd * n0[j] * siluf_(g0[j]); r[4 + j] = y1[j] * rstd * n1[j] * siluf_(g1[j]); }
            *(u32x4*)(p.MG + o) = (u32x4){pack2(r[0], r[1]), pack2(r[2], r[3]), pack2(r[4], r[5]), pack2(r[6], r[7])};
        }
    }
}

#define N_PHASES 20
__device__ __forceinline__ void run_phase(const Params& p, int ph, int bid, int nblk, char* smem) {
    const float* mod0 = p.mod;
    const float* mod1 = p.mod + 9 * 6144;
    switch (ph) {
    case 0: phase0a(p, bid, nblk, smem); break;
    case 1: phase0b(p, bid, nblk); break;
    case 2: phase_norm(p, bid, nblk, p.x, p.ctx, p.norm1_g, mod0, 0, NT); break;
    case 3: phase_gemm8_store_bf(p.H, NT, p.wt_evin, EVC, (bf16_t*)p.P, bid, nblk, smem); break;
    case 4: phase_feat0(p, bid, nblk, smem); break;
    case 5: phase_lora(p, bid, nblk, smem); break;
    case 6: phase_scan_attn(p, bid, nblk, smem); break;
    case 7: phase_rw_readout(p, bid, nblk); break;
    case 8: phase_outproj8<false>(p, bid, nblk, smem, p.wt_evout, NT, p.x, p.ctx, p.X1, mod0 + 2048); break;
    case 9: phase_router(p, bid, nblk, smem, 0, p.X1, NT); break;
    case 10: phase_moe_gu8(p, bid, nblk, smem, 0); break;
    case 11: phase_moe_dn8(p, bid, nblk, smem, 0); break;
    case 12: phase_combine<true>(p, bid, nblk, p.X1, p.X2, mod0 + 5120, NT, true, p.norm1_g + DM, mod1); break;
    case 13: phase_gemm8_store_hg(p, bid, nblk, smem); break;
    case 14: phase_hgrn(p, bid, nblk, smem); break;
    case 15: phase_hgrn_readout(p, bid, nblk); break;
    case 16: phase_outproj8<true>(p, bid, nblk, smem, p.wt_odout, NX, p.X2, p.X2 + (size_t)NX * DM, p.X1, mod1 + 2048); break;
    case 17: phase_router(p, bid, nblk, smem, 1, p.X1, NX); break;
    case 18: phase_moe_gu8(p, bid, nblk, smem, 1); break;
    case 19: phase_moe_dn8(p, bid, nblk, smem, 1); break;
    default: break;
    }
}
__device__ __forceinline__ void final_phase(const Params& p, int bid, int nblk) {
    phase_combine<false>(p, bid, nblk, p.X1, p.out, p.mod + 9 * 6144 + 5120, NX, false, nullptr, nullptr);
}

struct KArgs { const float* in[35]; float* out; char* ws; };

__host__ __device__ __forceinline__ size_t make_params(Params& p, const KArgs& a) {
    const float** ins = (const float**)&p;
    for (int i = 0; i < 35; ++i) ins[i] = a.in[i];
    p.out = a.out;
    char* ws = a.ws;
    size_t off = 0;
#define TAKE(bytes) (ws + off); off += (((size_t)(bytes)) + 255) & ~(size_t)255
    p.bar = (unsigned*)TAKE(16384);
    p.counts = (int*)TAKE(1024);
    p.scal = (float*)TAKE(256);
    p.mod = (float*)TAKE((size_t)2 * 9 * 6144 * 4);
    p.mod_part = (float*)TAKE((size_t)16 * 2 * 9 * 6144 * 4);
    p.rope_cos = (float*)TAKE((size_t)65536 * 4);
    p.rope_sin = (float*)TAKE((size_t)65536 * 4);
    p.wt_evin = (bf16_t*)TAKE((size_t)EVC * 1024 * 2);
    p.wt_evout = (bf16_t*)TAKE((size_t)1024 * 1024 * 2);
    p.wt_odin = (bf16_t*)TAKE((size_t)ODC * 1024 * 2);
    p.wt_odout = (bf16_t*)TAKE((size_t)1024 * 1024 * 2);
    p.wt_w2 = (bf16_t*)TAKE((size_t)1024 * 64 * 2);
    p.wt_a2 = (bf16_t*)TAKE((size_t)1024 * 64 * 2);
    p.wt_g2 = (bf16_t*)TAKE((size_t)512 * 128 * 2);
    p.wt_gu = (bf16_t*)TAKE((size_t)64 * 2048 * 1024 * 2);
    p.wt_dn = (bf16_t*)TAKE((size_t)64 * 1024 * 1024 * 2);
    p.lists = (int*)TAKE((size_t)2 * NEXP * NT * 4);
    p.GATE = (float*)TAKE((size_t)NASG * 4);
    p.H = (bf16_t*)TAKE((size_t)NT * DM * 2);
    p.MG = (bf16_t*)TAKE((size_t)NT * DM * 2);
    p.X1 = (bf16_t*)TAKE((size_t)NT * DM * 2);
    p.X2 = (bf16_t*)TAKE((size_t)NT * DM * 2);
    const size_t scratch0 = off;
    p.P = (float*)TAKE((size_t)NT * ODC * 4);
    const size_t after_p = off;
    p.Q = (bf16_t*)TAKE((size_t)8 * 8 * SEQ * 64 * 2);
    p.Qc = (bf16_t*)TAKE((size_t)8 * 8 * CTXL * 64 * 2);
    p.Kd = (bf16_t*)TAKE((size_t)8 * 8 * NKEY * 64 * 2);
    p.Vd = (bf16_t*)TAKE((size_t)8 * 4 * NKEY * 128 * 2);
    p.rR = (bf16_t*)TAKE((size_t)NT * 512 * 2);
    p.rK = (bf16_t*)TAKE((size_t)NT * 512 * 2);
    p.rV = (bf16_t*)TAKE((size_t)NT * 512 * 2);
    p.rKK = (bf16_t*)TAKE((size_t)NT * 512 * 2);
    p.rG = (bf16_t*)TAKE((size_t)NT * 512 * 2);
    p.rW = (float*)TAKE((size_t)2 * NT * 512 * 4);
    p.rKD = (bf16_t*)TAKE((size_t)2 * NT * 512 * 2);
    p.rBV = (bf16_t*)TAKE((size_t)2 * NT * 512 * 2);
    p.rY = (float*)TAKE((size_t)2 * NT * 512 * 4);
    p.rTW = (bf16_t*)TAKE((size_t)NT * 64 * 2);
    p.rAD = (bf16_t*)TAKE((size_t)NT * 64 * 2);
    p.rSG = (bf16_t*)TAKE((size_t)NT * 128 * 2);
    const size_t end_l0 = off;
    off = after_p;
    p.HO = (float*)TAKE((size_t)2 * NX * 1024 * 4);
    const size_t end_l1 = off;
    off = scratch0;
    p.ACT = (bf16_t*)TAKE((size_t)NASG * 1024 * 2);
    p.YS = (bf16_t*)TAKE((size_t)NASG * 1024 * 2);
    const size_t end_moe = off;
#undef TAKE
    size_t total = end_l0 > end_l1 ? end_l0 : end_l1;
    if (end_moe > total) total = end_moe;
    return total;
}

#if MULTI_LAUNCH
template <int PH>
__global__ void __launch_bounds__(256, 2) k_phase(KArgs a) {
    Params p; make_params(p, a);
    __shared__ __attribute__((aligned(16))) char smem[SMEM_BYTES];
    if (PH < N_PHASES) run_phase(p, PH, blockIdx.x, gridDim.x, smem);
    else final_phase(p, blockIdx.x, gridDim.x);
}
template <int PH> static void launch_all(const KArgs& p, hipStream_t stream) {
    hipLaunchKernelGGL(k_phase<PH>, dim3(1024), dim3(256), 0, stream, p);
    if constexpr (PH < N_PHASES) launch_all<PH + 1>(p, stream);
}
#else
__global__ void __launch_bounds__(NTHR, 2) k_mega(KArgs a) {
    Params p; make_params(p, a);
    extern __shared__ __attribute__((aligned(16))) char smem[];
    cg::grid_group grid = cg::this_grid();
    const int bid = blockIdx.x, nblk = gridDim.x;
    volatile LAS unsigned* st = (volatile LAS unsigned*)(smem + SMEM_BYTES);
    if (tidx() == 0) { st[0] = 0u; st[1] = 0u; }
    __syncthreads();
    const XcdBarrier xb = xcd_barrier_post(p.bar, st);
    run_phase(p, 0, bid, nblk, smem);
    if (a.ws == nullptr) grid.sync();
    xcd_barrier(xb);
    if (EXTRA == 4) { run_phase(p, 0, bid, nblk, smem); xcd_barrier(xb); }
#ifndef REPMASK
#define REPMASK 0u
#endif
#define PH(n) run_phase(p, n, bid, nblk, smem); xcd_barrier(xb); if ((REPMASK >> n) & 1u) { run_phase(p, n, bid, nblk, smem); xcd_barrier(xb); } \
    if (EXTRA == 6 && n == 6) { if (bid == 0 && tidx() == 0) p.counts[64] = 0; xcd_barrier(xb); run_phase(p, 6, bid, nblk, smem); xcd_barrier(xb); } \
    if (EXTRA == 5 && n == 9) { phase_router(p, bid, nblk, smem, 0, p.X1, NT, true); xcd_barrier(xb); } if (EXTRA == 5 && n == 17) { phase_router(p, bid, nblk, smem, 1, p.X1, NX, true); xcd_barrier(xb); }
    PH(1) PH(2) PH(3) PH(4) PH(5) PH(6) PH(7) PH(8) PH(9) PH(10) PH(11) PH(12) PH(13) PH(14) PH(15) PH(16) PH(17) PH(18) PH(19)
#undef PH
    final_phase(p, bid, nblk);
}
#endif


extern "C" void kernel_launch(void* const* d_in, const int* in_sizes, int n_in, void* d_out, int out_size, void* d_ws, size_t ws_size, hipStream_t stream) {
    KArgs a{};
    for (int i = 0; i < 35; ++i) a.in[i] = (const float*)d_in[i];
    a.out = (float*)d_out;
    a.ws = (char*)d_ws;
    Params p{};
    const size_t total = make_params(p, a);
    if (total > ws_size) { fprintf(stderr, "workspace too small: need %zu have %zu\n", total, ws_size); return; }

#if MULTI_LAUNCH
    launch_all<0>(a, stream);
#else
    static int grid_blocks = 0;
    if (!grid_blocks) {
        int dev = 0, cus = 0, per_cu = 0;
        hipGetDevice(&dev);
        hipDeviceGetAttribute(&cus, hipDeviceAttributeMultiprocessorCount, dev);
        hipFuncSetAttribute((const void*)k_mega, hipFuncAttributeMaxDynamicSharedMemorySize, SMEM_BYTES + 16);
        hipOccupancyMaxActiveBlocksPerMultiprocessor(&per_cu, k_mega, NTHR, SMEM_BYTES + 16);
        if (per_cu > 1) per_cu = 1;
        if (per_cu < 1) per_cu = 1;
        grid_blocks = cus * per_cu;
    }
    hipMemsetAsync(p.bar, 0, XCD_BAR_WORDS * 4, stream);
    void* args[] = {(void*)&a};
    hipError_t e = hipLaunchCooperativeKernel((void*)k_mega, dim3(grid_blocks), dim3(NTHR), args, SMEM_BYTES + 16, stream);
    if (e != hipSuccess) fprintf(stderr, "cooperative launch failed: %s (grid %d)\n", hipGetErrorString(e), grid_blocks);
#endif
}
```

```cpp
#include <hip/hip_runtime.h>
#include <hip/hip_cooperative_groups.h>
#include <stdint.h>
#include <stdio.h>

namespace cg = cooperative_groups;

typedef unsigned short bf16_t;
typedef short bf16x8 __attribute__((ext_vector_type(8)));
typedef float f32x4 __attribute__((ext_vector_type(4)));
typedef unsigned u32x4 __attribute__((ext_vector_type(4)));

#define NX 16384
#define NC 2048
#define NT 18432
#define DM 1024
#define SEQ 2048
#define CTXL 256
#define NKEY 2304
#define EVC 3328
#define ODC 5120
#define NEXP 32
#define NASG (NT * 4)
#ifndef EXTRA
#define EXTRA 0
#endif
#define NTHR 512
#define SMEM_BYTES 131072
#define HLDS 65536

#ifndef MULTI_LAUNCH
#define MULTI_LAUNCH 0
#endif

struct Params {
    const float *x, *c, *ctx, *c_ctx, *ada_w, *ada_b, *norm1_g, *norm2_g, *ev_w_in, *ev_w_out, *da_q_norm, *da_k_norm,
        *da_lambda, *da_subln, *rw_mu, *rw_w0, *rw_w2, *rw_a0, *rw_a2, *rw_g2, *rw_k_k, *rw_k_a, *rw_r_k, *rw_ln_w,
        *rw_ln_b, *od_w_in, *od_w_out, *hg_norm, *hg_lb, *router_w, *router_b, *moe_w_gu, *moe_b_gu, *moe_w_dn, *moe_b_dn;
    float* out;
    bf16_t *wt_evin, *wt_evout, *wt_odin, *wt_odout, *wt_gu, *wt_dn, *wt_w2, *wt_a2, *wt_g2;
    float *mod_part, *mod, *rope_cos, *rope_sin, *scal;
    int *counts, *lists;
    unsigned* bar;
    bf16_t* H;
    float* P;
    bf16_t *Q, *Qc, *Kd, *Vd;
    bf16_t *rR, *rK, *rV, *rKK, *rKD, *rBV, *rG, *rY;
    float *rW;
    bf16_t *rTW, *rAD, *rSG;
    bf16_t* MG;
    bf16_t *X1, *X2;
    float* GATE;
    bf16_t* ACT;
    bf16_t* YS;
    float* HO;
};

typedef float f32x2_ __attribute__((ext_vector_type(2)));
typedef __bf16 bf16x2_ __attribute__((ext_vector_type(2)));
__device__ __forceinline__ unsigned pack2(float a, float b) {
    const f32x2_ v = {a, b};
    return __builtin_bit_cast(unsigned, __builtin_convertvector(v, bf16x2_));
}
__device__ __forceinline__ bf16_t f2bf(float f) { return (bf16_t)(pack2(f, 0.f) & 0xffffu); }
__device__ __forceinline__ int tidx() { int t = __builtin_amdgcn_workitem_id_x(); asm volatile("" : "+v"(t)); return t; }
__device__ __forceinline__ int uni(int v) { return __builtin_amdgcn_readfirstlane(v); }
template <class T> __device__ __forceinline__ T* uni_ptr(T* ptr) {
    const unsigned long long v = (unsigned long long)ptr;
    const unsigned lo = (unsigned)__builtin_amdgcn_readfirstlane((int)(unsigned)v), hi = (unsigned)__builtin_amdgcn_readfirstlane((int)(unsigned)(v >> 32));
    return (T*)(((unsigned long long)hi << 32) | lo);
}
__device__ __forceinline__ float bf2f(bf16_t h) { return __uint_as_float(((unsigned)h) << 16); }
template <int CTRL, int ROWMASK> __device__ __forceinline__ float dpp_zero(float x) {
    return __int_as_float(__builtin_amdgcn_update_dpp(0, __float_as_int(x), CTRL, ROWMASK, 0xf, false));
}
__device__ __forceinline__ float wave_sum(float v) {
    v += dpp_zero<0xB1, 0xf>(v);
    v += dpp_zero<0x4E, 0xf>(v);
    v += dpp_zero<0x141, 0xf>(v);
    v += dpp_zero<0x140, 0xf>(v);
    v += dpp_zero<0x142, 0xa>(v);
    v += dpp_zero<0x143, 0xc>(v);
    return __int_as_float(__builtin_amdgcn_readlane(__float_as_int(v), 63));
}
template <int CTRL> __device__ __forceinline__ float dpp_f(float x) {
    return __int_as_float(__builtin_amdgcn_mov_dpp(__float_as_int(x), CTRL, 0xf, 0xf, true));
}
__device__ __forceinline__ float sum8(float x) {
    x += dpp_f<0xB1>(x);
    x += dpp_f<0x4E>(x);
    x += dpp_f<0x141>(x);
    return x;
}
__device__ __forceinline__ float sigmoidf_(float x) { return __builtin_amdgcn_rcpf(1.0f + __expf(-x)); }
__device__ __forceinline__ float siluf_(float x) { return x * __builtin_amdgcn_rcpf(1.0f + __expf(-x)); }
__device__ __forceinline__ int modrow(int tok) { return tok < NX ? (tok >> 11) : 8; }


#define XB_TMO      128
#define XB_XCNT(j)  (256  + 64 * (j))
#define XB_XSUB(j)  (1280 + 64 * (j))
#define XB_XGEN(j)  (2304 + 64 * (j))
#define XB_TOP      3328
#define XB_TOPGEN   3392
#define XCD_BAR_WORDS 3456
#define XB_SPIN_CAP (1u << 27)
#define LAS __attribute__((address_space(3)))
__device__ __forceinline__ unsigned xb_ld(unsigned* p)              { return __hip_atomic_load(p, __ATOMIC_RELAXED, __HIP_MEMORY_SCOPE_AGENT); }
__device__ __forceinline__ unsigned xb_add(unsigned* p, unsigned v) { return __hip_atomic_fetch_add(p, v, __ATOMIC_RELAXED, __HIP_MEMORY_SCOPE_AGENT); }
__device__ __forceinline__ unsigned xb_xcc_id() { return (unsigned)__builtin_amdgcn_s_getreg((3 << 11) | 20) & 0xFu; }
#define XB_SPIN(cond, bar) do { unsigned _sp = 0; while (cond) { __builtin_amdgcn_s_sleep(1); \
    if ((++_sp & 255u) == 0u) { if (xb_ld(&(bar)[XB_TMO])) break; if (_sp > XB_SPIN_CAP) { atomicAdd(&(bar)[XB_TMO], 1u); break; } } } } while (0)
struct XcdBarrier { unsigned* bar; unsigned x; volatile LAS unsigned* st; };
__device__ __forceinline__ XcdBarrier xcd_barrier_post(unsigned* bar, volatile LAS unsigned* st) {
    XcdBarrier b; b.bar = bar; b.x = xb_xcc_id(); b.st = st;
    if (tidx() == 0) (void)xb_add(&bar[XB_XCNT(b.x)], 1u);
    return b;
}
__device__ __forceinline__ void xcd_barrier_complete(unsigned* bar, unsigned x, unsigned& nloc, unsigned& nx) {
    const unsigned G = gridDim.x * gridDim.y * gridDim.z;
    unsigned sum, cnt, mine, sp = 0u;
    for (;;) {
        sum = 0u; cnt = 0u; mine = 0u;
#pragma unroll
        for (unsigned j = 0; j < 16; ++j) { const unsigned c = xb_ld(&bar[XB_XCNT(j)]); sum += c; cnt += (c > 0u) ? 1u : 0u; mine = (j == x) ? c : mine; }
        if (sum == G) break;
        __builtin_amdgcn_s_sleep(1);
        if ((++sp & 255u) == 0u) { if (xb_ld(&bar[XB_TMO])) break; if (sp > XB_SPIN_CAP) { atomicAdd(&bar[XB_TMO], 1u); break; } }
    }
    nloc = mine > 0u ? mine : 1u; nx = cnt > 0u ? cnt : 1u;
}
__device__ __forceinline__ void xcd_barrier(const XcdBarrier& b) {
    asm volatile("s_waitcnt vmcnt(0)" ::: "memory");
    __syncthreads();
    if (tidx() == 0) {
        unsigned* bar = b.bar;
        __builtin_amdgcn_s_waitcnt(0);
        unsigned nloc = b.st[0], nx = b.st[1];
        if (nloc == 0u) { xcd_barrier_complete(bar, b.x, nloc, nx); b.st[0] = nloc; b.st[1] = nx; }
        const unsigned old = xb_add(&bar[XB_XSUB(b.x)], 1u);
        const unsigned gen = old / nloc;
        if (old + 1u == (gen + 1u) * nloc) {
            __builtin_amdgcn_fence(__ATOMIC_RELEASE, "agent");
            asm volatile("s_waitcnt vmcnt(0)" ::: "memory");
            const unsigned og = xb_add(&bar[XB_TOP], 1u);
            const unsigned tg = og / nx;
            if (og + 1u == (tg + 1u) * nx) xb_add(&bar[XB_TOPGEN], 1u);
            else XB_SPIN(xb_ld(&bar[XB_TOPGEN]) == tg, bar);
            __builtin_amdgcn_fence(__ATOMIC_ACQUIRE, "agent");
            xb_add(&bar[XB_XGEN(b.x)], 1u);
            asm volatile("s_waitcnt vmcnt(0)" ::: "memory");
        } else {
            XB_SPIN(xb_ld(&bar[XB_XGEN(b.x)]) == gen, bar);
            __builtin_amdgcn_fence(__ATOMIC_ACQUIRE, "agent");
            asm volatile("s_waitcnt vmcnt(0)" ::: "memory");
        }
    }
    __syncthreads();
}


__device__ __forceinline__ int q_next(int* ctr, char* smem) {
    volatile unsigned* slot = (volatile unsigned*)(smem + SMEM_BYTES + 8);
    __syncthreads();
    if (tidx() == 0) *slot = (unsigned)atomicAdd(ctr, 1);
    __syncthreads();
    return (int)*slot;
}

struct ARows {
    const bf16_t* base;
    int lda;
    const int* idx;
    int shift;
    int row0;
};

template <bool PAIRED, class Epi>
__device__ __forceinline__ void gemm_tile(const ARows ar, int mcount, const bf16_t* __restrict__ Bt, int ldb, int K, Epi& epi, char* smem) {
    const int tid = tidx() & 255, lane = tid & 63, wid = tid >> 6;
    const int wr = wid >> 1, wc = wid & 1, fr = lane & 15, fq = lane >> 4;
    bf16_t* sA = (bf16_t*)smem;
    bf16_t* sB = sA + 128 * 64;
    const int lrow = tid >> 3, lch = tid & 7;
    const bf16_t* aptr[4];
    const bf16_t* bptr[4];
#pragma unroll
    for (int i = 0; i < 4; ++i) {
        const int r = lrow + 32 * i;
        const int rr = r < mcount ? r : 0;
        const int rowid = ar.idx ? (ar.idx[rr] >> ar.shift) : (ar.row0 + rr);
        aptr[i] = ar.base + (size_t)rowid * ar.lda + lch * 8;
        bptr[i] = Bt + (size_t)r * ldb + lch * 8;
    }
    u32x4 ra[4], rb[4];
#pragma unroll
    for (int i = 0; i < 4; ++i) { ra[i] = *(const u32x4*)(aptr[i]); rb[i] = *(const u32x4*)(bptr[i]); }
    f32x4 acc[4][4];
#pragma unroll
    for (int m = 0; m < 4; ++m)
#pragma unroll
        for (int n = 0; n < 4; ++n) acc[m][n] = (f32x4){0.f, 0.f, 0.f, 0.f};
    const int nk = K >> 6;
    for (int kt = 0; kt < nk; ++kt) {
#pragma unroll
        for (int i = 0; i < 4; ++i) {
            const int r = lrow + 32 * i;
            const int off = r * 64 + ((lch ^ (r & 7)) << 3);
            *(u32x4*)(sA + off) = ra[i];
            *(u32x4*)(sB + off) = rb[i];
        }
        __syncthreads();
        if (kt + 1 < nk) {
#pragma unroll
            for (int i = 0; i < 4; ++i) { ra[i] = *(const u32x4*)(aptr[i] + (kt + 1) * 64); rb[i] = *(const u32x4*)(bptr[i] + (kt + 1) * 64); }
        }
#pragma unroll
        for (int ks = 0; ks < 2; ++ks) {
            bf16x8 af[4], bfr[4];
            const int ch = ks * 4 + fq;
#pragma unroll
            for (int m = 0; m < 4; ++m) { const int r = wr * 64 + m * 16 + fr; af[m] = *(const bf16x8*)(sA + r * 64 + ((ch ^ (r & 7)) << 3)); }
#pragma unroll
            for (int n = 0; n < 4; ++n) { const int r = wc * 64 + n * 16 + fr; bfr[n] = *(const bf16x8*)(sB + r * 64 + ((ch ^ (r & 7)) << 3)); }
#pragma unroll
            for (int m = 0; m < 4; ++m)
#pragma unroll
                for (int n = 0; n < 4; ++n) acc[m][n] = __builtin_amdgcn_mfma_f32_16x16x32_bf16(bfr[n], af[m], acc[m][n], 0, 0, 0);
        }
        __syncthreads();
    }
#pragma unroll
    for (int m = 0; m < 4; ++m) {
        const int r = wr * 64 + m * 16 + fr;
        if (r < mcount) {
            if constexpr (PAIRED) {
                epi.pair(r, wc * 32 + fq * 4, acc[m][0], acc[m][1]);
                epi.pair(r, wc * 32 + 16 + fq * 4, acc[m][2], acc[m][3]);
            } else {
#pragma unroll
                for (int n = 0; n < 4; ++n) epi.one(r, wc * 64 + n * 16 + fq * 4, acc[m][n]);
            }
        }
    }
}


namespace g8 {
#define G8_LAS __attribute__((address_space(3)))
constexpr int BM = 256, BK = 64, HALF = 128, HTB = HALF * BK * 2;
__device__ __forceinline__ int lds_byte(int r, int c) { const int st = (r >> 4) * 2 + (c >> 5), rr = r & 15, cc = c & 31, ob = rr * 64 + cc * 2; return st * 1024 + (ob ^ (((ob >> 9) & 1) << 5)); }
__device__ __forceinline__ void stage_rc(int b, int& R, int& C) { const int st = b / 1024, sb = b % 1024, swz = sb ^ (((sb >> 9) & 1) << 5); R = (st >> 1) * 16 + swz / 64; C = (st & 1) * 32 + (swz % 64) / 2; }
struct Unit {
    const char* a;
    const char* b;
    const int* gidx;
    const int* idx;
    int shift, rows;
    int i0, i1, i2;
};
template <class Epi, class Sched>
__device__ __forceinline__ void gemm_phase(G8_LAS unsigned char* lds, const int K, Sched& S, const Epi& E) {
    const int tid = tidx(), wid = __builtin_amdgcn_readfirstlane(tid >> 6), lane = tid & 63, wr = wid >> 2, wc = wid & 3, fr = lane & 15, fq = lane >> 4;
    const int nt = K / BK;
    int sR[2], sC[2];
    unsigned voffB[2];
#pragma unroll
    for (int i = 0; i < 2; ++i) { stage_rc(tid * 16 + i * 8192, sR[i], sC[i]); voffB[i] = (unsigned)(sR[i] * K + sC[i]) * 2u; }
    const size_t kstep = (size_t)(BK * 2);
    const size_t hstep = (size_t)HALF * K * 2;
    const unsigned ldsw = (unsigned)wid * 1024u;
    const int aoff = lds_byte(wr * 64 + fr, fq * 8), boff = lds_byte(wc * 32 + fr, fq * 8);
    auto a_offsets = [&](const Unit& u, unsigned (&o)[2][2]) {
#pragma unroll
        for (int h = 0; h < 2; ++h)
#pragma unroll
            for (int i = 0; i < 2; ++i) {
                int r = sR[i] + h * HALF;
                if (u.gidx) { r = r < u.rows ? r : (u.rows - 1); r = u.gidx[r] >> u.shift; }
                o[h][i] = (unsigned)(r * K + sC[i]) * 2u;
            }
    };
#define G8_SA(b, h) (((b) * 2 + (h)) * HTB)
#define G8_SB(b, h) ((4 + (b) * 2 + (h)) * HTB)
#define G8_STAGE2(bufoff, gbase, o0, o1) do { \
        __builtin_amdgcn_global_load_lds((const unsigned*)((const char*)(gbase) + (o0)), (G8_LAS unsigned*)(lds + (bufoff) + ldsw), 16, 0, 0); \
        __builtin_amdgcn_global_load_lds((const unsigned*)((const char*)(gbase) + (o1)), (G8_LAS unsigned*)(lds + (bufoff) + ldsw + 8192), 16, 0, 0); } while (0)
#define G8_STAGE_B(bufoff, gbase) G8_STAGE2(bufoff, gbase, voffB[0], voffB[1])
#define G8_LDA(dst, b, h) do { _Pragma("unroll") for (int m = 0; m < 4; ++m) _Pragma("unroll") for (int k = 0; k < 2; ++k) dst[m][k] = *(const G8_LAS bf16x8*)(lds + G8_SA(b, h) + aoff + m * 2048 + k * 1024); } while (0)
#define G8_LDB(dst, b, h) do { _Pragma("unroll") for (int n = 0; n < 2; ++n) _Pragma("unroll") for (int k = 0; k < 2; ++k) dst[n][k] = *(const G8_LAS bf16x8*)(lds + G8_SB(b, h) + boff + n * 2048 + k * 1024); } while (0)
#define G8_MMA(ai, bj, At, Bt) do { __builtin_amdgcn_s_setprio(1); _Pragma("unroll") for (int m = 0; m < 4; ++m) _Pragma("unroll") for (int n = 0; n < 2; ++n) _Pragma("unroll") for (int k = 0; k < 2; ++k) \
        acc[ai][bj][m][n] = __builtin_amdgcn_mfma_f32_16x16x32_bf16(Bt[n][k], At[m][k], acc[ai][bj][m][n], 0, 0, 0); __builtin_amdgcn_s_setprio(0); } while (0)
#define G8_WAIT_V(n) asm volatile("s_waitcnt vmcnt(" #n ")" ::: "memory")
#define G8_WAIT_L(n) asm volatile("s_waitcnt lgkmcnt(" #n ")" ::: "memory")
#define G8_BAR __builtin_amdgcn_s_barrier()
#define G8_SCHED __builtin_amdgcn_sched_barrier(0)
    Unit cur, nxt;
    if (!S.next(cur)) return;
    unsigned oc[2][2], on[2][2];
    a_offsets(cur, oc);
    f32x4 acc[2][2][4][2];
#pragma unroll
    for (int a = 0; a < 2; ++a)
#pragma unroll
        for (int b = 0; b < 2; ++b)
#pragma unroll
            for (int m = 0; m < 4; ++m)
#pragma unroll
                for (int n = 0; n < 2; ++n) acc[a][b][m][n] = (f32x4){0.f, 0.f, 0.f, 0.f};
    bf16x8 At[4][2], B0[2][2], B1[2][2];
    const char* cA = cur.a; const char* cB = cur.b;
    G8_STAGE_B(G8_SB(0, 0), cB); G8_STAGE_B(G8_SB(0, 1), cB + hstep); G8_STAGE2(G8_SA(0, 0), cA, oc[0][0], oc[0][1]); G8_STAGE2(G8_SA(0, 1), cA, oc[1][0], oc[1][1]);
    if (wr == 1) G8_BAR;
    G8_WAIT_V(2); G8_BAR;
    G8_STAGE_B(G8_SB(1, 0), cB + kstep); G8_STAGE2(G8_SA(1, 0), cA + kstep, oc[0][0], oc[0][1]); G8_STAGE_B(G8_SB(1, 1), cB + hstep + kstep);
    G8_WAIT_V(6); G8_BAR;
    for (;;) {
        const bool has_next = S.next(nxt);
        if (has_next) a_offsets(nxt, on);
        else {
#pragma unroll
            for (int h = 0; h < 2; ++h) { on[h][0] = oc[h][0]; on[h][1] = oc[h][1]; }
        }
        const char* nA = has_next ? nxt.a : cA; const char* nB = has_next ? nxt.b : cB;
        for (int t = 0; t < nt; t += 2) {
            const bool last = (t == nt - 2);
            const char* a1 = cA + (size_t)(t + 1) * kstep;
            const char* a2 = last ? nA : cA + (size_t)(t + 2) * kstep; const char* b2 = last ? nB : cB + (size_t)(t + 2) * kstep;
            const char* a3 = a2 + kstep; const char* b3 = b2 + kstep;
            const unsigned p00 = last ? on[0][0] : oc[0][0], p01 = last ? on[0][1] : oc[0][1], p10 = last ? on[1][0] : oc[1][0], p11 = last ? on[1][1] : oc[1][1];
            G8_LDB(B0, 0, 0); G8_LDB(B1, 0, 1); G8_SCHED; G8_LDA(At, 0, 0); G8_STAGE2(G8_SA(1, 1), a1, oc[1][0], oc[1][1]);
            G8_WAIT_V(8); G8_WAIT_L(0); G8_BAR; G8_MMA(0, 0, At, B0); G8_MMA(0, 1, At, B1); G8_BAR; G8_SCHED;
            G8_LDA(At, 0, 1); G8_STAGE_B(G8_SB(0, 0), b2); G8_STAGE_B(G8_SB(0, 1), b2 + hstep); G8_STAGE2(G8_SA(0, 0), a2, p00, p01);
            G8_WAIT_V(8); G8_WAIT_L(0); G8_BAR; G8_MMA(1, 0, At, B0); G8_MMA(1, 1, At, B1); G8_BAR; G8_SCHED;
            G8_LDB(B0, 1, 0); G8_LDB(B1, 1, 1); G8_SCHED; G8_LDA(At, 1, 0); G8_STAGE2(G8_SA(0, 1), a2, p10, p11);
            G8_WAIT_V(8); G8_WAIT_L(0); G8_BAR; G8_MMA(0, 0, At, B0); G8_MMA(0, 1, At, B1); G8_BAR; G8_SCHED;
            G8_LDA(At, 1, 1); G8_STAGE_B(G8_SB(1, 0), b3); G8_STAGE_B(G8_SB(1, 1), b3 + hstep); G8_STAGE2(G8_SA(1, 0), a3, p00, p01);
            G8_WAIT_V(8); G8_WAIT_L(0); G8_BAR; G8_MMA(1, 0, At, B0); G8_MMA(1, 1, At, B1); G8_BAR; G8_SCHED;
        }
        if (wr == 0) G8_BAR;
        E(acc, cur, wr, wc, fr, fq);
        if (!has_next) break;
#pragma unroll
        for (int a = 0; a < 2; ++a)
#pragma unroll
            for (int b = 0; b < 2; ++b)
#pragma unroll
                for (int m = 0; m < 4; ++m)
#pragma unroll
                    for (int n = 0; n < 2; ++n) acc[a][b][m][n] = (f32x4){0.f, 0.f, 0.f, 0.f};
        cur = nxt; cA = nA; cB = nB;
#pragma unroll
        for (int h = 0; h < 2; ++h) { oc[h][0] = on[h][0]; oc[h][1] = on[h][1]; }
        if (wr == 1) G8_BAR;
    }
    G8_WAIT_V(0);
    G8_BAR;
#undef G8_SA
#undef G8_SB
#undef G8_STAGE2
#undef G8_STAGE_B
#undef G8_LDA
#undef G8_LDB
#undef G8_MMA
#undef G8_WAIT_V
#undef G8_WAIT_L
#undef G8_BAR
#undef G8_SCHED
}
}

__device__ __forceinline__ int gu_row(int col) {
    const int half = col >> 10, unit = col & 1023, T = unit >> 7, ul = unit & 127, wc = ul >> 5, r = ul & 31, fq = r >> 3, bj = (r >> 2) & 1, jj = r & 3;
    return 256 * T + 128 * bj + 32 * wc + 16 * half + 4 * fq + jj;
}
__device__ __forceinline__ int p32_row(int col) {
    const int x = col & 31;
    return (col & ~31) + 16 * ((x >> 2) & 1) + 4 * (x >> 3) + (x & 3);
}
struct ConvDesc { const float* src; bf16_t* dst; int N, Kd, kt, nt, perm, pad; };
struct ConvRegs { f32x4 v0, v1, v2, v3; };
__device__ __forceinline__ ConvRegs conv_load(const ConvDesc& d) {
    const int tid = tidx() & 255, r = tid >> 4, c4 = (tid & 15) * 4;
    ConvRegs x;
    const float* b0 = d.src + (size_t)(d.kt * 64 + r) * d.N + d.nt * 64 + c4;
    x.v0 = *(const f32x4*)(b0); x.v1 = *(const f32x4*)(b0 + (size_t)16 * d.N); x.v2 = *(const f32x4*)(b0 + (size_t)32 * d.N); x.v3 = *(const f32x4*)(b0 + (size_t)48 * d.N);
    return x;
}
__device__ __forceinline__ void conv_store(const ConvRegs& x, const ConvDesc& d, float* lds) {
    const int tid = tidx() & 255;
    {
        const int r = tid >> 4, c4 = (tid & 15) * 4;
        float* q = lds + r * 65 + c4;
        q[0] = x.v0[0]; q[1] = x.v0[1]; q[2] = x.v0[2]; q[3] = x.v0[3];
        q[16 * 65 + 0] = x.v1[0]; q[16 * 65 + 1] = x.v1[1]; q[16 * 65 + 2] = x.v1[2]; q[16 * 65 + 3] = x.v1[3];
        q[32 * 65 + 0] = x.v2[0]; q[32 * 65 + 1] = x.v2[1]; q[32 * 65 + 2] = x.v2[2]; q[32 * 65 + 3] = x.v2[3];
        q[48 * 65 + 0] = x.v3[0]; q[48 * 65 + 1] = x.v3[1]; q[48 * 65 + 2] = x.v3[2]; q[48 * 65 + 3] = x.v3[3];
    }
    __syncthreads();
    {
        const int n = tid >> 2, kseg = (tid & 3) * 16;
        unsigned w[8];
#pragma unroll
        for (int j = 0; j < 8; ++j) w[j] = pack2(lds[(kseg + 2 * j) * 65 + n], lds[(kseg + 2 * j + 1) * 65 + n]);
        const int ncol = d.nt * 64 + n;
        const int row = d.perm == 1 ? gu_row(ncol) : (d.perm == 2 ? p32_row(ncol) : (d.perm == 3 ? ((ncol >> 6) * 128 + (ncol & 63)) : ncol));
        uint4* q = (uint4*)(d.dst + (size_t)row * d.Kd + d.kt * 64 + kseg);
        q[0] = make_uint4(w[0], w[1], w[2], w[3]);
        q[1] = make_uint4(w[4], w[5], w[6], w[7]);
    }
    __syncthreads();
}
__device__ __forceinline__ void conv_tile(const float* __restrict__ src, int N, bf16_t* __restrict__ dst, int Kd, int kt, int nt, int perm, float* lds) {
    const ConvDesc d{src, dst, N, Kd, kt, nt, perm, 0};
    const ConvRegs x = conv_load(d);
    conv_store(x, d, lds);
}

#define CONV_GRP 8
#define N_MODP 768
#define CV0 832
#define CV1 (CV0 + 16)
#define CV2 (CV1 + 16)
#define CV3 (CV2 + 16)
#define CV4 (CV3 + 256)
#define N_CONV CV4
#define N_ROPE 64
#define N_P0A (N_MODP + N_CONV + N_ROPE + 2)

__device__ __forceinline__ void phase0a(const Params& p, int bid, int nblk, char* smem) {
    const int half = tidx() >> 8, tid = tidx() & 255;
    float* lds = (float*)(smem + half * HLDS);
    for (int it0 = bid * 2; it0 < N_P0A; it0 += nblk * 2) {
        const int it = it0 + half;
        if (it < N_MODP) {
            const int l = it / 384, rem = it % 384, cb = rem / 16, kc = rem % 16;
            for (int e = tid; e < 9 * 64; e += 256) {
                const int r = e >> 6, k = e & 63;
                const float v = (r < 8) ? p.c[r * DM + kc * 64 + k] : p.c_ctx[kc * 64 + k];
                lds[e] = siluf_(v);
            }
            __syncthreads();
            const int col = cb * 256 + tid;
            const float* w = p.ada_w + (size_t)l * DM * 6144 + (size_t)(kc * 64) * 6144 + col;
            float acc[9];
#pragma unroll
            for (int r = 0; r < 9; ++r) acc[r] = 0.f;
#pragma unroll 1
            for (int k0 = 0; k0 < 64; k0 += 16) {
                float wv[16];
#pragma unroll
                for (int k = 0; k < 16; ++k) wv[k] = w[(size_t)(k0 + k) * 6144];
#pragma unroll
                for (int k = 0; k < 16; ++k)
#pragma unroll
                    for (int r = 0; r < 9; ++r) acc[r] += lds[r * 64 + k0 + k] * wv[k];
            }
#pragma unroll
            for (int r = 0; r < 9; ++r) p.mod_part[((size_t)(kc * 2 + l) * 9 + r) * 6144 + col] = acc[r];
            __syncthreads();
        } else if (it < N_MODP + N_CONV) {
            const int j = it - N_MODP;
            if (j < CV0) { conv_tile(p.ev_w_in, EVC, p.wt_evin, 1024, j / 52, j % 52, 2, lds); }
            else if (j < CV1) { const int q = j - CV0, z = q >> 3, nt = q & 7; conv_tile(p.rw_w2 + (size_t)z * 64 * 512, 512, p.wt_w2 + (size_t)z * 512 * 64, 64, 0, nt, 0, lds); }
            else if (j < CV2) { const int q = j - CV1, z = q >> 3, nt = q & 7; conv_tile(p.rw_a2 + (size_t)z * 64 * 512, 512, p.wt_a2 + (size_t)z * 64 * 64, 64, 0, nt, 3, lds); }
            else if (j < CV3) { const int q = j - CV2, kt = q >> 3, nt = q & 7; conv_tile(p.rw_g2, 512, p.wt_g2, 128, kt, nt, 0, lds); }
            else { const int q = j - CV3; conv_tile(p.ev_w_out, 1024, p.wt_evout, 1024, q >> 4, q & 15, 2, lds); }
        } else if (it < N_MODP + N_CONV + N_ROPE) {
            const int j = it - N_MODP - N_CONV;
#pragma unroll
            for (int i = 0; i < 4; ++i) {
                const int e = (j * 4 + i) * 256 + tid;
                const int t = e >> 5, a = (e >> 4) & 1, pp = e & 15;
                const float pos = (float)(a == 0 ? (t >> 6) : (t & 63));
                const float inv = powf(10000.0f, -(float)pp / 16.0f);
                const float ang = pos * inv;
                p.rope_cos[e] = cosf(ang);
                p.rope_sin[e] = sinf(ang);
            }
        } else if (it == N_MODP + N_CONV + N_ROPE) {
            if (tid < 64) {
                const float* lf = p.da_lambda;
                float a = lf[tid] * lf[64 + tid], b = lf[128 + tid] * lf[192 + tid];
                a = wave_sum(a); b = wave_sum(b);
                if (tid == 0) p.scal[0] = expf(a) - expf(b) + 0.2f;
            }
            if (tid < 128) p.counts[tid] = 0;
        }
    }
}

__device__ __forceinline__ void phase0b(const Params& p, int bid, int nblk) {
    for (int e = bid * NTHR + tidx(); e < 2 * 9 * 6144; e += nblk * NTHR) {
        const int l = e / (9 * 6144), rem = e % (9 * 6144);
        float s = p.ada_b[l * 6144 + rem % 6144];
#pragma unroll
        for (int kc = 0; kc < 16; ++kc) s += p.mod_part[(size_t)(kc * 2 + l) * 9 * 6144 + rem];
        p.mod[e] = s;
    }
}

__device__ __forceinline__ void phase_norm(const Params& p, int bid, int nblk, const float* xs_lat, const float* xs_ctx, const float* gain, const float* modl, int sh_off, int ntok) {
    const int lane = tidx() & 63, wid = tidx() >> 6;
    for (int tok = bid * 8 + wid; tok < ntok; tok += nblk * 8) {
        const float* xr = tok < NX ? xs_lat + (size_t)tok * DM : xs_ctx + (size_t)(tok - NX) * DM;
        const float* mr = modl + modrow(tok) * 6144 + sh_off;
        float4 v[4];
        float ss = 0.f;
#pragma unroll
        for (int i = 0; i < 4; ++i) { v[i] = *(const float4*)(xr + lane * 4 + 256 * i); ss += v[i].x * v[i].x + v[i].y * v[i].y + v[i].z * v[i].z + v[i].w * v[i].w; }
        ss = wave_sum(ss);
        const float rstd = rsqrtf(ss * (1.0f / 1024.0f) + 1e-6f);
#pragma unroll
        for (int i = 0; i < 4; ++i) {
            const int c = lane * 4 + 256 * i;
            const float4 g = *(const float4*)(gain + c), sh = *(const float4*)(mr + c), sc = *(const float4*)(mr + 1024 + c);
            const float a0 = v[i].x * rstd * g.x * (1.f + sc.x) + sh.x, a1 = v[i].y * rstd * g.y * (1.f + sc.y) + sh.y;
            const float a2 = v[i].z * rstd * g.z * (1.f + sc.z) + sh.z, a3 = v[i].w * rstd * g.w * (1.f + sc.w) + sh.w;
            *(uint2*)(p.H + (size_t)tok * DM + c) = make_uint2(pack2(a0, a1), pack2(a2, a3));
        }
    }
}

struct EpiStoreF32 {
    float* C; int ldc; int row0; int col0;
    __device__ __forceinline__ void one(int r, int c, f32x4 v) const { *(f32x4*)(C + (size_t)(row0 + r) * ldc + col0 + c) = v; }
};


struct TileIter {
    int mg0, mcnt, ntn, total, full, i, step;
    __device__ __forceinline__ void init(int MT, int NTN, int bid, int nblk) {
        const int g = bid & 7, lb = (bid >> 3) * 2 + (tidx() >> 8), nb = (nblk >> 3) * 2;
        mg0 = (MT * g) >> 3; mcnt = ((MT * (g + 1)) >> 3) - mg0; ntn = NTN; total = mcnt * NTN; full = mcnt >> 3; i = lb; step = nb;
    }
    __device__ __forceinline__ bool next(int& mt, int& nt) {
        if (i >= total) return false;
        const int band = 8 * ntn;
        if (i < full * band) { const int ms = i / band, r = i - ms * band; nt = r >> 3; mt = mg0 + ms * 8 + (r & 7); }
        else { const int rem = mcnt - full * 8, j = i - full * band; nt = j / rem; mt = mg0 + full * 8 + (j - nt * rem); }
        i += step;
        return true;
    }
};
__device__ __forceinline__ void phase_gemm_store(const bf16_t* A, int M, const bf16_t* Wt, int N, int K, float* C, int bid, int nblk, char* smem) {
    TileIter ti; ti.init(M / 128, N / 128, bid, nblk);
    char* hs = smem + (tidx() >> 8) * HLDS;
    for (;;) {
        int mt = 0, nt = 0;
        const bool v = ti.next(mt, nt);
        if (!__syncthreads_or(v ? 1 : 0)) break;
        if (!v) { mt = 0; nt = 0; }
        ARows ar{A, K, nullptr, 0, mt * 128};
        EpiStoreF32 epi{C, N, mt * 128, nt * 128};
        gemm_tile<false>(ar, v ? 128 : 0, Wt + (size_t)nt * 128 * K, K, K, epi, hs);
    }
}

struct EpiResid {
    const float* xin_lat; const float* xin_ctx; float* xout; const float* gmod; int row0; int col0;
    __device__ __forceinline__ void one(int r, int c, f32x4 v) const {
        const int tok = row0 + r, cc = col0 + c;
        const float* xr = tok < NX ? xin_lat + (size_t)tok * DM : xin_ctx + (size_t)(tok - NX) * DM;
        const f32x4 xi = *(const f32x4*)(xr + cc);
        const f32x4 g = *(const f32x4*)(gmod + modrow(tok) * 6144 + cc);
        *(f32x4*)(xout + (size_t)tok * DM + cc) = xi + g * v;
    }
};
__device__ __forceinline__ void phase_outproj(const Params& p, int bid, int nblk, char* smem, const bf16_t* Wt, int ntok, const float* xin_lat, const float* xin_ctx, float* xout, const float* gmod) {
    TileIter ti; ti.init(ntok / 128, 8, bid, nblk);
    char* hs = smem + (tidx() >> 8) * HLDS;
    for (;;) {
        int mt = 0, nt = 0;
        const bool v = ti.next(mt, nt);
        if (!__syncthreads_or(v ? 1 : 0)) break;
        if (!v) { mt = 0; nt = 0; }
        ARows ar{p.MG, DM, nullptr, 0, mt * 128};
        EpiResid epi{xin_lat, xin_ctx, xout, gmod, mt * 128, nt * 128};
        gemm_tile<false>(ar, v ? 128 : 0, Wt + (size_t)nt * 128 * DM, DM, DM, epi, hs);
    }
}

__device__ __forceinline__ void unpack8(const u32x4 w, float (&v)[8]) {
#pragma unroll
    for (int i = 0; i < 4; ++i) { v[2 * i] = __uint_as_float(w[i] << 16); v[2 * i + 1] = __uint_as_float(w[i] & 0xffff0000u); }
}
__device__ __forceinline__ u32x4 pack8f(const float (&v)[8]) { return (u32x4){pack2(v[0], v[1]), pack2(v[2], v[3]), pack2(v[4], v[5]), pack2(v[6], v[7])}; }
__device__ __forceinline__ void phase_feat0(const Params& p, int bid, int nblk, char* smem) {
    const int lane = tidx() & 63, wid = tidx() >> 6;
    const bf16_t* P16 = (const bf16_t*)p.P;
    const int l7 = lane & 7, g = lane >> 3;
    for (int tok = bid * 8 + wid; tok < NT; tok += nblk * 8) {
        const bool lat = tok < NX;
        const int b = lat ? (tok >> 11) : ((tok - NX) >> 8);
        const int t = lat ? (tok & 2047) : ((tok - NX) & 255);
        const int key = lat ? (CTXL + t) : t;
        const bf16_t* pr = P16 + (size_t)tok * EVC;
        {
            float cs[8], sn[8];
            if (lat) {
                const int a = l7 >> 2, ro = t * 32 + a * 16 + (l7 & 1) * 8;
                const f32x4 c0 = *(const f32x4*)(p.rope_cos + ro), c1 = *(const f32x4*)(p.rope_cos + ro + 4), s0 = *(const f32x4*)(p.rope_sin + ro), s1 = *(const f32x4*)(p.rope_sin + ro + 4);
#pragma unroll
                for (int j = 0; j < 4; ++j) { cs[j] = c0[j]; cs[4 + j] = c1[j]; sn[j] = s0[j]; sn[4 + j] = s1[j]; }
            }
            const bool hf = (l7 >> 1) & 1;
#pragma unroll
            for (int qk = 0; qk < 2; ++qk) {
                float v[8];
                unpack8(*(const u32x4*)(pr + qk * 512 + lane * 8), v);
                const float* nw = (qk == 0 ? p.da_q_norm : p.da_k_norm) + l7 * 8;
                const f32x4 n0 = *(const f32x4*)nw, n1 = *(const f32x4*)(nw + 4);
                float ss = 0.f;
#pragma unroll
                for (int j = 0; j < 8; ++j) ss += v[j] * v[j];
                ss = sum8(ss);
                const float rstd = rsqrtf(ss * (1.0f / 64.0f) + 1e-6f) * (qk == 0 ? 0.125f * 1.4426950408889634f : 1.0f);
#pragma unroll
                for (int j = 0; j < 8; ++j) v[j] = v[j] * rstd * (j < 4 ? n0[j] : n1[j - 4]);
                if (lat) {
#pragma unroll
                    for (int j = 0; j < 8; ++j) {
                        const float o = dpp_f<0x4E>(v[j]);
                        v[j] = hf ? (v[j] * cs[j] + o * sn[j]) : (v[j] * cs[j] - o * sn[j]);
                    }
                }
                const u32x4 w = pack8f(v);
                if (qk == 0) {
                    if (lat) *(u32x4*)(p.Q + (((size_t)b * 8 + g) * SEQ + t) * 64 + l7 * 8) = w;
                    else *(u32x4*)(p.Qc + (((size_t)b * 8 + g) * CTXL + t) * 64 + l7 * 8) = w;
                } else *(u32x4*)(p.Kd + (((size_t)b * 8 + g) * NKEY + key) * 64 + l7 * 8) = w;
            }
        }
        const int slen = lat ? SEQ : CTXL;
        const bool hasp = t > 0, hasn = t < slen - 1;
        const bf16_t* pw = pr + 1536;
        auto shifted = [&](int c0, float (&y)[8]) {
            float pv[8], nv[8];
            unpack8(*(const u32x4*)(pw + c0), y);
            if (hasp) unpack8(*(const u32x4*)(pw + c0 - EVC), pv); else {
#pragma unroll
                for (int j = 0; j < 8; ++j) pv[j] = 0.f; }
            if (hasn) unpack8(*(const u32x4*)(pw + c0 + EVC), nv); else {
#pragma unroll
                for (int j = 0; j < 8; ++j) nv[j] = 0.f; }
            const f32x4 m0 = *(const f32x4*)(p.rw_mu + c0), m1 = *(const f32x4*)(p.rw_mu + c0 + 4);
#pragma unroll
            for (int j = 0; j < 8; ++j) y[j] = y[j] + (j < 4 ? m0[j] : m1[j - 4]) * (0.5f * (pv[j] + nv[j]) - y[j]);
        };
        {
            float y[8];
            shifted(lane * 8, y);
            *(u32x4*)(p.rR + (size_t)tok * 512 + lane * 8) = pack8f(y);
        }
        {
            float y[8];
            shifted(512 + lane * 8, y);
            *(u32x4*)(p.rK + (size_t)tok * 512 + lane * 8) = pack8f(y);
            const f32x4 k0 = *(const f32x4*)(p.rw_k_k + lane * 8), k1 = *(const f32x4*)(p.rw_k_k + lane * 8 + 4);
            float ss = 0.f;
#pragma unroll
            for (int j = 0; j < 8; ++j) { y[j] *= (j < 4 ? k0[j] : k1[j - 4]); ss += y[j] * y[j]; }
            const float inv = 1.0f / fmaxf(sqrtf(sum8(ss)), 1e-12f);
#pragma unroll
            for (int j = 0; j < 8; ++j) y[j] *= inv;
            *(u32x4*)(p.rKK + (size_t)tok * 512 + lane * 8) = pack8f(y);
        }
        {
            float y[8];
            shifted(1024 + lane * 8, y);
            *(u32x4*)(p.rV + (size_t)tok * 512 + lane * 8) = pack8f(y);
        }
        if (lane < 32) {
            float y[8];
            shifted(1536 + lane * 8, y);
            if (lane < 8) {
#pragma unroll
                for (int j = 0; j < 8; ++j) y[j] = tanhf(y[j]);
                *(u32x4*)(p.rTW + (size_t)tok * 64 + lane * 8) = pack8f(y);
            } else if (lane < 16) {
                *(u32x4*)(p.rAD + (size_t)tok * 64 + (lane - 8) * 8) = pack8f(y);
            } else {
#pragma unroll
                for (int j = 0; j < 8; ++j) y[j] = sigmoidf_(y[j]);
                *(u32x4*)(p.rSG + (size_t)tok * 128 + (lane - 16) * 8) = pack8f(y);
            }
        }
    }
    {
        const int half = tidx() >> 8, tid = tidx() & 255;
        float* lds = (float*)(smem + half * HLDS);
        for (int it = bid * 2 + half; it < 8 * 36 * 4; it += nblk * 2) {
            const int b = it / 144, rem = it % 144, kt = rem >> 2, h = rem & 3;
            __syncthreads();
#pragma unroll
            for (int i = 0; i < 8; ++i) {
                const int e = i * 256 + tid, key = e >> 5, c4 = (e & 31) * 4;
                const int kg = kt * 64 + key;
                const int tok = kg < CTXL ? NX + b * CTXL + kg : b * SEQ + (kg - CTXL);
                const uint2 v = *(const uint2*)((const bf16_t*)p.P + (size_t)tok * EVC + 1024 + h * 128 + c4);
                float* d = lds + key * 129 + c4;
                d[0] = __uint_as_float(v.x << 16); d[1] = __uint_as_float(v.x & 0xffff0000u); d[2] = __uint_as_float(v.y << 16); d[3] = __uint_as_float(v.y & 0xffff0000u);
            }
            __syncthreads();
            {
                const int dv = tid >> 1, half = tid & 1;
                unsigned w[16];
#pragma unroll
                for (int j = 0; j < 16; ++j) { const int q = 2 * j, key = 16 * ((q >> 2) & 1) + 4 * (q >> 3) + (q & 3);
                    w[j] = pack2(lds[(half * 32 + key) * 129 + dv], lds[(half * 32 + key + 1) * 129 + dv]); }
                u32x4* dst = (u32x4*)(p.Vd + (((size_t)b * 4 + h) * 128 + dv) * NKEY + kt * 64 + half * 32);
#pragma unroll
                for (int j = 0; j < 4; ++j) dst[j] = (u32x4){w[4 * j], w[4 * j + 1], w[4 * j + 2], w[4 * j + 3]};
            }
        }
    }
}

struct EpiDecay {
    const float* w0; float* W; int row0; int col0;
    __device__ __forceinline__ void one(int r, int c, f32x4 v) const {
        const int tok = row0 + r, cc = col0 + c, z = cc >> 9, ch = cc & 511;
        f32x4 o;
        const f32x4 w0v = *(const f32x4*)(w0 + z * 512 + ch);
#pragma unroll
        for (int j = 0; j < 4; ++j) {
            const float x = w0v[j] + v[j];
            const float u = -x;
            const float sp = fmaxf(u, 0.f) + __logf(1.0f + __expf(-fabsf(u)));
            const float wlog = -sp - 0.5f;
            o[j] = __expf(-__expf(wlog));
        }
        *(f32x4*)(W + ((size_t)z * NT + tok) * 512 + ch) = o;
    }
};
struct EpiStoreBf16 {
    bf16_t* C; int ldc; int row0; int col0;
    __device__ __forceinline__ void one(int r, int c, f32x4 v) const { *(uint2*)(C + (size_t)(row0 + r) * ldc + col0 + c) = make_uint2(pack2(v[0], v[1]), pack2(v[2], v[3])); }
};
struct EpiArate {
    const float* a0; const float* k_a; const bf16_t* rK; const bf16_t* rKK; bf16_t* KD; bf16_t* BV; int row0; int col0;
    __device__ __forceinline__ void one(int r, int c, f32x4 v) const {
        const int tok = row0 + r, z = (c >> 6) & 1, ch = (col0 >> 1) + (c & 63);
        const uint2 ku = *(const uint2*)(rK + (size_t)tok * 512 + ch), kku = *(const uint2*)(rKK + (size_t)tok * 512 + ch);
        const f32x4 k = (f32x4){__uint_as_float(ku.x << 16), __uint_as_float(ku.x & 0xffff0000u), __uint_as_float(ku.y << 16), __uint_as_float(ku.y & 0xffff0000u)};
        const f32x4 kk = (f32x4){__uint_as_float(kku.x << 16), __uint_as_float(kku.x & 0xffff0000u), __uint_as_float(kku.y << 16), __uint_as_float(kku.y & 0xffff0000u)};
        f32x4 kd, bv;
        const f32x4 a0v = *(const f32x4*)(a0 + z * 512 + ch), kav = *(const f32x4*)(k_a + ch);
#pragma unroll
        for (int j = 0; j < 4; ++j) {
            const float arate = sigmoidf_(a0v[j] + v[j]);
            kd[j] = k[j] * (1.f + (arate - 1.f) * kav[j]);
            bv[j] = kk[j] * arate;
        }
        *(uint2*)(KD + ((size_t)z * NT + tok) * 512 + ch) = make_uint2(pack2(kd[0], kd[1]), pack2(kd[2], kd[3]));
        *(uint2*)(BV + ((size_t)z * NT + tok) * 512 + ch) = make_uint2(pack2(bv[0], bv[1]), pack2(bv[2], bv[3]));
    }
};
__device__ __forceinline__ void phase_lora(const Params& p, int bid, int nblk, char* smem) {
    const int half = tidx() >> 8;
    char* hs = smem + half * HLDS;
    for (int it0 = bid * 2; it0 < 144 * 20; it0 += nblk * 2) {
        const int it = it0 + half;
        if (it < 1152) {
            const int mt = it >> 3, q = it & 7;
            ARows ar{p.rTW, 64, nullptr, 0, mt * 128};
            EpiDecay epi{p.rw_w0, p.rW, mt * 128, q * 128};
            gemm_tile<false>(ar, 128, p.wt_w2 + (size_t)q * 128 * 64, 64, 64, epi, hs);
        } else if (it < 2304) {
            const int j = it - 1152, mt = j >> 3, q = j & 7;
            ARows ar{p.rAD, 64, nullptr, 0, mt * 128};
            EpiArate epi{p.rw_a0, p.rw_k_a, p.rK, p.rKK, p.rKD, p.rBV, mt * 128, q * 128};
            gemm_tile<false>(ar, 128, p.wt_a2 + (size_t)q * 128 * 64, 64, 64, epi, hs);
        } else {
            const int j = it - 2304, mt = j >> 2, q = j & 3;
            ARows ar{p.rSG, 128, nullptr, 0, mt * 128};
            EpiStoreBf16 epi{p.rG, 512, mt * 128, q * 128};
            gemm_tile<false>(ar, 128, p.wt_g2 + (size_t)q * 128 * 128, 128, 128, epi, hs);
        }
    }
}

__device__ __forceinline__ int scan_tok(int z, int b, int s) {
    if (s < CTXL) { const int tc = z == 0 ? s : (CTXL - 1 - s); return NX + b * CTXL + tc; }
    const int t = s - CTXL; return b * SEQ + (z == 0 ? t : (SEQ - 1 - t));
}
typedef float f32x2 __attribute__((ext_vector_type(2)));
__device__ __forceinline__ bf16x8 cvt8(const f32x4 a, const f32x4 b) {
    union { bf16x8 v; unsigned u[4]; } r;
    r.u[0] = pack2(a[0], a[1]); r.u[1] = pack2(a[2], a[3]); r.u[2] = pack2(b[0], b[1]); r.u[3] = pack2(b[2], b[3]);
    return r.v;
}
__device__ __forceinline__ void rwkv_chunk_chain(const Params& p, int chain, char* smem) {
    const int z = chain >> 6, b = (chain >> 3) & 7, h = chain & 7;
    const int tid = tidx(), lane = tid & 63, fr = lane & 15, fq = lane >> 4;
    const int wv_ = __builtin_amdgcn_readfirstlane(tid >> 6);
    bf16_t* AR = (bf16_t*)(smem + 43008);
    bf16_t* BK = (bf16_t*)(smem + 47104);
    bf16_t* BKT = (bf16_t*)(smem + 51200);
    bf16_t* VT = (bf16_t*)(smem + 55296);
    bf16_t* SB = (bf16_t*)(smem + 59392);
    float* AM = (float*)(smem + 67584);
    float* RH = (float*)(smem + 71680);
    float* GC = (float*)(smem + 75776);
    f32x4 S0 = (f32x4){0.f, 0.f, 0.f, 0.f}, S1 = S0;
    for (int i = tid; i < 2048; i += NTHR) ((unsigned*)SB)[i] = 0u;
    const size_t zoff = (size_t)z * NT * 512;
    const char* src1; const char* src2 = nullptr; unsigned dst1, dst2 = 0; int st1, st2 = 0;
    if (wv_ < 4) { src1 = (const char*)(p.rW + zoff + h * 64 + (lane & 15) * 4); st1 = 4 * wv_ + (lane >> 4); dst1 = wv_ * 1024; }
    else if (wv_ < 6) { src1 = (const char*)(p.rR + h * 64 + (lane & 7) * 8); st1 = 8 * (wv_ - 4) + (lane >> 3); dst1 = 4096 + (wv_ - 4) * 1024; }
    else { src1 = (const char*)(p.rKD + zoff + h * 64 + (lane & 7) * 8); st1 = 8 * (wv_ - 6) + (lane >> 3); dst1 = 6144 + (wv_ - 6) * 1024; }
    if (wv_ < 2) { src2 = (const char*)(p.rKK + h * 64 + (lane & 7) * 8); st2 = 8 * wv_ + (lane >> 3); dst2 = 8192 + wv_ * 1024; }
    else if (wv_ < 4) { src2 = (const char*)(p.rBV + zoff + h * 64 + (lane & 7) * 8); st2 = 8 * (wv_ - 2) + (lane >> 3); dst2 = 10240 + (wv_ - 2) * 1024; }
    else if (wv_ < 6) { src2 = (const char*)(p.rV + h * 64 + (lane & 7) * 8); st2 = 8 * (wv_ - 4) + (lane >> 3); dst2 = 12288 + (wv_ - 4) * 1024; }
    const int esz1 = wv_ < 4 ? 4 : 2;
    auto issue = [&](int chunk) {
        char* bb = smem + (chunk % 3) * 14336;
        const int tok1 = scan_tok(z, b, chunk * 16 + st1);
        __builtin_amdgcn_global_load_lds((const unsigned*)(src1 + (size_t)tok1 * 512 * esz1), (__attribute__((address_space(3))) unsigned*)(bb + dst1), 16, 0, 0);
        if (wv_ < 6) {
            const int tok2 = scan_tok(z, b, chunk * 16 + st2);
            __builtin_amdgcn_global_load_lds((const unsigned*)(src2 + (size_t)tok2 * 512 * 2), (__attribute__((address_space(3))) unsigned*)(bb + dst2), 16, 0, 0);
        }
    };
    issue(0); issue(1);
    const int ch = lane, t0 = 2 * wv_, t1 = t0 + 1;
    const int tokdir = z == 0 ? 1 : -1;
    for (int chunk = 0; chunk < 144; ++chunk) {
        if (chunk + 1 < 144) { if (wv_ < 6) asm volatile("s_waitcnt vmcnt(2)" ::: "memory"); else asm volatile("s_waitcnt vmcnt(1)" ::: "memory"); }
        else asm volatile("s_waitcnt vmcnt(0)" ::: "memory");
        __syncthreads();
        if (chunk + 2 < 144) issue(chunk + 2);
        const float* cbw = (const float*)(smem + (chunk % 3) * 14336);
        const bf16_t* cb = (const bf16_t*)(smem + (chunk % 3) * 14336 + 4096);
        const float w0 = cbw[t0 * 64 + ch], w1 = cbw[t1 * 64 + ch];
        {
            float gb = 1.f, gall = 1.f;
#pragma unroll
            for (int t = 0; t < 16; ++t) { const float wt = cbw[t * 64 + ch]; gall *= wt; if (t < t0) gb *= wt; }
            const float gt0 = gb * w0, gt1 = gt0 * w1;
            const float ig0 = __builtin_amdgcn_rcpf(gt0), ig1 = __builtin_amdgcn_rcpf(gt1);
            const float a0 = -gb * bf2f(cb[2048 + t0 * 64 + ch]), a1 = -gt0 * bf2f(cb[2048 + t1 * 64 + ch]);
            const float r0 = gt0 * bf2f(cb[t0 * 64 + ch]), r1 = gt1 * bf2f(cb[t1 * 64 + ch]);
            const float b0 = bf2f(cb[3072 + t0 * 64 + ch]) * ig0, b1 = bf2f(cb[3072 + t1 * 64 + ch]) * ig1;
            const float k0 = bf2f(cb[1024 + t0 * 64 + ch]) * ig0, k1 = bf2f(cb[1024 + t1 * 64 + ch]) * ig1;
            const float v0 = bf2f(cb[4096 + t0 * 64 + ch]), v1 = bf2f(cb[4096 + t1 * 64 + ch]);
            const int cc = ch >> 3, cw = ch & 7;
            AR[t0 * 64 + ((cc ^ (t0 & 7)) << 3) + cw] = f2bf(a0);
            AR[t1 * 64 + ((cc ^ (t1 & 7)) << 3) + cw] = f2bf(a1);
            AR[(16 + t0) * 64 + ((cc ^ (t0 & 7)) << 3) + cw] = f2bf(r0);
            AR[(16 + t1) * 64 + ((cc ^ (t1 & 7)) << 3) + cw] = f2bf(r1);
            BK[t0 * 64 + ((cc ^ (t0 & 7)) << 3) + cw] = f2bf(b0);
            BK[t1 * 64 + ((cc ^ (t1 & 7)) << 3) + cw] = f2bf(b1);
            BK[(16 + t0) * 64 + ((cc ^ (t0 & 7)) << 3) + cw] = f2bf(k0);
            BK[(16 + t1) * 64 + ((cc ^ (t1 & 7)) << 3) + cw] = f2bf(k1);
            const int sw = (ch >> 2) & 3;
            *(unsigned*)(BKT + ch * 32 + (((t0 >> 3) ^ sw) << 3) + (t0 & 7)) = pack2(b0, b1);
            *(unsigned*)(BKT + ch * 32 + ((((16 + t0) >> 3) ^ sw) << 3) + (t0 & 7)) = pack2(k0, k1);
            *(unsigned*)(VT + ch * 32 + ((((16 + t0) >> 3) ^ sw) << 3) + (t0 & 7)) = pack2(v0, v1);
            if (wv_ == 0) GC[ch] = gall;
        }
        __syncthreads();
        f32x4 G2 = (f32x4){0.f, 0.f, 0.f, 0.f};
        {
            const int rb = wv_ >> 2, vb = wv_ & 3;
            const int ra = 16 * rb + fr, rs = 16 * vb + fr;
#pragma unroll
            for (int ks = 0; ks < 2; ++ks) {
                const int c = ks * 4 + fq;
                const bf16x8 af = *(const bf16x8*)(AR + ra * 64 + ((c ^ (ra & 7)) << 3));
                const bf16x8 sf = *(const bf16x8*)(SB + rs * 64 + ((c ^ (rs & 7)) << 3));
                G2 = __builtin_amdgcn_mfma_f32_16x16x32_bf16(sf, af, G2, 0, 0, 0);
            }
        }
        if (wv_ < 4) {
            const int rb = wv_ >> 1, cbk = wv_ & 1;
            const int ra = 16 * rb + fr, rk = 16 * cbk + fr;
            f32x4 G1 = (f32x4){0.f, 0.f, 0.f, 0.f};
#pragma unroll
            for (int ks = 0; ks < 2; ++ks) {
                const int c = ks * 4 + fq;
                const bf16x8 af = *(const bf16x8*)(AR + ra * 64 + ((c ^ (ra & 7)) << 3));
                const bf16x8 bf = *(const bf16x8*)(BK + rk * 64 + ((c ^ (rk & 7)) << 3));
                G1 = __builtin_amdgcn_mfma_f32_16x16x32_bf16(af, bf, G1, 0, 0, 0);
            }
            if (wv_ == 0) {
                f32x4 m;
#pragma unroll
                for (int j = 0; j < 4; ++j) m[j] = (fr < 4 * fq + j) ? G1[j] : 0.f;
                *(f32x4*)(AM + fr * 16 + 4 * fq) = m;
            } else {
#pragma unroll
                for (int j = 0; j < 4; ++j) {
                    const int t = 4 * fq + j;
                    const bool keep = rb == 0 ? (fr < t) : (fr <= t);
                    AM[wv_ * 256 + t * 16 + fr] = keep ? G1[j] : 0.f;
                }
            }
        }
        __syncthreads();
        if (wv_ < 4) {
            union { bf16x8 v; unsigned u[4]; } af;
            if (fq < 2) {
                const f32x4 x0 = *(const f32x4*)(AM + 256 + fr * 16 + 8 * fq), x1 = *(const f32x4*)(AM + 256 + fr * 16 + 8 * fq + 4);
                af.v = cvt8(x0, x1);
            } else { af.u[0] = 0u; af.u[1] = 0u; af.u[2] = 0u; af.u[3] = 0u; }
            const int rv = 16 * wv_ + fr;
            const bf16x8 vf = *(const bf16x8*)(VT + rv * 32 + (((2 + (fq & 1)) ^ ((rv >> 2) & 3)) << 3));
            G2 = __builtin_amdgcn_mfma_f32_16x16x32_bf16(vf, af.v, G2, 0, 0, 0);
            *(f32x4*)(RH + fr * 64 + 16 * wv_ + 4 * fq) = G2;
        }
        __syncthreads();
        if (wv_ == 0) {
            float x[16];
#pragma unroll
            for (int t = 0; t < 16; ++t) x[t] = RH[t * 64 + lane];
#pragma unroll
            for (int i = 0; i < 15; ++i) {
                const float xi = x[i];
#pragma unroll
                for (int q = 0; q < 4; ++q) {
                    if (4 * q + 3 > i) {
                        const f32x4 acol = *(const f32x4*)(AM + i * 16 + 4 * q);
#pragma unroll
                        for (int j = 0; j < 4; ++j) if (4 * q + j > i) x[4 * q + j] += acol[j] * xi;
                    }
                }
            }
            const int sw = (lane >> 2) & 3;
            *(u32x4*)(VT + lane * 32 + ((0 ^ sw) << 3)) = (u32x4){pack2(x[0], x[1]), pack2(x[2], x[3]), pack2(x[4], x[5]), pack2(x[6], x[7])};
            *(u32x4*)(VT + lane * 32 + ((1 ^ sw) << 3)) = (u32x4){pack2(x[8], x[9]), pack2(x[10], x[11]), pack2(x[12], x[13]), pack2(x[14], x[15])};
        }
        __syncthreads();
        if (wv_ >= 4) {
            const int vb = wv_ & 3, rv = 16 * vb + fr;
            const float* am = AM + (fq < 2 ? 512 : 768) + fr * 16 + 8 * (fq & 1);
            const bf16x8 af = cvt8(*(const f32x4*)am, *(const f32x4*)(am + 4));
            const bf16x8 vf = *(const bf16x8*)(VT + rv * 32 + ((fq ^ ((rv >> 2) & 3)) << 3));
            G2 = __builtin_amdgcn_mfma_f32_16x16x32_bf16(vf, af, G2, 0, 0, 0);
            const int tok = scan_tok(z, b, chunk * 16) + tokdir * fr;
            *(uint2*)(p.rY + zoff + (size_t)tok * 512 + h * 64 + 16 * vb + 4 * fq) = make_uint2(pack2(G2[0], G2[1]), pack2(G2[2], G2[3]));
        }
        {
            const int vb = wv_ >> 1, kb0 = 2 * (wv_ & 1);
            const int rv = 16 * vb + fr;
            const bf16x8 uf = *(const bf16x8*)(VT + rv * 32 + ((fq ^ ((rv >> 2) & 3)) << 3));
            const int rk0 = 16 * kb0 + fr, rk1 = rk0 + 16;
            const bf16x8 b0 = *(const bf16x8*)(BKT + rk0 * 32 + ((fq ^ ((rk0 >> 2) & 3)) << 3));
            const bf16x8 b1 = *(const bf16x8*)(BKT + rk1 * 32 + ((fq ^ ((rk1 >> 2) & 3)) << 3));
            S0 = __builtin_amdgcn_mfma_f32_16x16x32_bf16(uf, b0, S0, 0, 0, 0);
            S1 = __builtin_amdgcn_mfma_f32_16x16x32_bf16(uf, b1, S1, 0, 0, 0);
            const float gc0 = GC[rk0], gc1 = GC[rk1];
            S0 *= gc0; S1 *= gc1;
#pragma unroll
            for (int j = 0; j < 4; ++j) {
                const int v = 16 * vb + 4 * fq + j;
                SB[v * 64 + (((rk0 >> 3) ^ (v & 7)) << 3) + (rk0 & 7)] = f2bf(S0[j]);
                SB[v * 64 + (((rk1 >> 3) ^ (v & 7)) << 3) + (rk1 & 7)] = f2bf(S1[j]);
            }
        }
    }
    asm volatile("s_waitcnt vmcnt(0)" ::: "memory");
    __syncthreads();
}

__device__ __forceinline__ float max3_s(float a, float b, float c) { float r; asm("v_max3_f32 %0, %1, %2, %3" : "=v"(r) : "v"(a), "v"(b), "v"(c)); return r; }
__device__ __forceinline__ void attn_item(const Params& p, int b, int h, int q0, bool isctx, char* smem) {
    const int tid = tidx(), lane = tid & 63, wid = tid >> 6, fr = lane & 15, fq = lane >> 4;
    bf16_t* sKV = (bf16_t*)smem;
    const int ntiles = isctx ? (CTXL / 64) : (NKEY / 64);
    bf16x8 qf[2][2];
#pragma unroll
    for (int m = 0; m < 2; ++m) {
        const bf16_t* qp = isctx ? p.Qc + (((size_t)b * 8 + h * 2 + m) * CTXL + q0 + wid * 16 + fr) * 64
                                 : p.Q + (((size_t)b * 8 + h * 2 + m) * SEQ + q0 + wid * 16 + fr) * 64;
        qf[m][0] = *(const bf16x8*)(qp + fq * 8);
        qf[m][1] = *(const bf16x8*)(qp + 32 + fq * 8);
    }
    f32x4 o[2][8];
#pragma unroll
    for (int m = 0; m < 2; ++m)
#pragma unroll
        for (int mb = 0; mb < 8; ++mb) o[m][mb] = (f32x4){0.f, 0.f, 0.f, 0.f};
    float mrun[2] = {0.f, 0.f}, lrun[2] = {0.f, 0.f};
    const int lrow = tid >> 3, lch = tid & 7;
    const bf16_t* kbase = p.Kd + (((size_t)b * 8 + h * 2) * NKEY + lrow) * 64 + lch * 8;
    const bf16_t* vbase = p.Vd + (((size_t)b * 4 + h) * 128 + lrow) * NKEY + lch * 8;
    u32x4 rk[2], rv[2];
#pragma unroll
    for (int i = 0; i < 2; ++i) { rk[i] = *(const u32x4*)(kbase + i * (NKEY * 64)); rv[i] = *(const u32x4*)(vbase + i * (64 * NKEY)); }
    __syncthreads();
#pragma unroll
    for (int i = 0; i < 2; ++i) {
        const int r = lrow + 64 * i;
        const int off = r * 64 + ((lch ^ (r & 7)) << 3);
        *(u32x4*)(sKV + off) = rk[i];
        *(u32x4*)(sKV + 8192 + off) = rv[i];
    }
    if (ntiles > 1) {
#pragma unroll
        for (int i = 0; i < 2; ++i) { rk[i] = *(const u32x4*)(kbase + 4096 + i * (NKEY * 64)); rv[i] = *(const u32x4*)(vbase + 64 + i * (64 * NKEY)); }
    }
    for (int t = 0; t < ntiles; ++t) {
        __syncthreads();
        const bf16_t* sK = sKV + (t & 1) * 16384;
        const bf16_t* sV = sK + 8192;
        if (t + 1 < ntiles) {
            bf16_t* dK = sKV + ((t + 1) & 1) * 16384;
#pragma unroll
            for (int i = 0; i < 2; ++i) {
                const int r = lrow + 64 * i;
                const int off = r * 64 + ((lch ^ (r & 7)) << 3);
                *(u32x4*)(dK + off) = rk[i];
                *(u32x4*)(dK + 8192 + off) = rv[i];
            }
            if (t + 2 < ntiles) {
#pragma unroll
                for (int i = 0; i < 2; ++i) { rk[i] = *(const u32x4*)(kbase + (t + 2) * 4096 + i * (NKEY * 64)); rv[i] = *(const u32x4*)(vbase + (t + 2) * 64 + i * (64 * NKEY)); }
            }
        }
        bf16x8 pf[2][2];
#pragma unroll
        for (int m = 0; m < 2; ++m) {
            f32x4 sc[4];
            const float nm = -mrun[m];
#pragma unroll
            for (int kb = 0; kb < 4; ++kb) {
                sc[kb] = (f32x4){nm, nm, nm, nm};
                const int r = m * 64 + kb * 16 + fr;
#pragma unroll
                for (int ks = 0; ks < 2; ++ks) {
                    const bf16x8 kf = *(const bf16x8*)(sK + r * 64 + (((ks * 4 + fq) ^ (r & 7)) << 3));
                    sc[kb] = __builtin_amdgcn_mfma_f32_16x16x32_bf16(kf, qf[m][ks], sc[kb], 0, 0, 0);
                }
            }
            float mx = max3_s(sc[0][0], sc[0][1], sc[0][2]);
            mx = max3_s(mx, sc[0][3], sc[1][0]); mx = max3_s(mx, sc[1][1], sc[1][2]); mx = max3_s(mx, sc[1][3], sc[2][0]);
            mx = max3_s(mx, sc[2][1], sc[2][2]); mx = max3_s(mx, sc[2][3], sc[3][0]); mx = max3_s(mx, sc[3][1], sc[3][2]);
            mx = fmaxf(mx, sc[3][3]);
            mx = fmaxf(mx, __shfl_xor(mx, 16));
            mx = fmaxf(mx, __shfl_xor(mx, 32));
            if (!__all(mx <= 8.0f)) {
                const float d = mx > 8.0f ? mx : 0.f;
                const float scale = __builtin_amdgcn_exp2f(-d);
                mrun[m] += d;
                lrun[m] *= scale;
#pragma unroll
                for (int mb = 0; mb < 8; ++mb) o[m][mb] *= scale;
#pragma unroll
                for (int kb = 0; kb < 4; ++kb) sc[kb] -= d;
            }
            float ls = 0.f;
#pragma unroll
            for (int kb = 0; kb < 4; ++kb)
#pragma unroll
                for (int j = 0; j < 4; ++j) { const float e = __builtin_amdgcn_exp2f(sc[kb][j]); sc[kb][j] = e; ls += e; }
            lrun[m] += ls;
#pragma unroll
            for (int ksp = 0; ksp < 2; ++ksp) {
                const u32x4 pk = (u32x4){pack2(sc[2 * ksp][0], sc[2 * ksp][1]), pack2(sc[2 * ksp][2], sc[2 * ksp][3]), pack2(sc[2 * ksp + 1][0], sc[2 * ksp + 1][1]), pack2(sc[2 * ksp + 1][2], sc[2 * ksp + 1][3])};
                pf[m][ksp] = __builtin_bit_cast(bf16x8, pk);
            }
        }
#pragma unroll
        for (int ksp = 0; ksp < 2; ++ksp) {
#pragma unroll
            for (int mb = 0; mb < 8; ++mb) {
                const int r = mb * 16 + fr;
                const bf16x8 vfv = *(const bf16x8*)(sV + r * 64 + (((4 * ksp + fq) ^ (r & 7)) << 3));
                o[0][mb] = __builtin_amdgcn_mfma_f32_16x16x32_bf16(vfv, pf[0][ksp], o[0][mb], 0, 0, 0);
                o[1][mb] = __builtin_amdgcn_mfma_f32_16x16x32_bf16(vfv, pf[1][ksp], o[1][mb], 0, 0, 0);
                if ((mb & 3) == 3) asm volatile("" ::: "memory");
            }
        }
    }
    {
        float l0 = lrun[0], l1 = lrun[1];
        l0 += __shfl_xor(l0, 16); l0 += __shfl_xor(l0, 32);
        l1 += __shfl_xor(l1, 16); l1 += __shfl_xor(l1, 32);
        const float i0 = 1.0f / l0, i1 = p.scal[0] / l1;
        float ss = 0.f;
#pragma unroll
        for (int mb = 0; mb < 8; ++mb) {
            o[0][mb] = o[0][mb] * i0 - o[1][mb] * i1;
            ss += o[0][mb][0] * o[0][mb][0] + o[0][mb][1] * o[0][mb][1] + o[0][mb][2] * o[0][mb][2] + o[0][mb][3] * o[0][mb][3];
        }
        ss += __shfl_xor(ss, 16); ss += __shfl_xor(ss, 32);
        const float rstd = rsqrtf(ss * (1.0f / 128.0f) + 1e-6f) * 0.8f;
        const int tok = (isctx ? NX + b * CTXL : b * SEQ) + q0 + wid * 16 + fr;
        bf16_t* dst = p.MG + (size_t)tok * DM + h * 128 + fq * 4;
#pragma unroll
        for (int mb = 0; mb < 8; ++mb) {
            const f32x4 g = *(const f32x4*)(p.da_subln + mb * 16 + fq * 4);
            *(uint2*)(dst + mb * 16) = make_uint2(pack2(o[0][mb][0] * rstd * g[0], o[0][mb][1] * rstd * g[1]), pack2(o[0][mb][2] * rstd * g[2], o[0][mb][3] * rstd * g[3]));
        }
    }
}

#define N_ATT_LAT 512
#define N_ATT_CTX 64
#define N_CONV_LATE (1280 + 256 + 16384 + 8192)
__device__ __forceinline__ ConvDesc conv_late_desc(const Params& p, int pr) {
    const int j = pr * 2 + (tidx() >> 8);
    if (j < 1280) return ConvDesc{p.od_w_in, p.wt_odin, ODC, 1024, j / 80, j % 80, 2, 0};
    if (j < 1536) { const int q = j - 1280; return ConvDesc{p.od_w_out, p.wt_odout, 1024, 1024, q >> 4, q & 15, 2, 0}; }
    if (j < 1536 + 16384) { const int q = j - 1536, mat = q >> 9, t = q & 511; return ConvDesc{p.moe_w_gu + (size_t)mat * 1024 * 2048, p.wt_gu + (size_t)mat * 2048 * 1024, 2048, 1024, t >> 5, t & 31, 1, 0}; }
    const int q = j - 1536 - 16384, mat = q >> 8, t = q & 255;
    return ConvDesc{p.moe_w_dn + (size_t)mat * 1024 * 1024, p.wt_dn + (size_t)mat * 1024 * 1024, 1024, 1024, t >> 4, t & 15, 2, 0};
}
__device__ __forceinline__ ConvDesc conv_l1_desc(const Params& p, int pr) {
    const int j = pr * 2 + (tidx() >> 8);
    if (j < 16384) { const int mat = 32 + (j >> 9), t = j & 511; return ConvDesc{p.moe_w_gu + (size_t)mat * 1024 * 2048, p.wt_gu + (size_t)mat * 2048 * 1024, 2048, 1024, t >> 5, t & 31, 1, 0}; }
    const int q = j - 16384, mat = 32 + (q >> 8), t = q & 255;
    return ConvDesc{p.moe_w_dn + (size_t)mat * 1024 * 1024, p.wt_dn + (size_t)mat * 1024 * 1024, 1024, 1024, t >> 4, t & 15, 2, 0};
}
template <bool L1> __device__ __forceinline__ void conv_group(const Params& p, int g, char* smem) {
    float* lds = (float*)(smem + (tidx() >> 8) * HLDS);
    ConvDesc d = L1 ? conv_l1_desc(p, g * CONV_GRP) : conv_late_desc(p, g * CONV_GRP);
    ConvRegs x = conv_load(d);
#pragma unroll 1
    for (int q = 0; q < CONV_GRP; ++q) {
        ConvDesc dn = d; ConvRegs xn = x;
        if (q + 1 < CONV_GRP) { dn = L1 ? conv_l1_desc(p, g * CONV_GRP + q + 1) : conv_late_desc(p, g * CONV_GRP + q + 1); xn = conv_load(dn); }
        conv_store(x, d, lds);
        d = dn; x = xn;
    }
}
__device__ __forceinline__ void phase_scan_attn(const Params& p, int bid, int nblk, char* smem) {
    for (int it = bid; it < 128; it += nblk) rwkv_chunk_chain(p, it, smem);
    const int n_att = N_ATT_LAT + N_ATT_CTX, n_all = n_att + (N_CONV_LATE / 2) / CONV_GRP;
    for (;;) {
        const int it = q_next(p.counts + 64, smem);
        if (it >= n_all) break;
        if (it < N_ATT_LAT) attn_item(p, it >> 6, (it >> 4) & 3, (it & 15) * 128, false, smem);
        else if (it < n_att) { const int j = it - N_ATT_LAT; attn_item(p, j >> 3, (j >> 1) & 3, (j & 1) * 128, true, smem); }
        else {
            conv_group<false>(p, it - n_att, smem);
        }
    }
}

__device__ __forceinline__ void phase_rw_readout(const Params& p, int bid, int nblk) {
    const int lane = tidx() & 63, wid = tidx() >> 6;
    const int c0 = lane * 8;
    f32x4 rk0 = *(const f32x4*)(p.rw_r_k + c0), rk1 = *(const f32x4*)(p.rw_r_k + c0 + 4);
    f32x4 lw0 = *(const f32x4*)(p.rw_ln_w + c0), lw1 = *(const f32x4*)(p.rw_ln_w + c0 + 4);
    f32x4 lb0 = *(const f32x4*)(p.rw_ln_b + c0), lb1 = *(const f32x4*)(p.rw_ln_b + c0 + 4);
    for (int tok = bid * 8 + wid; tok < NT; tok += nblk * 8) {
        const size_t o = (size_t)tok * 512 + c0, zo = (size_t)NT * 512;
        float tya[8], tyb[8], tr[8], tka[8], tkb[8], tv[8], tg[8];
        unpack8(*(const u32x4*)(p.rY + o), tya); unpack8(*(const u32x4*)(p.rY + zo + o), tyb);
        unpack8(*(const u32x4*)(p.rR + o), tr); unpack8(*(const u32x4*)(p.rKD + o), tka); unpack8(*(const u32x4*)(p.rKD + zo + o), tkb);
        unpack8(*(const u32x4*)(p.rV + o), tv); unpack8(*(const u32x4*)(p.rG + o), tg);
        const f32x4 r0 = (f32x4){tr[0], tr[1], tr[2], tr[3]}, r1 = (f32x4){tr[4], tr[5], tr[6], tr[7]};
        const f32x4 ka0 = (f32x4){tka[0], tka[1], tka[2], tka[3]}, ka1 = (f32x4){tka[4], tka[5], tka[6], tka[7]}, kb0 = (f32x4){tkb[0], tkb[1], tkb[2], tkb[3]}, kb1 = (f32x4){tkb[4], tkb[5], tkb[6], tkb[7]};
        const f32x4 v0 = (f32x4){tv[0], tv[1], tv[2], tv[3]}, v1 = (f32x4){tv[4], tv[5], tv[6], tv[7]}, g0 = (f32x4){tg[0], tg[1], tg[2], tg[3]}, g1 = (f32x4){tg[4], tg[5], tg[6], tg[7]};
        const f32x4 y0 = (f32x4){tya[0] + tyb[0], tya[1] + tyb[1], tya[2] + tyb[2], tya[3] + tyb[3]}, y1 = (f32x4){tya[4] + tyb[4], tya[5] + tyb[5], tya[6] + tyb[6], tya[7] + tyb[7]};
        const float mean = sum8((y0[0] + y0[1]) + (y0[2] + y0[3]) + (y1[0] + y1[1]) + (y1[2] + y1[3])) * (1.0f / 64.0f);
        const f32x4 d0 = y0 - mean, d1 = y1 - mean;
        const float var = sum8((d0[0] * d0[0] + d0[1] * d0[1]) + (d0[2] * d0[2] + d0[3] * d0[3]) + (d1[0] * d1[0] + d1[1] * d1[1]) + (d1[2] * d1[2] + d1[3] * d1[3])) * (1.0f / 64.0f);
        const float rs = rsqrtf(var + 64e-5f);
        const f32x4 b0 = r0 * (ka0 + kb0) * rk0, b1 = r1 * (ka1 + kb1) * rk1;
        const float bon = sum8((b0[0] + b0[1]) + (b0[2] + b0[3]) + (b1[0] + b1[1]) + (b1[2] + b1[3]));
        const f32x4 o0 = (d0 * rs * lw0 + lb0 + bon * v0) * g0, o1 = (d1 * rs * lw1 + lb1 + bon * v1) * g1;
        *(u32x4*)(p.MG + (size_t)tok * DM + 512 + c0) = (u32x4){pack2(o0[0], o0[1]), pack2(o0[2], o0[3]), pack2(o1[0], o1[1]), pack2(o1[2], o1[3])};
    }
}

__device__ __forceinline__ void phase_router(const Params& p, int bid, int nblk, char* smem, int layer, const bf16_t* X, int ntok, bool dry = false) {
    const int tid = tidx(), lane = tid & 63, wid = tid >> 6;
    float* hrow = (float*)smem;
    float* part = hrow + 16 * 1028;
    float* logits = part + 8 * 512;
    const float* gain = p.norm2_g + layer * DM;
    const float* modl = p.mod + (size_t)layer * 9 * 6144;
    const float* wr = p.router_w + (size_t)layer * DM * NEXP;
    const float* br = p.router_b + layer * NEXP;
    int* counts = p.counts + layer * NEXP;
    int* lists = p.lists + (size_t)layer * NEXP * NT;
    for (int it = bid; it < ntok / 16; it += nblk) {
        __syncthreads();
#pragma unroll
        for (int u = 0; u < 2; ++u) {
            const int tl = wid * 2 + u, tok = it * 16 + tl;
            const bf16_t* xr = X + (size_t)tok * DM;
            const float* mr = modl + modrow(tok) * 6144 + 3072;
            float v0[8], v1[8];
            unpack8(*(const u32x4*)(xr + lane * 8), v0); unpack8(*(const u32x4*)(xr + 512 + lane * 8), v1);
            float ss = 0.f;
#pragma unroll
            for (int j = 0; j < 8; ++j) ss += v0[j] * v0[j] + v1[j] * v1[j];
            ss = wave_sum(ss);
            const float rstd = rsqrtf(ss * (1.0f / 1024.0f) + 1e-6f);
#pragma unroll
            for (int i = 0; i < 2; ++i) {
                const int c = lane * 8 + 512 * i;
                const f32x4 g0 = *(const f32x4*)(gain + c), g1 = *(const f32x4*)(gain + c + 4), sh0 = *(const f32x4*)(mr + c), sh1 = *(const f32x4*)(mr + c + 4);
                const f32x4 sc0 = *(const f32x4*)(mr + 1024 + c), sc1 = *(const f32x4*)(mr + 1024 + c + 4);
                float a[8];
#pragma unroll
                for (int j = 0; j < 4; ++j) {
                    a[j] = (i == 0 ? v0[j] : v1[j]) * rstd * g0[j] * (1.f + sc0[j]) + sh0[j];
                    a[4 + j] = (i == 0 ? v0[4 + j] : v1[4 + j]) * rstd * g1[j] * (1.f + sc1[j]) + sh1[j];
                }
                *(u32x4*)(p.H + (size_t)tok * DM + c) = pack8f(a);
                *(f32x4*)(hrow + tl * 1028 + c) = (f32x4){a[0], a[1], a[2], a[3]};
                *(f32x4*)(hrow + tl * 1028 + c + 4) = (f32x4){a[4], a[5], a[6], a[7]};
            }
        }
        __syncthreads();
        {
            const int tokl = lane & 15, kq = lane >> 4;
            f32x4 c0 = (f32x4){0.f, 0.f, 0.f, 0.f}, c1 = c0;
            const float* hp = hrow + tokl * 1028 + wid * 128 + kq;
            const float* wp = wr + (size_t)(wid * 128 + kq) * 32 + tokl;
#pragma unroll 8
            for (int ks = 0; ks < 32; ++ks) {
                const float a = hp[ks * 4];
                const float b0 = wp[ks * 128], b1 = wp[ks * 128 + 16];
                c0 = __builtin_amdgcn_mfma_f32_16x16x4f32(a, b0, c0, 0, 0, 0);
                c1 = __builtin_amdgcn_mfma_f32_16x16x4f32(a, b1, c1, 0, 0, 0);
            }
#pragma unroll
            for (int j = 0; j < 4; ++j) {
                part[wid * 512 + (4 * kq + j) * 32 + tokl] = c0[j];
                part[wid * 512 + (4 * kq + j) * 32 + 16 + tokl] = c1[j];
            }
        }
        __syncthreads();
        {
            const int tl = tid >> 5, e = tid & 31;
            float a = br[e];
#pragma unroll
            for (int w = 0; w < 8; ++w) a += part[w * 512 + tl * 32 + e];
            logits[tl * 32 + e] = a;
        }
        __syncthreads();
        if (tid < 16) {
            const int tok = it * 16 + tid;
            float lv[32];
#pragma unroll
            for (int e = 0; e < 32; ++e) lv[e] = logits[tid * 32 + e];
            float tv[4]; int te[4];
#pragma unroll
            for (int k = 0; k < 4; ++k) {
                float best = -3.0e38f; int bi = 0;
#pragma unroll
                for (int e = 0; e < 32; ++e) { if (lv[e] > best) { best = lv[e]; bi = e; } }
                tv[k] = best; te[k] = bi;
#pragma unroll
                for (int e = 0; e < 32; ++e) { if (e == bi) lv[e] = -3.0e38f; }
            }
            const float e1 = __expf(tv[1] - tv[0]), e2 = __expf(tv[2] - tv[0]), e3 = __expf(tv[3] - tv[0]);
            const float inv = 1.0f / (1.0f + e1 + e2 + e3);
            const float gt[4] = {inv, e1 * inv, e2 * inv, e3 * inv};
#pragma unroll
            for (int k = 0; k < 4; ++k) {
                p.GATE[(size_t)tok * 4 + k] = gt[k];
                if (!dry) {
                    const int pos = atomicAdd(&counts[te[k]], 1);
                    lists[(size_t)te[k] * NT + pos] = tok * 4 + k;
                }
            }
        }
    }
}

struct EpiGU {
    const float* bias; bf16_t* act; int pos0; int unit0;
    __device__ __forceinline__ void pair(int r, int cu, f32x4 g, f32x4 u) const {
        const int unit = unit0 + cu;
        unsigned w[2]; float o[4];
#pragma unroll
        for (int j = 0; j < 4; ++j) {
            const float gate = fminf(g[j] + bias[unit + j], 7.0f);
            const float up = fminf(fmaxf(u[j] + bias[1024 + unit + j], -7.0f), 7.0f);
            o[j] = (up + 1.0f) * gate * sigmoidf_(1.702f * gate);
        }
        w[0] = pack2(o[0], o[1]); w[1] = pack2(o[2], o[3]);
        *(uint2*)(act + (size_t)(pos0 + r) * 1024 + unit) = make_uint2(w[0], w[1]);
    }
};
struct MoeIter {
    int cnt[4], off[4], tiles[4], ntn, i, step, g;
    __device__ __forceinline__ void init(const int* counts, int NTN, int bid, int nblk) {
        g = bid & 7; i = (bid >> 3) * 2 + (tidx() >> 8); step = (nblk >> 3) * 2; ntn = NTN;
        int o = 0;
#pragma unroll
        for (int q = 0; q < 4; ++q) { cnt[q] = 0; off[q] = 0; tiles[q] = 0; }
        for (int e = 0; e < NEXP; ++e) {
            const int c = counts[e];
            if ((e & 7) == g) {
                const int q = e >> 3;
#pragma unroll
                for (int qq = 0; qq < 4; ++qq) if (qq == q) { cnt[qq] = c; off[qq] = o; tiles[qq] = ((c + 127) >> 7) * NTN; }
            }
            o += c;
        }
    }
    __device__ __forceinline__ bool next(int& e, int& mt, int& nt, int& eoff, int& ecnt) {
        int j = i, q = 0;
        if (j >= tiles[0]) { j -= tiles[0]; q = 1; if (j >= tiles[1]) { j -= tiles[1]; q = 2; if (j >= tiles[2]) { j -= tiles[2]; q = 3; if (j >= tiles[3]) return false; } } }
        int c = cnt[0], o = off[0];
        if (q == 1) { c = cnt[1]; o = off[1]; } else if (q == 2) { c = cnt[2]; o = off[2]; } else if (q == 3) { c = cnt[3]; o = off[3]; }
        const int mcnt = (c + 127) >> 7, full = mcnt >> 3, band = 8 * ntn;
        if (j < full * band) { const int ms = j / band, r = j - ms * band; nt = r >> 3; mt = ms * 8 + (r & 7); }
        else { const int rem = mcnt - full * 8, jj = j - full * band; nt = jj / rem; mt = full * 8 + (jj - nt * rem); }
        e = q * 8 + g; eoff = o; ecnt = c;
        i += step;
        return true;
    }
};

struct PlainOrder8 {
    const char* A; const char* Bt; int K;
    int mg0, mcnt, ntn, total, full, i, step;
    __device__ __forceinline__ void init(const bf16_t* A_, const bf16_t* Bt_, int K_, int MT, int NTN, int bid, int nblk) {
        A = (const char*)A_; Bt = (const char*)Bt_; K = K_;
        const int g = bid & 7;
        mg0 = (MT * g) >> 3; mcnt = ((MT * (g + 1)) >> 3) - mg0; ntn = NTN; total = mcnt * NTN; full = mcnt >> 3; i = bid >> 3; step = nblk >> 3;
    }
    __device__ __forceinline__ bool next(g8::Unit& u) {
        if (i >= total) return false;
        int mt, nt;
        const int band = 8 * ntn;
        if (i < full * band) { const int ms = i / band, r = i - ms * band; nt = r >> 3; mt = mg0 + ms * 8 + (r & 7); }
        else { const int rem = mcnt - full * 8, j = i - full * band; nt = j / rem; mt = mg0 + full * 8 + (j - nt * rem); }
        i += step;
        u.a = A + (size_t)mt * 256 * K * 2; u.b = Bt + (size_t)nt * 256 * K * 2; u.gidx = nullptr; u.idx = nullptr; u.shift = 0; u.rows = 256; u.i0 = mt * 256; u.i1 = nt * 256; u.i2 = 0;
        return true;
    }
};
struct Epi8Store {
    float* C; int ldc;
    __device__ __forceinline__ void operator()(const f32x4 (&acc)[2][2][4][2], const g8::Unit& u, int wr, int wc, int fr, int fq) const {
#pragma unroll
        for (int ai = 0; ai < 2; ++ai)
#pragma unroll
            for (int m = 0; m < 4; ++m) {
                float* rowp = C + (size_t)(u.i0 + ai * 128 + wr * 64 + m * 16 + fr) * ldc + u.i1 + wc * 32 + fq * 4;
#pragma unroll
                for (int bj = 0; bj < 2; ++bj)
#pragma unroll
                    for (int n = 0; n < 2; ++n) *(f32x4*)(rowp + bj * 128 + n * 16) = acc[ai][bj][m][n];
            }
    }
};
struct Epi8StoreBf {
    bf16_t* C; int ldc;
    __device__ __forceinline__ void operator()(const f32x4 (&acc)[2][2][4][2], const g8::Unit& u, int wr, int wc, int fr, int fq) const {
#pragma unroll
        for (int ai = 0; ai < 2; ++ai)
#pragma unroll
            for (int m = 0; m < 4; ++m) {
                bf16_t* rowp = C + (size_t)(u.i0 + ai * 128 + wr * 64 + m * 16 + fr) * ldc + u.i1 + wc * 32 + fq * 8;
#pragma unroll
                for (int bj = 0; bj < 2; ++bj) {
                    const f32x4 v0 = acc[ai][bj][m][0], v1 = acc[ai][bj][m][1];
                    *(u32x4*)(rowp + bj * 128) = (u32x4){pack2(v0[0], v0[1]), pack2(v0[2], v0[3]), pack2(v1[0], v1[1]), pack2(v1[2], v1[3])};
                }
            }
    }
};
struct Epi8StoreHg {
    bf16_t* C; const float* hg_lb;
    __device__ __forceinline__ void operator()(const f32x4 (&acc)[2][2][4][2], const g8::Unit& u, int wr, int wc, int fr, int fq) const {
        const int c0 = u.i1 + wc * 32 + fq * 8;
        const int kind = u.i1 < 1024 ? 0 : (u.i1 < 3072 ? 1 : 2);
        f32x4 lbv[2][2];
        if (kind == 1) {
#pragma unroll
            for (int bj = 0; bj < 2; ++bj)
#pragma unroll
                for (int n = 0; n < 2; ++n) {
                    const int ch = (c0 + bj * 128 + n * 4) & 1023;
                    const f32x4 h0 = *(const f32x4*)(hg_lb + ch), h1 = *(const f32x4*)(hg_lb + 1024 + ch);
#pragma unroll
                    for (int j = 0; j < 4; ++j) lbv[bj][n][j] = 1.f - __builtin_amdgcn_rcpf(1.0f + __expf(h0[j] - h1[j]));
                }
        }
#pragma unroll
        for (int ai = 0; ai < 2; ++ai)
#pragma unroll
            for (int m = 0; m < 4; ++m) {
                bf16_t* rowp = C + (size_t)(u.i0 + ai * 128 + wr * 64 + m * 16 + fr) * ODC + c0;
#pragma unroll
                for (int bj = 0; bj < 2; ++bj) {
                    f32x4 v0 = acc[ai][bj][m][0], v1 = acc[ai][bj][m][1];
                    if (kind == 0) {
#pragma unroll
                        for (int j = 0; j < 4; ++j) { v0[j] = siluf_(v0[j]); v1[j] = siluf_(v1[j]); }
                    } else if (kind == 1) {
#pragma unroll
                        for (int j = 0; j < 4; ++j) {
                            v0[j] = lbv[bj][0][j] * __builtin_amdgcn_rcpf(1.0f + __expf(v0[j]));
                            v1[j] = lbv[bj][1][j] * __builtin_amdgcn_rcpf(1.0f + __expf(v1[j]));
                        }
                    }
                    *(u32x4*)(rowp + bj * 128) = (u32x4){pack2(v0[0], v0[1]), pack2(v0[2], v0[3]), pack2(v1[0], v1[1]), pack2(v1[2], v1[3])};
                }
                asm volatile("" ::: "memory");
            }
    }
};
template <bool IN_BF16>
struct Epi8Resid {
    const void* xin_lat; const void* xin_ctx; bf16_t* xout; const float* gmod;
    __device__ __forceinline__ void operator()(const f32x4 (&acc)[2][2][4][2], const g8::Unit& u, int wr, int wc, int fr, int fq) const {
        const int c0 = u.i1 + wc * 32 + fq * 8;
        const float* gr = gmod + modrow(u.i0) * 6144 + c0;
        f32x4 g[2][2];
#pragma unroll
        for (int bj = 0; bj < 2; ++bj)
#pragma unroll
            for (int n = 0; n < 2; ++n) g[bj][n] = *(const f32x4*)(gr + bj * 128 + n * 4);
#pragma unroll
        for (int ai = 0; ai < 2; ++ai)
#pragma unroll
            for (int m = 0; m < 4; ++m) {
                const int tok = u.i0 + ai * 128 + wr * 64 + m * 16 + fr;
                const size_t ro = (tok < NX ? (size_t)tok * DM : (size_t)(tok - NX) * DM) + c0;
                bf16_t* orow = xout + (size_t)tok * DM + c0;
                if constexpr (IN_BF16) {
                    const bf16_t* xr = (tok < NX ? (const bf16_t*)xin_lat : (const bf16_t*)xin_ctx) + ro;
                    const u32x4 xw0 = *(const u32x4*)(xr), xw1 = *(const u32x4*)(xr + 128);
#pragma unroll
                    for (int bj = 0; bj < 2; ++bj) {
                        float xf[8], o[8];
                        unpack8(bj == 0 ? xw0 : xw1, xf);
                        const f32x4 v0 = acc[ai][bj][m][0], v1 = acc[ai][bj][m][1];
#pragma unroll
                        for (int j = 0; j < 4; ++j) { o[j] = xf[j] + g[bj][0][j] * v0[j]; o[4 + j] = xf[4 + j] + g[bj][1][j] * v1[j]; }
                        *(u32x4*)(orow + bj * 128) = pack8f(o);
                    }
                } else {
                    const float* xr = (tok < NX ? (const float*)xin_lat : (const float*)xin_ctx) + ro;
                    f32x4 xi[2][2];
#pragma unroll
                    for (int bj = 0; bj < 2; ++bj)
#pragma unroll
                        for (int n = 0; n < 2; ++n) xi[bj][n] = *(const f32x4*)(xr + bj * 128 + n * 4);
#pragma unroll
                    for (int bj = 0; bj < 2; ++bj) {
                        const f32x4 o0 = xi[bj][0] + g[bj][0] * acc[ai][bj][m][0], o1 = xi[bj][1] + g[bj][1] * acc[ai][bj][m][1];
                        *(u32x4*)(orow + bj * 128) = (u32x4){pack2(o0[0], o0[1]), pack2(o0[2], o0[3]), pack2(o1[0], o1[1]), pack2(o1[2], o1[3])};
                    }
                }
                asm volatile("" ::: "memory");
            }
    }
};
struct MoeOrder8 {
    int cvec;
    const int* lists; const char* A; const char* W; int wrows, ntn, i, step, g;
    bool gather;
    __device__ __forceinline__ void init(const int* counts_, const int* lists_, const bf16_t* A_, const bf16_t* W_, int wrows_, bool gather_, int bid, int nblk) {
        cvec = counts_[tidx() & 31]; lists = lists_; A = (const char*)A_; W = (const char*)W_; wrows = wrows_; ntn = wrows_ / 256; gather = gather_;
        g = bid & 7; i = bid >> 3; step = nblk >> 3;
    }
    __device__ __forceinline__ bool next(g8::Unit& u) {
        int j = i, o = 0, fe = -1, fo = 0, fc = 0, fm = 1;
#pragma unroll
        for (int e = 0; e < NEXP; ++e) {
            const int c = __builtin_amdgcn_readlane(cvec, e);
            if ((e & 7) == g && fe < 0) {
                const int mcnt = (c + 255) >> 8, t = mcnt * ntn;
                if (j < t) { fe = e; fo = o; fc = c; fm = mcnt; }
                else j -= t;
            }
            o += c;
        }
        if (fe < 0) return false;
        const int nt = j / fm, mt = j - nt * fm;
        i += step;
        u.idx = lists + (size_t)fe * NT + mt * 256; u.gidx = gather ? u.idx : nullptr; u.rows = min(256, fc - mt * 256); u.shift = 2;
        u.a = gather ? A : A + (size_t)(fo + mt * 256) * 1024 * 2;
        u.b = W + ((size_t)fe * wrows + (size_t)nt * 256) * 1024 * 2;
        u.i0 = fo + mt * 256;
        u.i1 = nt;
        u.i2 = fe;
        return true;
    }
};
struct Epi8GU {
    const float* bias; bf16_t* act;
    __device__ __forceinline__ void operator()(const f32x4 (&acc)[2][2][4][2], const g8::Unit& u, int wr, int wc, int fr, int fq) const {
        const float* be = bias + (size_t)u.i2 * 2048;
        const int unit = u.i1 * 128 + wc * 32 + fq * 8;
        const f32x4 bg0 = *(const f32x4*)(be + unit), bg1 = *(const f32x4*)(be + unit + 4), bu0 = *(const f32x4*)(be + 1024 + unit), bu1 = *(const f32x4*)(be + 1024 + unit + 4);
#pragma unroll
        for (int ai = 0; ai < 2; ++ai)
#pragma unroll
            for (int m = 0; m < 4; ++m) {
                const int r = ai * 128 + wr * 64 + m * 16 + fr;
                if (r < u.rows) {
                    float o[8];
#pragma unroll
                    for (int bj = 0; bj < 2; ++bj) {
                        const f32x4 g = acc[ai][bj][m][0] + (bj ? bg1 : bg0), up = acc[ai][bj][m][1] + (bj ? bu1 : bu0);
#pragma unroll
                        for (int j = 0; j < 4; ++j) {
                            const float gate = fminf(g[j], 7.0f);
                            const float uu = fminf(fmaxf(up[j], -7.0f), 7.0f);
                            o[bj * 4 + j] = (uu + 1.0f) * gate * sigmoidf_(1.702f * gate);
                        }
                    }
                    *(u32x4*)(act + (size_t)(u.i0 + r) * 1024 + unit) = (u32x4){pack2(o[0], o[1]), pack2(o[2], o[3]), pack2(o[4], o[5]), pack2(o[6], o[7])};
                }
                asm volatile("" ::: "memory");
            }
    }
};
struct Epi8DN {
    const float* bias; bf16_t* ys;
    __device__ __forceinline__ void operator()(const f32x4 (&acc)[2][2][4][2], const g8::Unit& u, int wr, int wc, int fr, int fq) const {
        const int cb = u.i1 * 256 + wc * 32 + fq * 8;
        const float* be = bias + (size_t)u.i2 * 1024 + cb;
        const f32x4 b00 = *(const f32x4*)(be), b01 = *(const f32x4*)(be + 4), b10 = *(const f32x4*)(be + 128), b11 = *(const f32x4*)(be + 132);
#pragma unroll
        for (int ai = 0; ai < 2; ++ai)
#pragma unroll
            for (int m = 0; m < 4; ++m) {
                const int r = ai * 128 + wr * 64 + m * 16 + fr;
                if (r < u.rows) {
                    const int a = u.idx[r];
                    bf16_t* orow = ys + (size_t)a * 1024 + cb;
#pragma unroll
                    for (int bj = 0; bj < 2; ++bj) {
                        const f32x4 v0 = acc[ai][bj][m][0] + (bj ? b10 : b00), v1 = acc[ai][bj][m][1] + (bj ? b11 : b01);
                        *(u32x4*)(orow + bj * 128) = (u32x4){pack2(v0[0], v0[1]), pack2(v0[2], v0[3]), pack2(v1[0], v1[1]), pack2(v1[2], v1[3])};
                    }
                }
                asm volatile("" ::: "memory");
            }
    }
};
__device__ __forceinline__ void phase_gemm8_store(const bf16_t* A, int M, const bf16_t* Wt, int N, float* C, int bid, int nblk, char* smem) {
    PlainOrder8 S; S.init(A, Wt, DM, M / 256, N / 256, bid, nblk);
    Epi8Store E{C, N};
    g8::gemm_phase((G8_LAS unsigned char*)smem, DM, S, E);
}
__device__ __forceinline__ void phase_gemm8_store_bf(const bf16_t* A, int M, const bf16_t* Wt, int N, bf16_t* C, int bid, int nblk, char* smem) {
    PlainOrder8 S; S.init(A, Wt, DM, M / 256, N / 256, bid, nblk);
    Epi8StoreBf E{C, N};
    g8::gemm_phase((G8_LAS unsigned char*)smem, DM, S, E);
}
__device__ __forceinline__ void phase_gemm8_store_hg(const Params& p, int bid, int nblk, char* smem) {
    PlainOrder8 S; S.init(p.H, p.wt_odin, DM, NT / 256, ODC / 256, bid, nblk);
    Epi8StoreHg E{(bf16_t*)p.P, p.hg_lb};
    g8::gemm_phase((G8_LAS unsigned char*)smem, DM, S, E);
}
template <bool IN_BF16>
__device__ __forceinline__ void phase_outproj8(const Params& p, int bid, int nblk, char* smem, const bf16_t* Wt, int ntok, const void* xin_lat, const void* xin_ctx, bf16_t* xout, const float* gmod) {
    PlainOrder8 S; S.init(p.MG, Wt, DM, ntok / 256, 4, bid, nblk);
    Epi8Resid<IN_BF16> E{xin_lat, xin_ctx, xout, gmod};
    g8::gemm_phase((G8_LAS unsigned char*)smem, DM, S, E);
}
__device__ __forceinline__ void phase_moe_gu8(const Params& p, int bid, int nblk, char* smem, int layer) {
    MoeOrder8 S; S.init(p.counts + layer * NEXP, p.lists + (size_t)layer * NEXP * NT, p.H, p.wt_gu + (size_t)layer * NEXP * 2048 * 1024, 2048, true, bid, nblk);
    Epi8GU E{p.moe_b_gu + (size_t)layer * NEXP * 2048, p.ACT};
    g8::gemm_phase((G8_LAS unsigned char*)smem, DM, S, E);
}
__device__ __forceinline__ void phase_moe_dn8(const Params& p, int bid, int nblk, char* smem, int layer) {
    MoeOrder8 S; S.init(p.counts + layer * NEXP, p.lists + (size_t)layer * NEXP * NT, p.ACT, p.wt_dn + (size_t)layer * NEXP * 1024 * 1024, 1024, false, bid, nblk);
    Epi8DN E{p.moe_b_dn + (size_t)layer * NEXP * 1024, p.YS};
    g8::gemm_phase((G8_LAS unsigned char*)smem, DM, S, E);
}

template <bool OUT_BF16>
__device__ __forceinline__ void phase_combine(const Params& p, int bid, int nblk, const bf16_t* Xin, void* Xout, const float* gmod  , int ntok,
                              bool do_norm, const float* gain, const float* modn) {
    const int lane = tidx() & 63, wid = tidx() >> 6;
    for (int tok = bid * 8 + wid; tok < ntok; tok += nblk * 8) {
        const float* gr = gmod + modrow(tok) * 6144;
        const f32x4 gt = *(const f32x4*)(p.GATE + (size_t)tok * 4);
        const bf16_t* ys = p.YS + (size_t)tok * 4 * 1024;
        float v0[8], v1[8];
        float ss = 0.f;
#pragma unroll
        for (int i = 0; i < 2; ++i) {
            const int c = lane * 8 + 512 * i;
            float xi[8], y0[8], y1[8], y2[8], y3[8];
            unpack8(*(const u32x4*)(Xin + (size_t)tok * DM + c), xi);
            unpack8(*(const u32x4*)(ys + c), y0); unpack8(*(const u32x4*)(ys + 1024 + c), y1); unpack8(*(const u32x4*)(ys + 2048 + c), y2); unpack8(*(const u32x4*)(ys + 3072 + c), y3);
            const f32x4 ga = *(const f32x4*)(gr + c), gb = *(const f32x4*)(gr + c + 4);
            float o[8];
#pragma unroll
            for (int j = 0; j < 8; ++j) {
                o[j] = xi[j] + (j < 4 ? ga[j & 3] : gb[j & 3]) * (gt[0] * y0[j] + gt[1] * y1[j] + gt[2] * y2[j] + gt[3] * y3[j]);
                ss += o[j] * o[j];
                if (i == 0) v0[j] = o[j]; else v1[j] = o[j];
            }
            if constexpr (OUT_BF16) *(u32x4*)((bf16_t*)Xout + (size_t)tok * DM + c) = pack8f(o);
            else {
                *(f32x4*)((float*)Xout + (size_t)tok * DM + c) = (f32x4){o[0], o[1], o[2], o[3]};
                *(f32x4*)((float*)Xout + (size_t)tok * DM + c + 4) = (f32x4){o[4], o[5], o[6], o[7]};
            }
        }
        if (do_norm) {
            ss = wave_sum(ss);
            const float rstd = rsqrtf(ss * (1.0f / 1024.0f) + 1e-6f);
            const float* mr = modn + modrow(tok) * 6144;
#pragma unroll
            for (int i = 0; i < 2; ++i) {
                const int c = lane * 8 + 512 * i;
                const f32x4 g0 = *(const f32x4*)(gain + c), g1 = *(const f32x4*)(gain + c + 4), sh0 = *(const f32x4*)(mr + c), sh1 = *(const f32x4*)(mr + c + 4);
                const f32x4 sc0 = *(const f32x4*)(mr + 1024 + c), sc1 = *(const f32x4*)(mr + 1024 + c + 4);
                float a[8];
#pragma unroll
                for (int j = 0; j < 4; ++j) {
                    a[j] = (i == 0 ? v0[j] : v1[j]) * rstd * g0[j] * (1.f + sc0[j]) + sh0[j];
                    a[4 + j] = (i == 0 ? v0[4 + j] : v1[4 + j]) * rstd * g1[j] * (1.f + sc1[j]) + sh1[j];
                }
                *(u32x4*)(p.H + (size_t)tok * DM + c) = pack8f(a);
            }
        }
    }
}

__device__ __forceinline__ bf16x8 pack8(const f32x4 a, const f32x4 b) {
    union { bf16x8 v; unsigned u[4]; } r;
    r.u[0] = pack2(a[0], a[1]); r.u[1] = pack2(a[2], a[3]); r.u[2] = pack2(b[0], b[1]); r.u[3] = pack2(b[2], b[3]);
    return r.v;
}
__device__ __forceinline__ void hgrn_chain(const Params& p, int chain, char* smem) {
    const int z = chain >> 6, b = (chain >> 3) & 7, h = chain & 7;
    const int tid = tidx(), lane = tid & 63, wid = tid >> 6, fr = lane & 15, fq = lane >> 4;
    bf16_t* sQ = (bf16_t*)smem;
    bf16_t* sK = sQ + 32 * 128;
    bf16_t* sKL = sK + 32 * 128;
    bf16_t* sV = sKL + 128 * 32;
    float* sT = (float*)(sV + 128 * 32);
    float* sEBL = sT + 1024;
    const int cp = tid & 63, g4 = tid >> 6;
    f32x4 S[8];
#pragma unroll
    for (int mi = 0; mi < 8; ++mi) S[mi] = (f32x4){0.f, 0.f, 0.f, 0.f};
    unsigned qA[4], fA[4], iA[4], qB[4], fB[4], iB[4];
    auto issue = [&](int chunk, unsigned (&rq)[4], unsigned (&rf)[4], unsigned (&ri)[4]) {
        const int tok0 = scan_tok(z, b, chunk * 32 + g4 * 4);
        const unsigned* pr = (const unsigned*)((const bf16_t*)p.P + (size_t)tok0 * ODC + h * 128) + cp;
        const int stride = z == 0 ? ODC / 2 : -(ODC / 2);
#pragma unroll
        for (int i = 0; i < 4; ++i) {
            rq[i] = pr[0]; rf[i] = pr[512 * (1 + z)]; ri[i] = pr[1536];
            pr += stride;
        }
    };
    issue(0, qA, fA, iA);
    issue(1, qB, fB, iB);
    auto body = [&](int chunk, unsigned (&rq)[4], unsigned (&rf)[4], unsigned (&ri)[4]) {
        float bc0[4], bc1[4], k0[4], k1[4];
        {
            float run0 = 1.f, run1 = 1.f;
#pragma unroll
            for (int i = 0; i < 4; ++i) {
                k0[i] = __uint_as_float(rf[i] << 16); k1[i] = __uint_as_float(rf[i] & 0xffff0000u);
                run0 *= 1.f - k0[i]; run1 *= 1.f - k1[i];
                bc0[i] = run0; bc1[i] = run1;
            }
            *(f32x2_*)(sT + g4 * 128 + 2 * cp) = (f32x2_){run0, run1};
        }
        __syncthreads();
        {
            float boff0 = 1.f, boff1 = 1.f, ebl0 = 1.f, ebl1 = 1.f;
#pragma unroll
            for (int j = 0; j < 8; ++j) {
                const f32x2_ t = *(const f32x2_*)(sT + j * 128 + 2 * cp);
                if (j < g4) { boff0 *= t[0]; boff1 *= t[1]; }
                ebl0 *= t[0]; ebl1 *= t[1];
            }
            if (g4 == 0) *(f32x2_*)(sEBL + 2 * cp) = (f32x2_){ebl0, ebl1};
            float kl0[4], kl1[4];
#pragma unroll
            for (int i = 0; i < 4; ++i) {
                const int t = g4 * 4 + i;
                const float eb0 = bc0[i] * boff0, eb1 = bc1[i] * boff1;
                const float emb0 = __builtin_amdgcn_rcpf(eb0), emb1 = __builtin_amdgcn_rcpf(eb1);
                const float qe0 = __uint_as_float(rq[i] << 16) * eb0, qe1 = __uint_as_float(rq[i] & 0xffff0000u) * eb1;
                const float ke0 = k0[i] * emb0, ke1 = k1[i] * emb1;
                kl0[i] = ke0 * ebl0; kl1[i] = ke1 * ebl1;
                const int off = t * 128 + (((cp >> 2) ^ (t & 15)) << 3) + ((cp & 3) << 1);
                *(unsigned*)(sQ + off) = pack2(qe0, qe1);
                *(unsigned*)(sK + off) = pack2(ke0, ke1);
            }
            const int ch0 = 2 * cp;
            const int o2 = ch0 * 32 + (((g4 >> 1) ^ ((ch0 >> 2) & 3)) << 3) + (g4 & 1) * 4;
            *(uint2*)(sKL + o2) = make_uint2(pack2(kl0[0], kl0[1]), pack2(kl0[2], kl0[3]));
            *(uint2*)(sKL + o2 + 32) = make_uint2(pack2(kl1[0], kl1[1]), pack2(kl1[2], kl1[3]));
            *(uint2*)(sV + o2) = make_uint2((ri[0] & 0xffffu) | (ri[1] << 16), (ri[2] & 0xffffu) | (ri[3] << 16));
            *(uint2*)(sV + o2 + 32) = make_uint2((ri[0] >> 16) | (ri[1] & 0xffff0000u), (ri[2] >> 16) | (ri[3] & 0xffff0000u));
        }
        __syncthreads();
        if (chunk + 2 < 72) issue(chunk + 2, rq, rf, ri);
        f32x4 sc00 = (f32x4){0.f, 0.f, 0.f, 0.f}, sc01 = sc00, sc11 = sc00;
#pragma unroll
        for (int ks = 0; ks < 4; ++ks) {
            const int c = ks * 4 + fq;
            const bf16x8 k0 = *(const bf16x8*)(sK + fr * 128 + ((c ^ fr) << 3));
            const bf16x8 k1 = *(const bf16x8*)(sK + (16 + fr) * 128 + ((c ^ fr) << 3));
            const bf16x8 q0 = *(const bf16x8*)(sQ + fr * 128 + ((c ^ fr) << 3));
            const bf16x8 q1 = *(const bf16x8*)(sQ + (16 + fr) * 128 + ((c ^ fr) << 3));
            sc00 = __builtin_amdgcn_mfma_f32_16x16x32_bf16(k0, q0, sc00, 0, 0, 0);
            sc01 = __builtin_amdgcn_mfma_f32_16x16x32_bf16(k0, q1, sc01, 0, 0, 0);
            sc11 = __builtin_amdgcn_mfma_f32_16x16x32_bf16(k1, q1, sc11, 0, 0, 0);
        }
#pragma unroll
        for (int j = 0; j < 4; ++j) { if (4 * fq + j > fr) { sc00[j] = 0.f; sc11[j] = 0.f; } }
        const f32x4 zero4 = (f32x4){0.f, 0.f, 0.f, 0.f};
        const bf16x8 pf0 = pack8(sc00, zero4), pf1 = pack8(sc01, sc11);
        asm volatile("" ::: "memory");
        f32x4 o[2];
        o[0] = zero4; o[1] = zero4;
        const int r0 = wid * 16 + fr;
        {
            union { bf16x8 v; uint2 u[2]; } vp0;
            vp0.u[0] = *(const uint2*)(sV + r0 * 32 + ((((fq >> 1)) ^ ((r0 >> 2) & 3)) << 3) + (fq & 1) * 4);
            vp0.u[1] = *(const uint2*)(sV + r0 * 32 + (((2 + (fq >> 1)) ^ ((r0 >> 2) & 3)) << 3) + (fq & 1) * 4);
            o[0] = __builtin_amdgcn_mfma_f32_16x16x32_bf16(vp0.v, pf0, o[0], 0, 0, 0);
            o[1] = __builtin_amdgcn_mfma_f32_16x16x32_bf16(vp0.v, pf1, o[1], 0, 0, 0);
        }
#pragma unroll
        for (int kp = 0; kp < 4; ++kp) {
            const bf16x8 sf0 = pack8(S[2 * kp], S[2 * kp + 1]);
            const int c0 = 4 * kp + (fq >> 1), c1 = c0 + 2;
            union { bf16x8 v; uint2 u[2]; } qa, qb;
            qa.u[0] = *(const uint2*)(sQ + fr * 128 + ((c0 ^ fr) << 3) + (fq & 1) * 4);
            qa.u[1] = *(const uint2*)(sQ + fr * 128 + ((c1 ^ fr) << 3) + (fq & 1) * 4);
            qb.u[0] = *(const uint2*)(sQ + (16 + fr) * 128 + ((c0 ^ fr) << 3) + (fq & 1) * 4);
            qb.u[1] = *(const uint2*)(sQ + (16 + fr) * 128 + ((c1 ^ fr) << 3) + (fq & 1) * 4);
            o[0] = __builtin_amdgcn_mfma_f32_16x16x32_bf16(sf0, qa.v, o[0], 0, 0, 0);
            o[1] = __builtin_amdgcn_mfma_f32_16x16x32_bf16(sf0, qb.v, o[1], 0, 0, 0);
        }
        if (chunk >= 8) {
#pragma unroll
            for (int tb = 0; tb < 2; ++tb) {
                const int tok = scan_tok(z, b, chunk * 32 + tb * 16 + fr);
                *(uint2*)((bf16_t*)p.HO + ((size_t)z * NX + tok) * 1024 + h * 128 + wid * 16 + fq * 4) = make_uint2(pack2(o[tb][0], o[tb][1]), pack2(o[tb][2], o[tb][3]));
            }
        }
        asm volatile("" ::: "memory");
        {
            const bf16x8 v0 = *(const bf16x8*)(sV + r0 * 32 + ((fq ^ ((r0 >> 2) & 3)) << 3));
#pragma unroll
            for (int mi = 0; mi < 8; ++mi) {
                const int r = mi * 16 + fr;
                const bf16x8 kl = *(const bf16x8*)(sKL + r * 32 + ((fq ^ ((r >> 2) & 3)) << 3));
                const f32x4 e = *(const f32x4*)(sEBL + mi * 16 + fq * 4);
                S[mi] = __builtin_amdgcn_mfma_f32_16x16x32_bf16(kl, v0, S[mi] * e, 0, 0, 0);
            }
        }
    };
    for (int chunk = 0; chunk < 72; chunk += 2) { body(chunk, qA, fA, iA); body(chunk + 1, qB, fB, iB); }
    __syncthreads();
}
__device__ __forceinline__ void phase_hgrn(const Params& p, int bid, int nblk, char* smem) {
    for (int it = bid; it < 128; it += nblk) hgrn_chain(p, it, smem);
    const int n_all = ((16384 + 8192) / 2) / CONV_GRP;
    for (;;) {
        const int it = q_next(p.counts + 65, smem);
        if (it >= n_all) break;
        conv_group<true>(p, it, smem);
    }
}
__device__ __forceinline__ void phase_hgrn_readout(const Params& p, int bid, int nblk) {
    const int lane = tidx() & 63, wid = tidx() >> 6;
    const int c0 = lane * 8;
    const f32x4 n0 = *(const f32x4*)(p.hg_norm + (c0 & 127)), n1 = *(const f32x4*)(p.hg_norm + (c0 & 127) + 4);
    for (int tok = bid * 8 + wid; tok < NX; tok += nblk * 8) {
#pragma unroll
        for (int q = 0; q < 2; ++q) {
            const size_t o = (size_t)tok * 1024 + q * 512 + c0, zo = (size_t)NX * 1024;
            float ta[8], tb[8], tg[8];
            unpack8(*(const u32x4*)((const bf16_t*)p.HO + o), ta); unpack8(*(const u32x4*)((const bf16_t*)p.HO + zo + o), tb);
            unpack8(*(const u32x4*)((const bf16_t*)p.P + (size_t)tok * ODC + 4096 + q * 512 + c0), tg);
            const f32x4 y0 = (f32x4){ta[0] + tb[0], ta[1] + tb[1], ta[2] + tb[2], ta[3] + tb[3]}, y1 = (f32x4){ta[4] + tb[4], ta[5] + tb[5], ta[6] + tb[6], ta[7] + tb[7]};
            const f32x4 g0 = (f32x4){tg[0], tg[1], tg[2], tg[3]}, g1 = (f32x4){tg[4], tg[5], tg[6], tg[7]};
            float ss = sum8((y0[0] * y0[0] + y0[1] * y0[1]) + (y0[2] * y0[2] + y0[3] * y0[3]) + (y1[0] * y1[0] + y1[1] * y1[1]) + (y1[2] * y1[2] + y1[3] * y1[3]));
            ss += dpp_f<0x140>(ss);
            const float rstd = rsqrtf(ss * (1.0f / 128.0f) + 1e-6f);
            float r[8];
#pragma unroll
            for (int j = 0; j < 4; ++j) { r[j] = y0[j] * rstd * n0[j] * siluf_(g0[j]); r[4 + j] = y1[j] * rstd * n1[j] * siluf_(g1[j]); }
            *(u32x4*)(p.MG + o) = (u32x4){pack2(r[0], r[1]), pack2(r[2], r[3]), pack2(r[4], r[5]), pack2(r[6], r[7])};
        }
    }
}

#define N_PHASES 20
__device__ __forceinline__ void run_phase(const Params& p, int ph, int bid, int nblk, char* smem) {
    const float* mod0 = p.mod;
    const float* mod1 = p.mod + 9 * 6144;
    switch (ph) {
    case 0: phase0a(p, bid, nblk, smem); break;
    case 1: phase0b(p, bid, nblk); break;
    case 2: phase_norm(p, bid, nblk, p.x, p.ctx, p.norm1_g, mod0, 0, NT); break;
    case 3: phase_gemm8_store_bf(p.H, NT, p.wt_evin, EVC, (bf16_t*)p.P, bid, nblk, smem); break;
    case 4: phase_feat0(p, bid, nblk, smem); break;
    case 5: phase_lora(p, bid, nblk, smem); break;
    case 6: phase_scan_attn(p, bid, nblk, smem); break;
    case 7: phase_rw_readout(p, bid, nblk); break;
    case 8: phase_outproj8<false>(p, bid, nblk, smem, p.wt_evout, NT, p.x, p.ctx, p.X1, mod0 + 2048); break;
    case 9: phase_router(p, bid, nblk, smem, 0, p.X1, NT); break;
    case 10: phase_moe_gu8(p, bid, nblk, smem, 0); break;
    case 11: phase_moe_dn8(p, bid, nblk, smem, 0); break;
    case 12: phase_combine<true>(p, bid, nblk, p.X1, p.X2, mod0 + 5120, NT, true, p.norm1_g + DM, mod1); break;
    case 13: phase_gemm8_store_hg(p, bid, nblk, smem); break;
    case 14: phase_hgrn(p, bid, nblk, smem); break;
    case 15: phase_hgrn_readout(p, bid, nblk); break;
    case 16: phase_outproj8<true>(p, bid, nblk, smem, p.wt_odout, NX, p.X2, p.X2 + (size_t)NX * DM, p.X1, mod1 + 2048); break;
    case 17: phase_router(p, bid, nblk, smem, 1, p.X1, NX); break;
    case 18: phase_moe_gu8(p, bid, nblk, smem, 1); break;
    case 19: phase_moe_dn8(p, bid, nblk, smem, 1); break;
    default: break;
    }
}
__device__ __forceinline__ void final_phase(const Params& p, int bid, int nblk) {
    phase_combine<false>(p, bid, nblk, p.X1, p.out, p.mod + 9 * 6144 + 5120, NX, false, nullptr, nullptr);
}

struct KArgs { const float* in[35]; float* out; char* ws; };

__host__ __device__ __forceinline__ size_t make_params(Params& p, const KArgs& a) {
    const float** ins = (const float**)&p;
    for (int i = 0; i < 35; ++i) ins[i] = a.in[i];
    p.out = a.out;
    char* ws = a.ws;
    size_t off = 0;
#define TAKE(bytes) (ws + off); off += (((size_t)(bytes)) + 255) & ~(size_t)255
    p.bar = (unsigned*)TAKE(16384);
    p.counts = (int*)TAKE(1024);
    p.scal = (float*)TAKE(256);
    p.mod = (float*)TAKE((size_t)2 * 9 * 6144 * 4);
    p.mod_part = (float*)TAKE((size_t)16 * 2 * 9 * 6144 * 4);
    p.rope_cos = (float*)TAKE((size_t)65536 * 4);
    p.rope_sin = (float*)TAKE((size_t)65536 * 4);
    p.wt_evin = (bf16_t*)TAKE((size_t)EVC * 1024 * 2);
    p.wt_evout = (bf16_t*)TAKE((size_t)1024 * 1024 * 2);
    p.wt_odin = (bf16_t*)TAKE((size_t)ODC * 1024 * 2);
    p.wt_odout = (bf16_t*)TAKE((size_t)1024 * 1024 * 2);
    p.wt_w2 = (bf16_t*)TAKE((size_t)1024 * 64 * 2);
    p.wt_a2 = (bf16_t*)TAKE((size_t)1024 * 64 * 2);
    p.wt_g2 = (bf16_t*)TAKE((size_t)512 * 128 * 2);
    p.wt_gu = (bf16_t*)TAKE((size_t)64 * 2048 * 1024 * 2);
    p.wt_dn = (bf16_t*)TAKE((size_t)64 * 1024 * 1024 * 2);
    p.lists = (int*)TAKE((size_t)2 * NEXP * NT * 4);
    p.GATE = (float*)TAKE((size_t)NASG * 4);
    p.H = (bf16_t*)TAKE((size_t)NT * DM * 2);
    p.MG = (bf16_t*)TAKE((size_t)NT * DM * 2);
    p.X1 = (bf16_t*)TAKE((size_t)NT * DM * 2);
    p.X2 = (bf16_t*)TAKE((size_t)NT * DM * 2);
    const size_t scratch0 = off;
    p.P = (float*)TAKE((size_t)NT * ODC * 4);
    const size_t after_p = off;
    p.Q = (bf16_t*)TAKE((size_t)8 * 8 * SEQ * 64 * 2);
    p.Qc = (bf16_t*)TAKE((size_t)8 * 8 * CTXL * 64 * 2);
    p.Kd = (bf16_t*)TAKE((size_t)8 * 8 * NKEY * 64 * 2);
    p.Vd = (bf16_t*)TAKE((size_t)8 * 4 * NKEY * 128 * 2);
    p.rR = (bf16_t*)TAKE((size_t)NT * 512 * 2);
    p.rK = (bf16_t*)TAKE((size_t)NT * 512 * 2);
    p.rV = (bf16_t*)TAKE((size_t)NT * 512 * 2);
    p.rKK = (bf16_t*)TAKE((size_t)NT * 512 * 2);
    p.rG = (bf16_t*)TAKE((size_t)NT * 512 * 2);
    p.rW = (float*)TAKE((size_t)2 * NT * 512 * 4);
    p.rKD = (bf16_t*)TAKE((size_t)2 * NT * 512 * 2);
    p.rBV = (bf16_t*)TAKE((size_t)2 * NT * 512 * 2);
    p.rY = (bf16_t*)TAKE((size_t)2 * NT * 512 * 2);
    p.rTW = (bf16_t*)TAKE((size_t)NT * 64 * 2);
    p.rAD = (bf16_t*)TAKE((size_t)NT * 64 * 2);
    p.rSG = (bf16_t*)TAKE((size_t)NT * 128 * 2);
    const size_t end_l0 = off;
    off = after_p;
    p.HO = (float*)TAKE((size_t)2 * NX * 1024 * 4);
    const size_t end_l1 = off;
    off = scratch0;
    p.ACT = (bf16_t*)TAKE((size_t)NASG * 1024 * 2);
    p.YS = (bf16_t*)TAKE((size_t)NASG * 1024 * 2);
    const size_t end_moe = off;
#undef TAKE
    size_t total = end_l0 > end_l1 ? end_l0 : end_l1;
    if (end_moe > total) total = end_moe;
    return total;
}

#if MULTI_LAUNCH
template <int PH>
__global__ void __launch_bounds__(256, 2) k_phase(KArgs a) {
    Params p; make_params(p, a);
    __shared__ __attribute__((aligned(16))) char smem[SMEM_BYTES];
    if (PH < N_PHASES) run_phase(p, PH, blockIdx.x, gridDim.x, smem);
    else final_phase(p, blockIdx.x, gridDim.x);
}
template <int PH> static void launch_all(const KArgs& p, hipStream_t stream) {
    hipLaunchKernelGGL(k_phase<PH>, dim3(1024), dim3(256), 0, stream, p);
    if constexpr (PH < N_PHASES) launch_all<PH + 1>(p, stream);
}
#else
__global__ void __launch_bounds__(NTHR, 2) k_mega(KArgs a) {
    Params p; make_params(p, a);
    extern __shared__ __attribute__((aligned(16))) char smem[];
    cg::grid_group grid = cg::this_grid();
    const int bid = blockIdx.x, nblk = gridDim.x;
    volatile LAS unsigned* st = (volatile LAS unsigned*)(smem + SMEM_BYTES);
    if (tidx() == 0) { st[0] = 0u; st[1] = 0u; }
    __syncthreads();
    const XcdBarrier xb = xcd_barrier_post(p.bar, st);
    run_phase(p, 0, bid, nblk, smem);
    if (a.ws == nullptr) grid.sync();
    xcd_barrier(xb);
    if (EXTRA == 4) { run_phase(p, 0, bid, nblk, smem); xcd_barrier(xb); }
#ifndef REPMASK
#define REPMASK 0u
#endif
#define PH(n) run_phase(p, n, bid, nblk, smem); xcd_barrier(xb); if ((REPMASK >> n) & 1u) { run_phase(p, n, bid, nblk, smem); xcd_barrier(xb); } \
    if (EXTRA == 6 && n == 6) { if (bid == 0 && tidx() == 0) p.counts[64] = 0; xcd_barrier(xb); run_phase(p, 6, bid, nblk, smem); xcd_barrier(xb); } \
    if (EXTRA == 5 && n == 9) { phase_router(p, bid, nblk, smem, 0, p.X1, NT, true); xcd_barrier(xb); } if (EXTRA == 5 && n == 17) { phase_router(p, bid, nblk, smem, 1, p.X1, NX, true); xcd_barrier(xb); }
    PH(1) PH(2) PH(3) PH(4) PH(5) PH(6) PH(7) PH(8) PH(9) PH(10) PH(11) PH(12) PH(13) PH(14) PH(15) PH(16) PH(17) PH(18) PH(19)
#undef PH
    final_phase(p, bid, nblk);
}
#endif


extern "C" void kernel_launch(void* const* d_in, const int* in_sizes, int n_in, void* d_out, int out_size, void* d_ws, size_t ws_size, hipStream_t stream) {
    KArgs a{};
    for (int i = 0; i < 35; ++i) a.in[i] = (const float*)d_in[i];
    a.out = (float*)d_out;
    a.ws = (char*)d_ws;
    Params p{};
    const size_t total = make_params(p, a);
    if (total > ws_size) { fprintf(stderr, "workspace too small: need %zu have %zu\n", total, ws_size); return; }

#if MULTI_LAUNCH
    launch_all<0>(a, stream);
#else
    static int grid_blocks = 0;
    if (!grid_blocks) {
        int dev = 0, cus = 0, per_cu = 0;
        hipGetDevice(&dev);
        hipDeviceGetAttribute(&cus, hipDeviceAttributeMultiprocessorCount, dev);
        hipFuncSetAttribute((const void*)k_mega, hipFuncAttributeMaxDynamicSharedMemorySize, SMEM_BYTES + 16);
        hipOccupancyMaxActiveBlocksPerMultiprocessor(&per_cu, k_mega, NTHR, SMEM_BYTES + 16);
        if (per_cu > 1) per_cu = 1;
        if (per_cu < 1) per_cu = 1;
        grid_blocks = cus * per_cu;
    }
    hipMemsetAsync(p.bar, 0, XCD_BAR_WORDS * 4, stream);
    void* args[] = {(void*)&a};
    hipError_t e = hipLaunchCooperativeKernel((void*)k_mega, dim3(grid_blocks), dim3(NTHR), args, SMEM_BYTES + 16, stream);
    if (e != hipSuccess) fprintf(stderr, "cooperative launch failed: %s (grid %d)\n", hipGetErrorString(e), grid_blocks);
#endif
}
```

```cpp
#include <hip/hip_runtime.h>
#include <hip/hip_cooperative_groups.h>
#include <stdint.h>
#include <stdio.h>

namespace cg = cooperative_groups;

typedef unsigned short bf16_t;
typedef short bf16x8 __attribute__((ext_vector_type(8)));
typedef float f32x4 __attribute__((ext_vector_type(4)));
typedef unsigned u32x4 __attribute__((ext_vector_type(4)));
typedef unsigned u32x2 __attribute__((ext_vector_type(2)));

#define NX 16384
#define NC 2048
#define NT 18432
#define DM 1024
#define SEQ 2048
#define CTXL 256
#define NKEY 2304
#define EVC 3328
#define ODC 5120
#define NEXP 32
#define NASG (NT * 4)
#ifndef EXTRA
#define EXTRA 0
#endif
#define NTHR 512
#define SMEM_BYTES 131072
#define HLDS 65536

#ifndef MULTI_LAUNCH
#define MULTI_LAUNCH 0
#endif

struct Params {
    const float *x, *c, *ctx, *c_ctx, *ada_w, *ada_b, *norm1_g, *norm2_g, *ev_w_in, *ev_w_out, *da_q_norm, *da_k_norm,
        *da_lambda, *da_subln, *rw_mu, *rw_w0, *rw_w2, *rw_a0, *rw_a2, *rw_g2, *rw_k_k, *rw_k_a, *rw_r_k, *rw_ln_w,
        *rw_ln_b, *od_w_in, *od_w_out, *hg_norm, *hg_lb, *router_w, *router_b, *moe_w_gu, *moe_b_gu, *moe_w_dn, *moe_b_dn;
    float* out;
    bf16_t *wt_evin, *wt_evout, *wt_odin, *wt_odout, *wt_gu, *wt_dn, *wt_w2, *wt_a2, *wt_g2;
    float *mod_part, *mod, *rope_cos, *rope_sin, *scal;
    int *counts, *lists;
    unsigned* bar;
    bf16_t* H;
    float* P;
    bf16_t *Q, *Qc, *Kd, *Vd;
    bf16_t *rR, *rK, *rV, *rKK, *rKD, *rBV, *rG, *rY;
    bf16_t *rW;
    bf16_t *rTW, *rAD, *rSG;
    bf16_t* MG;
    bf16_t *X1, *X2;
    float* GATE;
    bf16_t* ACT;
    bf16_t* YS;
    float* HO;
};

typedef float f32x2_ __attribute__((ext_vector_type(2)));
typedef __bf16 bf16x2_ __attribute__((ext_vector_type(2)));
__device__ __forceinline__ unsigned pack2(float a, float b) {
    const f32x2_ v = {a, b};
    return __builtin_bit_cast(unsigned, __builtin_convertvector(v, bf16x2_));
}
__device__ __forceinline__ bf16_t f2bf(float f) { return (bf16_t)(pack2(f, 0.f) & 0xffffu); }
__device__ __forceinline__ int tidx() { int t = __builtin_amdgcn_workitem_id_x(); asm volatile("" : "+v"(t)); return t; }
__device__ __forceinline__ int uni(int v) { return __builtin_amdgcn_readfirstlane(v); }
template <class T> __device__ __forceinline__ T* uni_ptr(T* ptr) {
    const unsigned long long v = (unsigned long long)ptr;
    const unsigned lo = (unsigned)__builtin_amdgcn_readfirstlane((int)(unsigned)v), hi = (unsigned)__builtin_amdgcn_readfirstlane((int)(unsigned)(v >> 32));
    return (T*)(((unsigned long long)hi << 32) | lo);
}
__device__ __forceinline__ float bf2f(bf16_t h) { return __uint_as_float(((unsigned)h) << 16); }
template <int CTRL, int ROWMASK> __device__ __forceinline__ float dpp_zero(float x) {
    return __int_as_float(__builtin_amdgcn_update_dpp(0, __float_as_int(x), CTRL, ROWMASK, 0xf, false));
}
__device__ __forceinline__ float wave_sum(float v) {
    v += dpp_zero<0xB1, 0xf>(v);
    v += dpp_zero<0x4E, 0xf>(v);
    v += dpp_zero<0x141, 0xf>(v);
    v += dpp_zero<0x140, 0xf>(v);
    v += dpp_zero<0x142, 0xa>(v);
    v += dpp_zero<0x143, 0xc>(v);
    return __int_as_float(__builtin_amdgcn_readlane(__float_as_int(v), 63));
}
template <int CTRL> __device__ __forceinline__ float dpp_f(float x) {
    return __int_as_float(__builtin_amdgcn_mov_dpp(__float_as_int(x), CTRL, 0xf, 0xf, true));
}
__device__ __forceinline__ float sum8(float x) {
    x += dpp_f<0xB1>(x);
    x += dpp_f<0x4E>(x);
    x += dpp_f<0x141>(x);
    return x;
}
__device__ __forceinline__ float sigmoidf_(float x) { return __builtin_amdgcn_rcpf(1.0f + __expf(-x)); }
__device__ __forceinline__ float siluf_(float x) { return x * __builtin_amdgcn_rcpf(1.0f + __expf(-x)); }
__device__ __forceinline__ int modrow(int tok) { return tok < NX ? (tok >> 11) : 8; }


#define XB_TMO      128
#define XB_XCNT(j)  (256  + 64 * (j))
#define XB_XSUB(j)  (1280 + 64 * (j))
#define XB_XGEN(j)  (2304 + 64 * (j))
#define XB_TOP      3328
#define XB_TOPGEN   3392
#define XCD_BAR_WORDS 3456
#define XB_SPIN_CAP (1u << 27)
#define LAS __attribute__((address_space(3)))
__device__ __forceinline__ unsigned xb_ld(unsigned* p)              { return __hip_atomic_load(p, __ATOMIC_RELAXED, __HIP_MEMORY_SCOPE_AGENT); }
__device__ __forceinline__ unsigned xb_add(unsigned* p, unsigned v) { return __hip_atomic_fetch_add(p, v, __ATOMIC_RELAXED, __HIP_MEMORY_SCOPE_AGENT); }
__device__ __forceinline__ unsigned xb_xcc_id() { return (unsigned)__builtin_amdgcn_s_getreg((3 << 11) | 20) & 0xFu; }
#define XB_SPIN(cond, bar) do { unsigned _sp = 0; while (cond) { __builtin_amdgcn_s_sleep(1); \
    if ((++_sp & 255u) == 0u) { if (xb_ld(&(bar)[XB_TMO])) break; if (_sp > XB_SPIN_CAP) { atomicAdd(&(bar)[XB_TMO], 1u); break; } } } } while (0)
struct XcdBarrier { unsigned* bar; unsigned x; volatile LAS unsigned* st; };
__device__ __forceinline__ XcdBarrier xcd_barrier_post(unsigned* bar, volatile LAS unsigned* st) {
    XcdBarrier b; b.bar = bar; b.x = xb_xcc_id(); b.st = st;
    if (tidx() == 0) (void)xb_add(&bar[XB_XCNT(b.x)], 1u);
    return b;
}
__device__ __forceinline__ void xcd_barrier_complete(unsigned* bar, unsigned x, unsigned& nloc, unsigned& nx) {
    const unsigned G = gridDim.x * gridDim.y * gridDim.z;
    unsigned sum, cnt, mine, sp = 0u;
    for (;;) {
        sum = 0u; cnt = 0u; mine = 0u;
#pragma unroll
        for (unsigned j = 0; j < 16; ++j) { const unsigned c = xb_ld(&bar[XB_XCNT(j)]); sum += c; cnt += (c > 0u) ? 1u : 0u; mine = (j == x) ? c : mine; }
        if (sum == G) break;
        __builtin_amdgcn_s_sleep(1);
        if ((++sp & 255u) == 0u) { if (xb_ld(&bar[XB_TMO])) break; if (sp > XB_SPIN_CAP) { atomicAdd(&bar[XB_TMO], 1u); break; } }
    }
    nloc = mine > 0u ? mine : 1u; nx = cnt > 0u ? cnt : 1u;
}
__device__ __forceinline__ void xcd_barrier(const XcdBarrier& b) {
    asm volatile("s_waitcnt vmcnt(0)" ::: "memory");
    __syncthreads();
    if (tidx() == 0) {
        unsigned* bar = b.bar;
        __builtin_amdgcn_s_waitcnt(0);
        unsigned nloc = b.st[0], nx = b.st[1];
        if (nloc == 0u) { xcd_barrier_complete(bar, b.x, nloc, nx); b.st[0] = nloc; b.st[1] = nx; }
        const unsigned old = xb_add(&bar[XB_XSUB(b.x)], 1u);
        const unsigned gen = old / nloc;
        if (old + 1u == (gen + 1u) * nloc) {
            __builtin_amdgcn_fence(__ATOMIC_RELEASE, "agent");
            asm volatile("s_waitcnt vmcnt(0)" ::: "memory");
            const unsigned og = xb_add(&bar[XB_TOP], 1u);
            const unsigned tg = og / nx;
            if (og + 1u == (tg + 1u) * nx) xb_add(&bar[XB_TOPGEN], 1u);
            else XB_SPIN(xb_ld(&bar[XB_TOPGEN]) == tg, bar);
            __builtin_amdgcn_fence(__ATOMIC_ACQUIRE, "agent");
            xb_add(&bar[XB_XGEN(b.x)], 1u);
            asm volatile("s_waitcnt vmcnt(0)" ::: "memory");
        } else {
            XB_SPIN(xb_ld(&bar[XB_XGEN(b.x)]) == gen, bar);
            __builtin_amdgcn_fence(__ATOMIC_ACQUIRE, "agent");
            asm volatile("s_waitcnt vmcnt(0)" ::: "memory");
        }
    }
    __syncthreads();
}


__device__ __forceinline__ int q_next(int* ctr, char* smem) {
    volatile unsigned* slot = (volatile unsigned*)(smem + SMEM_BYTES + 8);
    __syncthreads();
    if (tidx() == 0) *slot = (unsigned)atomicAdd(ctr, 1);
    __syncthreads();
    return (int)*slot;
}

struct ARows {
    const bf16_t* base;
    int lda;
    const int* idx;
    int shift;
    int row0;
};

template <bool PAIRED, class Epi, bool TILE = false>
__device__ __forceinline__ void gemm_tile(const ARows ar, int mcount, const bf16_t* __restrict__ Bt, int ldb, int K, Epi& epi, char* smem) {
    const int tid = tidx() & 255, lane = tid & 63, wid = tid >> 6;
    const int wr = wid >> 1, wc = wid & 1, fr = lane & 15, fq = lane >> 4;
    bf16_t* sA = (bf16_t*)smem;
    bf16_t* sB = sA + 128 * 64;
    const int lrow = tid >> 3, lch = tid & 7;
    const bf16_t* aptr[4];
    const bf16_t* bptr[4];
#pragma unroll
    for (int i = 0; i < 4; ++i) {
        const int r = lrow + 32 * i;
        const int rr = r < mcount ? r : 0;
        const int rowid = ar.idx ? (ar.idx[rr] >> ar.shift) : (ar.row0 + rr);
        aptr[i] = ar.base + (size_t)rowid * ar.lda + lch * 8;
        bptr[i] = Bt + (size_t)r * ldb + lch * 8;
    }
    u32x4 ra[4], rb[4];
#pragma unroll
    for (int i = 0; i < 4; ++i) { ra[i] = *(const u32x4*)(aptr[i]); rb[i] = *(const u32x4*)(bptr[i]); }
    f32x4 acc[4][4];
#pragma unroll
    for (int m = 0; m < 4; ++m)
#pragma unroll
        for (int n = 0; n < 4; ++n) acc[m][n] = (f32x4){0.f, 0.f, 0.f, 0.f};
    const int nk = K >> 6;
    for (int kt = 0; kt < nk; ++kt) {
#pragma unroll
        for (int i = 0; i < 4; ++i) {
            const int r = lrow + 32 * i;
            const int off = r * 64 + ((lch ^ (r & 7)) << 3);
            *(u32x4*)(sA + off) = ra[i];
            *(u32x4*)(sB + off) = rb[i];
        }
        __syncthreads();
        if (kt + 1 < nk) {
#pragma unroll
            for (int i = 0; i < 4; ++i) { ra[i] = *(const u32x4*)(aptr[i] + (kt + 1) * 64); rb[i] = *(const u32x4*)(bptr[i] + (kt + 1) * 64); }
        }
#pragma unroll
        for (int ks = 0; ks < 2; ++ks) {
            bf16x8 af[4], bfr[4];
            const int ch = ks * 4 + fq;
#pragma unroll
            for (int m = 0; m < 4; ++m) { const int r = wr * 64 + m * 16 + fr; af[m] = *(const bf16x8*)(sA + r * 64 + ((ch ^ (r & 7)) << 3)); }
#pragma unroll
            for (int n = 0; n < 4; ++n) { const int r = wc * 64 + n * 16 + fr; bfr[n] = *(const bf16x8*)(sB + r * 64 + ((ch ^ (r & 7)) << 3)); }
#pragma unroll
            for (int m = 0; m < 4; ++m)
#pragma unroll
                for (int n = 0; n < 4; ++n) acc[m][n] = __builtin_amdgcn_mfma_f32_16x16x32_bf16(bfr[n], af[m], acc[m][n], 0, 0, 0);
        }
        __syncthreads();
    }
    if constexpr (TILE) epi.tile(acc, wr, wc, fr, fq);
    else {
#pragma unroll
        for (int m = 0; m < 4; ++m) {
            const int r = wr * 64 + m * 16 + fr;
            if (r < mcount) {
                if constexpr (PAIRED) {
                    epi.pair(r, wc * 32 + fq * 4, acc[m][0], acc[m][1]);
                    epi.pair(r, wc * 32 + 16 + fq * 4, acc[m][2], acc[m][3]);
                } else {
#pragma unroll
                    for (int n = 0; n < 4; ++n) epi.one(r, wc * 64 + n * 16 + fq * 4, acc[m][n]);
                }
            }
        }
    }
}


namespace g8 {
#define G8_LAS __attribute__((address_space(3)))
constexpr int BM = 256, BK = 64, HALF = 128, HTB = HALF * BK * 2;
__device__ __forceinline__ int lds_byte(int r, int c) { const int st = (r >> 4) * 2 + (c >> 5), rr = r & 15, cc = c & 31, ob = rr * 64 + cc * 2; return st * 1024 + (ob ^ (((ob >> 9) & 1) << 5)); }
__device__ __forceinline__ void stage_rc(int b, int& R, int& C) { const int st = b / 1024, sb = b % 1024, swz = sb ^ (((sb >> 9) & 1) << 5); R = (st >> 1) * 16 + swz / 64; C = (st & 1) * 32 + (swz % 64) / 2; }
struct Unit {
    const char* a;
    const char* b;
    const int* gidx;
    const int* idx;
    int shift, rows;
    int i0, i1, i2;
};
template <class Epi, class Sched>
__device__ __forceinline__ void gemm_phase(G8_LAS unsigned char* lds, const int K, Sched& S, const Epi& E) {
    const int tid = tidx(), wid = __builtin_amdgcn_readfirstlane(tid >> 6), lane = tid & 63, wr = wid >> 2, wc = wid & 3, fr = lane & 15, fq = lane >> 4;
    const int nt = K / BK;
    int sR[2], sC[2];
    unsigned voffB[2];
#pragma unroll
    for (int i = 0; i < 2; ++i) { stage_rc(tid * 16 + i * 8192, sR[i], sC[i]); voffB[i] = (unsigned)(sR[i] * K + sC[i]) * 2u; }
    const size_t kstep = (size_t)(BK * 2);
    const size_t hstep = (size_t)HALF * K * 2;
    const unsigned ldsw = (unsigned)wid * 1024u;
    const int aoff = lds_byte(wr * 64 + fr, fq * 8), boff = lds_byte(wc * 32 + fr, fq * 8);
    auto a_offsets = [&](const Unit& u, unsigned (&o)[2][2]) {
#pragma unroll
        for (int h = 0; h < 2; ++h)
#pragma unroll
            for (int i = 0; i < 2; ++i) {
                int r = sR[i] + h * HALF;
                if (u.gidx) { r = r < u.rows ? r : (u.rows - 1); r = u.gidx[r] >> u.shift; }
                o[h][i] = (unsigned)(r * K + sC[i]) * 2u;
            }
    };
#define G8_SA(b, h) (((b) * 2 + (h)) * HTB)
#define G8_SB(b, h) ((4 + (b) * 2 + (h)) * HTB)
#define G8_STAGE2(bufoff, gbase, o0, o1) do { \
        __builtin_amdgcn_global_load_lds((const unsigned*)((const char*)(gbase) + (o0)), (G8_LAS unsigned*)(lds + (bufoff) + ldsw), 16, 0, 0); \
        __builtin_amdgcn_global_load_lds((const unsigned*)((const char*)(gbase) + (o1)), (G8_LAS unsigned*)(lds + (bufoff) + ldsw + 8192), 16, 0, 0); } while (0)
#define G8_STAGE_B(bufoff, gbase) G8_STAGE2(bufoff, gbase, voffB[0], voffB[1])
#define G8_LDA(dst, b, h) do { _Pragma("unroll") for (int m = 0; m < 4; ++m) _Pragma("unroll") for (int k = 0; k < 2; ++k) dst[m][k] = *(const G8_LAS bf16x8*)(lds + G8_SA(b, h) + aoff + m * 2048 + k * 1024); } while (0)
#define G8_LDB(dst, b, h) do { _Pragma("unroll") for (int n = 0; n < 2; ++n) _Pragma("unroll") for (int k = 0; k < 2; ++k) dst[n][k] = *(const G8_LAS bf16x8*)(lds + G8_SB(b, h) + boff + n * 2048 + k * 1024); } while (0)
#define G8_MMA(ai, bj, At, Bt) do { __builtin_amdgcn_s_setprio(1); _Pragma("unroll") for (int m = 0; m < 4; ++m) _Pragma("unroll") for (int n = 0; n < 2; ++n) _Pragma("unroll") for (int k = 0; k < 2; ++k) \
        acc[ai][bj][m][n] = __builtin_amdgcn_mfma_f32_16x16x32_bf16(Bt[n][k], At[m][k], acc[ai][bj][m][n], 0, 0, 0); __builtin_amdgcn_s_setprio(0); } while (0)
#define G8_WAIT_V(n) asm volatile("s_waitcnt vmcnt(" #n ")" ::: "memory")
#define G8_WAIT_L(n) asm volatile("s_waitcnt lgkmcnt(" #n ")" ::: "memory")
#define G8_BAR __builtin_amdgcn_s_barrier()
#define G8_SCHED __builtin_amdgcn_sched_barrier(0)
    Unit cur, nxt;
    if (!S.next(cur)) return;
    unsigned oc[2][2], on[2][2];
    a_offsets(cur, oc);
    f32x4 acc[2][2][4][2];
#pragma unroll
    for (int a = 0; a < 2; ++a)
#pragma unroll
        for (int b = 0; b < 2; ++b)
#pragma unroll
            for (int m = 0; m < 4; ++m)
#pragma unroll
                for (int n = 0; n < 2; ++n) acc[a][b][m][n] = (f32x4){0.f, 0.f, 0.f, 0.f};
    bf16x8 At[4][2], B0[2][2], B1[2][2];
    const char* cA = cur.a; const char* cB = cur.b;
    G8_STAGE_B(G8_SB(0, 0), cB); G8_STAGE_B(G8_SB(0, 1), cB + hstep); G8_STAGE2(G8_SA(0, 0), cA, oc[0][0], oc[0][1]); G8_STAGE2(G8_SA(0, 1), cA, oc[1][0], oc[1][1]);
    if (wr == 1) G8_BAR;
    G8_WAIT_V(2); G8_BAR;
    G8_STAGE_B(G8_SB(1, 0), cB + kstep); G8_STAGE2(G8_SA(1, 0), cA + kstep, oc[0][0], oc[0][1]); G8_STAGE_B(G8_SB(1, 1), cB + hstep + kstep);
    G8_WAIT_V(6); G8_BAR;
    for (;;) {
        const bool has_next = S.next(nxt);
        if (has_next) a_offsets(nxt, on);
        else {
#pragma unroll
            for (int h = 0; h < 2; ++h) { on[h][0] = oc[h][0]; on[h][1] = oc[h][1]; }
        }
        const char* nA = has_next ? nxt.a : cA; const char* nB = has_next ? nxt.b : cB;
        for (int t = 0; t < nt; t += 2) {
            const bool last = (t == nt - 2);
            const char* a1 = cA + (size_t)(t + 1) * kstep;
            const char* a2 = last ? nA : cA + (size_t)(t + 2) * kstep; const char* b2 = last ? nB : cB + (size_t)(t + 2) * kstep;
            const char* a3 = a2 + kstep; const char* b3 = b2 + kstep;
            const unsigned p00 = last ? on[0][0] : oc[0][0], p01 = last ? on[0][1] : oc[0][1], p10 = last ? on[1][0] : oc[1][0], p11 = last ? on[1][1] : oc[1][1];
            G8_LDB(B0, 0, 0); G8_LDB(B1, 0, 1); G8_SCHED; G8_LDA(At, 0, 0); G8_STAGE2(G8_SA(1, 1), a1, oc[1][0], oc[1][1]);
            G8_WAIT_V(8); G8_WAIT_L(0); G8_BAR; G8_MMA(0, 0, At, B0); G8_MMA(0, 1, At, B1); G8_BAR; G8_SCHED;
            G8_LDA(At, 0, 1); G8_STAGE_B(G8_SB(0, 0), b2); G8_STAGE_B(G8_SB(0, 1), b2 + hstep); G8_STAGE2(G8_SA(0, 0), a2, p00, p01);
            G8_WAIT_V(8); G8_WAIT_L(0); G8_BAR; G8_MMA(1, 0, At, B0); G8_MMA(1, 1, At, B1); G8_BAR; G8_SCHED;
            G8_LDB(B0, 1, 0); G8_LDB(B1, 1, 1); G8_SCHED; G8_LDA(At, 1, 0); G8_STAGE2(G8_SA(0, 1), a2, p10, p11);
            G8_WAIT_V(8); G8_WAIT_L(0); G8_BAR; G8_MMA(0, 0, At, B0); G8_MMA(0, 1, At, B1); G8_BAR; G8_SCHED;
            G8_LDA(At, 1, 1); G8_STAGE_B(G8_SB(1, 0), b3); G8_STAGE_B(G8_SB(1, 1), b3 + hstep); G8_STAGE2(G8_SA(1, 0), a3, p00, p01);
            G8_WAIT_V(8); G8_WAIT_L(0); G8_BAR; G8_MMA(1, 0, At, B0); G8_MMA(1, 1, At, B1); G8_BAR; G8_SCHED;
        }
        if (wr == 0) G8_BAR;
        E(acc, cur, wr, wc, fr, fq);
        if (!has_next) break;
#pragma unroll
        for (int a = 0; a < 2; ++a)
#pragma unroll
            for (int b = 0; b < 2; ++b)
#pragma unroll
                for (int m = 0; m < 4; ++m)
#pragma unroll
                    for (int n = 0; n < 2; ++n) acc[a][b][m][n] = (f32x4){0.f, 0.f, 0.f, 0.f};
        cur = nxt; cA = nA; cB = nB;
#pragma unroll
        for (int h = 0; h < 2; ++h) { oc[h][0] = on[h][0]; oc[h][1] = on[h][1]; }
        if (wr == 1) G8_BAR;
    }
    G8_WAIT_V(0);
    G8_BAR;
#undef G8_SA
#undef G8_SB
#undef G8_STAGE2
#undef G8_STAGE_B
#undef G8_LDA
#undef G8_LDB
#undef G8_MMA
#undef G8_WAIT_V
#undef G8_WAIT_L
#undef G8_BAR
#undef G8_SCHED
}
}

__device__ __forceinline__ int gu_row(int col) {
    const int half = col >> 10, unit = col & 1023, T = unit >> 7, ul = unit & 127, wc = ul >> 5, r = ul & 31, fq = r >> 3, bj = (r >> 2) & 1, jj = r & 3;
    return 256 * T + 128 * bj + 32 * wc + 16 * half + 4 * fq + jj;
}
__device__ __forceinline__ int p32_row(int col) {
    const int x = col & 31;
    return (col & ~31) + 16 * ((x >> 2) & 1) + 4 * (x >> 3) + (x & 3);
}
struct ConvDesc { const float* src; bf16_t* dst; int N, Kd, kt, nt, perm, pad; };
struct ConvRegs { f32x4 v0, v1, v2, v3; };
__device__ __forceinline__ ConvRegs conv_load(const ConvDesc& d) {
    const int tid = tidx() & 255, r = tid >> 4, c4 = (tid & 15) * 4;
    ConvRegs x;
    const float* b0 = d.src + (size_t)(d.kt * 64 + r) * d.N + d.nt * 64 + c4;
    x.v0 = __builtin_nontemporal_load((const f32x4*)(b0)); x.v1 = __builtin_nontemporal_load((const f32x4*)(b0 + (size_t)16 * d.N)); x.v2 = __builtin_nontemporal_load((const f32x4*)(b0 + (size_t)32 * d.N)); x.v3 = __builtin_nontemporal_load((const f32x4*)(b0 + (size_t)48 * d.N));
    return x;
}
__device__ __forceinline__ void conv_store(const ConvRegs& x, const ConvDesc& d, float* lds) {
    const int tid = tidx() & 255;
    {
        const int r = tid >> 4, c4 = (tid & 15) * 4;
        float* q = lds + r * 65 + c4;
        q[0] = x.v0[0]; q[1] = x.v0[1]; q[2] = x.v0[2]; q[3] = x.v0[3];
        q[16 * 65 + 0] = x.v1[0]; q[16 * 65 + 1] = x.v1[1]; q[16 * 65 + 2] = x.v1[2]; q[16 * 65 + 3] = x.v1[3];
        q[32 * 65 + 0] = x.v2[0]; q[32 * 65 + 1] = x.v2[1]; q[32 * 65 + 2] = x.v2[2]; q[32 * 65 + 3] = x.v2[3];
        q[48 * 65 + 0] = x.v3[0]; q[48 * 65 + 1] = x.v3[1]; q[48 * 65 + 2] = x.v3[2]; q[48 * 65 + 3] = x.v3[3];
    }
    __syncthreads();
    {
        const int n = tid >> 2, kseg = (tid & 3) * 16;
        unsigned w[8];
#pragma unroll
        for (int j = 0; j < 8; ++j) w[j] = pack2(lds[(kseg + 2 * j) * 65 + n], lds[(kseg + 2 * j + 1) * 65 + n]);
        const int ncol = d.nt * 64 + n;
        const int row = d.perm == 1 ? gu_row(ncol) : (d.perm == 2 ? p32_row(ncol) : (d.perm == 3 ? ((ncol >> 6) * 128 + (ncol & 63)) : ncol));
        uint4* q = (uint4*)(d.dst + (size_t)row * d.Kd + d.kt * 64 + kseg);
        __builtin_nontemporal_store((u32x4){w[0], w[1], w[2], w[3]}, (u32x4*)q);
        __builtin_nontemporal_store((u32x4){w[4], w[5], w[6], w[7]}, (u32x4*)q + 1);
    }
    __syncthreads();
}
__device__ __forceinline__ void conv_tile(const float* __restrict__ src, int N, bf16_t* __restrict__ dst, int Kd, int kt, int nt, int perm, float* lds) {
    const ConvDesc d{src, dst, N, Kd, kt, nt, perm, 0};
    const ConvRegs x = conv_load(d);
    conv_store(x, d, lds);
}

#define CONV_GRP 8
#define N_MODP 768
#define CV0 832
#define CV1 (CV0 + 16)
#define CV2 (CV1 + 16)
#define CV3 (CV2 + 16)
#define CV4 (CV3 + 256)
#define N_CONV CV4
#define N_ROPE 64
#define N_P0A (N_MODP + N_CONV + N_ROPE + 2)

__device__ __forceinline__ void phase0a(const Params& p, int bid, int nblk, char* smem) {
    const int half = tidx() >> 8, tid = tidx() & 255;
    float* lds = (float*)(smem + half * HLDS);
    for (int it0 = bid * 2; it0 < N_P0A; it0 += nblk * 2) {
        const int it = it0 + half;
        if (it < N_MODP) {
            const int l = it / 384, rem = it % 384, cb = rem / 16, kc = rem % 16;
            for (int e = tid; e < 9 * 64; e += 256) {
                const int r = e >> 6, k = e & 63;
                const float v = (r < 8) ? p.c[r * DM + kc * 64 + k] : p.c_ctx[kc * 64 + k];
                lds[e] = siluf_(v);
            }
            __syncthreads();
            const int col = cb * 256 + tid;
            const float* w = p.ada_w + (size_t)l * DM * 6144 + (size_t)(kc * 64) * 6144 + col;
            float acc[9];
#pragma unroll
            for (int r = 0; r < 9; ++r) acc[r] = 0.f;
#pragma unroll 1
            for (int k0 = 0; k0 < 64; k0 += 16) {
                float wv[16];
#pragma unroll
                for (int k = 0; k < 16; ++k) wv[k] = w[(size_t)(k0 + k) * 6144];
#pragma unroll
                for (int k = 0; k < 16; ++k)
#pragma unroll
                    for (int r = 0; r < 9; ++r) acc[r] += lds[r * 64 + k0 + k] * wv[k];
            }
#pragma unroll
            for (int r = 0; r < 9; ++r) p.mod_part[((size_t)(kc * 2 + l) * 9 + r) * 6144 + col] = acc[r];
            __syncthreads();
        } else if (it < N_MODP + N_CONV) {
            const int j = it - N_MODP;
            if (j < CV0) { conv_tile(p.ev_w_in, EVC, p.wt_evin, 1024, j / 52, j % 52, 2, lds); }
            else if (j < CV1) { const int q = j - CV0, z = q >> 3, nt = q & 7; conv_tile(p.rw_w2 + (size_t)z * 64 * 512, 512, p.wt_w2 + (size_t)z * 512 * 64, 64, 0, nt, 0, lds); }
            else if (j < CV2) { const int q = j - CV1, z = q >> 3, nt = q & 7; conv_tile(p.rw_a2 + (size_t)z * 64 * 512, 512, p.wt_a2 + (size_t)z * 64 * 64, 64, 0, nt, 3, lds); }
            else if (j < CV3) { const int q = j - CV2, kt = q >> 3, nt = q & 7; conv_tile(p.rw_g2, 512, p.wt_g2, 128, kt, nt, 0, lds); }
            else { const int q = j - CV3; conv_tile(p.ev_w_out, 1024, p.wt_evout, 1024, q >> 4, q & 15, 2, lds); }
        } else if (it < N_MODP + N_CONV + N_ROPE) {
            const int j = it - N_MODP - N_CONV;
#pragma unroll
            for (int i = 0; i < 4; ++i) {
                const int e = (j * 4 + i) * 256 + tid;
                const int t = e >> 5, a = (e >> 4) & 1, pp = e & 15;
                const float pos = (float)(a == 0 ? (t >> 6) : (t & 63));
                const float inv = powf(10000.0f, -(float)pp / 16.0f);
                const float ang = pos * inv;
                p.rope_cos[e] = cosf(ang);
                p.rope_sin[e] = sinf(ang);
            }
        } else if (it == N_MODP + N_CONV + N_ROPE) {
            if (tid < 64) {
                const float* lf = p.da_lambda;
                float a = lf[tid] * lf[64 + tid], b = lf[128 + tid] * lf[192 + tid];
                a = wave_sum(a); b = wave_sum(b);
                if (tid == 0) p.scal[0] = expf(a) - expf(b) + 0.2f;
            }
            if (tid < 128) p.counts[tid] = 0;
        }
    }
}

__device__ __forceinline__ void phase0b(const Params& p, int bid, int nblk) {
    for (int e = bid * NTHR + tidx(); e < 2 * 9 * 6144; e += nblk * NTHR) {
        const int l = e / (9 * 6144), rem = e % (9 * 6144);
        float s = p.ada_b[l * 6144 + rem % 6144];
#pragma unroll
        for (int kc = 0; kc < 16; ++kc) s += p.mod_part[(size_t)(kc * 2 + l) * 9 * 6144 + rem];
        p.mod[e] = s;
    }
}

__device__ __forceinline__ void phase_norm(const Params& p, int bid, int nblk, const float* xs_lat, const float* xs_ctx, const float* gain, const float* modl, int sh_off, int ntok) {
    const int lane = tidx() & 63, wid = tidx() >> 6;
    for (int tok = bid * 8 + wid; tok < ntok; tok += nblk * 8) {
        const float* xr = tok < NX ? xs_lat + (size_t)tok * DM : xs_ctx + (size_t)(tok - NX) * DM;
        const float* mr = modl + modrow(tok) * 6144 + sh_off;
        float4 v[4];
        float ss = 0.f;
#pragma unroll
        for (int i = 0; i < 4; ++i) { { const f32x4 t_ = __builtin_nontemporal_load((const f32x4*)(xr + lane * 4 + 256 * i)); v[i] = make_float4(t_[0], t_[1], t_[2], t_[3]); } ss += v[i].x * v[i].x + v[i].y * v[i].y + v[i].z * v[i].z + v[i].w * v[i].w; }
        ss = wave_sum(ss);
        const float rstd = rsqrtf(ss * (1.0f / 1024.0f) + 1e-6f);
#pragma unroll
        for (int i = 0; i < 4; ++i) {
            const int c = lane * 4 + 256 * i;
            const float4 g = *(const float4*)(gain + c), sh = *(const float4*)(mr + c), sc = *(const float4*)(mr + 1024 + c);
            const float a0 = v[i].x * rstd * g.x * (1.f + sc.x) + sh.x, a1 = v[i].y * rstd * g.y * (1.f + sc.y) + sh.y;
            const float a2 = v[i].z * rstd * g.z * (1.f + sc.z) + sh.z, a3 = v[i].w * rstd * g.w * (1.f + sc.w) + sh.w;
            *(uint2*)(p.H + (size_t)tok * DM + c) = make_uint2(pack2(a0, a1), pack2(a2, a3));
        }
    }
}

struct EpiStoreF32 {
    float* C; int ldc; int row0; int col0;
    __device__ __forceinline__ void one(int r, int c, f32x4 v) const { *(f32x4*)(C + (size_t)(row0 + r) * ldc + col0 + c) = v; }
};


struct TileIter {
    int mg0, mcnt, ntn, total, full, i, step;
    __device__ __forceinline__ void init(int MT, int NTN, int bid, int nblk) {
        const int g = bid & 7, lb = (bid >> 3) * 2 + (tidx() >> 8), nb = (nblk >> 3) * 2;
        mg0 = (MT * g) >> 3; mcnt = ((MT * (g + 1)) >> 3) - mg0; ntn = NTN; total = mcnt * NTN; full = mcnt >> 3; i = lb; step = nb;
    }
    __device__ __forceinline__ bool next(int& mt, int& nt) {
        if (i >= total) return false;
        const int band = 8 * ntn;
        if (i < full * band) { const int ms = i / band, r = i - ms * band; nt = r >> 3; mt = mg0 + ms * 8 + (r & 7); }
        else { const int rem = mcnt - full * 8, j = i - full * band; nt = j / rem; mt = mg0 + full * 8 + (j - nt * rem); }
        i += step;
        return true;
    }
};
__device__ __forceinline__ void phase_gemm_store(const bf16_t* A, int M, const bf16_t* Wt, int N, int K, float* C, int bid, int nblk, char* smem) {
    TileIter ti; ti.init(M / 128, N / 128, bid, nblk);
    char* hs = smem + (tidx() >> 8) * HLDS;
    for (;;) {
        int mt = 0, nt = 0;
        const bool v = ti.next(mt, nt);
        if (!__syncthreads_or(v ? 1 : 0)) break;
        if (!v) { mt = 0; nt = 0; }
        ARows ar{A, K, nullptr, 0, mt * 128};
        EpiStoreF32 epi{C, N, mt * 128, nt * 128};
        gemm_tile<false>(ar, v ? 128 : 0, Wt + (size_t)nt * 128 * K, K, K, epi, hs);
    }
}

struct EpiResid {
    const float* xin_lat; const float* xin_ctx; float* xout; const float* gmod; int row0; int col0;
    __device__ __forceinline__ void one(int r, int c, f32x4 v) const {
        const int tok = row0 + r, cc = col0 + c;
        const float* xr = tok < NX ? xin_lat + (size_t)tok * DM : xin_ctx + (size_t)(tok - NX) * DM;
        const f32x4 xi = *(const f32x4*)(xr + cc);
        const f32x4 g = *(const f32x4*)(gmod + modrow(tok) * 6144 + cc);
        *(f32x4*)(xout + (size_t)tok * DM + cc) = xi + g * v;
    }
};
__device__ __forceinline__ void phase_outproj(const Params& p, int bid, int nblk, char* smem, const bf16_t* Wt, int ntok, const float* xin_lat, const float* xin_ctx, float* xout, const float* gmod) {
    TileIter ti; ti.init(ntok / 128, 8, bid, nblk);
    char* hs = smem + (tidx() >> 8) * HLDS;
    for (;;) {
        int mt = 0, nt = 0;
        const bool v = ti.next(mt, nt);
        if (!__syncthreads_or(v ? 1 : 0)) break;
        if (!v) { mt = 0; nt = 0; }
        ARows ar{p.MG, DM, nullptr, 0, mt * 128};
        EpiResid epi{xin_lat, xin_ctx, xout, gmod, mt * 128, nt * 128};
        gemm_tile<false>(ar, v ? 128 : 0, Wt + (size_t)nt * 128 * DM, DM, DM, epi, hs);
    }
}

__device__ __forceinline__ void unpack8(const u32x4 w, float (&v)[8]) {
#pragma unroll
    for (int i = 0; i < 4; ++i) { v[2 * i] = __uint_as_float(w[i] << 16); v[2 * i + 1] = __uint_as_float(w[i] & 0xffff0000u); }
}
__device__ __forceinline__ u32x4 pack8f(const float (&v)[8]) { return (u32x4){pack2(v[0], v[1]), pack2(v[2], v[3]), pack2(v[4], v[5]), pack2(v[6], v[7])}; }
__device__ __forceinline__ void phase_feat0(const Params& p, int bid, int nblk, char* smem) {
    const int lane = tidx() & 63, wid = tidx() >> 6;
    const bf16_t* P16 = (const bf16_t*)p.P;
    const int l7 = lane & 7, g = lane >> 3;
    const int c3 = 1536 + (lane & 31) * 8;
    const f32x4 qn0 = *(const f32x4*)(p.da_q_norm + l7 * 8), qn1 = *(const f32x4*)(p.da_q_norm + l7 * 8 + 4);
    const f32x4 kn0 = *(const f32x4*)(p.da_k_norm + l7 * 8), kn1 = *(const f32x4*)(p.da_k_norm + l7 * 8 + 4);
    const f32x4 kk0 = *(const f32x4*)(p.rw_k_k + lane * 8), kk1 = *(const f32x4*)(p.rw_k_k + lane * 8 + 4);
    f32x4 mu[4][2];
#pragma unroll
    for (int sgm = 0; sgm < 4; ++sgm) {
        const int c0 = sgm < 3 ? sgm * 512 + lane * 8 : c3;
        mu[sgm][0] = *(const f32x4*)(p.rw_mu + c0); mu[sgm][1] = *(const f32x4*)(p.rw_mu + c0 + 4);
    }
    auto load_raw = [&](int tok, u32x4 (&raw)[14], f32x4 (&rope)[4]) {
        const bool lat = tok < NX;
        const int t = lat ? (tok & 2047) : ((tok - NX) & 255);
        const int slen = lat ? SEQ : CTXL;
        const bf16_t* pr = P16 + (size_t)tok * EVC;
        raw[0] = *(const u32x4*)(pr + lane * 8); raw[1] = *(const u32x4*)(pr + 512 + lane * 8);
        const bf16_t* pw = pr + 1536;
        const bf16_t* pp = t > 0 ? pw - EVC : pw;
        const bf16_t* pn = t < slen - 1 ? pw + EVC : pw;
#pragma unroll
        for (int sgm = 0; sgm < 4; ++sgm) {
            const int c0 = sgm < 3 ? sgm * 512 + lane * 8 : c3;
            raw[2 + 3 * sgm] = *(const u32x4*)(pw + c0); raw[3 + 3 * sgm] = *(const u32x4*)(pp + c0); raw[4 + 3 * sgm] = *(const u32x4*)(pn + c0);
        }
        const int ro = t * 32 + (l7 >> 2) * 16 + (l7 & 1) * 8;
        rope[0] = *(const f32x4*)(p.rope_cos + ro); rope[1] = *(const f32x4*)(p.rope_cos + ro + 4); rope[2] = *(const f32x4*)(p.rope_sin + ro); rope[3] = *(const f32x4*)(p.rope_sin + ro + 4);
    };
    auto process = [&](int tok, const u32x4 (&raw)[14], const f32x4 (&rope)[4]) {
        const bool lat = tok < NX;
        const int b = lat ? (tok >> 11) : ((tok - NX) >> 8);
        const int t = lat ? (tok & 2047) : ((tok - NX) & 255);
        const int key = lat ? (CTXL + t) : t;
        {
            const bool hf = (l7 >> 1) & 1;
#pragma unroll
            for (int qk = 0; qk < 2; ++qk) {
                float v[8];
                unpack8(raw[qk], v);
                const f32x4 n0 = qk == 0 ? qn0 : kn0, n1 = qk == 0 ? qn1 : kn1;
                float ss = 0.f;
#pragma unroll
                for (int j = 0; j < 8; ++j) ss += v[j] * v[j];
                ss = sum8(ss);
                const float rstd = rsqrtf(ss * (1.0f / 64.0f) + 1e-6f) * (qk == 0 ? 0.125f * 1.4426950408889634f : 1.0f);
#pragma unroll
                for (int j = 0; j < 8; ++j) v[j] = v[j] * rstd * (j < 4 ? n0[j] : n1[j - 4]);
                if (lat) {
#pragma unroll
                    for (int j = 0; j < 8; ++j) {
                        const float o = dpp_f<0x4E>(v[j]);
                        const float cs = j < 4 ? rope[0][j & 3] : rope[1][j & 3], sn = j < 4 ? rope[2][j & 3] : rope[3][j & 3];
                        v[j] = hf ? (v[j] * cs + o * sn) : (v[j] * cs - o * sn);
                    }
                }
                const u32x4 w = pack8f(v);
                if (qk == 0) {
                    if (lat) *(u32x4*)(p.Q + (((size_t)b * 8 + g) * SEQ + t) * 64 + l7 * 8) = w;
                    else *(u32x4*)(p.Qc + (((size_t)b * 8 + g) * CTXL + t) * 64 + l7 * 8) = w;
                } else *(u32x4*)(p.Kd + (((size_t)b * 8 + g) * NKEY + key) * 64 + l7 * 8) = w;
            }
        }
        const int slen = lat ? SEQ : CTXL;
        const float hp = t > 0 ? 0.5f : 0.f, hn = t < slen - 1 ? 0.5f : 0.f;
        auto shifted = [&](int sgm, float (&y)[8]) {
            float pv[8], nv[8];
            unpack8(raw[2 + 3 * sgm], y); unpack8(raw[3 + 3 * sgm], pv); unpack8(raw[4 + 3 * sgm], nv);
#pragma unroll
            for (int j = 0; j < 8; ++j) y[j] = y[j] + (j < 4 ? mu[sgm][0][j & 3] : mu[sgm][1][j & 3]) * ((hp * pv[j] + hn * nv[j]) - y[j]);
        };
        {
            float y[8];
            shifted(0, y);
            *(u32x4*)(p.rR + (size_t)tok * 512 + lane * 8) = pack8f(y);
        }
        {
            float y[8];
            shifted(1, y);
            *(u32x4*)(p.rK + (size_t)tok * 512 + lane * 8) = pack8f(y);
            float ss = 0.f;
#pragma unroll
            for (int j = 0; j < 8; ++j) { y[j] *= (j < 4 ? kk0[j] : kk1[j - 4]); ss += y[j] * y[j]; }
            const float inv = 1.0f / fmaxf(sqrtf(sum8(ss)), 1e-12f);
#pragma unroll
            for (int j = 0; j < 8; ++j) y[j] *= inv;
            *(u32x4*)(p.rKK + (size_t)tok * 512 + lane * 8) = pack8f(y);
        }
        {
            float y[8];
            shifted(2, y);
            *(u32x4*)(p.rV + (size_t)tok * 512 + lane * 8) = pack8f(y);
        }
        {
            float y[8];
            shifted(3, y);
            if (lane < 8) {
#pragma unroll
                for (int j = 0; j < 8; ++j) y[j] = tanhf(y[j]);
                *(u32x4*)(p.rTW + (size_t)tok * 64 + lane * 8) = pack8f(y);
            } else if (lane < 16) {
                *(u32x4*)(p.rAD + (size_t)tok * 64 + (lane - 8) * 8) = pack8f(y);
            } else if (lane < 32) {
#pragma unroll
                for (int j = 0; j < 8; ++j) y[j] = sigmoidf_(y[j]);
                *(u32x4*)(p.rSG + (size_t)tok * 128 + (lane - 16) * 8) = pack8f(y);
            }
        }
    };
    {
        const int runlen = (NT + nblk * 8 - 1) / (nblk * 8);
        const int tok0 = (bid * 8 + wid) * runlen;
        auto load_row = [&](int tk, u32x4 (&r)[4]) {
            const int tc = tk < 0 ? 0 : (tk > NT - 1 ? NT - 1 : tk);
            const bf16_t* pw = P16 + (size_t)tc * EVC + 1536;
#pragma unroll
            for (int sgm = 0; sgm < 4; ++sgm) r[sgm] = __builtin_nontemporal_load((const u32x4*)(pw + (sgm < 3 ? sgm * 512 + lane * 8 : c3)));
        };
        auto load_qk = [&](int tk, u32x4 (&qk)[2], f32x4 (&rope)[4]) {
            const int tc = tk > NT - 1 ? NT - 1 : tk;
            const bool lat = tc < NX;
            const int t = lat ? (tc & 2047) : ((tc - NX) & 255);
            const bf16_t* pr = P16 + (size_t)tc * EVC;
            qk[0] = __builtin_nontemporal_load((const u32x4*)(pr + lane * 8)); qk[1] = __builtin_nontemporal_load((const u32x4*)(pr + 512 + lane * 8));
            const int ro = t * 32 + (l7 >> 2) * 16 + (l7 & 1) * 8;
            rope[0] = *(const f32x4*)(p.rope_cos + ro); rope[1] = *(const f32x4*)(p.rope_cos + ro + 4); rope[2] = *(const f32x4*)(p.rope_sin + ro); rope[3] = *(const f32x4*)(p.rope_sin + ro + 4);
        };
        u32x4 rP[4], rC[4], rN[4], rF[4], qkC[2], qkN[2];
        f32x4 ropeC[4], ropeN[4];
        load_row(tok0 - 1, rP); load_row(tok0, rC); load_row(tok0 + 1, rN); load_qk(tok0, qkC, ropeC);
        for (int i = 0; i < runlen && tok0 + i < NT; ++i) {
            const int tok = tok0 + i;
            load_row(tok + 2, rF); load_qk(tok + 1, qkN, ropeN);
            u32x4 raw[14];
            raw[0] = qkC[0]; raw[1] = qkC[1];
#pragma unroll
            for (int sgm = 0; sgm < 4; ++sgm) { raw[2 + 3 * sgm] = rC[sgm]; raw[3 + 3 * sgm] = rP[sgm]; raw[4 + 3 * sgm] = rN[sgm]; }
            process(tok, raw, ropeC);
#pragma unroll
            for (int sgm = 0; sgm < 4; ++sgm) { rP[sgm] = rC[sgm]; rC[sgm] = rN[sgm]; rN[sgm] = rF[sgm]; }
            qkC[0] = qkN[0]; qkC[1] = qkN[1];
#pragma unroll
            for (int q = 0; q < 4; ++q) ropeC[q] = ropeN[q];
        }
    }
    {
        const int half = tidx() >> 8, tid = tidx() & 255;
        float* lds = (float*)(smem + half * HLDS);
        for (int it = bid * 2 + half; it < 8 * 36 * 4; it += nblk * 2) {
            const int b = it / 144, rem = it % 144, kt = rem >> 2, h = rem & 3;
            __syncthreads();
#pragma unroll
            for (int i = 0; i < 8; ++i) {
                const int e = i * 256 + tid, key = e >> 5, c4 = (e & 31) * 4;
                const int kg = kt * 64 + key;
                const int tok = kg < CTXL ? NX + b * CTXL + kg : b * SEQ + (kg - CTXL);
                const u32x2 v_ = __builtin_nontemporal_load((const u32x2*)((const bf16_t*)p.P + (size_t)tok * EVC + 1024 + h * 128 + c4));
                const uint2 v = make_uint2(v_[0], v_[1]);
                float* d = lds + key * 129 + c4;
                d[0] = __uint_as_float(v.x << 16); d[1] = __uint_as_float(v.x & 0xffff0000u); d[2] = __uint_as_float(v.y << 16); d[3] = __uint_as_float(v.y & 0xffff0000u);
            }
            __syncthreads();
            {
                const int dv = tid >> 1, half = tid & 1;
                unsigned w[16];
#pragma unroll
                for (int j = 0; j < 16; ++j) { const int q = 2 * j, key = 16 * ((q >> 2) & 1) + 4 * (q >> 3) + (q & 3);
                    w[j] = pack2(lds[(half * 32 + key) * 129 + dv], lds[(half * 32 + key + 1) * 129 + dv]); }
                u32x4* dst = (u32x4*)(p.Vd + (((size_t)b * 4 + h) * 128 + dv) * NKEY + kt * 64 + half * 32);
#pragma unroll
                for (int j = 0; j < 4; ++j) dst[j] = (u32x4){w[4 * j], w[4 * j + 1], w[4 * j + 2], w[4 * j + 3]};
            }
        }
    }
}

__device__ __forceinline__ f32x4 bf4(const u32x2 w) { return (f32x4){__uint_as_float(w[0] << 16), __uint_as_float(w[0] & 0xffff0000u), __uint_as_float(w[1] << 16), __uint_as_float(w[1] & 0xffff0000u)}; }
struct EpiDecay {
    const float* w0; bf16_t* W; int row0; int col0;
    __device__ __forceinline__ void tile(const f32x4 (&acc)[4][4], int wr, int wc, int fr, int fq) const {
        const int cc0 = col0 + wc * 64 + fq * 4, z = cc0 >> 9, ch0 = cc0 & 511;
        f32x4 w0v[4];
#pragma unroll
        for (int n = 0; n < 4; ++n) w0v[n] = *(const f32x4*)(w0 + cc0 + n * 16);
#pragma unroll
        for (int m = 0; m < 4; ++m) {
            bf16_t* orow = W + ((size_t)z * NT + row0 + wr * 64 + m * 16 + fr) * 512 + ch0;
#pragma unroll
            for (int n = 0; n < 4; ++n) {
                f32x4 o;
#pragma unroll
                for (int j = 0; j < 4; ++j) {
                    const float x = w0v[n][j] + acc[m][n][j];
                    const float sg = __builtin_amdgcn_rcpf(1.0f + __builtin_amdgcn_exp2f(-1.4426950408889634f * x));
                    o[j] = 1.0f - __builtin_amdgcn_exp2f(-0.6065306597126334f * 1.4426950408889634f * sg);
                }
                *(u32x2*)(orow + n * 16) = (u32x2){pack2(o[0], o[1]), pack2(o[2], o[3])};
            }
        }
    }
};
struct EpiStoreBf16 {
    bf16_t* C; int ldc; int row0; int col0;
    __device__ __forceinline__ void tile(const f32x4 (&acc)[4][4], int wr, int wc, int fr, int fq) const {
#pragma unroll
        for (int m = 0; m < 4; ++m) {
            bf16_t* orow = C + (size_t)(row0 + wr * 64 + m * 16 + fr) * ldc + col0 + wc * 64 + fq * 4;
#pragma unroll
            for (int n = 0; n < 4; ++n) *(u32x2*)(orow + n * 16) = (u32x2){pack2(acc[m][n][0], acc[m][n][1]), pack2(acc[m][n][2], acc[m][n][3])};
        }
    }
};
struct EpiArate {
    const float* a0; bf16_t* AR; int row0; int col0;
    __device__ __forceinline__ void tile(const f32x4 (&acc)[4][4], int wr, int wc, int fr, int fq) const {
        const int z = wc, ch0 = (col0 >> 1) + fq * 4;
        f32x4 a0v[4];
#pragma unroll
        for (int n = 0; n < 4; ++n) a0v[n] = *(const f32x4*)(a0 + z * 512 + ch0 + n * 16);
#pragma unroll
        for (int m = 0; m < 4; ++m) {
            const size_t ro = ((size_t)z * NT + row0 + wr * 64 + m * 16 + fr) * 512 + ch0;
#pragma unroll
            for (int n = 0; n < 4; ++n) {
                f32x4 ar;
#pragma unroll
                for (int j = 0; j < 4; ++j) ar[j] = sigmoidf_(a0v[n][j] + acc[m][n][j]);
                *(u32x2*)(AR + ro + n * 16) = (u32x2){pack2(ar[0], ar[1]), pack2(ar[2], ar[3])};
            }
        }
    }
};
__device__ __forceinline__ void phase_lora(const Params& p, int bid, int nblk, char* smem) {
    const int half = tidx() >> 8;
    char* hs = smem + half * HLDS;
    for (int it0 = bid * 2; it0 < 144 * 20; it0 += nblk * 2) {
        const int grp = (it0 + half) / 10, rr = (it0 + half) % 10;
        const int it = rr < 4 ? grp * 4 + rr : (rr < 8 ? 1152 + grp * 4 + (rr - 4) : 2304 + grp * 2 + (rr - 8));
        if (it < 1152) {
            const int mt = it >> 3, q = it & 7;
            ARows ar{p.rTW, 64, nullptr, 0, mt * 128};
            EpiDecay epi{p.rw_w0, p.rW, mt * 128, q * 128};
            gemm_tile<false, EpiDecay, true>(ar, 128, p.wt_w2 + (size_t)q * 128 * 64, 64, 64, epi, hs);
        } else if (it < 2304) {
            const int j = it - 1152, mt = j >> 3, q = j & 7;
            ARows ar{p.rAD, 64, nullptr, 0, mt * 128};
            EpiArate epi{p.rw_a0, p.rBV, mt * 128, q * 128};
            gemm_tile<false, EpiArate, true>(ar, 128, p.wt_a2 + (size_t)q * 128 * 64, 64, 64, epi, hs);
        } else {
            const int j = it - 2304, mt = j >> 2, q = j & 3;
            ARows ar{p.rSG, 128, nullptr, 0, mt * 128};
            EpiStoreBf16 epi{p.rG, 512, mt * 128, q * 128};
            gemm_tile<false, EpiStoreBf16, true>(ar, 128, p.wt_g2 + (size_t)q * 128 * 128, 128, 128, epi, hs);
        }
    }
}

__device__ __forceinline__ int scan_tok(int z, int b, int s) {
    if (s < CTXL) { const int tc = z == 0 ? s : (CTXL - 1 - s); return NX + b * CTXL + tc; }
    const int t = s - CTXL; return b * SEQ + (z == 0 ? t : (SEQ - 1 - t));
}
typedef float f32x2 __attribute__((ext_vector_type(2)));
__device__ __forceinline__ bf16x8 cvt8(const f32x4 a, const f32x4 b) {
    union { bf16x8 v; unsigned u[4]; } r;
    r.u[0] = pack2(a[0], a[1]); r.u[1] = pack2(a[2], a[3]); r.u[2] = pack2(b[0], b[1]); r.u[3] = pack2(b[2], b[3]);
    return r.v;
}
__device__ __forceinline__ void rwkv_chunk_chain(const Params& p, int chain, char* smem) {
    const int z = chain >> 6, b = (chain >> 3) & 7, h = chain & 7;
    const int tid = tidx(), lane = tid & 63, fr = lane & 15, fq = lane >> 4;
    const int wv_ = __builtin_amdgcn_readfirstlane(tid >> 6);
    bf16_t* AR = (bf16_t*)(smem + 43008);
    bf16_t* BK = (bf16_t*)(smem + 47104);
    bf16_t* BKT = (bf16_t*)(smem + 51200);
    bf16_t* VT = (bf16_t*)(smem + 55296);
    bf16_t* SB = (bf16_t*)(smem + 59392);
    float* AM = (float*)(smem + 67584);
    float* RH = (float*)(smem + 71680);
    float* GC = (float*)(smem + 75776);
    f32x4 S0 = (f32x4){0.f, 0.f, 0.f, 0.f}, S1 = S0;
    for (int i = tid; i < 2048; i += NTHR) ((unsigned*)SB)[i] = 0u;
    const size_t zoff = (size_t)z * NT * 512;
    const char* src1; const char* src2 = nullptr; unsigned dst1, dst2 = 0; int st1, st2 = 0;
    const bool has1 = (wv_ & 6) != 2;
    if (wv_ < 4) { src1 = (const char*)(p.rW + zoff + h * 64 + (lane & 7) * 8); st1 = 8 * (wv_ & 1) + (lane >> 3); dst1 = (wv_ & 1) * 1024; }
    else if (wv_ < 6) { src1 = (const char*)(p.rR + h * 64 + (lane & 7) * 8); st1 = 8 * (wv_ - 4) + (lane >> 3); dst1 = 4096 + (wv_ - 4) * 1024; }
    else { src1 = (const char*)(p.rK + h * 64 + (lane & 7) * 8); st1 = 8 * (wv_ - 6) + (lane >> 3); dst1 = 6144 + (wv_ - 6) * 1024; }
    if (wv_ < 2) { src2 = (const char*)(p.rKK + h * 64 + (lane & 7) * 8); st2 = 8 * wv_ + (lane >> 3); dst2 = 8192 + wv_ * 1024; }
    else if (wv_ < 4) { src2 = (const char*)(p.rBV + zoff + h * 64 + (lane & 7) * 8); st2 = 8 * (wv_ - 2) + (lane >> 3); dst2 = 10240 + (wv_ - 2) * 1024; }
    else if (wv_ < 6) { src2 = (const char*)(p.rV + h * 64 + (lane & 7) * 8); st2 = 8 * (wv_ - 4) + (lane >> 3); dst2 = 12288 + (wv_ - 4) * 1024; }
    auto issue = [&](int chunk) {
        char* bb = smem + (chunk % 3) * 14336;
        const int tok1 = scan_tok(z, b, chunk * 16 + st1);
        if (has1) __builtin_amdgcn_global_load_lds((const unsigned*)(src1 + (size_t)tok1 * 512 * 2), (__attribute__((address_space(3))) unsigned*)(bb + dst1), 16, 0, 0);
        if (wv_ < 6) {
            const int tok2 = scan_tok(z, b, chunk * 16 + st2);
            __builtin_amdgcn_global_load_lds((const unsigned*)(src2 + (size_t)tok2 * 512 * 2), (__attribute__((address_space(3))) unsigned*)(bb + dst2), 16, 0, 0);
        }
    };
    issue(0); issue(1);
    const int ch = lane, t0 = 2 * wv_, t1 = t0 + 1;
    const float kach = p.rw_k_a[h * 64 + ch];
    const int tokdir = z == 0 ? 1 : -1;
    for (int chunk = 0; chunk < 144; ++chunk) {
        if (chunk + 1 < 144) { if ((wv_ & 2) == 0) asm volatile("s_waitcnt vmcnt(2)" ::: "memory"); else asm volatile("s_waitcnt vmcnt(1)" ::: "memory"); }
        else asm volatile("s_waitcnt vmcnt(0)" ::: "memory");
        __syncthreads();
        if (chunk + 2 < 144) issue(chunk + 2);
        const bf16_t* cbw = (const bf16_t*)(smem + (chunk % 3) * 14336);
        const bf16_t* cb = (const bf16_t*)(smem + (chunk % 3) * 14336 + 4096);
        const float w0 = 1.f - bf2f(cbw[t0 * 64 + ch]), w1 = 1.f - bf2f(cbw[t1 * 64 + ch]);
        {
            float gb = 1.f, gall = 1.f;
#pragma unroll
            for (int t = 0; t < 16; ++t) { const float wt = 1.f - bf2f(cbw[t * 64 + ch]); gall *= wt; if (t < t0) gb *= wt; }
            const float gt0 = gb * w0, gt1 = gt0 * w1;
            const float ig0 = __builtin_amdgcn_rcpf(gt0), ig1 = __builtin_amdgcn_rcpf(gt1);
            const float a0 = -gb * bf2f(cb[2048 + t0 * 64 + ch]), a1 = -gt0 * bf2f(cb[2048 + t1 * 64 + ch]);
            const float r0 = gt0 * bf2f(cb[t0 * 64 + ch]), r1 = gt1 * bf2f(cb[t1 * 64 + ch]);
            const float kk0 = bf2f(cb[2048 + t0 * 64 + ch]), kk1 = bf2f(cb[2048 + t1 * 64 + ch]), ar0 = bf2f(cb[3072 + t0 * 64 + ch]), ar1 = bf2f(cb[3072 + t1 * 64 + ch]);
            const float b0 = kk0 * ar0 * ig0, b1 = kk1 * ar1 * ig1;
            const float k0 = bf2f(cb[1024 + t0 * 64 + ch]) * (1.f + (ar0 - 1.f) * kach) * ig0, k1 = bf2f(cb[1024 + t1 * 64 + ch]) * (1.f + (ar1 - 1.f) * kach) * ig1;
            const float v0 = bf2f(cb[4096 + t0 * 64 + ch]), v1 = bf2f(cb[4096 + t1 * 64 + ch]);
            const int cc = ch >> 3, cw = ch & 7;
            AR[t0 * 64 + ((cc ^ (t0 & 7)) << 3) + cw] = f2bf(a0);
            AR[t1 * 64 + ((cc ^ (t1 & 7)) << 3) + cw] = f2bf(a1);
            AR[(16 + t0) * 64 + ((cc ^ (t0 & 7)) << 3) + cw] = f2bf(r0);
            AR[(16 + t1) * 64 + ((cc ^ (t1 & 7)) << 3) + cw] = f2bf(r1);
            BK[t0 * 64 + ((cc ^ (t0 & 7)) << 3) + cw] = f2bf(b0);
            BK[t1 * 64 + ((cc ^ (t1 & 7)) << 3) + cw] = f2bf(b1);
            BK[(16 + t0) * 64 + ((cc ^ (t0 & 7)) << 3) + cw] = f2bf(k0);
            BK[(16 + t1) * 64 + ((cc ^ (t1 & 7)) << 3) + cw] = f2bf(k1);
            const int sw = (ch >> 2) & 3;
            *(unsigned*)(BKT + ch * 32 + (((t0 >> 3) ^ sw) << 3) + (t0 & 7)) = pack2(b0, b1);
            *(unsigned*)(BKT + ch * 32 + ((((16 + t0) >> 3) ^ sw) << 3) + (t0 & 7)) = pack2(k0, k1);
            *(unsigned*)(VT + ch * 32 + ((((16 + t0) >> 3) ^ sw) << 3) + (t0 & 7)) = pack2(v0, v1);
            if (wv_ == 0) GC[ch] = gall;
        }
        __syncthreads();
        f32x4 G2 = (f32x4){0.f, 0.f, 0.f, 0.f};
        {
            const int rb = wv_ >> 2, vb = wv_ & 3;
            const int ra = 16 * rb + fr, rs = 16 * vb + fr;
#pragma unroll
            for (int ks = 0; ks < 2; ++ks) {
                const int c = ks * 4 + fq;
                const bf16x8 af = *(const bf16x8*)(AR + ra * 64 + ((c ^ (ra & 7)) << 3));
                const bf16x8 sf = *(const bf16x8*)(SB + rs * 64 + ((c ^ (rs & 7)) << 3));
                G2 = __builtin_amdgcn_mfma_f32_16x16x32_bf16(sf, af, G2, 0, 0, 0);
            }
        }
        if (wv_ < 4) {
            const int rb = wv_ >> 1, cbk = wv_ & 1;
            const int ra = 16 * rb + fr, rk = 16 * cbk + fr;
            f32x4 G1 = (f32x4){0.f, 0.f, 0.f, 0.f};
#pragma unroll
            for (int ks = 0; ks < 2; ++ks) {
                const int c = ks * 4 + fq;
                const bf16x8 af = *(const bf16x8*)(AR + ra * 64 + ((c ^ (ra & 7)) << 3));
                const bf16x8 bf = *(const bf16x8*)(BK + rk * 64 + ((c ^ (rk & 7)) << 3));
                G1 = __builtin_amdgcn_mfma_f32_16x16x32_bf16(af, bf, G1, 0, 0, 0);
            }
            if (wv_ == 0) {
                f32x4 m;
#pragma unroll
                for (int j = 0; j < 4; ++j) m[j] = (fr < 4 * fq + j) ? G1[j] : 0.f;
                *(f32x4*)(AM + fr * 16 + 4 * fq) = m;
            } else {
#pragma unroll
                for (int j = 0; j < 4; ++j) {
                    const int t = 4 * fq + j;
                    const bool keep = rb == 0 ? (fr < t) : (fr <= t);
                    AM[wv_ * 256 + t * 16 + fr] = keep ? G1[j] : 0.f;
                }
            }
        }
        __syncthreads();
        if (wv_ < 4) {
            union { bf16x8 v; unsigned u[4]; } af;
            if (fq < 2) {
                const f32x4 x0 = *(const f32x4*)(AM + 256 + fr * 16 + 8 * fq), x1 = *(const f32x4*)(AM + 256 + fr * 16 + 8 * fq + 4);
                af.v = cvt8(x0, x1);
            } else { af.u[0] = 0u; af.u[1] = 0u; af.u[2] = 0u; af.u[3] = 0u; }
            const int rv = 16 * wv_ + fr;
            const bf16x8 vf = *(const bf16x8*)(VT + rv * 32 + (((2 + (fq & 1)) ^ ((rv >> 2) & 3)) << 3));
            G2 = __builtin_amdgcn_mfma_f32_16x16x32_bf16(vf, af.v, G2, 0, 0, 0);
            *(f32x4*)(RH + fr * 64 + 16 * wv_ + 4 * fq) = G2;
        }
        __syncthreads();
        if (wv_ == 0) {
            float x[16];
#pragma unroll
            for (int t = 0; t < 16; ++t) x[t] = RH[t * 64 + lane];
#pragma unroll
            for (int i = 0; i < 15; ++i) {
                const float xi = x[i];
#pragma unroll
                for (int q = 0; q < 4; ++q) {
                    if (4 * q + 3 > i) {
                        const f32x4 acol = *(const f32x4*)(AM + i * 16 + 4 * q);
#pragma unroll
                        for (int j = 0; j < 4; ++j) if (4 * q + j > i) x[4 * q + j] += acol[j] * xi;
                    }
                }
            }
            const int sw = (lane >> 2) & 3;
            *(u32x4*)(VT + lane * 32 + ((0 ^ sw) << 3)) = (u32x4){pack2(x[0], x[1]), pack2(x[2], x[3]), pack2(x[4], x[5]), pack2(x[6], x[7])};
            *(u32x4*)(VT + lane * 32 + ((1 ^ sw) << 3)) = (u32x4){pack2(x[8], x[9]), pack2(x[10], x[11]), pack2(x[12], x[13]), pack2(x[14], x[15])};
        }
        __syncthreads();
        if (wv_ >= 4) {
            const int vb = wv_ & 3, rv = 16 * vb + fr;
            const float* am = AM + (fq < 2 ? 512 : 768) + fr * 16 + 8 * (fq & 1);
            const bf16x8 af = cvt8(*(const f32x4*)am, *(const f32x4*)(am + 4));
            const bf16x8 vf = *(const bf16x8*)(VT + rv * 32 + ((fq ^ ((rv >> 2) & 3)) << 3));
            G2 = __builtin_amdgcn_mfma_f32_16x16x32_bf16(vf, af, G2, 0, 0, 0);
            const int tok = scan_tok(z, b, chunk * 16) + tokdir * fr;
            *(uint2*)(p.rY + zoff + (size_t)tok * 512 + h * 64 + 16 * vb + 4 * fq) = make_uint2(pack2(G2[0], G2[1]), pack2(G2[2], G2[3]));
        }
        {
            const int vb = wv_ >> 1, kb0 = 2 * (wv_ & 1);
            const int rv = 16 * vb + fr;
            const bf16x8 uf = *(const bf16x8*)(VT + rv * 32 + ((fq ^ ((rv >> 2) & 3)) << 3));
            const int rk0 = 16 * kb0 + fr, rk1 = rk0 + 16;
            const bf16x8 b0 = *(const bf16x8*)(BKT + rk0 * 32 + ((fq ^ ((rk0 >> 2) & 3)) << 3));
            const bf16x8 b1 = *(const bf16x8*)(BKT + rk1 * 32 + ((fq ^ ((rk1 >> 2) & 3)) << 3));
            S0 = __builtin_amdgcn_mfma_f32_16x16x32_bf16(uf, b0, S0, 0, 0, 0);
            S1 = __builtin_amdgcn_mfma_f32_16x16x32_bf16(uf, b1, S1, 0, 0, 0);
            const float gc0 = GC[rk0], gc1 = GC[rk1];
            S0 *= gc0; S1 *= gc1;
#pragma unroll
            for (int j = 0; j < 4; ++j) {
                const int v = 16 * vb + 4 * fq + j;
                SB[v * 64 + (((rk0 >> 3) ^ (v & 7)) << 3) + (rk0 & 7)] = f2bf(S0[j]);
                SB[v * 64 + (((rk1 >> 3) ^ (v & 7)) << 3) + (rk1 & 7)] = f2bf(S1[j]);
            }
        }
    }
    asm volatile("s_waitcnt vmcnt(0)" ::: "memory");
    __syncthreads();
}

__device__ __forceinline__ float max3_s(float a, float b, float c) { return __builtin_fmaxf(__builtin_fmaxf(a, b), c); }
#define N_LATE512 (320 + 64 + 4096 + 2048)
__device__ __forceinline__ ConvDesc conv_late512_desc(const Params& p, int j) {
    if (j < 320) return ConvDesc{p.od_w_in, p.wt_odin, ODC, 1024, j / 20, j % 20, 2, 0};
    if (j < 384) { const int q = j - 320; return ConvDesc{p.od_w_out, p.wt_odout, 1024, 1024, q >> 2, q & 3, 2, 0}; }
    if (j < 384 + 4096) { const int q = j - 384, mat = q >> 7, t = q & 127; return ConvDesc{p.moe_w_gu + (size_t)mat * 1024 * 2048, p.wt_gu + (size_t)mat * 2048 * 1024, 2048, 1024, t >> 3, t & 7, 1, 0}; }
    const int q = j - 384 - 4096, mat = q >> 6, t = q & 63;
    return ConvDesc{p.moe_w_dn + (size_t)mat * 1024 * 1024, p.wt_dn + (size_t)mat * 1024 * 1024, 1024, 1024, t >> 2, t & 3, 2, 0};
}
struct ConvRegs8 { f32x4 v0, v1, v2, v3, v4, v5, v6, v7; };
__device__ __forceinline__ ConvRegs8 conv512_load(const ConvDesc& d) {
    const int tid = tidx(), kg = tid & 7, cg = tid >> 3;
    const float* b0 = d.src + (size_t)(d.kt * 64 + kg * 8) * d.N + d.nt * 256 + cg * 4;
    const size_t n = (size_t)d.N;
    ConvRegs8 x;
    x.v0 = __builtin_nontemporal_load((const f32x4*)(b0)); x.v1 = __builtin_nontemporal_load((const f32x4*)(b0 + n)); x.v2 = __builtin_nontemporal_load((const f32x4*)(b0 + 2 * n)); x.v3 = __builtin_nontemporal_load((const f32x4*)(b0 + 3 * n));
    x.v4 = __builtin_nontemporal_load((const f32x4*)(b0 + 4 * n)); x.v5 = __builtin_nontemporal_load((const f32x4*)(b0 + 5 * n)); x.v6 = __builtin_nontemporal_load((const f32x4*)(b0 + 6 * n)); x.v7 = __builtin_nontemporal_load((const f32x4*)(b0 + 7 * n));
    return x;
}
__device__ __forceinline__ void conv512_store(const ConvRegs8& x, const ConvDesc& d) {
    const int tid = tidx(), kg = tid & 7, cg = tid >> 3;
#pragma unroll
    for (int j = 0; j < 4; ++j) {
        const int ncol = d.nt * 256 + cg * 4 + j;
        const int row = d.perm == 1 ? gu_row(ncol) : p32_row(ncol);
        __builtin_nontemporal_store((u32x4){pack2(x.v0[j], x.v1[j]), pack2(x.v2[j], x.v3[j]), pack2(x.v4[j], x.v5[j]), pack2(x.v6[j], x.v7[j])}, (u32x4*)(d.dst + (size_t)row * d.Kd + d.kt * 64 + kg * 8));
    }
}
__device__ __forceinline__ void attn_item(const Params& p, int b, int h, int q0, bool isctx, char* smem, int cit) {
    const int tid = tidx(), lane = tid & 63, wid = tid >> 6, fr = lane & 15, fq = lane >> 4;
    bf16_t* sKV = (bf16_t*)smem;
    const int ntiles = isctx ? (CTXL / 64) : (NKEY / 64);
    const int cm = wid >> 2, qg = wid & 3;
    bf16x8 qf[2][2];
#pragma unroll
    for (int m = 0; m < 2; ++m) {
        const bf16_t* qp = isctx ? p.Qc + (((size_t)b * 8 + h * 2 + cm) * CTXL + q0 + qg * 32 + m * 16 + fr) * 64
                                 : p.Q + (((size_t)b * 8 + h * 2 + cm) * SEQ + q0 + qg * 32 + m * 16 + fr) * 64;
        qf[m][0] = *(const bf16x8*)(qp + fq * 8);
        qf[m][1] = *(const bf16x8*)(qp + 32 + fq * 8);
    }
    f32x4 o[2][8];
#pragma unroll
    for (int m = 0; m < 2; ++m)
#pragma unroll
        for (int mb = 0; mb < 8; ++mb) o[m][mb] = (f32x4){0.f, 0.f, 0.f, 0.f};
    float mrun[2] = {0.f, 0.f}, lrun[2] = {0.f, 0.f};
    const int lrow = tid >> 3, lch = tid & 7;
    const bf16_t* kbase = p.Kd + (((size_t)b * 8 + h * 2) * NKEY + lrow) * 64 + lch * 8;
    const bf16_t* vbase = p.Vd + (((size_t)b * 4 + h) * 128 + lrow) * NKEY + lch * 8;
    u32x4 rk[2], rv[2];
#pragma unroll
    for (int i = 0; i < 2; ++i) { rk[i] = *(const u32x4*)(kbase + i * (NKEY * 64)); rv[i] = *(const u32x4*)(vbase + i * (64 * NKEY)); }
    __syncthreads();
#pragma unroll
    for (int i = 0; i < 2; ++i) {
        const int r = lrow + 64 * i;
        const int off = r * 64 + ((lch ^ (r & 7)) << 3);
        *(u32x4*)(sKV + off) = rk[i];
        *(u32x4*)(sKV + 8192 + off) = rv[i];
    }
    if (ntiles > 1) {
#pragma unroll
        for (int i = 0; i < 2; ++i) { rk[i] = *(const u32x4*)(kbase + 4096 + i * (NKEY * 64)); rv[i] = *(const u32x4*)(vbase + 64 + i * (64 * NKEY)); }
    }
    ConvDesc cd = conv_late512_desc(p, 0);
    ConvRegs8 cx = {};
    bool chave = false;
    for (int t = 0; t < ntiles; ++t) {
        __syncthreads();
        const bf16_t* sK = sKV + (t & 1) * 16384;
        const bf16_t* sV = sK + 8192;
        if (t + 1 < ntiles) {
            bf16_t* dK = sKV + ((t + 1) & 1) * 16384;
#pragma unroll
            for (int i = 0; i < 2; ++i) {
                const int r = lrow + 64 * i;
                const int off = r * 64 + ((lch ^ (r & 7)) << 3);
                *(u32x4*)(dK + off) = rk[i];
                *(u32x4*)(dK + 8192 + off) = rv[i];
            }
            if (t + 2 < ntiles) {
#pragma unroll
                for (int i = 0; i < 2; ++i) { rk[i] = *(const u32x4*)(kbase + (t + 2) * 4096 + i * (NKEY * 64)); rv[i] = *(const u32x4*)(vbase + (t + 2) * 64 + i * (64 * NKEY)); }
            }
        }
        if (chave) conv512_store(cx, cd);
        chave = cit >= 0 && cit < 256 && t * 256 + cit < N_LATE512;
        if (chave) { cd = conv_late512_desc(p, t * 256 + cit); cx = conv512_load(cd); }
        bf16x8 pf[2][2];
        f32x4 scb[2][4];
#pragma unroll
        for (int kb = 0; kb < 4; ++kb) {
            scb[0][kb] = (f32x4){-mrun[0], -mrun[0], -mrun[0], -mrun[0]};
            scb[1][kb] = (f32x4){-mrun[1], -mrun[1], -mrun[1], -mrun[1]};
            const int r = cm * 64 + kb * 16 + fr;
#pragma unroll
            for (int ks = 0; ks < 2; ++ks) {
                const bf16x8 kf = *(const bf16x8*)(sK + r * 64 + (((ks * 4 + fq) ^ (r & 7)) << 3));
                scb[0][kb] = __builtin_amdgcn_mfma_f32_16x16x32_bf16(kf, qf[0][ks], scb[0][kb], 0, 0, 0);
                scb[1][kb] = __builtin_amdgcn_mfma_f32_16x16x32_bf16(kf, qf[1][ks], scb[1][kb], 0, 0, 0);
            }
        }
#pragma unroll
        for (int m = 0; m < 2; ++m) {
            f32x4 (&sc)[4] = scb[m];
            float mx = max3_s(sc[0][0], sc[0][1], sc[0][2]);
            mx = max3_s(mx, sc[0][3], sc[1][0]); mx = max3_s(mx, sc[1][1], sc[1][2]); mx = max3_s(mx, sc[1][3], sc[2][0]);
            mx = max3_s(mx, sc[2][1], sc[2][2]); mx = max3_s(mx, sc[2][3], sc[3][0]); mx = max3_s(mx, sc[3][1], sc[3][2]);
            mx = fmaxf(mx, sc[3][3]);
            mx = fmaxf(mx, __shfl_xor(mx, 16));
            mx = fmaxf(mx, __shfl_xor(mx, 32));
            if (!__all(mx <= 8.0f)) {
                const float d = mx > 8.0f ? mx : 0.f;
                const float scale = __builtin_amdgcn_exp2f(-d);
                mrun[m] += d;
                lrun[m] *= scale;
#pragma unroll
                for (int mb = 0; mb < 8; ++mb) o[m][mb] *= scale;
#pragma unroll
                for (int kb = 0; kb < 4; ++kb) sc[kb] -= d;
            }
            float ls = 0.f;
#pragma unroll
            for (int kb = 0; kb < 4; ++kb)
#pragma unroll
                for (int j = 0; j < 4; ++j) { const float e = __builtin_amdgcn_exp2f(sc[kb][j]); sc[kb][j] = e; ls += e; }
            lrun[m] += ls;
#pragma unroll
            for (int ksp = 0; ksp < 2; ++ksp) {
                const u32x4 pk = (u32x4){pack2(sc[2 * ksp][0], sc[2 * ksp][1]), pack2(sc[2 * ksp][2], sc[2 * ksp][3]), pack2(sc[2 * ksp + 1][0], sc[2 * ksp + 1][1]), pack2(sc[2 * ksp + 1][2], sc[2 * ksp + 1][3])};
                pf[m][ksp] = __builtin_bit_cast(bf16x8, pk);
            }
        }
#pragma unroll
        for (int ksp = 0; ksp < 2; ++ksp) {
#pragma unroll
            for (int mb = 0; mb < 8; ++mb) {
                const int r = mb * 16 + fr;
                const bf16x8 vfv = *(const bf16x8*)(sV + r * 64 + (((4 * ksp + fq) ^ (r & 7)) << 3));
                o[0][mb] = __builtin_amdgcn_mfma_f32_16x16x32_bf16(vfv, pf[0][ksp], o[0][mb], 0, 0, 0);
                o[1][mb] = __builtin_amdgcn_mfma_f32_16x16x32_bf16(vfv, pf[1][ksp], o[1][mb], 0, 0, 0);
                if ((mb & 3) == 3) asm volatile("" ::: "memory");
            }
        }
    }
    if (chave) conv512_store(cx, cd);
    {
        float l0 = lrun[0], l1 = lrun[1];
        l0 += __shfl_xor(l0, 16); l0 += __shfl_xor(l0, 32);
        l1 += __shfl_xor(l1, 16); l1 += __shfl_xor(l1, 32);
        f32x4* ex = (f32x4*)smem;
        __syncthreads();
        if (cm == 1) {
            const float lam = p.scal[0];
            const float i0 = lam / l0, i1 = lam / l1;
#pragma unroll
            for (int mb = 0; mb < 8; ++mb) {
                ex[((qg * 2 + 0) * 8 + mb) * 64 + lane] = o[0][mb] * i0;
                ex[((qg * 2 + 1) * 8 + mb) * 64 + lane] = o[1][mb] * i1;
            }
        }
        __syncthreads();
        if (cm == 0) {
#pragma unroll
            for (int m = 0; m < 2; ++m) {
                const float inv = 1.0f / (m == 0 ? l0 : l1);
                float ss = 0.f;
#pragma unroll
                for (int mb = 0; mb < 8; ++mb) {
                    o[m][mb] = o[m][mb] * inv - ex[((qg * 2 + m) * 8 + mb) * 64 + lane];
                    ss += o[m][mb][0] * o[m][mb][0] + o[m][mb][1] * o[m][mb][1] + o[m][mb][2] * o[m][mb][2] + o[m][mb][3] * o[m][mb][3];
                }
                ss += __shfl_xor(ss, 16); ss += __shfl_xor(ss, 32);
                const float rstd = rsqrtf(ss * (1.0f / 128.0f) + 1e-6f) * 0.8f;
                const int tok = (isctx ? NX + b * CTXL : b * SEQ) + q0 + qg * 32 + m * 16 + fr;
                bf16_t* dst = p.MG + (size_t)tok * DM + h * 128 + fq * 4;
#pragma unroll
                for (int mb = 0; mb < 8; ++mb) {
                    const f32x4 g = *(const f32x4*)(p.da_subln + mb * 16 + fq * 4);
                    *(uint2*)(dst + mb * 16) = make_uint2(pack2(o[m][mb][0] * rstd * g[0], o[m][mb][1] * rstd * g[1]), pack2(o[m][mb][2] * rstd * g[2], o[m][mb][3] * rstd * g[3]));
                }
            }
        }
    }
}

#define N_ATT_LAT 512
#define N_ATT_CTX 64
#define N_CONV_LATE (1280 + 256 + 16384 + 8192)
__device__ __forceinline__ ConvDesc conv_late_desc(const Params& p, int pr) {
    const int j = pr * 2 + (tidx() >> 8);
    if (j < 1280) return ConvDesc{p.od_w_in, p.wt_odin, ODC, 1024, j / 80, j % 80, 2, 0};
    if (j < 1536) { const int q = j - 1280; return ConvDesc{p.od_w_out, p.wt_odout, 1024, 1024, q >> 4, q & 15, 2, 0}; }
    if (j < 1536 + 16384) { const int q = j - 1536, mat = q >> 9, t = q & 511; return ConvDesc{p.moe_w_gu + (size_t)mat * 1024 * 2048, p.wt_gu + (size_t)mat * 2048 * 1024, 2048, 1024, t >> 5, t & 31, 1, 0}; }
    const int q = j - 1536 - 16384, mat = q >> 8, t = q & 255;
    return ConvDesc{p.moe_w_dn + (size_t)mat * 1024 * 1024, p.wt_dn + (size_t)mat * 1024 * 1024, 1024, 1024, t >> 4, t & 15, 2, 0};
}
__device__ __forceinline__ ConvDesc conv_l1_desc(const Params& p, int pr) {
    const int j = pr * 2 + (tidx() >> 8);
    if (j < 16384) { const int mat = 32 + (j >> 9), t = j & 511; return ConvDesc{p.moe_w_gu + (size_t)mat * 1024 * 2048, p.wt_gu + (size_t)mat * 2048 * 1024, 2048, 1024, t >> 5, t & 31, 1, 0}; }
    const int q = j - 16384, mat = 32 + (q >> 8), t = q & 255;
    return ConvDesc{p.moe_w_dn + (size_t)mat * 1024 * 1024, p.wt_dn + (size_t)mat * 1024 * 1024, 1024, 1024, t >> 4, t & 15, 2, 0};
}
template <bool L1> __device__ __forceinline__ void conv_group(const Params& p, int g, char* smem) {
    float* lds = (float*)(smem + (tidx() >> 8) * HLDS);
    ConvDesc d = L1 ? conv_l1_desc(p, g * CONV_GRP) : conv_late_desc(p, g * CONV_GRP);
    ConvRegs x = conv_load(d);
#pragma unroll 1
    for (int q = 0; q < CONV_GRP; ++q) {
        ConvDesc dn = d; ConvRegs xn = x;
        if (q + 1 < CONV_GRP) { dn = L1 ? conv_l1_desc(p, g * CONV_GRP + q + 1) : conv_late_desc(p, g * CONV_GRP + q + 1); xn = conv_load(dn); }
        conv_store(x, d, lds);
        d = dn; x = xn;
    }
}
template <bool L1> __device__ __forceinline__ void conv_fill(const Params& p, int n, char* smem) {
    const int n_all = L1 ? ((16384 + 8192) / 2) / CONV_GRP : (N_CONV_LATE / 2) / CONV_GRP;
    for (int k = 0; k < n; ++k) {
        const int it = q_next(p.counts + (L1 ? 65 : 66), smem);
        if (it >= n_all) break;
        conv_group<L1>(p, it, smem);
    }
}
__device__ __forceinline__ void phase_scan_attn(const Params& p, int bid, int nblk, char* smem) {
    for (int it = bid; it < 128; it += nblk) rwkv_chunk_chain(p, it, smem);
    const int n_att = N_ATT_LAT + N_ATT_CTX;
    for (;;) {
        const int it = q_next(p.counts + 64, smem);
        if (it >= n_att) break;
        if (it < N_ATT_LAT) attn_item(p, it >> 6, (it >> 4) & 3, (it & 15) * 128, false, smem, it);
        else { const int j = it - N_ATT_LAT; attn_item(p, j >> 3, (j >> 1) & 3, (j & 1) * 128, true, smem, -1); }
    }
}

__device__ __forceinline__ void phase_rw_readout(const Params& p, int bid, int nblk) {
    const int lane = tidx() & 63, wid = tidx() >> 6;
    const int c0 = lane * 8;
    f32x4 rk0 = *(const f32x4*)(p.rw_r_k + c0), rk1 = *(const f32x4*)(p.rw_r_k + c0 + 4);
    const f32x4 kac0 = *(const f32x4*)(p.rw_k_a + c0), kac1 = *(const f32x4*)(p.rw_k_a + c0 + 4);
    f32x4 lw0 = *(const f32x4*)(p.rw_ln_w + c0), lw1 = *(const f32x4*)(p.rw_ln_w + c0 + 4);
    f32x4 lb0 = *(const f32x4*)(p.rw_ln_b + c0), lb1 = *(const f32x4*)(p.rw_ln_b + c0 + 4);
    for (int tok = bid * 8 + wid; tok < NT; tok += nblk * 8) {
        const size_t o = (size_t)tok * 512 + c0, zo = (size_t)NT * 512;
        float tya[8], tyb[8], tr[8], tka[8], tkb[8], tk[8], tv[8], tg[8];
        unpack8(__builtin_nontemporal_load((const u32x4*)(p.rY + o)), tya); unpack8(__builtin_nontemporal_load((const u32x4*)(p.rY + zo + o)), tyb);
        unpack8(__builtin_nontemporal_load((const u32x4*)(p.rR + o)), tr); unpack8(__builtin_nontemporal_load((const u32x4*)(p.rBV + o)), tka); unpack8(__builtin_nontemporal_load((const u32x4*)(p.rBV + zo + o)), tkb); unpack8(__builtin_nontemporal_load((const u32x4*)(p.rK + o)), tk);
        unpack8(__builtin_nontemporal_load((const u32x4*)(p.rV + o)), tv); unpack8(__builtin_nontemporal_load((const u32x4*)(p.rG + o)), tg);
        const f32x4 r0 = (f32x4){tr[0], tr[1], tr[2], tr[3]}, r1 = (f32x4){tr[4], tr[5], tr[6], tr[7]};
        const f32x4 ka0 = (f32x4){tka[0], tka[1], tka[2], tka[3]}, ka1 = (f32x4){tka[4], tka[5], tka[6], tka[7]}, kb0 = (f32x4){tkb[0], tkb[1], tkb[2], tkb[3]}, kb1 = (f32x4){tkb[4], tkb[5], tkb[6], tkb[7]};
        const f32x4 v0 = (f32x4){tv[0], tv[1], tv[2], tv[3]}, v1 = (f32x4){tv[4], tv[5], tv[6], tv[7]}, g0 = (f32x4){tg[0], tg[1], tg[2], tg[3]}, g1 = (f32x4){tg[4], tg[5], tg[6], tg[7]};
        const f32x4 y0 = (f32x4){tya[0] + tyb[0], tya[1] + tyb[1], tya[2] + tyb[2], tya[3] + tyb[3]}, y1 = (f32x4){tya[4] + tyb[4], tya[5] + tyb[5], tya[6] + tyb[6], tya[7] + tyb[7]};
        const float mean = sum8((y0[0] + y0[1]) + (y0[2] + y0[3]) + (y1[0] + y1[1]) + (y1[2] + y1[3])) * (1.0f / 64.0f);
        const f32x4 d0 = y0 - mean, d1 = y1 - mean;
        const float var = sum8((d0[0] * d0[0] + d0[1] * d0[1]) + (d0[2] * d0[2] + d0[3] * d0[3]) + (d1[0] * d1[0] + d1[1] * d1[1]) + (d1[2] * d1[2] + d1[3] * d1[3])) * (1.0f / 64.0f);
        const float rs = rsqrtf(var + 64e-5f);
        const f32x4 kr0 = (f32x4){tk[0], tk[1], tk[2], tk[3]}, kr1 = (f32x4){tk[4], tk[5], tk[6], tk[7]};
        const f32x4 b0 = r0 * (kr0 * (2.f + (ka0 + kb0 - 2.f) * kac0)) * rk0, b1 = r1 * (kr1 * (2.f + (ka1 + kb1 - 2.f) * kac1)) * rk1;
        const float bon = sum8((b0[0] + b0[1]) + (b0[2] + b0[3]) + (b1[0] + b1[1]) + (b1[2] + b1[3]));
        const f32x4 o0 = (d0 * rs * lw0 + lb0 + bon * v0) * g0, o1 = (d1 * rs * lw1 + lb1 + bon * v1) * g1;
        *(u32x4*)(p.MG + (size_t)tok * DM + 512 + c0) = (u32x4){pack2(o0[0], o0[1]), pack2(o0[2], o0[3]), pack2(o1[0], o1[1]), pack2(o1[2], o1[3])};
    }
}

__device__ __forceinline__ void phase_router(const Params& p, int bid, int nblk, char* smem, int layer, const bf16_t* X, int ntok, bool dry = false) {
    const int tid = tidx(), lane = tid & 63, wid = tid >> 6;
    float* hrow = (float*)smem;
    float* part = hrow + 16 * 1028;
    float* logits = part + 8 * 512;
    float* selv = logits + 512;
    int* sele = (int*)(selv + 64);
    const float* gain = p.norm2_g + layer * DM;
    const float* modl = p.mod + (size_t)layer * 9 * 6144;
    const float* wr = p.router_w + (size_t)layer * DM * NEXP;
    const float* br = p.router_b + layer * NEXP;
    int* counts = p.counts + layer * NEXP;
    int* lists = p.lists + (size_t)layer * NEXP * NT;
    const int tokl = lane & 15, kq = lane >> 4;
    float wb[64];
    {
        const float* wp = wr + (size_t)(wid * 128 + kq) * 32 + tokl;
#pragma unroll
        for (int ks = 0; ks < 32; ++ks) { wb[2 * ks] = wp[ks * 128]; wb[2 * ks + 1] = wp[ks * 128 + 16]; }
    }
    const float bias_e = br[tid & 31];
    const int nit = ntok / 16;
    int it = bid;
    u32x4 xa0, xa1, xb0, xb1;
    if (it < nit) {
        const bf16_t* xr = X + (size_t)(it * 16 + wid * 2) * DM + lane * 8;
        xa0 = *(const u32x4*)(xr); xa1 = *(const u32x4*)(xr + 512); xb0 = *(const u32x4*)(xr + DM); xb1 = *(const u32x4*)(xr + DM + 512);
    }
    int pend_pos = 0, pend_dst = -1, pend_val = 0;
    for (; it < nit; it += nblk) {
        __syncthreads();
#pragma unroll
        for (int u = 0; u < 2; ++u) {
            const int tl = wid * 2 + u, tok = it * 16 + tl;
            const float* mr = modl + modrow(tok) * 6144 + 3072;
            float v0[8], v1[8];
            unpack8(u == 0 ? xa0 : xb0, v0); unpack8(u == 0 ? xa1 : xb1, v1);
            float ss = 0.f;
#pragma unroll
            for (int j = 0; j < 8; ++j) ss += v0[j] * v0[j] + v1[j] * v1[j];
            ss = wave_sum(ss);
            const float rstd = rsqrtf(ss * (1.0f / 1024.0f) + 1e-6f);
#pragma unroll
            for (int i = 0; i < 2; ++i) {
                const int c = lane * 8 + 512 * i;
                const f32x4 g0 = *(const f32x4*)(gain + c), g1 = *(const f32x4*)(gain + c + 4), sh0 = *(const f32x4*)(mr + c), sh1 = *(const f32x4*)(mr + c + 4);
                const f32x4 sc0 = *(const f32x4*)(mr + 1024 + c), sc1 = *(const f32x4*)(mr + 1024 + c + 4);
                float a[8];
#pragma unroll
                for (int j = 0; j < 4; ++j) {
                    a[j] = (i == 0 ? v0[j] : v1[j]) * rstd * g0[j] * (1.f + sc0[j]) + sh0[j];
                    a[4 + j] = (i == 0 ? v0[4 + j] : v1[4 + j]) * rstd * g1[j] * (1.f + sc1[j]) + sh1[j];
                }
                *(u32x4*)(p.H + (size_t)tok * DM + c) = pack8f(a);
                *(f32x4*)(hrow + tl * 1028 + c) = (f32x4){a[0], a[1], a[2], a[3]};
                *(f32x4*)(hrow + tl * 1028 + c + 4) = (f32x4){a[4], a[5], a[6], a[7]};
            }
        }
        if (it + nblk < nit) {
            const bf16_t* xr = X + (size_t)((it + nblk) * 16 + wid * 2) * DM + lane * 8;
            xa0 = *(const u32x4*)(xr); xa1 = *(const u32x4*)(xr + 512); xb0 = *(const u32x4*)(xr + DM); xb1 = *(const u32x4*)(xr + DM + 512);
        }
        if (pend_dst >= 0) { lists[(size_t)pend_dst * NT + pend_pos] = pend_val; pend_dst = -1; }
        __syncthreads();
        {
            f32x4 c0 = (f32x4){0.f, 0.f, 0.f, 0.f}, c1 = c0;
            const float* hp = hrow + tokl * 1028 + wid * 128 + kq;
#pragma unroll
            for (int ks = 0; ks < 32; ++ks) {
                const float a = hp[ks * 4];
                c0 = __builtin_amdgcn_mfma_f32_16x16x4f32(a, wb[2 * ks], c0, 0, 0, 0);
                c1 = __builtin_amdgcn_mfma_f32_16x16x4f32(a, wb[2 * ks + 1], c1, 0, 0, 0);
            }
#pragma unroll
            for (int j = 0; j < 4; ++j) {
                part[wid * 512 + (4 * kq + j) * 32 + tokl] = c0[j];
                part[wid * 512 + (4 * kq + j) * 32 + 16 + tokl] = c1[j];
            }
        }
        __syncthreads();
        const int tl = tid >> 5, e = tid & 31;
        float mine = bias_e;
#pragma unroll
        for (int w = 0; w < 8; ++w) mine += part[w * 512 + tl * 32 + e];
        logits[tl * 32 + e] = mine;
        __syncthreads();
        {
            int rank = 0;
#pragma unroll
            for (int q = 0; q < 8; ++q) {
                const f32x4 l4 = *(const f32x4*)(logits + tl * 32 + 4 * q);
#pragma unroll
                for (int j = 0; j < 4; ++j) rank += (l4[j] > mine || (l4[j] == mine && 4 * q + j < e)) ? 1 : 0;
            }
            if (rank < 4) { selv[tl * 4 + rank] = mine; sele[tl * 4 + rank] = e; }
        }
        __syncthreads();
        if (tid < 64) {
            const int t4 = tid >> 2, k = tid & 3, tok = it * 16 + t4;
            const f32x4 tv = *(const f32x4*)(selv + t4 * 4);
            const float e1 = __expf(tv[1] - tv[0]), e2 = __expf(tv[2] - tv[0]), e3 = __expf(tv[3] - tv[0]);
            const float inv = 1.0f / (1.0f + e1 + e2 + e3);
            const float gk = (k == 0 ? 1.0f : (k == 1 ? e1 : (k == 2 ? e2 : e3))) * inv;
            p.GATE[(size_t)tok * 4 + k] = gk;
            if (!dry) {
                const int ex = sele[t4 * 4 + k];
                pend_pos = atomicAdd(&counts[ex], 1);
                pend_dst = ex; pend_val = tok * 4 + k;
            }
        }
    }
    if (pend_dst >= 0) lists[(size_t)pend_dst * NT + pend_pos] = pend_val;
}

struct EpiGU {
    const float* bias; bf16_t* act; int pos0; int unit0;
    __device__ __forceinline__ void pair(int r, int cu, f32x4 g, f32x4 u) const {
        const int unit = unit0 + cu;
        unsigned w[2]; float o[4];
#pragma unroll
        for (int j = 0; j < 4; ++j) {
            const float gate = fminf(g[j] + bias[unit + j], 7.0f);
            const float up = fminf(fmaxf(u[j] + bias[1024 + unit + j], -7.0f), 7.0f);
            o[j] = (up + 1.0f) * gate * sigmoidf_(1.702f * gate);
        }
        w[0] = pack2(o[0], o[1]); w[1] = pack2(o[2], o[3]);
        *(uint2*)(act + (size_t)(pos0 + r) * 1024 + unit) = make_uint2(w[0], w[1]);
    }
};
struct MoeIter {
    int cnt[4], off[4], tiles[4], ntn, i, step, g;
    __device__ __forceinline__ void init(const int* counts, int NTN, int bid, int nblk) {
        g = bid & 7; i = (bid >> 3) * 2 + (tidx() >> 8); step = (nblk >> 3) * 2; ntn = NTN;
        int o = 0;
#pragma unroll
        for (int q = 0; q < 4; ++q) { cnt[q] = 0; off[q] = 0; tiles[q] = 0; }
        for (int e = 0; e < NEXP; ++e) {
            const int c = counts[e];
            if ((e & 7) == g) {
                const int q = e >> 3;
#pragma unroll
                for (int qq = 0; qq < 4; ++qq) if (qq == q) { cnt[qq] = c; off[qq] = o; tiles[qq] = ((c + 127) >> 7) * NTN; }
            }
            o += c;
        }
    }
    __device__ __forceinline__ bool next(int& e, int& mt, int& nt, int& eoff, int& ecnt) {
        int j = i, q = 0;
        if (j >= tiles[0]) { j -= tiles[0]; q = 1; if (j >= tiles[1]) { j -= tiles[1]; q = 2; if (j >= tiles[2]) { j -= tiles[2]; q = 3; if (j >= tiles[3]) return false; } } }
        int c = cnt[0], o = off[0];
        if (q == 1) { c = cnt[1]; o = off[1]; } else if (q == 2) { c = cnt[2]; o = off[2]; } else if (q == 3) { c = cnt[3]; o = off[3]; }
        const int mcnt = (c + 127) >> 7, full = mcnt >> 3, band = 8 * ntn;
        if (j < full * band) { const int ms = j / band, r = j - ms * band; nt = r >> 3; mt = ms * 8 + (r & 7); }
        else { const int rem = mcnt - full * 8, jj = j - full * band; nt = jj / rem; mt = full * 8 + (jj - nt * rem); }
        e = q * 8 + g; eoff = o; ecnt = c;
        i += step;
        return true;
    }
};

struct PlainOrder8 {
    const char* A; const char* Bt; int K;
    int mg0, mcnt, ntn, total, full, i, step, slack;
    __device__ __forceinline__ void init(const bf16_t* A_, const bf16_t* Bt_, int K_, int MT, int NTN, int bid, int nblk) {
        A = (const char*)A_; Bt = (const char*)Bt_; K = K_;
        const int g = bid & 7;
        mg0 = (MT * g) >> 3; mcnt = ((MT * (g + 1)) >> 3) - mg0; ntn = NTN; total = mcnt * NTN; full = mcnt >> 3; i = bid >> 3; step = nblk >> 3;
        slack = (total + step - 1) / step - (total > i ? (total - i + step - 1) / step : 0);
    }
    __device__ __forceinline__ bool next(g8::Unit& u) {
        if (i >= total) return false;
        int mt, nt;
        const int band = 8 * ntn;
        if (i < full * band) { const int ms = i / band, r = i - ms * band; nt = r >> 3; mt = mg0 + ms * 8 + (r & 7); }
        else { const int rem = mcnt - full * 8, j = i - full * band; nt = j / rem; mt = mg0 + full * 8 + (j - nt * rem); }
        i += step;
        u.a = A + (size_t)mt * 256 * K * 2; u.b = Bt + (size_t)nt * 256 * K * 2; u.gidx = nullptr; u.idx = nullptr; u.shift = 0; u.rows = 256; u.i0 = mt * 256; u.i1 = nt * 256; u.i2 = 0;
        return true;
    }
};
struct Epi8Store {
    float* C; int ldc;
    __device__ __forceinline__ void operator()(const f32x4 (&acc)[2][2][4][2], const g8::Unit& u, int wr, int wc, int fr, int fq) const {
#pragma unroll
        for (int ai = 0; ai < 2; ++ai)
#pragma unroll
            for (int m = 0; m < 4; ++m) {
                float* rowp = C + (size_t)(u.i0 + ai * 128 + wr * 64 + m * 16 + fr) * ldc + u.i1 + wc * 32 + fq * 4;
#pragma unroll
                for (int bj = 0; bj < 2; ++bj)
#pragma unroll
                    for (int n = 0; n < 2; ++n) *(f32x4*)(rowp + bj * 128 + n * 16) = acc[ai][bj][m][n];
            }
    }
};
struct Epi8StoreBf {
    bf16_t* C; int ldc;
    __device__ __forceinline__ void operator()(const f32x4 (&acc)[2][2][4][2], const g8::Unit& u, int wr, int wc, int fr, int fq) const {
#pragma unroll
        for (int ai = 0; ai < 2; ++ai)
#pragma unroll
            for (int m = 0; m < 4; ++m) {
                bf16_t* rowp = C + (size_t)(u.i0 + ai * 128 + wr * 64 + m * 16 + fr) * ldc + u.i1 + wc * 32 + fq * 8;
#pragma unroll
                for (int bj = 0; bj < 2; ++bj) {
                    const f32x4 v0 = acc[ai][bj][m][0], v1 = acc[ai][bj][m][1];
                    *(u32x4*)(rowp + bj * 128) = (u32x4){pack2(v0[0], v0[1]), pack2(v0[2], v0[3]), pack2(v1[0], v1[1]), pack2(v1[2], v1[3])};
                }
            }
    }
};
struct Epi8StoreHg {
    bf16_t* C; const float* hg_lb;
    __device__ __forceinline__ void operator()(const f32x4 (&acc)[2][2][4][2], const g8::Unit& u, int wr, int wc, int fr, int fq) const {
        const int c0 = u.i1 + wc * 32 + fq * 8;
        const int kind = u.i1 < 1024 ? 0 : (u.i1 < 3072 ? 1 : 2);
        f32x4 lbv[2][2];
        if (kind == 1) {
#pragma unroll
            for (int bj = 0; bj < 2; ++bj)
#pragma unroll
                for (int n = 0; n < 2; ++n) {
                    const int ch = (c0 + bj * 128 + n * 4) & 1023;
                    const f32x4 h0 = *(const f32x4*)(hg_lb + ch), h1 = *(const f32x4*)(hg_lb + 1024 + ch);
#pragma unroll
                    for (int j = 0; j < 4; ++j) lbv[bj][n][j] = 1.f - __builtin_amdgcn_rcpf(1.0f + __expf(h0[j] - h1[j]));
                }
        }
#pragma unroll
        for (int ai = 0; ai < 2; ++ai)
#pragma unroll
            for (int m = 0; m < 4; ++m) {
                bf16_t* rowp = C + (size_t)(u.i0 + ai * 128 + wr * 64 + m * 16 + fr) * ODC + c0;
#pragma unroll
                for (int bj = 0; bj < 2; ++bj) {
                    f32x4 v0 = acc[ai][bj][m][0], v1 = acc[ai][bj][m][1];
                    if (kind == 0) {
#pragma unroll
                        for (int j = 0; j < 4; ++j) { v0[j] = siluf_(v0[j]); v1[j] = siluf_(v1[j]); }
                    } else if (kind == 1) {
#pragma unroll
                        for (int j = 0; j < 4; ++j) {
                            v0[j] = lbv[bj][0][j] * __builtin_amdgcn_rcpf(1.0f + __expf(v0[j]));
                            v1[j] = lbv[bj][1][j] * __builtin_amdgcn_rcpf(1.0f + __expf(v1[j]));
                        }
                    }
                    *(u32x4*)(rowp + bj * 128) = (u32x4){pack2(v0[0], v0[1]), pack2(v0[2], v0[3]), pack2(v1[0], v1[1]), pack2(v1[2], v1[3])};
                }
                asm volatile("" ::: "memory");
            }
    }
};
template <bool IN_BF16>
struct Epi8Resid {
    const void* xin_lat; const void* xin_ctx; bf16_t* xout; const float* gmod;
    __device__ __forceinline__ void operator()(const f32x4 (&acc)[2][2][4][2], const g8::Unit& u, int wr, int wc, int fr, int fq) const {
        const int c0 = u.i1 + wc * 32 + fq * 8;
        const float* gr = gmod + modrow(u.i0) * 6144 + c0;
        f32x4 g[2][2];
#pragma unroll
        for (int bj = 0; bj < 2; ++bj)
#pragma unroll
            for (int n = 0; n < 2; ++n) g[bj][n] = *(const f32x4*)(gr + bj * 128 + n * 4);
#pragma unroll
        for (int ai = 0; ai < 2; ++ai)
#pragma unroll
            for (int m = 0; m < 4; ++m) {
                const int tok = u.i0 + ai * 128 + wr * 64 + m * 16 + fr;
                const size_t ro = (tok < NX ? (size_t)tok * DM : (size_t)(tok - NX) * DM) + c0;
                bf16_t* orow = xout + (size_t)tok * DM + c0;
                if constexpr (IN_BF16) {
                    const bf16_t* xr = (tok < NX ? (const bf16_t*)xin_lat : (const bf16_t*)xin_ctx) + ro;
                    const u32x4 xw0 = *(const u32x4*)(xr), xw1 = *(const u32x4*)(xr + 128);
#pragma unroll
                    for (int bj = 0; bj < 2; ++bj) {
                        float xf[8], o[8];
                        unpack8(bj == 0 ? xw0 : xw1, xf);
                        const f32x4 v0 = acc[ai][bj][m][0], v1 = acc[ai][bj][m][1];
#pragma unroll
                        for (int j = 0; j < 4; ++j) { o[j] = xf[j] + g[bj][0][j] * v0[j]; o[4 + j] = xf[4 + j] + g[bj][1][j] * v1[j]; }
                        *(u32x4*)(orow + bj * 128) = pack8f(o);
                    }
                } else {
                    const float* xr = (tok < NX ? (const float*)xin_lat : (const float*)xin_ctx) + ro;
                    f32x4 xi[2][2];
#pragma unroll
                    for (int bj = 0; bj < 2; ++bj)
#pragma unroll
                        for (int n = 0; n < 2; ++n) xi[bj][n] = *(const f32x4*)(xr + bj * 128 + n * 4);
#pragma unroll
                    for (int bj = 0; bj < 2; ++bj) {
                        const f32x4 o0 = xi[bj][0] + g[bj][0] * acc[ai][bj][m][0], o1 = xi[bj][1] + g[bj][1] * acc[ai][bj][m][1];
                        *(u32x4*)(orow + bj * 128) = (u32x4){pack2(o0[0], o0[1]), pack2(o0[2], o0[3]), pack2(o1[0], o1[1]), pack2(o1[2], o1[3])};
                    }
                }
                asm volatile("" ::: "memory");
            }
    }
};
struct MoeOrder8 {
    int cvec;
    const int* lists; const char* A; const char* W; int wrows, ntn, i, step, hi, slack;
    bool gather;
    __device__ __forceinline__ void init(const int* counts_, const int* lists_, const bf16_t* A_, const bf16_t* W_, int wrows_, bool gather_, int bid, int nblk) {
        cvec = counts_[tidx() & 31]; lists = lists_; A = (const char*)A_; W = (const char*)W_; wrows = wrows_; ntn = wrows_ / 256; gather = gather_;
        int total = 0;
#pragma unroll
        for (int e = 0; e < NEXP; ++e) total += ((__builtin_amdgcn_readlane(cvec, e) + 255) >> 8) * ntn;
        const int g = bid & 7;
        const int lo = (total * g) >> 3;
        hi = (total * (g + 1)) >> 3;
        i = lo + (bid >> 3); step = nblk >> 3;
        slack = (hi - lo + step - 1) / step - (hi > i ? (hi - i + step - 1) / step : 0);
    }
    __device__ __forceinline__ bool next(g8::Unit& u) {
        if (i >= hi) return false;
        int j = i, o = 0, fe = -1, fo = 0, fc = 0, fm = 1;
#pragma unroll
        for (int e = 0; e < NEXP; ++e) {
            const int c = __builtin_amdgcn_readlane(cvec, e);
            if (fe < 0) {
                const int mcnt = (c + 255) >> 8, t = mcnt * ntn;
                if (j < t) { fe = e; fo = o; fc = c; fm = mcnt; }
                else j -= t;
            }
            o += c;
        }
        if (fe < 0) return false;
        const int nt = j / fm, mt = j - nt * fm;
        i += step;
        u.idx = lists + (size_t)fe * NT + mt * 256; u.gidx = gather ? u.idx : nullptr; u.rows = min(256, fc - mt * 256); u.shift = 2;
        u.a = gather ? A : A + (size_t)(fo + mt * 256) * 1024 * 2;
        u.b = W + ((size_t)fe * wrows + (size_t)nt * 256) * 1024 * 2;
        u.i0 = fo + mt * 256;
        u.i1 = nt;
        u.i2 = fe;
        return true;
    }
};
struct Epi8GU {
    const float* bias; bf16_t* act;
    __device__ __forceinline__ void operator()(const f32x4 (&acc)[2][2][4][2], const g8::Unit& u, int wr, int wc, int fr, int fq) const {
        const float* be = bias + (size_t)u.i2 * 2048;
        const int unit = u.i1 * 128 + wc * 32 + fq * 8;
        const f32x4 bg0 = *(const f32x4*)(be + unit), bg1 = *(const f32x4*)(be + unit + 4), bu0 = *(const f32x4*)(be + 1024 + unit), bu1 = *(const f32x4*)(be + 1024 + unit + 4);
#pragma unroll
        for (int ai = 0; ai < 2; ++ai)
#pragma unroll
            for (int m = 0; m < 4; ++m) {
                const int r = ai * 128 + wr * 64 + m * 16 + fr;
                if (r < u.rows) {
                    float o[8];
#pragma unroll
                    for (int bj = 0; bj < 2; ++bj) {
                        const f32x4 g = acc[ai][bj][m][0] + (bj ? bg1 : bg0), up = acc[ai][bj][m][1] + (bj ? bu1 : bu0);
#pragma unroll
                        for (int j = 0; j < 4; ++j) {
                            const float gate = fminf(g[j], 7.0f);
                            const float uu = fminf(fmaxf(up[j], -7.0f), 7.0f);
                            const float sg = __builtin_amdgcn_rcpf(1.0f + __builtin_amdgcn_exp2f(gate * (-1.702f * 1.4426950408889634f)));
                            o[bj * 4 + j] = __builtin_fmaf(uu, gate, gate) * sg;
                        }
                    }
                    *(u32x4*)(act + (size_t)(u.i0 + r) * 1024 + unit) = (u32x4){pack2(o[0], o[1]), pack2(o[2], o[3]), pack2(o[4], o[5]), pack2(o[6], o[7])};
                }
                asm volatile("" ::: "memory");
            }
    }
};
struct Epi8DN {
    const float* bias; bf16_t* ys;
    __device__ __forceinline__ void operator()(const f32x4 (&acc)[2][2][4][2], const g8::Unit& u, int wr, int wc, int fr, int fq) const {
        const int cb = u.i1 * 256 + wc * 32 + fq * 8;
        const float* be = bias + (size_t)u.i2 * 1024 + cb;
        const f32x4 b00 = *(const f32x4*)(be), b01 = *(const f32x4*)(be + 4), b10 = *(const f32x4*)(be + 128), b11 = *(const f32x4*)(be + 132);
        int asg[8];
#pragma unroll
        for (int st = 0; st < 8; ++st) { const int r = (st >> 2) * 128 + wr * 64 + (st & 3) * 16 + fr; asg[st] = u.idx[r < u.rows ? r : 0]; }
#pragma unroll
        for (int ai = 0; ai < 2; ++ai)
#pragma unroll
            for (int m = 0; m < 4; ++m) {
                const int r = ai * 128 + wr * 64 + m * 16 + fr;
                if (r < u.rows) {
                    const int a = asg[ai * 4 + m];
                    bf16_t* orow = ys + (size_t)a * 1024 + cb;
#pragma unroll
                    for (int bj = 0; bj < 2; ++bj) {
                        const f32x4 v0 = acc[ai][bj][m][0] + (bj ? b10 : b00), v1 = acc[ai][bj][m][1] + (bj ? b11 : b01);
                        *(u32x4*)(orow + bj * 128) = (u32x4){pack2(v0[0], v0[1]), pack2(v0[2], v0[3]), pack2(v1[0], v1[1]), pack2(v1[2], v1[3])};
                    }
                }
                asm volatile("" ::: "memory");
            }
    }
};
__device__ __forceinline__ void phase_gemm8_store(const bf16_t* A, int M, const bf16_t* Wt, int N, float* C, int bid, int nblk, char* smem) {
    PlainOrder8 S; S.init(A, Wt, DM, M / 256, N / 256, bid, nblk);
    Epi8Store E{C, N};
    g8::gemm_phase((G8_LAS unsigned char*)smem, DM, S, E);
}
__device__ __forceinline__ void phase_gemm8_store_bf(const Params& p, const bf16_t* A, int M, const bf16_t* Wt, int N, bf16_t* C, int bid, int nblk, char* smem) {
    PlainOrder8 S; S.init(A, Wt, DM, M / 256, N / 256, bid, nblk);
    Epi8StoreBf E{C, N};
    const int slack = S.slack;
    g8::gemm_phase((G8_LAS unsigned char*)smem, DM, S, E);
    if (slack > 0) { __syncthreads(); conv_fill<true>(p, 1, smem); }
}
__device__ __forceinline__ void phase_gemm8_store_hg(const Params& p, int bid, int nblk, char* smem) {
    PlainOrder8 S; S.init(p.H, p.wt_odin, DM, NT / 256, ODC / 256, bid, nblk);
    Epi8StoreHg E{(bf16_t*)p.P, p.hg_lb};
    const int slack = S.slack;
    g8::gemm_phase((G8_LAS unsigned char*)smem, DM, S, E);
    if (slack > 0) { __syncthreads(); conv_fill<true>(p, 1, smem); }
}
template <bool IN_BF16>
__device__ __forceinline__ void phase_outproj8(const Params& p, int bid, int nblk, char* smem, const bf16_t* Wt, int ntok, const void* xin_lat, const void* xin_ctx, bf16_t* xout, const float* gmod) {
    PlainOrder8 S; S.init(p.MG, Wt, DM, ntok / 256, 4, bid, nblk);
    Epi8Resid<IN_BF16> E{xin_lat, xin_ctx, xout, gmod};
    const int slack = S.slack;
    g8::gemm_phase((G8_LAS unsigned char*)smem, DM, S, E);
    if (!IN_BF16 && slack > 0 && ((bid >> 3) & 1)) { __syncthreads(); conv_fill<true>(p, 1, smem); }
}
__device__ __forceinline__ void phase_moe_gu8(const Params& p, int bid, int nblk, char* smem, int layer) {
    MoeOrder8 S; S.init(p.counts + layer * NEXP, p.lists + (size_t)layer * NEXP * NT, p.H, p.wt_gu + (size_t)layer * NEXP * 2048 * 1024, 2048, true, bid, nblk);
    Epi8GU E{p.moe_b_gu + (size_t)layer * NEXP * 2048, p.ACT};
    const int slack = S.slack;
    g8::gemm_phase((G8_LAS unsigned char*)smem, DM, S, E);
    if (layer == 0 && slack > 0) { __syncthreads(); conv_fill<true>(p, 1, smem); }
}
__device__ __forceinline__ void phase_moe_dn8(const Params& p, int bid, int nblk, char* smem, int layer) {
    MoeOrder8 S; S.init(p.counts + layer * NEXP, p.lists + (size_t)layer * NEXP * NT, p.ACT, p.wt_dn + (size_t)layer * NEXP * 1024 * 1024, 1024, false, bid, nblk);
    Epi8DN E{p.moe_b_dn + (size_t)layer * NEXP * 1024, p.YS};
    const int slack = S.slack;
    g8::gemm_phase((G8_LAS unsigned char*)smem, DM, S, E);
    if (layer == 0 && slack > 0) { __syncthreads(); conv_fill<true>(p, 1, smem); }
}

template <bool OUT_BF16>
__device__ __forceinline__ void phase_combine(const Params& p, int bid, int nblk, const bf16_t* Xin, void* Xout, const float* gmod  , int ntok,
                              bool do_norm, const float* gain, const float* modn) {
    const int lane = tidx() & 63, wid = tidx() >> 6;
    for (int tok = bid * 8 + wid; tok < ntok; tok += nblk * 8) {
        const float* gr = gmod + modrow(tok) * 6144;
        const f32x4 gt = *(const f32x4*)(p.GATE + (size_t)tok * 4);
        const bf16_t* ys = p.YS + (size_t)tok * 4 * 1024;
        float v0[8], v1[8];
        float ss = 0.f;
#pragma unroll
        for (int i = 0; i < 2; ++i) {
            const int c = lane * 8 + 512 * i;
            float xi[8], y0[8], y1[8], y2[8], y3[8];
            unpack8(__builtin_nontemporal_load((const u32x4*)(Xin + (size_t)tok * DM + c)), xi);
            unpack8(__builtin_nontemporal_load((const u32x4*)(ys + c)), y0); unpack8(__builtin_nontemporal_load((const u32x4*)(ys + 1024 + c)), y1); unpack8(__builtin_nontemporal_load((const u32x4*)(ys + 2048 + c)), y2); unpack8(__builtin_nontemporal_load((const u32x4*)(ys + 3072 + c)), y3);
            const f32x4 ga = *(const f32x4*)(gr + c), gb = *(const f32x4*)(gr + c + 4);
            float o[8];
#pragma unroll
            for (int j = 0; j < 8; ++j) {
                o[j] = xi[j] + (j < 4 ? ga[j & 3] : gb[j & 3]) * (gt[0] * y0[j] + gt[1] * y1[j] + gt[2] * y2[j] + gt[3] * y3[j]);
                ss += o[j] * o[j];
                if (i == 0) v0[j] = o[j]; else v1[j] = o[j];
            }
            if constexpr (OUT_BF16) *(u32x4*)((bf16_t*)Xout + (size_t)tok * DM + c) = pack8f(o);
            else {
                __builtin_nontemporal_store((f32x4){o[0], o[1], o[2], o[3]}, (f32x4*)((float*)Xout + (size_t)tok * DM + c));
                __builtin_nontemporal_store((f32x4){o[4], o[5], o[6], o[7]}, (f32x4*)((float*)Xout + (size_t)tok * DM + c + 4));
            }
        }
        if (do_norm) {
            ss = wave_sum(ss);
            const float rstd = rsqrtf(ss * (1.0f / 1024.0f) + 1e-6f);
            const float* mr = modn + modrow(tok) * 6144;
#pragma unroll
            for (int i = 0; i < 2; ++i) {
                const int c = lane * 8 + 512 * i;
                const f32x4 g0 = *(const f32x4*)(gain + c), g1 = *(const f32x4*)(gain + c + 4), sh0 = *(const f32x4*)(mr + c), sh1 = *(const f32x4*)(mr + c + 4);
                const f32x4 sc0 = *(const f32x4*)(mr + 1024 + c), sc1 = *(const f32x4*)(mr + 1024 + c + 4);
                float a[8];
#pragma unroll
                for (int j = 0; j < 4; ++j) {
                    a[j] = (i == 0 ? v0[j] : v1[j]) * rstd * g0[j] * (1.f + sc0[j]) + sh0[j];
                    a[4 + j] = (i == 0 ? v0[4 + j] : v1[4 + j]) * rstd * g1[j] * (1.f + sc1[j]) + sh1[j];
                }
                *(u32x4*)(p.H + (size_t)tok * DM + c) = pack8f(a);
            }
        }
    }
}

__device__ __forceinline__ bf16x8 pack8(const f32x4 a, const f32x4 b) {
    union { bf16x8 v; unsigned u[4]; } r;
    r.u[0] = pack2(a[0], a[1]); r.u[1] = pack2(a[2], a[3]); r.u[2] = pack2(b[0], b[1]); r.u[3] = pack2(b[2], b[3]);
    return r.v;
}
#define HG_BAR() do { asm volatile("s_waitcnt lgkmcnt(0)" ::: "memory"); __builtin_amdgcn_s_barrier(); asm volatile("" ::: "memory"); } while (0)
__device__ __forceinline__ void hgrn_chain(const Params& p, int chain, char* smem) {
    const int z = chain >> 6, b = (chain >> 3) & 7, h = chain & 7;
    const int tid = tidx(), lane = tid & 63, wid = tid >> 6, fr = lane & 15, fq = lane >> 4;
    bf16_t* const sbase = (bf16_t*)smem;
    float* const sTb = (float*)(smem + 65536);
    float* const sEb = (float*)(smem + 73728);
    const int cp = tid & 63, g4 = tid >> 6;
    f32x4 S[8];
#pragma unroll
    for (int mi = 0; mi < 8; ++mi) S[mi] = (f32x4){0.f, 0.f, 0.f, 0.f};
    unsigned qA[4], fA[4], iA[4], qB[4], fB[4], iB[4];
    auto issue = [&](int chunk, unsigned (&rq)[4], unsigned (&rf)[4], unsigned (&ri)[4]) {
        const int tok0 = scan_tok(z, b, chunk * 32 + g4 * 4);
        const unsigned* pr = (const unsigned*)((const bf16_t*)p.P + (size_t)tok0 * ODC + h * 128) + cp;
        const int stride = z == 0 ? ODC / 2 : -(ODC / 2);
#pragma unroll
        for (int i = 0; i < 4; ++i) {
            rq[i] = pr[0]; rf[i] = pr[512 * (1 + z)]; ri[i] = pr[1536];
            pr += stride;
        }
    };
    issue(0, qA, fA, iA);
    issue(1, qB, fB, iB);
    float bc0[4], bc1[4], k0[4], k1[4];
    auto part1 = [&](int par, const unsigned (&rf)[4]) {
        float run0 = 1.f, run1 = 1.f;
#pragma unroll
        for (int i = 0; i < 4; ++i) {
            k0[i] = __uint_as_float(rf[i] << 16); k1[i] = __uint_as_float(rf[i] & 0xffff0000u);
            run0 *= 1.f - k0[i]; run1 *= 1.f - k1[i];
            bc0[i] = run0; bc1[i] = run1;
        }
        *(f32x2_*)(sTb + par * 1024 + g4 * 128 + 2 * cp) = (f32x2_){run0, run1};
    };
    auto part2 = [&](int par, const unsigned (&rq)[4], const unsigned (&ri)[4]) {
        bf16_t* sQ = sbase + par * 16384; bf16_t* sK = sQ + 32 * 128; bf16_t* sKL = sK + 32 * 128; bf16_t* sV = sKL + 128 * 32;
        const float* sT = sTb + par * 1024;
        float boff0 = 1.f, boff1 = 1.f, ebl0 = 1.f, ebl1 = 1.f;
#pragma unroll
        for (int j = 0; j < 8; ++j) {
            const f32x2_ t = *(const f32x2_*)(sT + j * 128 + 2 * cp);
            if (j < g4) { boff0 *= t[0]; boff1 *= t[1]; }
            ebl0 *= t[0]; ebl1 *= t[1];
        }
        if (g4 == 0) *(f32x2_*)(sEb + par * 128 + 2 * cp) = (f32x2_){ebl0, ebl1};
        float kl0[4], kl1[4];
#pragma unroll
        for (int i = 0; i < 4; ++i) {
            const int t = g4 * 4 + i;
            const float eb0 = bc0[i] * boff0, eb1 = bc1[i] * boff1;
            const float emb0 = __builtin_amdgcn_rcpf(eb0), emb1 = __builtin_amdgcn_rcpf(eb1);
            const float qe0 = __uint_as_float(rq[i] << 16) * eb0, qe1 = __uint_as_float(rq[i] & 0xffff0000u) * eb1;
            const float ke0 = k0[i] * emb0, ke1 = k1[i] * emb1;
            kl0[i] = ke0 * ebl0; kl1[i] = ke1 * ebl1;
            const int off = t * 128 + (((cp >> 2) ^ (t & 15)) << 3) + ((cp & 3) << 1);
            *(unsigned*)(sQ + off) = pack2(qe0, qe1);
            *(unsigned*)(sK + off) = pack2(ke0, ke1);
        }
        const int ch0 = 2 * cp;
        const int o2 = ch0 * 32 + (((g4 >> 1) ^ ((ch0 >> 2) & 3)) << 3) + (g4 & 1) * 4;
        *(uint2*)(sKL + o2) = make_uint2(pack2(kl0[0], kl0[1]), pack2(kl0[2], kl0[3]));
        *(uint2*)(sKL + o2 + 32) = make_uint2(pack2(kl1[0], kl1[1]), pack2(kl1[2], kl1[3]));
        *(uint2*)(sV + o2) = make_uint2((ri[0] & 0xffffu) | (ri[1] << 16), (ri[2] & 0xffffu) | (ri[3] << 16));
        *(uint2*)(sV + o2 + 32) = make_uint2((ri[0] >> 16) | (ri[1] & 0xffff0000u), (ri[2] >> 16) | (ri[3] & 0xffff0000u));
    };
    auto mma = [&](int chunk, int par) {
        const bf16_t* sQ = sbase + par * 16384; const bf16_t* sK = sQ + 32 * 128; const bf16_t* sKL = sK + 32 * 128; const bf16_t* sV = sKL + 128 * 32;
        const float* sEBL = sEb + par * 128;
        const int r0 = wid * 16 + fr;
        if (chunk >= 8) {
        f32x4 sc00 = (f32x4){0.f, 0.f, 0.f, 0.f}, sc01 = sc00, sc11 = sc00;
#pragma unroll
        for (int ks = 0; ks < 4; ++ks) {
            const int c = ks * 4 + fq;
            const bf16x8 kf0 = *(const bf16x8*)(sK + fr * 128 + ((c ^ fr) << 3));
            const bf16x8 kf1 = *(const bf16x8*)(sK + (16 + fr) * 128 + ((c ^ fr) << 3));
            const bf16x8 q0 = *(const bf16x8*)(sQ + fr * 128 + ((c ^ fr) << 3));
            const bf16x8 q1 = *(const bf16x8*)(sQ + (16 + fr) * 128 + ((c ^ fr) << 3));
            sc00 = __builtin_amdgcn_mfma_f32_16x16x32_bf16(kf0, q0, sc00, 0, 0, 0);
            sc01 = __builtin_amdgcn_mfma_f32_16x16x32_bf16(kf0, q1, sc01, 0, 0, 0);
            sc11 = __builtin_amdgcn_mfma_f32_16x16x32_bf16(kf1, q1, sc11, 0, 0, 0);
        }
#pragma unroll
        for (int j = 0; j < 4; ++j) { if (4 * fq + j > fr) { sc00[j] = 0.f; sc11[j] = 0.f; } }
        const f32x4 zero4 = (f32x4){0.f, 0.f, 0.f, 0.f};
        const bf16x8 pf0 = pack8(sc00, zero4), pf1 = pack8(sc01, sc11);
        f32x4 o[2];
        o[0] = zero4; o[1] = zero4;
        {
            union { bf16x8 v; uint2 u[2]; } vp0;
            vp0.u[0] = *(const uint2*)(sV + r0 * 32 + ((((fq >> 1)) ^ ((r0 >> 2) & 3)) << 3) + (fq & 1) * 4);
            vp0.u[1] = *(const uint2*)(sV + r0 * 32 + (((2 + (fq >> 1)) ^ ((r0 >> 2) & 3)) << 3) + (fq & 1) * 4);
            o[0] = __builtin_amdgcn_mfma_f32_16x16x32_bf16(vp0.v, pf0, o[0], 0, 0, 0);
            o[1] = __builtin_amdgcn_mfma_f32_16x16x32_bf16(vp0.v, pf1, o[1], 0, 0, 0);
        }
#pragma unroll
        for (int kp = 0; kp < 4; ++kp) {
            const bf16x8 sf0 = pack8(S[2 * kp], S[2 * kp + 1]);
            const int c0 = 4 * kp + (fq >> 1), c1 = c0 + 2;
            union { bf16x8 v; uint2 u[2]; } qa, qb;
            qa.u[0] = *(const uint2*)(sQ + fr * 128 + ((c0 ^ fr) << 3) + (fq & 1) * 4);
            qa.u[1] = *(const uint2*)(sQ + fr * 128 + ((c1 ^ fr) << 3) + (fq & 1) * 4);
            qb.u[0] = *(const uint2*)(sQ + (16 + fr) * 128 + ((c0 ^ fr) << 3) + (fq & 1) * 4);
            qb.u[1] = *(const uint2*)(sQ + (16 + fr) * 128 + ((c1 ^ fr) << 3) + (fq & 1) * 4);
            o[0] = __builtin_amdgcn_mfma_f32_16x16x32_bf16(sf0, qa.v, o[0], 0, 0, 0);
            o[1] = __builtin_amdgcn_mfma_f32_16x16x32_bf16(sf0, qb.v, o[1], 0, 0, 0);
        }
#pragma unroll
        for (int tb = 0; tb < 2; ++tb) {
            const int tok = scan_tok(z, b, chunk * 32 + tb * 16 + fr);
            *(uint2*)((bf16_t*)p.HO + ((size_t)z * NX + tok) * 1024 + h * 128 + wid * 16 + fq * 4) = make_uint2(pack2(o[tb][0], o[tb][1]), pack2(o[tb][2], o[tb][3]));
        }
        }
        {
            const bf16x8 v0 = *(const bf16x8*)(sV + r0 * 32 + ((fq ^ ((r0 >> 2) & 3)) << 3));
#pragma unroll
            for (int mi = 0; mi < 8; ++mi) {
                const int r = mi * 16 + fr;
                const bf16x8 kl = *(const bf16x8*)(sKL + r * 32 + ((fq ^ ((r >> 2) & 3)) << 3));
                const f32x4 e = *(const f32x4*)(sEBL + mi * 16 + fq * 4);
                S[mi] = __builtin_amdgcn_mfma_f32_16x16x32_bf16(kl, v0, S[mi] * e, 0, 0, 0);
            }
        }
    };
    part1(0, fA);
    __syncthreads();
    part2(0, qA, iA);
    issue(2, qA, fA, iA);
    for (int c = 0; c < 72; c += 2) {
        part1(1, fB);
        HG_BAR();
        part2(1, qB, iB);
        if (c + 3 < 72) issue(c + 3, qB, fB, iB);
        mma(c, 0);
        if (c + 2 < 72) part1(0, fA);
        HG_BAR();
        if (c + 2 < 72) { part2(0, qA, iA); if (c + 4 < 72) issue(c + 4, qA, fA, iA); }
        mma(c + 1, 1);
    }
    __syncthreads();
}
__device__ __forceinline__ void phase_hgrn(const Params& p, int bid, int nblk, char* smem) {
    for (int it = bid; it < 128; it += nblk) hgrn_chain(p, it, smem);
    const int n_all = ((16384 + 8192) / 2) / CONV_GRP;
    for (;;) {
        const int it = q_next(p.counts + 65, smem);
        if (it >= n_all) break;
        conv_group<true>(p, it, smem);
    }
}
__device__ __forceinline__ void phase_hgrn_readout(const Params& p, int bid, int nblk) {
    const int lane = tidx() & 63, wid = tidx() >> 6;
    const int c0 = lane * 8;
    const f32x4 n0 = *(const f32x4*)(p.hg_norm + (c0 & 127)), n1 = *(const f32x4*)(p.hg_norm + (c0 & 127) + 4);
    for (int tok = bid * 8 + wid; tok < NX; tok += nblk * 8) {
#pragma unroll
        for (int q = 0; q < 2; ++q) {
            const size_t o = (size_t)tok * 1024 + q * 512 + c0, zo = (size_t)NX * 1024;
            float ta[8], tb[8], tg[8];
            unpack8(__builtin_nontemporal_load((const u32x4*)((const bf16_t*)p.HO + o)), ta); unpack8(__builtin_nontemporal_load((const u32x4*)((const bf16_t*)p.HO + zo + o)), tb);
            unpack8(__builtin_nontemporal_load((const u32x4*)((const bf16_t*)p.P + (size_t)tok * ODC + 4096 + q * 512 + c0)), tg);
            const f32x4 y0 = (f32x4){ta[0] + tb[0], ta[1] + tb[1], ta[2] + tb[2], ta[3] + tb[3]}, y1 = (f32x4){ta[4] + tb[4], ta[5] + tb[5], ta[6] + tb[6], ta[7] + tb[7]};
            const f32x4 g0 = (f32x4){tg[0], tg[1], tg[2], tg[3]}, g1 = (f32x4){tg[4], tg[5], tg[6], tg[7]};
            float ss = sum8((y0[0] * y0[0] + y0[1] * y0[1]) + (y0[2] * y0[2] + y0[3] * y0[3]) + (y1[0] * y1[0] + y1[1] * y1[1]) + (y1[2] * y1[2] + y1[3] * y1[3]));
            ss += dpp_f<0x140>(ss);
            const float rstd = rsqrtf(ss * (1.0f / 128.0f) + 1e-6f);
            float r[8];
#pragma unroll
            for (int j = 0; j < 4; ++j) { r[j] = y0[j] * rstd * n0[j] * siluf_(g0[j]); r[4 + j] = y1[j] * rstd * n1[j] * siluf_(g1[j]); }
            *(u32x4*)(p.MG + o) = (u32x4){pack2(r[0], r[1]), pack2(r[2], r[3]), pack2(r[4], r[5]), pack2(r[6], r[7])};
        }
    }
}

#define N_PHASES 20
__device__ __forceinline__ void run_phase(const Params& p, int ph, int bid, int nblk, char* smem) {
    const float* mod0 = p.mod;
    const float* mod1 = p.mod + 9 * 6144;
    switch (ph) {
    case 0: phase0a(p, bid, nblk, smem); break;
    case 1: phase0b(p, bid, nblk); break;
    case 2: phase_norm(p, bid, nblk, p.x, p.ctx, p.norm1_g, mod0, 0, NT); break;
    case 3: phase_gemm8_store_bf(p, p.H, NT, p.wt_evin, EVC, (bf16_t*)p.P, bid, nblk, smem); break;
    case 4: phase_feat0(p, bid, nblk, smem); break;
    case 5: phase_lora(p, bid, nblk, smem); break;
    case 6: phase_scan_attn(p, bid, nblk, smem); break;
    case 7: phase_rw_readout(p, bid, nblk); break;
    case 8: phase_outproj8<false>(p, bid, nblk, smem, p.wt_evout, NT, p.x, p.ctx, p.X1, mod0 + 2048); break;
    case 9: phase_router(p, bid, nblk, smem, 0, p.X1, NT); break;
    case 10: phase_moe_gu8(p, bid, nblk, smem, 0); break;
    case 11: phase_moe_dn8(p, bid, nblk, smem, 0); break;
    case 12: phase_combine<true>(p, bid, nblk, p.X1, p.X2, mod0 + 5120, NT, true, p.norm1_g + DM, mod1); break;
    case 13: phase_gemm8_store_hg(p, bid, nblk, smem); break;
    case 14: phase_hgrn(p, bid, nblk, smem); break;
    case 15: phase_hgrn_readout(p, bid, nblk); break;
    case 16: phase_outproj8<true>(p, bid, nblk, smem, p.wt_odout, NX, p.X2, p.X2 + (size_t)NX * DM, p.X1, mod1 + 2048); break;
    case 17: phase_router(p, bid, nblk, smem, 1, p.X1, NX); break;
    case 18: phase_moe_gu8(p, bid, nblk, smem, 1); break;
    case 19: phase_moe_dn8(p, bid, nblk, smem, 1); break;
    default: break;
    }
}
__device__ __forceinline__ void final_phase(const Params& p, int bid, int nblk) {
    phase_combine<false>(p, bid, nblk, p.X1, p.out, p.mod + 9 * 6144 + 5120, NX, false, nullptr, nullptr);
}

struct KArgs { const float* in[35]; float* out; char* ws; };

__host__ __device__ __forceinline__ size_t make_params(Params& p, const KArgs& a) {
    const float** ins = (const float**)&p;
    for (int i = 0; i < 35; ++i) ins[i] = a.in[i];
    p.out = a.out;
    char* ws = a.ws;
    size_t off = 0;
#define TAKE(bytes) (ws + off); off += (((size_t)(bytes)) + 255) & ~(size_t)255
    p.bar = (unsigned*)TAKE(16384);
    p.counts = (int*)TAKE(1024);
    p.scal = (float*)TAKE(256);
    p.mod = (float*)TAKE((size_t)2 * 9 * 6144 * 4);
    p.mod_part = (float*)TAKE((size_t)16 * 2 * 9 * 6144 * 4);
    p.rope_cos = (float*)TAKE((size_t)65536 * 4);
    p.rope_sin = (float*)TAKE((size_t)65536 * 4);
    p.wt_evin = (bf16_t*)TAKE((size_t)EVC * 1024 * 2);
    p.wt_evout = (bf16_t*)TAKE((size_t)1024 * 1024 * 2);
    p.wt_odin = (bf16_t*)TAKE((size_t)ODC * 1024 * 2);
    p.wt_odout = (bf16_t*)TAKE((size_t)1024 * 1024 * 2);
    p.wt_w2 = (bf16_t*)TAKE((size_t)1024 * 64 * 2);
    p.wt_a2 = (bf16_t*)TAKE((size_t)1024 * 64 * 2);
    p.wt_g2 = (bf16_t*)TAKE((size_t)512 * 128 * 2);
    p.wt_gu = (bf16_t*)TAKE((size_t)64 * 2048 * 1024 * 2);
    p.wt_dn = (bf16_t*)TAKE((size_t)64 * 1024 * 1024 * 2);
    p.lists = (int*)TAKE((size_t)2 * NEXP * NT * 4);
    p.GATE = (float*)TAKE((size_t)NASG * 4);
    p.H = (bf16_t*)TAKE((size_t)NT * DM * 2);
    p.MG = (bf16_t*)TAKE((size_t)NT * DM * 2);
    p.X1 = (bf16_t*)TAKE((size_t)NT * DM * 2);
    p.X2 = (bf16_t*)TAKE((size_t)NT * DM * 2);
    const size_t scratch0 = off;
    p.P = (float*)TAKE((size_t)NT * ODC * 4);
    const size_t after_p = off;
    p.Q = (bf16_t*)TAKE((size_t)8 * 8 * SEQ * 64 * 2);
    p.Qc = (bf16_t*)TAKE((size_t)8 * 8 * CTXL * 64 * 2);
    p.Kd = (bf16_t*)TAKE((size_t)8 * 8 * NKEY * 64 * 2);
    p.Vd = (bf16_t*)TAKE((size_t)8 * 4 * NKEY * 128 * 2);
    p.rR = (bf16_t*)TAKE((size_t)NT * 512 * 2);
    p.rK = (bf16_t*)TAKE((size_t)NT * 512 * 2);
    p.rV = (bf16_t*)TAKE((size_t)NT * 512 * 2);
    p.rKK = (bf16_t*)TAKE((size_t)NT * 512 * 2);
    p.rG = (bf16_t*)TAKE((size_t)NT * 512 * 2);
    p.rW = (bf16_t*)TAKE((size_t)2 * NT * 512 * 2);
    p.rKD = (bf16_t*)TAKE((size_t)2 * NT * 512 * 2);
    p.rBV = (bf16_t*)TAKE((size_t)2 * NT * 512 * 2);
    p.rY = (bf16_t*)TAKE((size_t)2 * NT * 512 * 2);
    p.rTW = (bf16_t*)TAKE((size_t)NT * 64 * 2);
    p.rAD = (bf16_t*)TAKE((size_t)NT * 64 * 2);
    p.rSG = (bf16_t*)TAKE((size_t)NT * 128 * 2);
    const size_t end_l0 = off;
    off = after_p;
    p.HO = (float*)TAKE((size_t)2 * NX * 1024 * 4);
    const size_t end_l1 = off;
    off = scratch0;
    p.ACT = (bf16_t*)TAKE((size_t)NASG * 1024 * 2);
    p.YS = (bf16_t*)TAKE((size_t)NASG * 1024 * 2);
    const size_t end_moe = off;
#undef TAKE
    size_t total = end_l0 > end_l1 ? end_l0 : end_l1;
    if (end_moe > total) total = end_moe;
    return total;
}

#if MULTI_LAUNCH
template <int PH>
__global__ void __launch_bounds__(256, 2) k_phase(KArgs a) {
    Params p; make_params(p, a);
    __shared__ __attribute__((aligned(16))) char smem[SMEM_BYTES];
    if (PH < N_PHASES) run_phase(p, PH, blockIdx.x, gridDim.x, smem);
    else final_phase(p, blockIdx.x, gridDim.x);
}
template <int PH> static void launch_all(const KArgs& p, hipStream_t stream) {
    hipLaunchKernelGGL(k_phase<PH>, dim3(1024), dim3(256), 0, stream, p);
    if constexpr (PH < N_PHASES) launch_all<PH + 1>(p, stream);
}
#else
__global__ void __launch_bounds__(NTHR, 2) k_mega(KArgs a) {
    Params p; make_params(p, a);
    extern __shared__ __attribute__((aligned(16))) char smem[];
    cg::grid_group grid = cg::this_grid();
    const int bid = blockIdx.x, nblk = gridDim.x;
    volatile LAS unsigned* st = (volatile LAS unsigned*)(smem + SMEM_BYTES);
    if (tidx() == 0) { st[0] = 0u; st[1] = 0u; }
    __syncthreads();
    const XcdBarrier xb = xcd_barrier_post(p.bar, st);
    run_phase(p, 0, bid, nblk, smem);
    if (a.ws == nullptr) grid.sync();
    xcd_barrier(xb);
    if (EXTRA == 4) { run_phase(p, 0, bid, nblk, smem); xcd_barrier(xb); }
#ifndef REPMASK
#define REPMASK 0u
#endif
#define PH(n) run_phase(p, n, bid, nblk, smem); xcd_barrier(xb); if ((REPMASK >> n) & 1u) { run_phase(p, n, bid, nblk, smem); xcd_barrier(xb); } \
    if (EXTRA == 6 && n == 6) { if (bid == 0 && tidx() == 0) p.counts[64] = 0; xcd_barrier(xb); run_phase(p, 6, bid, nblk, smem); xcd_barrier(xb); } \
    if (EXTRA == 5 && n == 9) { phase_router(p, bid, nblk, smem, 0, p.X1, NT, true); xcd_barrier(xb); } if (EXTRA == 5 && n == 17) { phase_router(p, bid, nblk, smem, 1, p.X1, NX, true); xcd_barrier(xb); }
    PH(1) PH(2) PH(3) PH(4) PH(5) PH(6) PH(7) PH(8) PH(9) PH(10) PH(11) PH(12) PH(13) PH(14) PH(15) PH(16) PH(17) PH(18) PH(19)
#undef PH
    final_phase(p, bid, nblk);
}
#endif


extern "C" void kernel_launch(void* const* d_in, const int* in_sizes, int n_in, void* d_out, int out_size, void* d_ws, size_t ws_size, hipStream_t stream) {
    KArgs a{};
    for (int i = 0; i < 35; ++i) a.in[i] = (const float*)d_in[i];
    a.out = (float*)d_out;
    a.ws = (char*)d_ws;
    Params p{};
    const size_t total = make_params(p, a);
    if (total > ws_size) { fprintf(stderr, "workspace too small: need %zu have %zu\n", total, ws_size); return; }

#if MULTI_LAUNCH
    launch_all<0>(a, stream);
#else
    static int grid_blocks = 0;
    if (!grid_blocks) {
        int dev = 0, cus = 0, per_cu = 0;
        hipGetDevice(&dev);
        hipDeviceGetAttribute(&cus, hipDeviceAttributeMultiprocessorCount, dev);
        hipFuncSetAttribute((const void*)k_mega, hipFuncAttributeMaxDynamicSharedMemorySize, SMEM_BYTES + 16);
        hipOccupancyMaxActiveBlocksPerMultiprocessor(&per_cu, k_mega, NTHR, SMEM_BYTES + 16);
        if (per_cu > 1) per_cu = 1;
        if (per_cu < 1) per_cu = 1;
        grid_blocks = cus * per_cu;
    }
    hipMemsetAsync(p.bar, 0, XCD_BAR_WORDS * 4, stream);
    void* args[] = {(void*)&a};
    hipError_t e = hipLaunchCooperativeKernel((void*)k_mega, dim3(grid_blocks), dim3(NTHR), args, SMEM_BYTES + 16, stream);
    if (e != hipSuccess) fprintf(stderr, "cooperative launch failed: %s (grid %d)\n", hipGetErrorString(e), grid_blocks);
#endif
}
```
